# Optimizing an MI355X kernel written in HIP

```python
import math
import functools
import jax
import jax.numpy as jnp
from jax import lax
import numpy as np

D_MODEL = 1024
BATCH = 2
SEQ = 8192
DEPTH = 2

EPS = 1e-6
D_FF = 4 * D_MODEL
N_EVEN = (DEPTH + 1) // 2
N_ODD = DEPTH // 2
CHUNK = 128
BLOCK_Q = 128

REL_BUCKETS = 32
REL_MAX_DIST = 128
N_BIAS_HEADS = 8

SSD_D_INNER = D_MODEL
SSD_HEAD_DIM = 64
SSD_HEADS = SSD_D_INNER // SSD_HEAD_DIM
SSD_GROUPS = 4
SSD_STATE = 128
SSD_CONV = 4
SSD_CONV_CH = SSD_D_INNER + 2 * SSD_GROUPS * SSD_STATE

DIFF_HEADS = N_BIAS_HEADS
DIFF_HEAD_DIM = D_MODEL // (2 * DIFF_HEADS)
DIFF_QK = DIFF_HEADS * 2 * DIFF_HEAD_DIM
DIFF_V = DIFF_HEADS * 2 * DIFF_HEAD_DIM

EVEN_SPLITS = (SSD_D_INNER, SSD_CONV_CH, SSD_HEADS, DIFF_QK, DIFF_QK, DIFF_V)
EVEN_IN = sum(EVEN_SPLITS)
EVEN_MIX = SSD_D_INNER + DIFF_V

RET_HEADS = 4
RET_QK_DIM = 128
RET_V_DIM = 256
ROPE_BASE = 10000.0

SWA_HEADS = N_BIAS_HEADS
SWA_KV_HEADS = 2
SWA_HEAD_DIM = 64
WINDOW = 128

ODD_SPLITS = (RET_HEADS * RET_QK_DIM, RET_HEADS * RET_QK_DIM, RET_HEADS * RET_V_DIM,
              RET_HEADS * RET_V_DIM, SWA_HEADS * SWA_HEAD_DIM,
              SWA_KV_HEADS * SWA_HEAD_DIM, SWA_KV_HEADS * SWA_HEAD_DIM)
ODD_IN = sum(ODD_SPLITS)
ODD_MIX = RET_HEADS * RET_V_DIM + SWA_HEADS * SWA_HEAD_DIM

kernel_name = "hybrid_ssd_diffattn_retention_swa_trunk"


def rms_norm(x, w=None):
    x32 = x.astype(jnp.float32)
    y = x32 * lax.rsqrt(jnp.mean(x32 * x32, axis=-1, keepdims=True) + EPS)
    if w is not None:
        y = y * w.astype(jnp.float32)
    return y.astype(x.dtype)


def split_cols(a, sizes):
    return jnp.split(a, np.cumsum(sizes)[:-1].tolist(), axis=-1)


def t5_bucket(dist):
    dist = jnp.maximum(dist, 0)
    max_exact = REL_BUCKETS // 2
    logd = jnp.log(jnp.maximum(dist, 1).astype(jnp.float32) / max_exact)
    large = max_exact + (logd / math.log(REL_MAX_DIST / max_exact)
                         * (REL_BUCKETS - max_exact)).astype(jnp.int32)
    large = jnp.minimum(large, REL_BUCKETS - 1)
    return jnp.where(dist < max_exact, dist, large)


def scan_chunk_states(chunk_states, chunk_decay):
    def step(carry, inp):
        st, dec = inp
        return carry * dec + st, carry
    init = jnp.zeros_like(chunk_states[:, 0])
    _, prev = lax.scan(step, init, (jnp.moveaxis(chunk_states, 1, 0), jnp.moveaxis(chunk_decay, 1, 0)))
    return jnp.moveaxis(prev, 0, 1)


def causal_depthwise_conv(x, w, b):
    ch = x.shape[-1]
    out = lax.conv_general_dilated(x, w[:, None, :].astype(x.dtype), window_strides=(1,),
                                   padding=[(SSD_CONV - 1, 0)],
                                   dimension_numbers=("NWC", "WIO", "NWC"),
                                   feature_group_count=ch)
    return out + b.astype(x.dtype)


def ssd_chunked(xh, dt, A, Bg, Cg):
    b, s, h, p = xh.shape
    g, n = Bg.shape[-2:]
    r = h // g
    nc = s // CHUNK
    X = (xh * dt[..., None]).reshape(b, nc, CHUNK, g, r, p)
    Bc = Bg.reshape(b, nc, CHUNK, g, n)
    Cc = Cg.reshape(b, nc, CHUNK, g, n)
    a_cs = jnp.cumsum((dt * A).reshape(b, nc, CHUNK, g, r), axis=2)
    causal = jnp.tril(jnp.ones((CHUNK, CHUNK), dtype=bool))
    seg = a_cs[:, :, :, None] - a_cs[:, :, None, :]
    decay_in = jnp.exp(jnp.where(causal[:, :, None, None], seg, -jnp.inf))
    cb = jnp.einsum("bclgn,bcsgn->bclsg", Cc, Bc)
    y_diag = jnp.einsum("bclsg,bclsgr,bcsgrp->bclgrp", cb, decay_in, X)
    decay_to_end = jnp.exp(a_cs[:, :, -1:] - a_cs)
    chunk_states = jnp.einsum("bcsgn,bcsgr,bcsgrp->bcgrpn", Bc, decay_to_end, X)
    state_prev = scan_chunk_states(chunk_states, jnp.exp(a_cs[:, :, -1])[..., None, None])
    y_off = jnp.einsum("bclgn,bcgrpn,bclgr->bclgrp", Cc, state_prev, jnp.exp(a_cs))
    return (y_diag + y_off).reshape(b, s, h, p)


def ssd_mixer(z, xbc, dt_raw, conv_w, conv_b, dt_bias, A_log, D_skip, norm_w):
    b, s, _ = z.shape
    xbc = jax.nn.silu(causal_depthwise_conv(xbc, conv_w, conv_b))
    xs, Bs, Cs = split_cols(xbc, (SSD_D_INNER, SSD_GROUPS * SSD_STATE, SSD_GROUPS * SSD_STATE))
    xh = xs.astype(jnp.float32).reshape(b, s, SSD_HEADS, SSD_HEAD_DIM)
    dt = jax.nn.softplus(dt_raw.astype(jnp.float32) + dt_bias.astype(jnp.float32))
    A = -jnp.exp(A_log.astype(jnp.float32))
    y = ssd_chunked(xh, dt, A,
                    Bs.astype(jnp.float32).reshape(b, s, SSD_GROUPS, SSD_STATE),
                    Cs.astype(jnp.float32).reshape(b, s, SSD_GROUPS, SSD_STATE))
    y = y + xh * D_skip.astype(jnp.float32)[:, None]
    y = y.reshape(b, s, SSD_D_INNER) * jax.nn.silu(z.astype(jnp.float32))
    return rms_norm(y, norm_w).astype(z.dtype)


def diff_attention(q, k, v, lam, subln_w, rel_bias, layer_idx):
    b, s = q.shape[:2]
    lam_init = 0.8 - 0.6 * math.exp(-0.3 * layer_idx)
    lam32 = lam.astype(jnp.float32)
    lam_full = (jnp.exp(jnp.sum(lam32[0] * lam32[1])) - jnp.exp(jnp.sum(lam32[2] * lam32[3])) + lam_init)
    q32 = q.astype(jnp.float32) * DIFF_HEAD_DIM ** -0.5
    k32 = k.astype(jnp.float32)
    v32 = v.astype(jnp.float32)
    nb = s // BLOCK_Q
    q_blocks = jnp.moveaxis(q32.reshape(b, nb, BLOCK_Q, DIFF_HEADS, 2, DIFF_HEAD_DIM), 1, 0)
    key_pos = jnp.arange(s)

    def one_block(args):
        q_blk, blk = args
        dist = (blk * BLOCK_Q + jnp.arange(BLOCK_Q))[:, None] - key_pos[None, :]
        bias = jnp.transpose(rel_bias[t5_bucket(dist)], (2, 0, 1)).astype(jnp.float32)
        logits = jnp.einsum("bqhmd,bkhmd->bhmqk", q_blk, k32) + bias[None, :, None]
        logits = jnp.where(dist >= 0, logits, -jnp.inf)
        p = jax.nn.softmax(logits, axis=-1)
        attn = p[:, :, 0] - lam_full * p[:, :, 1]
        return jnp.einsum("bhqk,bkhe->bqhe", attn, v32)

    out = lax.map(one_block, (q_blocks, jnp.arange(nb)))
    out = jnp.moveaxis(out, 0, 1).reshape(b, s, DIFF_HEADS, 2 * DIFF_HEAD_DIM)
    out = rms_norm(out, subln_w) * (1.0 - lam_init)
    return out.reshape(b, s, DIFF_V).astype(q.dtype)


def rope(t, pos):
    half = t.shape[-1] // 2
    inv = ROPE_BASE ** (-jnp.arange(half, dtype=jnp.float32) / half)
    ang = pos[:, None] * inv[None]
    cos = jnp.cos(ang)[None, :, None]
    sin = jnp.sin(ang)[None, :, None]
    t1, t2 = t[..., :half], t[..., half:]
    return jnp.concatenate([t1 * cos - t2 * sin, t1 * sin + t2 * cos], axis=-1)


def retention(q, k, v):
    b, s = q.shape[:2]
    nc = s // CHUNK
    pos = jnp.arange(s, dtype=jnp.float32)
    Q = rope(q.astype(jnp.float32), pos).reshape(b, nc, CHUNK, RET_HEADS, RET_QK_DIM)
    K = (rope(k.astype(jnp.float32), pos) * RET_QK_DIM ** -0.5).reshape(b, nc, CHUNK, RET_HEADS, RET_QK_DIM)
    V = v.astype(jnp.float32).reshape(b, nc, CHUNK, RET_HEADS, RET_V_DIM)
    log_gamma = jnp.log(1.0 - 2.0 ** (-5.0 - jnp.arange(RET_HEADS, dtype=jnp.float32)))
    idx = jnp.arange(CHUNK, dtype=jnp.float32)
    rel = idx[:, None] - idx[None, :]
    decay_mat = jnp.where(rel >= 0, jnp.exp(jnp.maximum(rel, 0.0)[None] * log_gamma[:, None, None]), 0.0)
    scores = jnp.einsum("bclhd,bcshd->bchls", Q, K) * decay_mat
    inner = jnp.einsum("bchls,bcshe->bclhe", scores, V)
    zeta = jnp.exp((CHUNK - 1 - idx)[None] * log_gamma[:, None])
    kv = jnp.einsum("bcshd,hs,bcshe->bchde", K, zeta, V)
    chunk_decay = jnp.broadcast_to(jnp.exp(CHUNK * log_gamma)[:, None, None], (b, nc, RET_HEADS, 1, 1))
    state_prev = scan_chunk_states(kv, chunk_decay)
    xi = jnp.exp((idx + 1.0)[None] * log_gamma[:, None])
    cross = jnp.einsum("bclhd,bchde,hl->bclhe", Q, state_prev, xi)
    out = (inner + cross).reshape(b, s, RET_HEADS, RET_V_DIM)
    return rms_norm(out).reshape(b, s, RET_HEADS * RET_V_DIM)


def sliding_window_attention(q, k, v, sinks, rel_bias):
    b, s = q.shape[:2]
    rep = SWA_HEADS // SWA_KV_HEADS
    nb = s // BLOCK_Q
    q32 = q.astype(jnp.float32).reshape(b, nb, BLOCK_Q, SWA_KV_HEADS, rep, SWA_HEAD_DIM) * SWA_HEAD_DIM ** -0.5

    def band(t):
        t = jnp.pad(t.astype(jnp.float32), ((0, 0), (BLOCK_Q, 0), (0, 0), (0, 0)))
        t = t.reshape(b, nb + 1, BLOCK_Q, SWA_KV_HEADS, SWA_HEAD_DIM)
        return jnp.concatenate([t[:, :-1], t[:, 1:]], axis=2)

    kb, vb = band(k), band(v)
    q_off = jnp.arange(BLOCK_Q)
    k_off = jnp.arange(2 * BLOCK_Q) - BLOCK_Q
    dist = q_off[:, None] - k_off[None, :]
    k_pos = (jnp.arange(nb) * BLOCK_Q)[:, None] + k_off[None, :]
    valid = ((dist >= 0) & (dist < WINDOW))[None] & (k_pos >= 0)[:, None, :]
    bias = jnp.transpose(rel_bias[t5_bucket(dist)], (2, 0, 1)).astype(jnp.float32)
    bias = bias.reshape(SWA_KV_HEADS, rep, BLOCK_Q, 2 * BLOCK_Q)
    logits = jnp.einsum("bnqgrd,bnkgd->bngrqk", q32, kb) + bias
    logits = jnp.where(valid[None, :, None, None], logits, -jnp.inf)
    sink = jnp.broadcast_to(sinks.astype(jnp.float32).reshape(1, 1, SWA_KV_HEADS, rep, 1, 1),
                            logits.shape[:-1] + (1,))
    p = jax.nn.softmax(jnp.concatenate([logits, sink], axis=-1), axis=-1)[..., :-1]
    out = jnp.einsum("bngrqk,bnkgd->bnqgrd", p, vb)
    return out.reshape(b, s, SWA_HEADS * SWA_HEAD_DIM).astype(q.dtype)


def even_mixer(h, w_in, conv_w, conv_b, dt_bias, A_log, D_skip, ssd_norm, lam, diff_norm, w_out,
               rel_bias, layer_idx):
    b, s, _ = h.shape
    z, xbc, dt_raw, q, k, v = split_cols(h @ w_in, EVEN_SPLITS)
    y_ssd = ssd_mixer(z, xbc, dt_raw, conv_w, conv_b, dt_bias, A_log, D_skip, ssd_norm)
    y_diff = diff_attention(q.reshape(b, s, DIFF_HEADS, 2, DIFF_HEAD_DIM),
                            k.reshape(b, s, DIFF_HEADS, 2, DIFF_HEAD_DIM),
                            v.reshape(b, s, DIFF_HEADS, 2 * DIFF_HEAD_DIM),
                            lam, diff_norm, rel_bias, layer_idx)
    return jnp.concatenate([y_ssd, y_diff], axis=-1) @ w_out


def odd_mixer(h, w_in, sinks, w_out, rel_bias):
    b, s, _ = h.shape
    rq, rk, rv, rg, sq, sk, sv = split_cols(h @ w_in, ODD_SPLITS)
    y_ret = retention(rq.reshape(b, s, RET_HEADS, RET_QK_DIM),
                      rk.reshape(b, s, RET_HEADS, RET_QK_DIM),
                      rv.reshape(b, s, RET_HEADS, RET_V_DIM))
    y_ret = (y_ret * jax.nn.silu(rg.astype(jnp.float32))).astype(h.dtype)
    y_swa = sliding_window_attention(sq.reshape(b, s, SWA_HEADS, SWA_HEAD_DIM),
                                     sk.reshape(b, s, SWA_KV_HEADS, SWA_HEAD_DIM),
                                     sv.reshape(b, s, SWA_KV_HEADS, SWA_HEAD_DIM),
                                     sinks, rel_bias)
    return jnp.concatenate([y_ret, y_swa], axis=-1) @ w_out


def squared_relu_mlp(h, w1, w2):
    return jnp.square(jax.nn.relu(h @ w1)) @ w2


def sandwich(x, c_act, sublayer, g_pre, g_post, w_mod, b_mod):
    shift, scale, gate = jnp.split(c_act @ w_mod + b_mod, 3, axis=-1)
    h = rms_norm(x, g_pre) * (1 + scale[:, None]) + shift[:, None]
    return x + gate[:, None] * rms_norm(sublayer(h), g_post)


def setup_inputs(seed: int = 0) -> dict:
    key = jax.random.key(seed)
    ks = jax.random.split(key, 24)

    def nrm(k, shape, scale):
        return jax.random.normal(k, shape, jnp.float32) * scale

    dt0 = jnp.exp(jax.random.uniform(ks[11], (N_EVEN, SSD_HEADS), jnp.float32,
                                     minval=math.log(1e-3), maxval=math.log(1e-1)))
    return {
        "x": nrm(ks[0], (BATCH, SEQ, D_MODEL), 1.0),
        "c": nrm(ks[1], (BATCH, D_MODEL), 1.0),
        "rel_bias": nrm(ks[2], (REL_BUCKETS, N_BIAS_HEADS), 0.5),
        "norm_gains": 1.0 + nrm(ks[3], (DEPTH, 4, D_MODEL), 0.05),
        "mod_w": nrm(ks[4], (DEPTH, 2, D_MODEL, 3 * D_MODEL), D_MODEL ** -0.5),
        "mod_b": nrm(ks[5], (DEPTH, 2, 3 * D_MODEL), 0.02),
        "mlp_w1": nrm(ks[6], (DEPTH, D_MODEL, D_FF), D_MODEL ** -0.5),
        "mlp_w2": nrm(ks[7], (DEPTH, D_FF, D_MODEL), D_FF ** -0.5),
        "e_w_in": nrm(ks[8], (N_EVEN, D_MODEL, EVEN_IN), D_MODEL ** -0.5),
        "e_conv_w": nrm(ks[9], (N_EVEN, SSD_CONV, SSD_CONV_CH), SSD_CONV ** -0.5),
        "e_conv_b": nrm(ks[10], (N_EVEN, SSD_CONV_CH), 0.02),
        "e_dt_bias": dt0 + jnp.log(-jnp.expm1(-dt0)),
        "e_A_log": jnp.log(jax.random.uniform(ks[12], (N_EVEN, SSD_HEADS), jnp.float32, minval=1.0, maxval=16.0)),
        "e_D": 1.0 + nrm(ks[13], (N_EVEN, SSD_HEADS), 0.05),
        "e_ssd_norm": 1.0 + nrm(ks[14], (N_EVEN, SSD_D_INNER), 0.05),
        "e_lambda": nrm(ks[15], (N_EVEN, 4, DIFF_HEAD_DIM), 0.1),
        "e_diff_norm": 1.0 + nrm(ks[16], (N_EVEN, 2 * DIFF_HEAD_DIM), 0.05),
        "e_w_out": nrm(ks[17], (N_EVEN, EVEN_MIX, D_MODEL), EVEN_MIX ** -0.5),
        "o_w_in": nrm(ks[18], (N_ODD, D_MODEL, ODD_IN), D_MODEL ** -0.5),
        "o_sinks": nrm(ks[19], (N_ODD, SWA_HEADS), 0.5),
        "o_w_out": nrm(ks[20], (N_ODD, ODD_MIX, D_MODEL), ODD_MIX ** -0.5),
    }


def reference(x, c, rel_bias, norm_gains, mod_w, mod_b, mlp_w1, mlp_w2, e_w_in, e_conv_w, e_conv_b,
              e_dt_bias, e_A_log, e_D, e_ssd_norm, e_lambda, e_diff_norm, e_w_out, o_w_in, o_sinks,
              o_w_out):
    c_act = jax.nn.silu(c)
    for layer in range(DEPTH):
        j = layer // 2
        if layer % 2 == 0:
            mixer = functools.partial(even_mixer, w_in=e_w_in[j], conv_w=e_conv_w[j], conv_b=e_conv_b[j],
                                      dt_bias=e_dt_bias[j], A_log=e_A_log[j], D_skip=e_D[j],
                                      ssd_norm=e_ssd_norm[j], lam=e_lambda[j], diff_norm=e_diff_norm[j],
                                      w_out=e_w_out[j], rel_bias=rel_bias, layer_idx=layer)
        else:
            mixer = functools.partial(odd_mixer, w_in=o_w_in[j], sinks=o_sinks[j], w_out=o_w_out[j],
                                      rel_bias=rel_bias)
        x = sandwich(x, c_act, mixer, norm_gains[layer, 0], norm_gains[layer, 1],
                     mod_w[layer, 0], mod_b[layer, 0])
        mlp = functools.partial(squared_relu_mlp, w1=mlp_w1[layer], w2=mlp_w2[layer])
        x = sandwich(x, c_act, mlp, norm_gains[layer, 2], norm_gains[layer, 3],
                     mod_w[layer, 1], mod_b[layer, 1])
    return x
```

```cpp
#include <hip/hip_runtime.h>
#include <cstdio>
#include <cstdint>
#include <cmath>
namespace pg8 {
#define PG8_LAS __attribute__((address_space(3)))
typedef unsigned short bf16_t;
typedef short bf16x8 __attribute__((ext_vector_type(8)));
typedef float f32x4 __attribute__((ext_vector_type(4)));
typedef unsigned u32x4 __attribute__((ext_vector_type(4)));
constexpr int BM = 256, BK = 64, HALF = 128, HTB = HALF * BK * 2  , STAGE_BYTES = 8 * HTB, NXCD = 8, WGM = 4;

__host__ __device__ __forceinline__ int lds_byte(int r, int c) { const int st = (r >> 4) * 2 + (c >> 5), rr = r & 15, cc = c & 31, ob = rr * 64 + cc * 2; return st * 1024 + (ob ^ (((ob >> 9) & 1) << 5)); }
__host__ __device__ __forceinline__ void stage_rc(int b, int& R, int& C) { const int st = b / 1024, sb = b % 1024, swz = sb ^ (((sb >> 9) & 1) << 5); R = (st >> 1) * 16 + swz / 64; C = (st & 1) * 32 + (swz % 64) / 2; }
__host__ __device__ __forceinline__ int perm32(int rho) { const int n = rho >> 4, i = rho & 15; return 8 * (i >> 2) + 4 * n + (i & 3); }

struct Unit { int pm, pn; };
struct Gemm { const bf16_t* A; const bf16_t* Bt; int M, N, K, lda; };

struct StaticOrder {
    int nM, nN, nwg, G, c;
    __host__ __device__ void init(int M, int N, int G_, int c_) { nM = M / BM; nN = N / BM; nwg = nM * nN; G = G_; c = c_; }
    __host__ __device__ bool next(int i, Unit& u) const {
        const long L = (long)i * G + c; if (L >= nwg) return false;
        int wgid = (int)L; { const int q = nwg / NXCD, r = nwg % NXCD, xcd = wgid % NXCD, off = wgid / NXCD; wgid = (xcd < r ? xcd * (q + 1) : r * (q + 1) + (xcd - r) * q) + off; }
        const int nig = WGM * nN, gid = wgid / nig, fm = gid * WGM, gsz = (nM - fm) < WGM ? (nM - fm) : WGM;
        u.pm = fm + ((wgid % nig) % gsz); u.pn = (wgid % nig) / gsz; return true;
    }
    __device__ __forceinline__ void a_ready(const Unit&) const {}
    __device__ __forceinline__ void done(const Unit&) const {}
};

__device__ __forceinline__ unsigned cvt_pk_bf16(float lo, float hi) { unsigned r; asm volatile("v_cvt_pk_bf16_f32 %0, %1, %2" : "=v"(r) : "v"(lo), "v"(hi)); return r; }
typedef float f32x2 __attribute__((ext_vector_type(2)));
__device__ __forceinline__ f32x2 gelu_pk(f32x2 v) {
    const f32x2 av = __builtin_elementwise_abs(v), d = av * 0.2316418882f + 1.0f;
    f32x2 t; t.x = __builtin_amdgcn_rcpf(d.x); t.y = __builtin_amdgcn_rcpf(d.y);
    f32x2 q = t * 0.5307027145f + (-0.7265760135f); q = q * t + 0.7107068705f; q = q * t + (-0.142248368f); q = q * t + 0.127414796f; q = q * t;
    const f32x2 s = (v * v) * (-0.72134752044f);
    f32x2 e; e.x = __builtin_amdgcn_exp2f(s.x); e.y = __builtin_amdgcn_exp2f(s.y);
    const f32x2 m = v * (q * e), r = v - m;
    f32x2 o; o.x = v.x < 0.f ? m.x : r.x; o.y = v.y < 0.f ? m.y : r.y; return o;
}

template <int ACT  > struct EpiBf16 {
    static constexpr bool PERM = true, AFTER_DRAIN = false; static_assert(ACT == 0 || ACT == 1 || ACT == 2, "EpiBf16: ACT is 0 (none), 1 (gelu_pk) or 2 (squared relu)");
    bf16_t* O; int ldc; const float* bias; int split_cols; size_t split_stride; float scale0;
    __device__ __forceinline__ void operator()(const f32x4 (&acc)[2][2][4][2], const Unit& u, int wr, int wc, int fr, int fq) const {
        const int row0 = u.pm * BM + wr * 64 + fr; int colt = u.pn * BM; bf16_t* base = O;
        float sc = 1.f; if (split_cols) { const int t = colt / split_cols; base += (size_t)t * split_stride; colt -= t * split_cols; if (t == 0) sc = scale0; }
        const int col0 = colt + wc * 32 + 8 * fq, bcol0 = u.pn * BM + wc * 32 + 8 * fq;
        f32x4 bv[2][2];
#pragma unroll
        for (int bj = 0; bj < 2; ++bj)
#pragma unroll
            for (int n = 0; n < 2; ++n) bv[bj][n] = bias ? *(const f32x4*)(bias + bcol0 + bj * HALF + 4 * n) : (f32x4){0.f, 0.f, 0.f, 0.f};
#pragma unroll
        for (int ai = 0; ai < 2; ++ai)
#pragma unroll
            for (int m = 0; m < 4; ++m) { bf16_t* rowp = base + (size_t)(row0 + ai * HALF + m * 16) * ldc + col0;
#pragma unroll
                for (int bj = 0; bj < 2; ++bj) { f32x4 v0 = acc[ai][bj][m][0] + bv[bj][0], v1 = acc[ai][bj][m][1] + bv[bj][1];
                    if (ACT == 1) { f32x2 a = gelu_pk((f32x2){v0[0], v0[1]}), b = gelu_pk((f32x2){v0[2], v0[3]}), c = gelu_pk((f32x2){v1[0], v1[1]}), d = gelu_pk((f32x2){v1[2], v1[3]});
                        v0 = (f32x4){a.x, a.y, b.x, b.y}; v1 = (f32x4){c.x, c.y, d.x, d.y}; }
                    if (ACT == 2) { v0 = __builtin_elementwise_max(v0, (f32x4){0.f,0.f,0.f,0.f}); v1 = __builtin_elementwise_max(v1, (f32x4){0.f,0.f,0.f,0.f}); v0 = v0 * v0; v1 = v1 * v1; }
                    v0 = v0 * sc; v1 = v1 * sc; u32x4 w; w.x = cvt_pk_bf16(v0[0], v0[1]); w.y = cvt_pk_bf16(v0[2], v0[3]); w.z = cvt_pk_bf16(v1[0], v1[1]); w.w = cvt_pk_bf16(v1[2], v1[3]);
                    *(u32x4*)(rowp + bj * HALF) = w; } }
    }
};

struct RowExch {
    float* slots;
    unsigned* cnt;
    unsigned* tmo;
    __device__ __forceinline__ void publish(const float (&ss)[2][4], const Unit& u, int wr, int wc, int fr, int fq, PG8_LAS unsigned char* lds, int wid, int lane) const {
        PG8_LAS float* P = (PG8_LAS float*)lds;
#pragma unroll
        for (int ai = 0; ai < 2; ++ai)
#pragma unroll
            for (int m = 0; m < 4; ++m) { float s = ss[ai][m]; s += __shfl_xor(s, 16); s += __shfl_xor(s, 32); if (fq == 0) P[(ai * HALF + wr * 64 + m * 16 + fr) * 4 + wc] = s; }
        asm volatile("s_waitcnt lgkmcnt(0)" ::: "memory"); __builtin_amdgcn_s_barrier(); asm volatile("" ::: "memory");
        const int row = wid * 32 + (lane & 31);
        if (lane < 32) { const f32x4 p = *(const PG8_LAS f32x4*)(P + row * 4);
            __hip_atomic_store((unsigned*)slots + ((size_t)(u.pm * BM + row) * 4 + u.pn), __float_as_uint((p[0] + p[1]) + (p[2] + p[3])), __ATOMIC_RELAXED, __HIP_MEMORY_SCOPE_AGENT); }
        asm volatile("s_waitcnt vmcnt(0)" ::: "memory");
        if (lane == 0) __hip_atomic_fetch_add(cnt + 8 * u.pm, 1u, __ATOMIC_RELAXED, __HIP_MEMORY_SCOPE_AGENT);
    }
    __device__ __forceinline__ void collect(const Unit& u, int wr, int fr, PG8_LAS unsigned char* lds, int wid, int lane, float eps, float (&rinv)[2][4]) const {
        PG8_LAS float* S = (PG8_LAS float*)(lds + 4096);
        const int row = wid * 32 + (lane & 31);
        if (wid == 0) { unsigned sp = 0;
            while ((unsigned)__builtin_amdgcn_readfirstlane(__hip_atomic_load(cnt + 8 * u.pm, __ATOMIC_RELAXED, __HIP_MEMORY_SCOPE_AGENT)) < 32u) { __builtin_amdgcn_s_sleep(1);
                if ((++sp & 255u) == 0u) { if (__hip_atomic_load(tmo, __ATOMIC_RELAXED, __HIP_MEMORY_SCOPE_AGENT)) break; if (sp > (1u << 18)) { if (lane == 0) atomicAdd(tmo, 1u); break; } } } }
        asm volatile("s_waitcnt lgkmcnt(0)" ::: "memory"); __builtin_amdgcn_s_barrier(); asm volatile("" ::: "memory");
        if (lane < 32) { const unsigned* sl = (const unsigned*)slots + (size_t)(u.pm * BM + row) * 4; float t = 0.f;
#pragma unroll
            for (int j = 0; j < 4; ++j) t += __uint_as_float(__hip_atomic_load(sl + j, __ATOMIC_RELAXED, __HIP_MEMORY_SCOPE_AGENT));
            S[row] = 1.0f / sqrtf(t * (1.0f / 1024.0f) + eps); }
        asm volatile("s_waitcnt lgkmcnt(0)" ::: "memory"); __builtin_amdgcn_s_barrier(); asm volatile("" ::: "memory");
#pragma unroll
        for (int ai = 0; ai < 2; ++ai)
#pragma unroll
            for (int m = 0; m < 4; ++m) rinv[ai][m] = S[ai * HALF + wr * 64 + m * 16 + fr];
        asm volatile("s_waitcnt lgkmcnt(0)" ::: "memory"); __builtin_amdgcn_s_barrier(); asm volatile("" ::: "memory");
    }
};
template <int SPOST, int SPRE, bool XINB, int XOUT> struct EpiNorm {
    static constexpr bool PERM = true, AFTER_DRAIN = true;
    const void* xin; void* xout; bf16_t* XN; const float* MOD; const float* ng; RowExch e1, e2; float eps;
    __device__ __forceinline__ void operator()(const f32x4 (&)[2][2][4][2], const Unit&, int, int, int, int) const {}
    __device__ __forceinline__ void fused(f32x4 (&acc)[2][2][4][2], const Unit& u, int wr, int wc, int fr, int fq, PG8_LAS unsigned char* lds, int wid, int lane) const {
        const int b = u.pm >> 5;
        const int col0 = u.pn * BM + wc * 32 + 8 * fq;
        const size_t off0 = (size_t)(u.pm * BM + wr * 64 + fr) * 1024 + col0;
#define EN_OFF(ai, m, bj) (off0 + (size_t)((ai) * HALF + (m) * 16) * 1024 + (bj) * HALF)
#define EN_UNPK_LO(q_) ((f32x4){__uint_as_float((q_)[0] << 16), __uint_as_float((q_)[0] & 0xffff0000u), __uint_as_float((q_)[1] << 16), __uint_as_float((q_)[1] & 0xffff0000u)})
#define EN_UNPK_HI(q_) ((f32x4){__uint_as_float((q_)[2] << 16), __uint_as_float((q_)[2] & 0xffff0000u), __uint_as_float((q_)[3] << 16), __uint_as_float((q_)[3] & 0xffff0000u)})
        float ss[2][4], r1[2][4];
#pragma unroll
        for (int ai = 0; ai < 2; ++ai)
#pragma unroll
            for (int m = 0; m < 4; ++m) { float s = 0.f;
#pragma unroll
                for (int bj = 0; bj < 2; ++bj)
#pragma unroll
                    for (int n = 0; n < 2; ++n) { const f32x4 x = acc[ai][bj][m][n]; s += (x[0] * x[0] + x[1] * x[1]) + (x[2] * x[2] + x[3] * x[3]); }
                ss[ai][m] = s; }
        e1.publish(ss, u, wr, wc, fr, fq, lds, wid, lane);
        u32x4 xb[2][4][2]; f32x4 xf[4][2][2];
        if constexpr (XINB) {
#pragma unroll
            for (int ai = 0; ai < 2; ++ai)
#pragma unroll
                for (int m = 0; m < 4; ++m)
#pragma unroll
                    for (int bj = 0; bj < 2; ++bj) xb[ai][m][bj] = *(const u32x4*)((const bf16_t*)xin + EN_OFF(ai, m, bj));
        } else {
#pragma unroll
            for (int m = 0; m < 4; ++m)
#pragma unroll
                for (int bj = 0; bj < 2; ++bj) { xf[m][bj][0] = *(const f32x4*)((const float*)xin + EN_OFF(0, m, bj)); xf[m][bj][1] = *(const f32x4*)((const float*)xin + EN_OFF(0, m, bj) + 4); }
        }
        f32x4 gp[2][2];
#pragma unroll
        for (int bj = 0; bj < 2; ++bj)
#pragma unroll
            for (int n = 0; n < 2; ++n) gp[bj][n] = *(const f32x4*)(MOD + (SPOST * 2 + b) * 3072 + 2048 + col0 + bj * HALF + 4 * n) * *(const f32x4*)(ng + (SPOST * 2 + 1) * 1024 + col0 + bj * HALF + 4 * n);
        e1.collect(u, wr, fr, lds, wid, lane, eps, r1);
#pragma unroll
        for (int ai = 0; ai < 2; ++ai) {
            if constexpr (!XINB) { if (ai == 1) {
#pragma unroll
                for (int m = 0; m < 4; ++m)
#pragma unroll
                    for (int bj = 0; bj < 2; ++bj) { xf[m][bj][0] = *(const f32x4*)((const float*)xin + EN_OFF(1, m, bj)); xf[m][bj][1] = *(const f32x4*)((const float*)xin + EN_OFF(1, m, bj) + 4); } } }
#pragma unroll
            for (int m = 0; m < 4; ++m) { const float r = r1[ai][m];
#pragma unroll
                for (int bj = 0; bj < 2; ++bj) { f32x4 x0, x1;
                    if constexpr (XINB) { x0 = EN_UNPK_LO(xb[ai][m][bj]); x1 = EN_UNPK_HI(xb[ai][m][bj]); } else { x0 = xf[m][bj][0]; x1 = xf[m][bj][1]; }
                    f32x4 v0 = x0 + gp[bj][0] * (acc[ai][bj][m][0] * r), v1 = x1 + gp[bj][1] * (acc[ai][bj][m][1] * r);
                    if constexpr (XOUT == 2) { *(f32x4*)((float*)xout + EN_OFF(ai, m, bj)) = v0; *(f32x4*)((float*)xout + EN_OFF(ai, m, bj) + 4) = v1; }
                    if constexpr (XOUT == 1) { u32x4 w; w.x = cvt_pk_bf16(v0[0], v0[1]); w.y = cvt_pk_bf16(v0[2], v0[3]); w.z = cvt_pk_bf16(v1[0], v1[1]); w.w = cvt_pk_bf16(v1[2], v1[3]);
                        v0 = EN_UNPK_LO(w); v1 = EN_UNPK_HI(w); }
                    acc[ai][bj][m][0] = v0; acc[ai][bj][m][1] = v1; } }
        }
        if constexpr (SPRE >= 0) {
            float r2[2][4];
#pragma unroll
            for (int ai = 0; ai < 2; ++ai)
#pragma unroll
                for (int m = 0; m < 4; ++m) { float s = 0.f;
#pragma unroll
                    for (int bj = 0; bj < 2; ++bj)
#pragma unroll
                        for (int n = 0; n < 2; ++n) { const f32x4 x = acc[ai][bj][m][n]; s += (x[0] * x[0] + x[1] * x[1]) + (x[2] * x[2] + x[3] * x[3]); }
                    ss[ai][m] = s; }
            e2.publish(ss, u, wr, wc, fr, fq, lds, wid, lane);
            if constexpr (XOUT == 1) {
#pragma unroll
                for (int ai = 0; ai < 2; ++ai)
#pragma unroll
                    for (int m = 0; m < 4; ++m)
#pragma unroll
                        for (int bj = 0; bj < 2; ++bj) { const f32x4 v0 = acc[ai][bj][m][0], v1 = acc[ai][bj][m][1];
                            u32x4 w; w.x = cvt_pk_bf16(v0[0], v0[1]); w.y = cvt_pk_bf16(v0[2], v0[3]); w.z = cvt_pk_bf16(v1[0], v1[1]); w.w = cvt_pk_bf16(v1[2], v1[3]);
                            *(u32x4*)((bf16_t*)xout + EN_OFF(ai, m, bj)) = w; }
            }
            f32x4 qc[2][2], sh[2][2];
#pragma unroll
            for (int bj = 0; bj < 2; ++bj)
#pragma unroll
                for (int n = 0; n < 2; ++n) { const int c = col0 + bj * HALF + 4 * n;
                    qc[bj][n] = *(const f32x4*)(ng + (SPRE * 2) * 1024 + c) * (*(const f32x4*)(MOD + (SPRE * 2 + b) * 3072 + 1024 + c) + 1.0f); sh[bj][n] = *(const f32x4*)(MOD + (SPRE * 2 + b) * 3072 + c); }
            e2.collect(u, wr, fr, lds, wid, lane, eps, r2);
#pragma unroll
            for (int ai = 0; ai < 2; ++ai)
#pragma unroll
                for (int m = 0; m < 4; ++m) { const float r = r2[ai][m];
#pragma unroll
                    for (int bj = 0; bj < 2; ++bj) { const f32x4 o0 = (acc[ai][bj][m][0] * r) * qc[bj][0] + sh[bj][0], o1 = (acc[ai][bj][m][1] * r) * qc[bj][1] + sh[bj][1];
                        u32x4 w; w.x = cvt_pk_bf16(o0[0], o0[1]); w.y = cvt_pk_bf16(o0[2], o0[3]); w.z = cvt_pk_bf16(o1[0], o1[1]); w.w = cvt_pk_bf16(o1[2], o1[3]);
                        *(u32x4*)(XN + EN_OFF(ai, m, bj)) = w; } }
        } else if constexpr (XOUT == 1) {
#pragma unroll
            for (int ai = 0; ai < 2; ++ai)
#pragma unroll
                for (int m = 0; m < 4; ++m)
#pragma unroll
                    for (int bj = 0; bj < 2; ++bj) { const f32x4 v0 = acc[ai][bj][m][0], v1 = acc[ai][bj][m][1];
                        u32x4 w; w.x = cvt_pk_bf16(v0[0], v0[1]); w.y = cvt_pk_bf16(v0[2], v0[3]); w.z = cvt_pk_bf16(v1[0], v1[1]); w.w = cvt_pk_bf16(v1[2], v1[3]);
                        *(u32x4*)((bf16_t*)xout + EN_OFF(ai, m, bj)) = w; }
        }
#undef EN_OFF
#undef EN_UNPK_LO
#undef EN_UNPK_HI
    }
};
template <class Epi, class Sched, bool ALIGN_EPI = false, bool SP2 = false>
__device__ __forceinline__ void gemm_phase(PG8_LAS unsigned char* lds, const Gemm g, const Sched& S, const Epi& E) {
    const int tid = threadIdx.x, wid = __builtin_amdgcn_readfirstlane(tid >> 6), lane = tid & 63, wr = wid >> 2, wc = wid & 3, fr = lane & 15, fq = lane >> 4;
    const int K = g.K, nt = K / BK;
    unsigned voffA[2], voffB[2];
#pragma unroll
    for (int i = 0; i < 2; ++i) { int R, C; stage_rc(tid * 16 + i * 8192, R, C); const int Rb = Epi::PERM ? ((R & ~31) + perm32(R & 31)) : R;
        voffA[i] = (unsigned)(R * g.lda + C) * 2u; voffB[i] = (unsigned)(Rb * K + C) * 2u; }
    const size_t kstep = (size_t)(BK * 2);
    const size_t hstepA = (size_t)HALF * g.lda * 2, hstepB = (size_t)HALF * K * 2;
    const size_t tstepA = 2 * hstepA, tstepB = 2 * hstepB;
    const unsigned ldsw = (unsigned)wid * 1024u;
    const int aoff = lds_byte(wr * 64 + fr, fq * 8), boff = lds_byte(wc * 32 + fr, fq * 8);
#define PG8_SA(b, h) (((b) * 2 + (h)) * HTB)
#define PG8_SB(b, h) ((4 + (b) * 2 + (h)) * HTB)
#define PG8_STAGE(bufoff, gbase, voff) do { _Pragma("unroll") for (int _i = 0; _i < 2; ++_i) \
        __builtin_amdgcn_global_load_lds((const unsigned*)((const char*)(gbase) + (voff)[_i]), (PG8_LAS unsigned*)(lds + (bufoff) + ldsw + _i * 8192), 16, 0, 0); } while (0)
#define PG8_LDA(dst, b, h) do { _Pragma("unroll") for (int m = 0; m < 4; ++m) _Pragma("unroll") for (int k = 0; k < 2; ++k) dst[m][k] = *(const PG8_LAS bf16x8*)(lds + PG8_SA(b, h) + aoff + m * 2048 + k * 1024); } while (0)
#define PG8_LDB(dst, b, h) do { _Pragma("unroll") for (int n = 0; n < 2; ++n) _Pragma("unroll") for (int k = 0; k < 2; ++k) dst[n][k] = *(const PG8_LAS bf16x8*)(lds + PG8_SB(b, h) + boff + n * 2048 + k * 1024); } while (0)
#define PG8_MMA(ai, bj, At, Bt) do { __builtin_amdgcn_s_setprio(1); _Pragma("unroll") for (int m = 0; m < 4; ++m) _Pragma("unroll") for (int n = 0; n < 2; ++n) _Pragma("unroll") for (int k = 0; k < 2; ++k) \
        acc[ai][bj][m][n] = __builtin_amdgcn_mfma_f32_16x16x32_bf16(Bt[n][k], At[m][k], acc[ai][bj][m][n], 0, 0, 0); __builtin_amdgcn_s_setprio(0); } while (0)
#define PG8_WAIT_V(n) asm volatile("s_waitcnt vmcnt(" #n ")" ::: "memory")
#define PG8_WAIT_L(n) asm volatile("s_waitcnt lgkmcnt(" #n ")" ::: "memory")
#define PG8_BAR __builtin_amdgcn_s_barrier()
#define PG8_SCHED __builtin_amdgcn_sched_barrier(0)
    Unit cur, nxt; int ui = 0;
    if (!S.next(0, cur)) return;
    f32x4 acc[2][2][4][2];
#pragma unroll
    for (int a = 0; a < 2; ++a)
#pragma unroll
        for (int b = 0; b < 2; ++b)
#pragma unroll
            for (int m = 0; m < 4; ++m)
#pragma unroll
                for (int n = 0; n < 2; ++n) acc[a][b][m][n] = (f32x4){0.f, 0.f, 0.f, 0.f};
    bf16x8 At[4][2], B0[2][2], B1[2][2];
    const char* cA = (const char*)g.A + (size_t)cur.pm * tstepA; const char* cB = (const char*)g.Bt + (size_t)cur.pn * tstepB;
    S.a_ready(cur);
    if constexpr (SP2) {
        PG8_STAGE(PG8_SB(0, 0), cB, voffB); PG8_STAGE(PG8_SB(0, 1), cB + hstepB, voffB); PG8_STAGE(PG8_SA(0, 0), cA, voffA); PG8_STAGE(PG8_SA(0, 1), cA + hstepA, voffA);
        if (wr == 1) PG8_BAR;
        PG8_WAIT_V(2); PG8_BAR;
        PG8_STAGE(PG8_SB(1, 0), cB + kstep, voffB); PG8_STAGE(PG8_SA(1, 0), cA + kstep, voffA); PG8_STAGE(PG8_SB(1, 1), cB + hstepB + kstep, voffB);
        PG8_WAIT_V(6); PG8_BAR;
    } else {
        PG8_STAGE(PG8_SB(0, 0), cB, voffB); PG8_STAGE(PG8_SA(0, 0), cA, voffA); PG8_STAGE(PG8_SB(0, 1), cB + hstepB, voffB); PG8_STAGE(PG8_SA(0, 1), cA + hstepA, voffA);
        if (wr == 1) PG8_BAR;
        PG8_WAIT_V(4); PG8_BAR;
        PG8_STAGE(PG8_SB(1, 0), cB + kstep, voffB); PG8_STAGE(PG8_SA(1, 0), cA + kstep, voffA); PG8_STAGE(PG8_SB(1, 1), cB + hstepB + kstep, voffB);
        PG8_WAIT_V(6); PG8_BAR;
    }
    for (;;) {
        const bool has_next = S.next(ui + 1, nxt);
        const char* nA = has_next ? (const char*)g.A + (size_t)nxt.pm * tstepA : cA; const char* nB = has_next ? (const char*)g.Bt + (size_t)nxt.pn * tstepB : cB;
        for (int t = 0; t < nt; t += 2) {
            const bool last = (t == nt - 2);
            const char* a1 = cA + (size_t)(t + 1) * kstep;
            const char* a2 = last ? nA : cA + (size_t)(t + 2) * kstep; const char* b2 = last ? nB : cB + (size_t)(t + 2) * kstep;
            const char* a3 = a2 + kstep; const char* b3 = b2 + kstep;
            if (last && has_next) S.a_ready(nxt);
            if constexpr (SP2) {
            PG8_LDB(B0, 0, 0); PG8_LDB(B1, 0, 1); PG8_SCHED; PG8_LDA(At, 0, 0); PG8_STAGE(PG8_SA(1, 1), a1 + hstepA, voffA);
            PG8_WAIT_V(8); PG8_WAIT_L(0); PG8_BAR; PG8_MMA(0, 0, At, B0); PG8_MMA(0, 1, At, B1); PG8_BAR; PG8_SCHED;
            PG8_LDA(At, 0, 1); PG8_STAGE(PG8_SB(0, 0), b2, voffB); PG8_STAGE(PG8_SB(0, 1), b2 + hstepB, voffB); PG8_STAGE(PG8_SA(0, 0), a2, voffA);
            PG8_WAIT_V(8); PG8_WAIT_L(0); PG8_BAR; PG8_MMA(1, 0, At, B0); PG8_MMA(1, 1, At, B1); PG8_BAR; PG8_SCHED;
            PG8_LDB(B0, 1, 0); PG8_LDB(B1, 1, 1); PG8_SCHED; PG8_LDA(At, 1, 0); PG8_STAGE(PG8_SA(0, 1), a2 + hstepA, voffA);
            PG8_WAIT_V(8); PG8_WAIT_L(0); PG8_BAR; PG8_MMA(0, 0, At, B0); PG8_MMA(0, 1, At, B1); PG8_BAR; PG8_SCHED;
            PG8_LDA(At, 1, 1); PG8_STAGE(PG8_SB(1, 0), b3, voffB); PG8_STAGE(PG8_SB(1, 1), b3 + hstepB, voffB); PG8_STAGE(PG8_SA(1, 0), a3, voffA);
            PG8_WAIT_V(8); PG8_WAIT_L(0); PG8_BAR; PG8_MMA(1, 0, At, B0); PG8_MMA(1, 1, At, B1); PG8_BAR; PG8_SCHED;
            } else {
            PG8_LDB(B0, 0, 0); PG8_SCHED; PG8_LDA(At, 0, 0); PG8_STAGE(PG8_SA(1, 1), a1 + hstepA, voffA);
            PG8_WAIT_L(8); PG8_BAR; PG8_WAIT_L(0); PG8_MMA(0, 0, At, B0); PG8_BAR; PG8_SCHED;
            PG8_LDB(B1, 0, 1); PG8_STAGE(PG8_SB(0, 0), b2, voffB);
            PG8_BAR; PG8_WAIT_L(0); PG8_MMA(0, 1, At, B1); PG8_BAR;
            PG8_LDA(At, 0, 1); PG8_STAGE(PG8_SA(0, 0), a2, voffA);
            PG8_BAR; PG8_WAIT_L(0); PG8_MMA(1, 0, At, B0); PG8_BAR; PG8_SCHED;
            PG8_STAGE(PG8_SB(0, 1), b2 + hstepB, voffB);
            PG8_WAIT_V(6); PG8_BAR; PG8_MMA(1, 1, At, B1); PG8_BAR;
            PG8_LDB(B0, 1, 0); PG8_SCHED; PG8_LDA(At, 1, 0); PG8_STAGE(PG8_SA(0, 1), a2 + hstepA, voffA);
            PG8_WAIT_L(8); PG8_BAR; PG8_WAIT_L(0); PG8_MMA(0, 0, At, B0); PG8_BAR; PG8_SCHED;
            PG8_LDB(B1, 1, 1); PG8_STAGE(PG8_SB(1, 0), b3, voffB);
            PG8_BAR; PG8_WAIT_L(0); PG8_MMA(0, 1, At, B1); PG8_BAR;
            PG8_LDA(At, 1, 1); PG8_STAGE(PG8_SA(1, 0), a3, voffA);
            PG8_BAR; PG8_WAIT_L(0); PG8_MMA(1, 0, At, B0); PG8_BAR; PG8_SCHED;
            PG8_STAGE(PG8_SB(1, 1), b3 + hstepB, voffB);
            PG8_WAIT_V(6); PG8_BAR; PG8_MMA(1, 1, At, B1); PG8_BAR;
            }
        }
        if constexpr (ALIGN_EPI) { if (wr == 0) PG8_BAR; }
        if constexpr (!Epi::AFTER_DRAIN) { E(acc, cur, wr, wc, fr, fq); S.done(cur); }
        if (!has_next) break;
#pragma unroll
        for (int a = 0; a < 2; ++a)
#pragma unroll
            for (int b = 0; b < 2; ++b)
#pragma unroll
                for (int m = 0; m < 4; ++m)
#pragma unroll
                    for (int n = 0; n < 2; ++n) acc[a][b][m][n] = (f32x4){0.f, 0.f, 0.f, 0.f};
        cur = nxt; cA = nA; cB = nB; ++ui;
        if constexpr (ALIGN_EPI) { if (wr == 1) PG8_BAR; }
    }
    PG8_WAIT_V(0);
    if constexpr (!ALIGN_EPI) { if (wr == 0) PG8_BAR; }
    PG8_BAR;
    if constexpr (Epi::AFTER_DRAIN) { E.fused(acc, cur, wr, wc, fr, fq, lds, wid, lane); S.done(cur); }
#undef PG8_SA
#undef PG8_SB
#undef PG8_STAGE
#undef PG8_LDA
#undef PG8_LDB
#undef PG8_MMA
#undef PG8_WAIT_V
#undef PG8_WAIT_L
#undef PG8_BAR
#undef PG8_SCHED
}
}

constexpr int NWAVES = 8, NTHR = NWAVES * 64;
constexpr int BATCH = 2, SEQ = 8192, DM = 1024, MTOK = BATCH * SEQ, FF = 4096;
constexpr int NPROJ0 = 6144, NPROJ1 = 3840;
constexpr float EPS = 1e-6f, LOG2E = 1.4426950408889634f;
constexpr int C0_Z = 0, C0_Q = 1024, C0_K = 2048, C0_V = 3072, C0_XBC = 4096;
constexpr int C1_RG = 0, C1_SQ = 1024, C1_RQ = 1536, C1_RK = 2048, C1_RV = 2560, C1_SK = 3584, C1_SV = 3712;
enum { I_X = 0, I_C, I_RELB, I_NG, I_MODW, I_MODB, I_W1, I_W2, I_EWIN, I_ECONVW, I_ECONVB, I_EDTB, I_EALOG, I_ED, I_ESSDN, I_ELAM, I_EDIFFN, I_EWOUT, I_OWIN, I_OSINK, I_OWOUT, N_IN };

constexpr size_t MiB = 1u << 20;
constexpr size_t WS_CTL = 0, CTL_ZERO_BYTES = 65536;
constexpr size_t WS_MOD = 256 * 1024;
constexpr size_t WS_WDT = 512 * 1024;
constexpr size_t WS_CHDEC = 576 * 1024;
constexpr size_t WS_SSQ = 640 * 1024;
constexpr size_t WS_WMIX = 1 * MiB;
constexpr size_t WS_WOUT0 = 13 * MiB, WS_WOUT1 = 9 * MiB;
constexpr size_t WS_PROJ0 = 17 * MiB;
constexpr size_t WS_XN2 = 17 * MiB;
constexpr size_t WS_WMLP = 49 * MiB;
constexpr size_t WS_H = 65 * MiB;
constexpr size_t WS_S = 209 * MiB;
constexpr size_t WS_DT = 241 * MiB;
constexpr size_t WS_W2L1 = 241 * MiB;
constexpr size_t WS_ROPE = 252 * MiB;
constexpr size_t WS_XCH = 250 * MiB;
constexpr size_t WS_END = 256 * MiB;
constexpr int CW_BAR = 4096;

constexpr int LDS_BYTES = 163840 - 1024;
constexpr int MISC_OFF = LDS_BYTES - 256;

#define GAS __attribute__((address_space(1)))
#define LAS __attribute__((address_space(3)))
typedef unsigned short bf16;
typedef unsigned v4u __attribute__((ext_vector_type(4)));
typedef unsigned v2u __attribute__((ext_vector_type(2)));
typedef float f32x4 __attribute__((ext_vector_type(4)));
typedef short bf16x8 __attribute__((ext_vector_type(8)));
typedef short v4i16_t __attribute__((ext_vector_type(4)));
typedef GAS unsigned gu32;
typedef LAS unsigned char* ldsp;
#define RLX_AGENT __ATOMIC_RELAXED, __HIP_MEMORY_SCOPE_AGENT
#define LDS_WAIT() asm volatile("s_waitcnt lgkmcnt(0)" ::: "memory")
#define VM_WAIT() asm volatile("s_waitcnt vmcnt(0)" ::: "memory")

__device__ __forceinline__ float bf2f(unsigned h) { return __uint_as_float(h << 16); }
typedef float f32x2_t __attribute__((ext_vector_type(2))); typedef __bf16 bf16x2_t __attribute__((ext_vector_type(2)));
__device__ __forceinline__ unsigned pk2(float lo, float hi) { f32x2_t v = {lo, hi}; bf16x2_t b = __builtin_convertvector(v, bf16x2_t); return __builtin_bit_cast(unsigned, b); }
__device__ __forceinline__ unsigned short f2bf(float f) { return (unsigned short)(pk2(f, 0.f) & 0xffffu); }
__device__ __forceinline__ float silu_f(float x) { return x * __builtin_amdgcn_rcpf(1.f + __expf(-x)); }
__device__ __forceinline__ float wave_sum(float v) {
#pragma unroll
    for (int o = 1; o < 64; o <<= 1) v += __shfl_xor(v, o);
    return v;
}
#define MFMA16(acc, rowfrag, colfrag) acc = __builtin_amdgcn_mfma_f32_16x16x32_bf16(colfrag, rowfrag, acc, 0, 0, 0)
__device__ __forceinline__ bf16x8 lds_frag(ldsp p) { return *(const LAS bf16x8*)p; }
__device__ __forceinline__ bf16x8 lds_frag_tr(ldsp p, int stride) {
    const v4i16_t lo = __builtin_amdgcn_ds_read_tr16_b64_v4i16((LAS v4i16_t*)p);
    const v4i16_t hi = __builtin_amdgcn_ds_read_tr16_b64_v4i16((LAS v4i16_t*)(p + 4 * stride));
    return (bf16x8){lo[0], lo[1], lo[2], lo[3], hi[0], hi[1], hi[2], hi[3]};
}
__device__ __forceinline__ int t5_bucket(int d) {
    if (d < 16) return d;
    const int v = 16 + (int)(logf((float)d * 0.0625f) / 2.0794415416798357f * 16.0f);
    return v < 31 ? v : 31;
}

#define XB_TMO      128
#define XB_XCNT(j)  (256  + 64 * (j))
#define XB_XSUB(j)  (1280 + 64 * (j))
#define XB_XGEN(j)  (2304 + 64 * (j))
#define XB_TOP      3328
#define XB_TOPGEN   3392
#define XCD_BAR_WORDS 3456
#define XB_SPIN_CAP (1u << 18)

__device__ __forceinline__ unsigned xb_ld(unsigned* p)              { return __hip_atomic_load(p, __ATOMIC_RELAXED, __HIP_MEMORY_SCOPE_AGENT); }
__device__ __forceinline__ unsigned xb_add(unsigned* p, unsigned v) { return __hip_atomic_fetch_add(p, v, __ATOMIC_RELAXED, __HIP_MEMORY_SCOPE_AGENT); }
__device__ __forceinline__ unsigned xb_xcc_id() { return (unsigned)__builtin_amdgcn_s_getreg((3 << 11) | 20) & 0xFu; }
#define XB_SPIN(cond, bar) do { unsigned _sp = 0; while (cond) { __builtin_amdgcn_s_sleep(1); \
    if ((++_sp & 255u) == 0u) { if (xb_ld(&(bar)[XB_TMO])) break; if (_sp > XB_SPIN_CAP) { atomicAdd(&(bar)[XB_TMO], 1u); break; } } } } while (0)

struct XcdBarrier {
    unsigned* bar; unsigned x;
    volatile LAS unsigned* st;
};

__device__ __forceinline__ XcdBarrier xcd_barrier_post(unsigned* bar, volatile LAS unsigned* st) {
    XcdBarrier b; b.bar = bar; b.x = xb_xcc_id(); b.st = st;
    if (threadIdx.x == 0) (void)xb_add(&bar[XB_XCNT(b.x)], 1u);
    return b;
}
__device__ __forceinline__ void xcd_barrier_complete(unsigned* bar, unsigned x, unsigned& nloc, unsigned& nx) {
    const unsigned G = gridDim.x * gridDim.y * gridDim.z;
    unsigned sum, cnt, mine, sp = 0u;
    for (;;) {
        sum = 0u; cnt = 0u; mine = 0u;
#pragma unroll
        for (unsigned j = 0; j < 16; ++j) { const unsigned c = xb_ld(&bar[XB_XCNT(j)]); sum += c; cnt += (c > 0u) ? 1u : 0u; mine = (j == x) ? c : mine; }
        if (sum == G) break;
        __builtin_amdgcn_s_sleep(1);
        if ((++sp & 255u) == 0u) { if (xb_ld(&bar[XB_TMO])) break; if (sp > XB_SPIN_CAP) { atomicAdd(&bar[XB_TMO], 1u); break; } }
    }
    nloc = mine > 0u ? mine : 1u; nx = cnt > 0u ? cnt : 1u;
}

template <bool WB = true> __device__ __forceinline__ void xcd_barrier(const XcdBarrier& b) {
    asm volatile("s_waitcnt vmcnt(0)" ::: "memory");
    __syncthreads();
    if (threadIdx.x == 0) {
        unsigned* bar = b.bar;
        __builtin_amdgcn_s_waitcnt(0);
        unsigned nloc = b.st[0], nx = b.st[1];
        if (nloc == 0u) { xcd_barrier_complete(bar, b.x, nloc, nx); b.st[0] = nloc; b.st[1] = nx; }
        const unsigned old = xb_add(&bar[XB_XSUB(b.x)], 1u);
        const unsigned gen = old / nloc;
        if (old + 1u == (gen + 1u) * nloc) {
            if (WB) asm volatile("buffer_inv sc1\n\tbuffer_wbl2 sc1\n\ts_waitcnt vmcnt(0)" ::: "memory"); else asm volatile("buffer_inv sc1" ::: "memory");
            xb_add(&bar[XB_TOP], 1u);
        } else {
            asm volatile("buffer_inv sc1" ::: "memory");
        }
        XB_SPIN(xb_ld(&bar[XB_TOP]) < (gen + 1u) * nx, bar);
        asm volatile("s_waitcnt vmcnt(0)" ::: "memory");
    }
    __syncthreads();
}

struct Seg { const float* W; int ldw, col0, ncols, K; bf16* WT; int row_off; };
struct CvtItem { const float* src; bf16* dst; int ldw, K; bool valid; };
template <int NSEG> __device__ __forceinline__ CvtItem cvt_resolve(const Seg (&segs)[NSEG], int it, int total, int lane) {
    CvtItem c; c.src = nullptr; c.dst = nullptr; c.ldw = 0; c.K = 0; c.valid = false;
    int r = it < total ? it : -1;
#pragma unroll
    for (int s = 0; s < NSEG; ++s) { const int nblk = segs[s].ncols / 32, n = (segs[s].K / 64) * nblk;
        if (!c.valid && r >= 0 && r < n) { const int kb = r / nblk, nb = r % nblk, k0 = 64 * kb, n0 = 32 * nb;
            c.src = segs[s].W + (size_t)(k0 + (lane >> 5)) * segs[s].ldw + segs[s].col0 + n0 + (lane & 31);
            c.dst = segs[s].WT + (size_t)(segs[s].row_off + n0 + (lane >> 3)) * segs[s].K + k0 + 8 * (lane & 7); c.ldw = segs[s].ldw; c.K = segs[s].K; c.valid = true; }
        r -= n; }
    return c;
}
__device__ __forceinline__ void cvt_loads(const CvtItem& c, float (&wv)[32]) {
    if (c.valid) {
#pragma unroll
        for (int i = 0; i < 32; ++i) wv[i] = c.src[(size_t)(2 * i) * c.ldw]; }
}
__device__ __forceinline__ void cvt_finish(const CvtItem& c, const float (&wv)[32], LAS float* scr, int lane) {
    if (c.valid) {
#pragma unroll
        for (int i = 0; i < 32; ++i) scr[(2 * i + (lane >> 5)) * 33 + (lane & 31)] = wv[i];
        LDS_WAIT(); asm volatile("" ::: "memory");
        const int cc = lane & 7;
#pragma unroll
        for (int j = 0; j < 4; ++j) { const int n = (lane >> 3) + 8 * j; const LAS float* p = scr + (8 * cc) * 33 + n;
            v4u o; o.x = pk2(p[0 * 33], p[1 * 33]); o.y = pk2(p[2 * 33], p[3 * 33]); o.z = pk2(p[4 * 33], p[5 * 33]); o.w = pk2(p[6 * 33], p[7 * 33]);
            *(v4u*)(c.dst + (size_t)(8 * j) * c.K) = o; }
        LDS_WAIT(); asm volatile("" ::: "memory"); }
}
template <int NSEG> __device__ __forceinline__ void convert_set(const Seg (&segs)[NSEG], ldsp lds, int gw, int NGW, int wave, int lane) {
    LAS float* scr = (LAS float*)(lds + wave * 16384);
    int total = 0;
#pragma unroll
    for (int s = 0; s < NSEG; ++s) total += (segs[s].K / 64) * (segs[s].ncols / 32);
    for (int it = gw; it < total; it += 2 * NGW) {
        const CvtItem ca = cvt_resolve<NSEG>(segs, it, total, lane), cb = cvt_resolve<NSEG>(segs, it + NGW, total, lane);
        float wa[32], wb[32];
        cvt_loads(ca, wa); cvt_loads(cb, wb);
        cvt_finish(ca, wa, scr, lane); cvt_finish(cb, wb, scr, lane);
    }
}
__device__ __forceinline__ void mod_phase(const float* c, const float* mod_w, const float* mod_b, float* MOD, ldsp lds, int tid, int lane, int wave) {
    for (int item = blockIdx.x; item < 192; item += gridDim.x) {
        const int s = item / 48, j0 = (item % 48) * 64, kpart = wave * 4 + (lane >> 4), jl = lane & 15;
        const float* wp = mod_w + ((size_t)s * 1024 + kpart * 32) * 3072 + j0 + 4 * jl;
        f32x4 a0 = {0.f, 0.f, 0.f, 0.f}, a1 = a0;
#pragma unroll
        for (int kk = 0; kk < 32; ++kk) { const int k = kpart * 32 + kk; const f32x4 w = *(const f32x4*)(wp + (size_t)kk * 3072);
            const float c0 = c[k], c1 = c[1024 + k]; const float s0 = c0 / (1.f + expf(-c0)), s1 = c1 / (1.f + expf(-c1)); a0 += w * s0; a1 += w * s1; }
        LAS f32x4* red = (LAS f32x4*)lds;
        red[(kpart * 2 + 0) * 16 + jl] = a0; red[(kpart * 2 + 1) * 16 + jl] = a1;
        __syncthreads();
        if (tid < 128) { const int b = tid >> 6, col = tid & 63; float sum = mod_b[s * 3072 + j0 + col];
#pragma unroll
            for (int kp = 0; kp < 32; ++kp) sum += ((LAS float*)lds)[((kp * 2 + b) * 16 + (col >> 2)) * 4 + (col & 3)];
            MOD[(s * 2 + b) * 3072 + j0 + col] = sum; }
        __syncthreads();
    }
}

template <int SPOST, int SPRE, bool XINB, int XOUT, int R = 2> __device__ __forceinline__ void norm_rows(const void* xin_, const bf16* Y, void* xout_, bf16* XN, const float* MOD, const float* ng, int gw, int NGW, int lane) {
    const float* xinf = (const float*)xin_; const bf16* xinb = (const bf16*)xin_; float* xoutf = (float*)xout_; bf16* xoutb = (bf16*)xout_;
    const int half = NGW >> 1; const bool split = !(NGW & 1);
    const int b0 = split ? gw / half : 0, b1 = split ? b0 + 1 : BATCH, w = split ? gw % half : gw, W = split ? half : NGW;
#define NR_COL(q) (8 * lane + 512 * ((q) >> 1) + 4 * ((q) & 1))
#define NR_UNPK(w_) ((f32x4){__uint_as_float((w_).x << 16), __uint_as_float((w_).x & 0xffff0000u), __uint_as_float((w_).y << 16), __uint_as_float((w_).y & 0xffff0000u)})
#define NR_LOAD(vx, vxb, vy, m_) do { _Pragma("unroll") for (int j = 0; j < 2; ++j) { \
        if constexpr (XINB) vxb[j] = *(const v4u*)(xinb + (size_t)(m_) * DM + 8 * lane + 512 * j); \
        else { vx[2 * j] = *(const f32x4*)(xinf + (size_t)(m_) * DM + NR_COL(2 * j)); vx[2 * j + 1] = *(const f32x4*)(xinf + (size_t)(m_) * DM + NR_COL(2 * j + 1)); } \
        if constexpr (SPOST >= 0) vy[j] = *(const v4u*)(Y + (size_t)(m_) * DM + 8 * lane + 512 * j); } } while (0)
#pragma unroll 1
    for (int b = b0; b < b1; ++b) {
        f32x4 g4[4], p4[4], s4[4], c4[4], q4[4];
#pragma unroll
        for (int q = 0; q < 4; ++q) {
            if constexpr (SPOST >= 0) { g4[q] = *(const f32x4*)(MOD + (SPOST * 2 + b) * 3072 + 2048 + NR_COL(q)); p4[q] = *(const f32x4*)(ng + (SPOST * 2 + 1) * DM + NR_COL(q)); }
            if constexpr (SPRE >= 0) { s4[q] = *(const f32x4*)(MOD + (SPRE * 2 + b) * 3072 + NR_COL(q)); c4[q] = *(const f32x4*)(MOD + (SPRE * 2 + b) * 3072 + 1024 + NR_COL(q)) + 1.0f;
                q4[q] = *(const f32x4*)(ng + (SPRE * 2) * DM + NR_COL(q)); }
        }
        const int cnt = w < SEQ ? (SEQ - w + W - 1) / W : 0;
        f32x4 vx[R][4]; v4u vxb[R][2], vy[R][2];
#pragma unroll
        for (int r = 0; r < R; ++r) if (r < cnt) NR_LOAD(vx[r], vxb[r], vy[r], b * SEQ + w + r * W);
        for (int i0 = 0; i0 < cnt; i0 += R) {
            f32x4 nx[R][4]; v4u nxb[R][2], ny[R][2];
#pragma unroll
            for (int r = 0; r < R; ++r) if (i0 + R + r < cnt) NR_LOAD(nx[r], nxb[r], ny[r], b * SEQ + w + (i0 + R + r) * W);
#pragma unroll
            for (int r = 0; r < R; ++r) if (i0 + r < cnt) {
                const int m = b * SEQ + w + (i0 + r) * W;
                f32x4 v[4];
#pragma unroll
                for (int j = 0; j < 2; ++j) { if constexpr (XINB) { const v2u lo = {vxb[r][j].x, vxb[r][j].y}, hi = {vxb[r][j].z, vxb[r][j].w}; v[2 * j] = NR_UNPK(lo); v[2 * j + 1] = NR_UNPK(hi); }
                                              else { v[2 * j] = vx[r][2 * j]; v[2 * j + 1] = vx[r][2 * j + 1]; } }
                if constexpr (SPOST >= 0) {
                    f32x4 y[4]; float ss = 0.f;
#pragma unroll
                    for (int j = 0; j < 2; ++j) { const v2u lo = {vy[r][j].x, vy[r][j].y}, hi = {vy[r][j].z, vy[r][j].w}; y[2 * j] = NR_UNPK(lo); y[2 * j + 1] = NR_UNPK(hi); }
#pragma unroll
                    for (int q = 0; q < 4; ++q) ss += (y[q].x * y[q].x + y[q].y * y[q].y) + (y[q].z * y[q].z + y[q].w * y[q].w);
                    const float rr = 1.0f / sqrtf(wave_sum(ss) * (1.f / DM) + EPS);
#pragma unroll
                    for (int q = 0; q < 4; ++q) v[q] = v[q] + g4[q] * ((y[q] * rr) * p4[q]);
                    if constexpr (XOUT == 2) {
#pragma unroll
                        for (int q = 0; q < 4; ++q) *(f32x4*)(xoutf + (size_t)m * DM + NR_COL(q)) = v[q]; }
                    if constexpr (XOUT == 1) {
#pragma unroll
                        for (int j = 0; j < 2; ++j) { v4u o; o.x = pk2(v[2 * j].x, v[2 * j].y); o.y = pk2(v[2 * j].z, v[2 * j].w); o.z = pk2(v[2 * j + 1].x, v[2 * j + 1].y); o.w = pk2(v[2 * j + 1].z, v[2 * j + 1].w);
                            *(v4u*)(xoutb + (size_t)m * DM + 8 * lane + 512 * j) = o;
                            const v2u lo = {o.x, o.y}, hi = {o.z, o.w}; v[2 * j] = NR_UNPK(lo); v[2 * j + 1] = NR_UNPK(hi); } }
                }
                if constexpr (SPRE >= 0) {
                    float ss = 0.f;
#pragma unroll
                    for (int q = 0; q < 4; ++q) ss += (v[q].x * v[q].x + v[q].y * v[q].y) + (v[q].z * v[q].z + v[q].w * v[q].w);
                    const float rr = 1.0f / sqrtf(wave_sum(ss) * (1.f / DM) + EPS);
#pragma unroll
                    for (int j = 0; j < 2; ++j) { const f32x4 oa = ((v[2 * j] * rr) * q4[2 * j]) * c4[2 * j] + s4[2 * j], ob = ((v[2 * j + 1] * rr) * q4[2 * j + 1]) * c4[2 * j + 1] + s4[2 * j + 1];
                        v4u o; o.x = pk2(oa.x, oa.y); o.y = pk2(oa.z, oa.w); o.z = pk2(ob.x, ob.y); o.w = pk2(ob.z, ob.w);
                        *(v4u*)(XN + (size_t)m * DM + 8 * lane + 512 * j) = o; }
                }
            }
#pragma unroll
            for (int r = 0; r < R; ++r) {
#pragma unroll
                for (int q = 0; q < 4; ++q) vx[r][q] = nx[r][q];
#pragma unroll
                for (int j = 0; j < 2; ++j) { vxb[r][j] = nxb[r][j]; vy[r][j] = ny[r][j]; } }
        }
    }
#undef NR_LOAD
#undef NR_UNPK
#undef NR_COL
}

__device__ __forceinline__ void dt_phase(const bf16* XN, const bf16* WDT, const float* dt_bias, float* DT, int gw, int NGW, int lane) {
    const int fr = lane & 15, fq = lane >> 4;
    for (int tile = gw; tile < MTOK / 16; tile += NGW) {
        f32x4 acc = {0.f, 0.f, 0.f, 0.f};
        const bf16* arow = XN + (size_t)(tile * 16 + fr) * DM + 8 * fq; const bf16* brow = WDT + fr * DM + 8 * fq;
#pragma unroll 8
        for (int ks = 0; ks < 32; ++ks) { const bf16x8 a = *(const bf16x8*)(arow + 32 * ks), bb = *(const bf16x8*)(brow + 32 * ks); MFMA16(acc, a, bb); }
        const f32x4 bi = *(const f32x4*)(dt_bias + 4 * fq); f32x4 o;
#pragma unroll
        for (int i = 0; i < 4; ++i) { const float v = acc[i] + bi[i]; o[i] = v > 20.f ? v : log1pf(expf(v)); }
        *(f32x4*)(DT + (size_t)(tile * 16 + fr) * 16 + 4 * fq) = o;
    }
}

__device__ __forceinline__ void ssd_dt_acs(const float* DT, const float* A_log, int t0, int g, LAS float* ACS, LAS float* DTS, LAS float* TMP, int tid) {
    const int r = tid >> 7, s = tid & 127, ln = tid & 63;
    const float dt = DT[(size_t)(t0 + s) * 16 + g * 4 + r];
    float v = -expf(A_log[g * 4 + r]) * dt; DTS[r * 128 + s] = dt;
#pragma unroll
    for (int d = 1; d < 64; d <<= 1) { const float t = __shfl_up(v, d); if (ln >= d) v += t; }
    if (ln == 63) TMP[tid >> 6] = v;
    __syncthreads();
    if (s >= 64) v += TMP[(tid >> 6) - 1];
    ACS[r * 128 + s] = v;
    __syncthreads();
}
__device__ __forceinline__ void ssd_conv_group(const bf16* PROJ0, const float* conv_w, const float* conv_b, int t0, bool first_chunk, int cch0, int tg, int mode, ldsp dst  , int stride,
                                               const LAS float* ACSr, const LAS float* DTSr) {
    float w[4][8], cb[8];
#pragma unroll
    for (int j = 0; j < 4; ++j) { const f32x4 a = *(const f32x4*)(conv_w + j * 2048 + cch0), b = *(const f32x4*)(conv_w + j * 2048 + cch0 + 4);
        w[j][0] = a[0]; w[j][1] = a[1]; w[j][2] = a[2]; w[j][3] = a[3]; w[j][4] = b[0]; w[j][5] = b[1]; w[j][6] = b[2]; w[j][7] = b[3]; }
    { const f32x4 a = *(const f32x4*)(conv_b + cch0), b = *(const f32x4*)(conv_b + cch0 + 4); cb[0] = a[0]; cb[1] = a[1]; cb[2] = a[2]; cb[3] = a[3]; cb[4] = b[0]; cb[5] = b[1]; cb[6] = b[2]; cb[7] = b[3]; }
    v4u raw[19];
    const bf16* src = PROJ0 + ((size_t)t0 + 16 * tg) * NPROJ0 + C0_XBC + cch0;
    const bool pad = first_chunk && tg == 0;
#pragma unroll
    for (int i = 0; i < 19; ++i) { if (i < 3 && pad) raw[i] = (v4u){0u, 0u, 0u, 0u}; else raw[i] = *(const v4u*)(src + (ptrdiff_t)(i - 3) * NPROJ0); }
    const float alast = ACSr[127];
#pragma unroll
    for (int k = 0; k < 16; ++k) { const int s = 16 * tg + k;
        float sc = 1.f; if (mode == 0) sc = DTSr[s] * __expf(alast - ACSr[s]); else if (mode == 1) sc = DTSr[s];
        float o[8];
#pragma unroll
        for (int c = 0; c < 8; ++c) { float v = cb[c];
#pragma unroll
            for (int j = 0; j < 4; ++j) { const unsigned d = raw[k + j][c >> 1]; v += w[j][c] * ((c & 1) ? __uint_as_float(d & 0xffff0000u) : __uint_as_float(d << 16)); }
            o[c] = silu_f(v) * sc; }
        v4u ow; ow.x = pk2(o[0], o[1]); ow.y = pk2(o[2], o[3]); ow.z = pk2(o[4], o[5]); ow.w = pk2(o[6], o[7]);
        *(LAS v4u*)(dst + s * stride) = ow; }
}
constexpr int SA_BS = 0, SA_XS = 34816, SA_ACS = 102400, SA_DTS = 104448, SA_TMP = 106496;
__device__ __forceinline__ void ssdA_unit(ldsp lds, const bf16* PROJ0, const float* DT, const float* conv_w, const float* conv_b, const float* A_log, bf16* ST, float* CHDEC, int u, int tid, int lane, int wave) {
    asm volatile("" : "+v"(tid), "+v"(lane));
    const int g = u & 3, c = (u >> 2) & 63, b = u >> 8, t0 = b * SEQ + c * 128;
    const int fr = lane & 15, fq = lane >> 4, trq = (lane & 15) >> 2, trp = lane & 3;
    LAS float* ACS = (LAS float*)(lds + SA_ACS); LAS float* DTS = (LAS float*)(lds + SA_DTS); LAS float* TMP = (LAS float*)(lds + SA_TMP);
    ssd_dt_acs(DT, A_log, t0, g, ACS, DTS, TMP, tid);
    if (tid < 4) CHDEC[(b * 64 + c) * 16 + g * 4 + tid] = __expf(ACS[tid * 128 + 127]);
    if (tid < 384) { const int cg = tid % 48, tg = tid / 48; const bool isx = cg < 32; const int r = isx ? (cg >> 3) : 0;
        ssd_conv_group(PROJ0, conv_w, conv_b, t0, c == 0, isx ? g * 256 + 8 * cg : 1024 + g * 128 + 8 * (cg - 32), tg, isx ? 0 : 2,
                       isx ? lds + SA_XS + cg * 16 : lds + SA_BS + (cg - 32) * 16, isx ? 528 : 272, ACS + r * 128, DTS + r * 128); }
    __syncthreads();
    const int r = wave >> 1, half = wave & 1;
    f32x4 acc[2][8];
#pragma unroll
    for (int j = 0; j < 2; ++j)
#pragma unroll
        for (int n = 0; n < 8; ++n) acc[j][n] = (f32x4){0.f, 0.f, 0.f, 0.f};
    bf16x8 fa[2][2], fb[2][8];
#define SA_READ(ks_, buf_) do { _Pragma("unroll") for (int j = 0; j < 2; ++j) fa[buf_][j] = lds_frag_tr(lds + SA_XS + (32 * (ks_) + 8 * fq + trq) * 528 + (r * 64 + (2 * half + j) * 16 + 4 * trp) * 2, 528); \
        _Pragma("unroll") for (int n = 0; n < 8; ++n) fb[buf_][n] = lds_frag_tr(lds + SA_BS + (32 * (ks_) + 8 * fq + trq) * 272 + (n * 16 + 4 * trp) * 2, 272); } while (0)
    SA_READ(0, 0);
#pragma unroll
    for (int ks = 0; ks < 4; ++ks) {
        if (ks < 3) SA_READ(ks + 1, (ks + 1) & 1);
        __builtin_amdgcn_sched_barrier(0);
#pragma unroll
        for (int n = 0; n < 8; ++n) { MFMA16(acc[0][n], fa[ks & 1][0], fb[ks & 1][n]); MFMA16(acc[1][n], fa[ks & 1][1], fb[ks & 1][n]); }
        __builtin_amdgcn_sched_barrier(0);
    }
#undef SA_READ
    bf16* so = ST + ((size_t)((b * 64 + c) * 16 + g * 4 + r) * 64) * 128;
#pragma unroll
    for (int j = 0; j < 2; ++j)
#pragma unroll
        for (int n = 0; n < 8; ++n) { v2u w; w.x = pk2(acc[j][n][0], acc[j][n][1]); w.y = pk2(acc[j][n][2], acc[j][n][3]);
            *(v2u*)(so + (size_t)((2 * half + j) * 16 + fr) * 128 + n * 16 + 4 * fq) = w; }
    __syncthreads();
}
__device__ __forceinline__ void ssd_scan(bf16* ST, const float* CHDEC, int gtid, int gthreads) {
    for (int e = gtid; e < 131072; e += gthreads) {
        const int b = e >> 16, rem = e & 65535, h = rem >> 12, pn = rem & 4095;
        unsigned* p = (unsigned*)ST + ((size_t)(b * 64) * 16 + h) * 4096 + pn; const float* dp = CHDEC + (b * 64) * 16 + h;
        float c0 = 0.f, c1 = 0.f;
#pragma unroll 1
        for (int hf = 0; hf < 2; ++hf) {
            unsigned v[32]; unsigned* pb = p + (size_t)hf * 32 * 16 * 4096;
            { const unsigned* q = pb;
#pragma unroll
              for (int c = 0; c < 32; ++c) { v[c] = *q; q += 16 * 4096; asm volatile("" : "+v"(q)); } }
#pragma unroll
            for (int c = 0; c < 32; ++c) { const float dec = dp[(hf * 32 + c) * 16]; const unsigned o = pk2(c0, c1); c0 = c0 * dec + __uint_as_float(v[c] << 16); c1 = c1 * dec + __uint_as_float(v[c] & 0xffff0000u); v[c] = o; }
            { unsigned* q = pb;
#pragma unroll
              for (int c = 0; c < 32; ++c) { *q = v[c]; q += 16 * 4096; asm volatile("" : "+v"(q)); } }
        }
    }
}
constexpr int SC_CS = 0, SC_BS = 34816, SC_XS = 69632, SC_ACS = 137216, SC_DTS = 139264, SC_TMP = 141312, SC_SP = 143360;
template <int PV> __device__ __forceinline__ void ssdC_unit(ldsp lds, const bf16* PROJ0, bf16* OUT  , int opitch, const float* DT, const float* conv_w, const float* conv_b, const float* A_log, const float* Dskip, const float* ssd_norm,
                                          const bf16* ST, float* SSQ, int u, int tid, int lane, int wave) {
    asm volatile("" : "+v"(tid), "+v"(lane));
    const int g = u & 3, c = (u >> 2) & 63, b = u >> 8, t0 = b * SEQ + c * 128;
    const int fr = lane & 15, fq = lane >> 4, trq = (lane & 15) >> 2, trp = lane & 3;
    LAS float* ACS = (LAS float*)(lds + SC_ACS); LAS float* DTS = (LAS float*)(lds + SC_DTS); LAS float* TMP = (LAS float*)(lds + SC_TMP);
    if (!(PV & 1)) ssd_dt_acs(DT, A_log, t0, g, ACS, DTS, TMP, tid);
    if (!(PV & 2)) { const int cg = tid & 63, tg = tid >> 6; const bool isx = cg < 32, isb = cg < 48; const int r = isx ? (cg >> 3) : 0;
      ssd_conv_group(PROJ0, conv_w, conv_b, t0, c == 0, isx ? g * 256 + 8 * cg : (isb ? 1024 + g * 128 + 8 * (cg - 32) : 1536 + g * 128 + 8 * (cg - 48)), tg, isx ? 1 : 2,
                     isx ? lds + SC_XS + cg * 16 : (isb ? lds + SC_BS + (cg - 32) * 16 : lds + SC_CS + (cg - 48) * 16), isx ? 528 : 272, ACS + r * 128, DTS + r * 128); }
    __syncthreads();
    const int l = 16 * wave + fr;
    const ldsp crow = lds + SC_CS + l * 272 + 16 * fq, mrow = lds + SC_BS + l * 272 + 16 * fq;
    const bf16* prow = PROJ0 + (size_t)(t0 + l) * NPROJ0; bf16* orow = OUT + (size_t)(t0 + l) * opitch;
    v2u zw[4]; f32x4 nwn[4]; float dskn;
    v4u spr[2];
    const int sprow = tid >> 3, spch = tid & 7;
    { const bf16* sp = ST + ((size_t)((b * 64 + c) * 16 + g * 4) * 64) * 128;
#pragma unroll
      for (int i = 0; i < 2; ++i) spr[i] = *(const v4u*)(sp + (size_t)(sprow) * 128 + (spch + 8 * i) * 8);
#pragma unroll
      for (int p = 0; p < 4; ++p) { zw[p] = *(const v2u*)(prow + C0_Z + (g * 4) * 64 + 16 * p + 4 * fq); nwn[p] = *(const f32x4*)(ssd_norm + (g * 4) * 64 + 16 * p + 4 * fq); }
      dskn = Dskip[g * 4]; }
    f32x4 cb[8];
#pragma unroll
    for (int n = 0; n < 8; ++n) cb[n] = (f32x4){0.f, 0.f, 0.f, 0.f};
#pragma unroll
    for (int ks = 0; ks < 4; ++ks) { const bf16x8 af = lds_frag(crow + 64 * ks); bf16x8 bfr[8];
#pragma unroll
        for (int n = 0; n < 8; ++n) bfr[n] = lds_frag(lds + SC_BS + (16 * n + fr) * 272 + 64 * ks + 16 * fq);
        __builtin_amdgcn_sched_barrier(0);
#pragma unroll
        for (int n = 0; n < 8; ++n) MFMA16(cb[n], af, bfr[n]);
        __builtin_amdgcn_sched_barrier(0); }
    __syncthreads();
    float ssq = 0.f;
#pragma unroll 1
    for (int r = 0; r < ((PV & 4) ? 0 : 4); ++r) {
        const int h = g * 4 + r; const float al = ACS[r * 128 + l];
#pragma unroll
        for (int i = 0; i < 2; ++i) *(LAS v4u*)(lds + SC_SP + sprow * 272 + (spch + 8 * i) * 16) = spr[i];
        v2u zc[4]; f32x4 nwc[4]; const float dskc = dskn;
#pragma unroll
        for (int p = 0; p < 4; ++p) { zc[p] = zw[p]; nwc[p] = nwn[p]; }
        if (r < 3 && !(PV & 8)) {
            const bf16* sp = ST + ((size_t)((b * 64 + c) * 16 + h + 1) * 64) * 128;
#pragma unroll
            for (int i = 0; i < 2; ++i) spr[i] = *(const v4u*)(sp + (size_t)(sprow) * 128 + (spch + 8 * i) * 8);
#pragma unroll
            for (int p = 0; p < 4; ++p) { zw[p] = *(const v2u*)(prow + C0_Z + (h + 1) * 64 + 16 * p + 4 * fq); nwn[p] = *(const f32x4*)(ssd_norm + (h + 1) * 64 + 16 * p + 4 * fq); }
            dskn = Dskip[h + 1];
        }
        __syncthreads();
#pragma unroll
        for (int n = 0; n < 8; ++n) { const f32x4 as = *(const LAS f32x4*)(ACS + r * 128 + 16 * n + 4 * fq); float mv[4];
#pragma unroll
            for (int i = 0; i < 4; ++i) { const int s = 16 * n + 4 * fq + i; mv[i] = (s <= l) ? cb[n][i] * __expf(al - as[i]) : 0.f; }
            v2u w; w.x = pk2(mv[0], mv[1]); w.y = pk2(mv[2], mv[3]); *(LAS v2u*)(lds + SC_BS + l * 272 + (16 * n + 4 * fq) * 2) = w; }
        f32x4 y[4], yo[4];
#pragma unroll
        for (int p = 0; p < 4; ++p) { y[p] = (f32x4){0.f, 0.f, 0.f, 0.f}; yo[p] = y[p]; }
#pragma unroll
        for (int ks = 0; ks < 4; ++ks) { const bf16x8 af = lds_frag(mrow + 64 * ks);
            bf16x8 xf[4];
#pragma unroll
            for (int p = 0; p < 4; ++p) xf[p] = lds_frag_tr(lds + SC_XS + (32 * ks + 8 * fq + trq) * 528 + (r * 64 + 16 * p + 4 * trp) * 2, 528);
#pragma unroll
            for (int p = 0; p < 4; ++p) MFMA16(y[p], af, xf[p]); }
#pragma unroll
        for (int ks = 0; ks < 4; ++ks) { const bf16x8 cf = lds_frag(crow + 64 * ks); bf16x8 sf[4];
#pragma unroll
            for (int p = 0; p < 4; ++p) sf[p] = lds_frag(lds + SC_SP + (16 * p + fr) * 272 + 64 * ks + 16 * fq);
#pragma unroll
            for (int p = 0; p < 4; ++p) MFMA16(yo[p], cf, sf[p]); }
        __syncthreads();
        const float el = __expf(al), rdt = dskc / DTS[r * 128 + l];
#pragma unroll
        for (int p = 0; p < 4; ++p) { const int ch = h * 64 + 16 * p + 4 * fq;
            const v2u xw = *(const LAS v2u*)(lds + SC_XS + l * 528 + (r * 64 + 16 * p + 4 * fq) * 2); const f32x4 nw = nwc[p];
            const float z[4] = {__uint_as_float(zc[p].x << 16), __uint_as_float(zc[p].x & 0xffff0000u), __uint_as_float(zc[p].y << 16), __uint_as_float(zc[p].y & 0xffff0000u)};
            const float xs[4] = {__uint_as_float(xw.x << 16), __uint_as_float(xw.x & 0xffff0000u), __uint_as_float(xw.y << 16), __uint_as_float(xw.y & 0xffff0000u)};
            float o[4];
#pragma unroll
            for (int i = 0; i < 4; ++i) { float v = y[p][i] + el * yo[p][i] + rdt * xs[i]; v *= silu_f(z[i]); ssq += v * v; o[i] = v * nw[i]; }
            v2u w; w.x = pk2(o[0], o[1]); w.y = pk2(o[2], o[3]); if (!(PV & 16)) *(v2u*)(orow + ch) = w; else asm volatile("" :: "v"(w.x), "v"(w.y)); }
    }
    ssq += __shfl_xor(ssq, 16); ssq += __shfl_xor(ssq, 32);
    if (fq == 0) SSQ[(size_t)(t0 + l) * 4 + g] = ssq;
    __syncthreads();
}
__device__ __forceinline__ void ssd_normalize_rows(bf16* PROJ0, const float* SSQ, int gw, int NGW, int lane) {
    for (int m = gw; m < MTOK; m += NGW) {
        const f32x4 q = *(const f32x4*)(SSQ + (size_t)m * 4); const float r = 1.0f / sqrtf(((q.x + q.y) + (q.z + q.w)) * (1.f / 1024.f) + EPS);
        v4u* p = (v4u*)(PROJ0 + (size_t)m * NPROJ0 + C0_Z + 8 * lane); v4u w0 = p[0], w1 = p[64];
#pragma unroll
        for (int i = 0; i < 4; ++i) { w0[i] = pk2(__uint_as_float(w0[i] << 16) * r, __uint_as_float(w0[i] & 0xffff0000u) * r); w1[i] = pk2(__uint_as_float(w1[i] << 16) * r, __uint_as_float(w1[i] & 0xffff0000u) * r); }
        p[0] = w0; p[64] = w1;
    }
}

__device__ __forceinline__ float quad_max(float v) {
    auto a = __builtin_amdgcn_permlane16_swap(__float_as_uint(v), __float_as_uint(v), false, false); v = fmaxf(__uint_as_float(a[0]), __uint_as_float(a[1]));
    auto b = __builtin_amdgcn_permlane32_swap(__float_as_uint(v), __float_as_uint(v), false, false); return fmaxf(__uint_as_float(b[0]), __uint_as_float(b[1]));
}
__device__ __forceinline__ float quad_sum(float v) {
    auto a = __builtin_amdgcn_permlane16_swap(__float_as_uint(v), __float_as_uint(v), false, false); v = __uint_as_float(a[0]) + __uint_as_float(a[1]);
    auto b = __builtin_amdgcn_permlane32_swap(__float_as_uint(v), __float_as_uint(v), false, false); return __uint_as_float(b[0]) + __uint_as_float(b[1]);
}
__device__ __forceinline__ void glds16_asm(const void* gsrc, unsigned lds_dst) { unsigned keep;
    asm volatile("s_mov_b32 %0, m0\n\ts_mov_b32 m0, %2\n\ts_nop 0\n\tglobal_load_lds_dwordx4 %1, off\n\ts_mov_b32 m0, %0" : "=&s"(keep) : "v"(gsrc), "s"(lds_dst) : "memory"); }
#ifndef DA_NOFAST
#define DA_NOFAST 0
#endif
#ifndef DA_SGB
#define DA_SGB true
#endif
#ifndef DA_PAR
#define DA_PAR 0
#endif
constexpr int DB_K = 0, DB_V = 65536, DB_TSZ = 16384, DB_BT = 147456, DB_XCH = 0;
__device__ __forceinline__ bf16x8 lds_frag_tr2(ldsp p0, ldsp p1) {
    const v4i16_t lo = __builtin_amdgcn_ds_read_tr16_b64_v4i16((LAS v4i16_t*)p0);
    const v4i16_t hi = __builtin_amdgcn_ds_read_tr16_b64_v4i16((LAS v4i16_t*)p1);
    return (bf16x8){lo[0], lo[1], lo[2], lo[3], hi[0], hi[1], hi[2], hi[3]};
}
#define DB_BAR() do { __builtin_amdgcn_sched_barrier(0); asm volatile("s_waitcnt lgkmcnt(0)" ::: "memory"); __builtin_amdgcn_s_barrier(); asm volatile("" ::: "memory"); __builtin_amdgcn_sched_barrier(0); } while (0)
constexpr size_t WS_KMAX = 32 * 1024;
__device__ __forceinline__ void kmax_rows(const bf16* PROJ0, unsigned* KMAX, int gw, int NGW, int lane) {
#pragma unroll 1
    for (int b = 0; b < BATCH; ++b) {
        float mx = 0.f; int m = b * SEQ + (gw % NGW); while (m < b * SEQ) m += NGW;
        for (; m < (b + 1) * SEQ; m += NGW) {
            const v4u* p = (const v4u*)(PROJ0 + (size_t)m * NPROJ0 + C0_K + 16 * lane); const v4u w0 = p[0], w1 = p[1]; float ss = 0.f;
#pragma unroll
            for (int i = 0; i < 4; ++i) { const float a0 = __uint_as_float(w0[i] << 16), a1 = __uint_as_float(w0[i] & 0xffff0000u), b0 = __uint_as_float(w1[i] << 16), b1 = __uint_as_float(w1[i] & 0xffff0000u);
                ss += (a0 * a0 + a1 * a1) + (b0 * b0 + b1 * b1); }
            ss += __shfl_xor(ss, 1); ss += __shfl_xor(ss, 2); mx = fmaxf(mx, ss);
        }
        if ((lane & 3) == 0) atomicMax(KMAX + b * 16 + (lane >> 2), __float_as_uint(mx));
    }
}
template <int PVAR> __device__ __forceinline__ void dattn5_unit(ldsp lds, const bf16* PROJ0, bf16* OUT  , int opitch, const float* rel_bias, const float* diff_norm, const unsigned* KMAX, float lam,
                                                                int b, int h, int qb, int tid, int lane, int wave) {
    asm volatile("" : "+v"(tid), "+v"(lane));
    const int fr = lane & 15, fq = lane >> 4, trq = (lane & 15) >> 2, trp = lane & 3;
    const int m = wave >> 2, rg = wave & 3;
    const size_t rowbase = (size_t)b * SEQ; const int q0 = qb * 128, row0 = q0 + 32 * rg;
    const int nt = 2 * qb + 2;
    const bf16* kvb = PROJ0 + rowbase * NPROJ0 + h * 128;
    const bf16* ksrc[2]; const bf16* vsrc[2];
#pragma unroll
    for (int i = 0; i < 2; ++i) { const int key = 4 * (wave + 8 * i) + (lane >> 4), slot = lane & 15;
        ksrc[i] = kvb + (size_t)key * NPROJ0 + C0_K + ((slot ^ (key & 15)) * 8); vsrc[i] = kvb + (size_t)key * NPROJ0 + C0_V + ((slot ^ ((key & 7) << 1)) * 8); }
    int kw = 0, vw = 0;
    const unsigned lds0 = (unsigned)(size_t)lds;
#define DB_DMAK(t) do { _Pragma("unroll") for (int i_ = 0; i_ < 2; ++i_) \
        glds16_asm(ksrc[i_] + (size_t)(64 * (t)) * NPROJ0, (unsigned)__builtin_amdgcn_readfirstlane((int)(lds0 + DB_K + kw * DB_TSZ + (wave + 8 * i_) * 1024))); \
        kw = (kw + 1) & 3; } while (0)
#define DB_DMAV(t) do { _Pragma("unroll") for (int i_ = 0; i_ < 2; ++i_) \
        glds16_asm(vsrc[i_] + (size_t)(64 * (t)) * NPROJ0, (unsigned)__builtin_amdgcn_readfirstlane((int)(lds0 + DB_V + vw * DB_TSZ + (wave + 8 * i_) * 1024))); \
        vw = (vw == 4) ? 0 : vw + 1; } while (0)
    DB_DMAK(0); DB_DMAV(0); DB_DMAK(1); DB_DMAV(1); if (nt > 2) { DB_DMAK(2); DB_DMAV(2); } if (nt > 3) DB_DMAK(3);
    const float SC = 0.125f * LOG2E, c31 = rel_bias[31 * 8 + h] * LOG2E;
    bf16x8 qf[2][2]; float qss[2] = {0.f, 0.f};
#pragma unroll
    for (int rt = 0; rt < 2; ++rt)
#pragma unroll
        for (int ks = 0; ks < 2; ++ks) { const v4u raw = *(const v4u*)(PROJ0 + (rowbase + row0 + 16 * rt + fr) * NPROJ0 + C0_Q + h * 128 + m * 64 + ks * 32 + fq * 8); v4u sc;
#pragma unroll
            for (int i = 0; i < 4; ++i) { sc[i] = pk2(__uint_as_float(raw[i] << 16) * SC, __uint_as_float(raw[i] & 0xffff0000u) * SC);
                const float r0 = __uint_as_float(sc[i] << 16), r1 = __uint_as_float(sc[i] & 0xffff0000u); qss[rt] += r0 * r0 + r1 * r1; }
            qf[rt][ks] = __builtin_bit_cast(bf16x8, sc); }
    LAS float* BT = (LAS float*)(lds + DB_BT);
    if (tid < 128) BT[tid] = (rel_bias[t5_bucket(tid) * 8 + h] - rel_bias[31 * 8 + h]) * LOG2E;
    float bmax = rel_bias[h];
#pragma unroll 1
    for (int k = 1; k < 32; ++k) bmax = fmaxf(bmax, rel_bias[k * 8 + h]);
    const float kmx = sqrtf(__uint_as_float(KMAX[(b * 8 + h) * 2 + m]));
    f32x4 cmv[2];
#pragma unroll
    for (int rt = 0; rt < 2; ++rt) { const float c = c31 - (sqrtf(quad_sum(qss[rt])) * kmx * 1.001f + bmax * LOG2E + 0.01f); cmv[rt] = (f32x4){c, c, c, c}; }
    f32x4 o[2][9], s[2][4], sn[2][4]; v4u pk[2][2];
#pragma unroll
    for (int rt = 0; rt < 2; ++rt) {
#pragma unroll
        for (int e = 0; e < 9; ++e) o[rt][e] = (f32x4){0.f, 0.f, 0.f, 0.f};
#pragma unroll
        for (int k2 = 0; k2 < 2; ++k2) pk[rt][k2] = (v4u){0u, 0u, 0u, 0u}; }
    const bf16x8 ones = {0x3F80, 0x3F80, 0x3F80, 0x3F80, 0x3F80, 0x3F80, 0x3F80, 0x3F80};
    const int vswz = ((4 * (fq & 1) + trq) << 1);
    const int vlane = (4 * fq + trq) * 256 + trp * 8;
    int vco[8], kx[2];
#pragma unroll
    for (int e = 0; e < 8; ++e) vco[e] = vlane + (((2 * e) ^ vswz) * 16);
#pragma unroll
    for (int ks = 0; ks < 2; ++ks) kx[ks] = fr * 256 + (((m * 8 + ks * 4 + fq) ^ fr) * 16);
    asm volatile("s_waitcnt vmcnt(0)" ::: "memory");
    DB_BAR();
    int kr = 0, vr = 0;
#define DA_SMAT(DST) do { const ldsp kbuf_ = lds + DB_K + kr * DB_TSZ; kr = (kr + 1) & 3; \
        _Pragma("unroll") for (int n_ = 0; n_ < 4; ++n_) { \
            const bf16x8 k0_ = lds_frag(kbuf_ + kx[0] + n_ * 4096), k1_ = lds_frag(kbuf_ + kx[1] + n_ * 4096); \
            _Pragma("unroll") for (int rt_ = 0; rt_ < 2; ++rt_) { DST[rt_][n_] = __builtin_amdgcn_mfma_f32_16x16x32_bf16(k0_, qf[rt_][0], cmv[rt_], 0, 0, 0); MFMA16(DST[rt_][n_], qf[rt_][1], k1_); } } } while (0)
    DA_SMAT(s);
#define DA_BODY(T_, FAR_, PV_, SN_, SA, SB) do { \
        const bool dmak_ = ((T_) + 4 < nt) && !(PVAR & 1), dmav_ = ((T_) + 3 < nt) && !(PVAR & 1); \
        if (dmak_) DB_DMAK((T_) + 4); \
        if (dmav_) DB_DMAV((T_) + 3); \
        if ((SN_) && !(PVAR & 4)) DA_SMAT(SB); \
        if ((PV_) && !(PVAR & 4)) { \
            const ldsp vb_ = lds + DB_V + vr * DB_TSZ; vr = (vr == 4) ? 0 : vr + 1; \
            _Pragma("unroll") for (int k2 = 0; k2 < 2; ++k2) { \
                _Pragma("unroll") for (int e = 0; e < 8; ++e) { const bf16x8 vf = lds_frag_tr2(vb_ + vco[e] + (32 * k2) * 256, vb_ + vco[e] + (32 * k2 + 16) * 256); \
                    MFMA16(o[0][e], __builtin_bit_cast(bf16x8, pk[0][k2]), vf); MFMA16(o[1][e], __builtin_bit_cast(bf16x8, pk[1][k2]), vf); } \
                MFMA16(o[0][8], __builtin_bit_cast(bf16x8, pk[0][k2]), ones); MFMA16(o[1][8], __builtin_bit_cast(bf16x8, pk[1][k2]), ones); } \
        } \
        if (!(PVAR & 2)) { \
            const int k0 = 64 * (T_); \
            _Pragma("unroll") for (int rt = 0; rt < 2; ++rt) { \
                if (FAR_) { \
                    _Pragma("unroll") for (int n = 0; n < 4; ++n) \
                        _Pragma("unroll") for (int i = 0; i < 4; ++i) SA[rt][n][i] = __builtin_amdgcn_exp2f(SA[rt][n][i]); \
                } else { \
                    const int row = row0 + 16 * rt + fr; \
                    _Pragma("unroll") for (int n = 0; n < 4; ++n) \
                        _Pragma("unroll") for (int i = 0; i < 4; ++i) { const int dist = row - (k0 + 16 * n + 4 * fq + i); const int di = min(max(dist, 0), 127); const float bb = BT[di]; \
                            const float pen = dist < 0 ? -INFINITY : 0.f; SA[rt][n][i] = __builtin_amdgcn_exp2f((SA[rt][n][i] + bb) + pen); } \
                } \
            } \
        } \
        _Pragma("unroll") for (int rt = 0; rt < 2; ++rt) \
            _Pragma("unroll") for (int k2 = 0; k2 < 2; ++k2) { pk[rt][k2].x = pk2(SA[rt][2 * k2][0], SA[rt][2 * k2][1]); pk[rt][k2].y = pk2(SA[rt][2 * k2][2], SA[rt][2 * k2][3]); \
                pk[rt][k2].z = pk2(SA[rt][2 * k2 + 1][0], SA[rt][2 * k2 + 1][1]); pk[rt][k2].w = pk2(SA[rt][2 * k2 + 1][2], SA[rt][2 * k2 + 1][3]); } \
        if (dmak_) asm volatile("s_waitcnt vmcnt(10)" ::: "memory"); else asm volatile("s_waitcnt vmcnt(0)" ::: "memory"); \
        asm volatile("s_waitcnt lgkmcnt(0)" ::: "memory"); __builtin_amdgcn_s_barrier(); asm volatile("" ::: "memory"); \
    } while (0)
#define DA_FAST(T_, SA, SB) do { \
        if (!(PVAR & 1)) { DB_DMAK((T_) + 4); DB_DMAV((T_) + 3); } \
        const ldsp vb_ = lds + DB_V + vr * DB_TSZ; vr = (vr == 4) ? 0 : vr + 1; \
        const ldsp kb_ = lds + DB_K + kr * DB_TSZ; kr = (kr + 1) & 3; \
        bf16x8 vfr[3], kfr[4]; \
        vfr[0] = lds_frag_tr2(vb_ + vco[0], vb_ + vco[0] + 16 * 256); vfr[1] = lds_frag_tr2(vb_ + vco[1], vb_ + vco[1] + 16 * 256); \
        __builtin_amdgcn_sched_barrier(0); \
        _Pragma("unroll") for (int g = 0; g < 52; ++g) { \
            if (g < 32) { const int f = g >> 1, rt = g & 1, k2 = f >> 3, e = f & 7; MFMA16(o[rt][e], __builtin_bit_cast(bf16x8, pk[rt][k2]), vfr[f % 3]); } \
            else if (g < 36) { const int jj = g - 32, rt = jj & 1, k2 = jj >> 1; MFMA16(o[rt][8], __builtin_bit_cast(bf16x8, pk[rt][k2]), ones); } \
            else { const int jj = g - 36, n = jj >> 2, ks = (jj >> 1) & 1, rt = jj & 1; \
                if (ks == 0) SB[rt][n] = __builtin_amdgcn_mfma_f32_16x16x32_bf16(kfr[(n * 2 + ks) & 3], qf[rt][ks], cmv[rt], 0, 0, 0); \
                else MFMA16(SB[rt][n], qf[rt][ks], kfr[(n * 2 + ks) & 3]); } \
            if (g >= 2 && g < 34) { const int jj = g - 2, rt = jj >> 4, n = (jj >> 2) & 3, i = jj & 3; SA[rt][n][i] = __builtin_amdgcn_exp2f(SA[rt][n][i]); } \
            if (g >= 36) { const int q_ = g - 36, rt = q_ >> 3, k2 = (q_ >> 2) & 1, w = q_ & 3; pk[rt][k2][w] = pk2(SA[rt][2 * k2 + (w >> 1)][2 * (w & 1)], SA[rt][2 * k2 + (w >> 1)][2 * (w & 1) + 1]); } \
            if (g < 32 && !(g & 1) && (g >> 1) + 2 < 16) { const int f = (g >> 1) + 2, k2 = f >> 3, e = f & 7; vfr[f % 3] = lds_frag_tr2(vb_ + vco[e] + (32 * k2) * 256, vb_ + vco[e] + (32 * k2 + 16) * 256); } \
            if (g >= 30 && g < 46 && !(g & 1)) { const int c_ = (g - 30) >> 1, n = c_ >> 1, ks = c_ & 1; kfr[c_ & 3] = lds_frag(kb_ + kx[ks] + n * 4096); } \
            __builtin_amdgcn_sched_barrier(0); \
        } \
        if (!(PVAR & 1)) asm volatile("s_waitcnt vmcnt(10)" ::: "memory"); \
        asm volatile("s_waitcnt lgkmcnt(0)" ::: "memory"); __builtin_amdgcn_s_barrier(); asm volatile("" ::: "memory"); \
    } while (0)
    int t = 0;
#define DA_COPY() do { _Pragma("unroll") for (int rt = 0; rt < 2; ++rt) _Pragma("unroll") for (int n = 0; n < 4; ++n) s[rt][n] = sn[rt][n]; } while (0)
    if (nt >= 6) {
        DA_BODY(0, true, false, true, s, sn); DA_COPY();
        for (t = 1; t + 1 <= nt - 5; t += 2) { DA_FAST(t, s, sn); DA_FAST(t + 1, sn, s); }
        if (t <= nt - 5) { DA_FAST(t, s, sn); DA_COPY(); ++t; }
    }
    for (; t < nt; ++t) { const bool far = (q0 - 64 * t - 63) >= 113; DA_BODY(t, far, t > 0, t + 1 < nt, s, sn); DA_COPY(); }
#undef DA_COPY
#undef DA_BODY
#undef DA_FAST
    if (!(PVAR & 4)) {
        const ldsp vb_ = lds + DB_V + vr * DB_TSZ;
#pragma unroll
        for (int k2 = 0; k2 < 2; ++k2) {
#pragma unroll
            for (int e = 0; e < 8; ++e) { const bf16x8 vf = lds_frag_tr2(vb_ + vco[e] + (32 * k2) * 256, vb_ + vco[e] + (32 * k2 + 16) * 256);
                MFMA16(o[0][e], __builtin_bit_cast(bf16x8, pk[0][k2]), vf); MFMA16(o[1][e], __builtin_bit_cast(bf16x8, pk[1][k2]), vf); }
            MFMA16(o[0][8], __builtin_bit_cast(bf16x8, pk[0][k2]), ones); MFMA16(o[1][8], __builtin_bit_cast(bf16x8, pk[1][k2]), ones); }
    }
    asm volatile("s_waitcnt lgkmcnt(0)" ::: "memory"); __builtin_amdgcn_s_barrier(); asm volatile("" ::: "memory");
#undef DB_DMAK
#undef DB_DMAV
#undef DA_SMAT
    float inv[2];
#pragma unroll
    for (int rt = 0; rt < 2; ++rt) inv[rt] = 1.0f / o[rt][8][0];
    LAS float* XCH = (LAS float*)(lds + DB_XCH) + rg * (32 * 132);
    if (m == 1) {
#pragma unroll
        for (int rt = 0; rt < 2; ++rt) { const float f = lam * inv[rt];
#pragma unroll
            for (int e = 0; e < 8; ++e) *(LAS f32x4*)(XCH + (16 * rt + fr) * 132 + 16 * e + 4 * fq) = o[rt][e] * f; }
    }
    __syncthreads();
    if (m == 0) {
        f32x4 dnw[8];
#pragma unroll
        for (int e = 0; e < 8; ++e) dnw[e] = *(const f32x4*)(diff_norm + 16 * e + 4 * fq);
#pragma unroll
        for (int rt = 0; rt < 2; ++rt) { float ssq = 0.f;
#pragma unroll
            for (int e = 0; e < 8; ++e) { const f32x4 x2 = *(const LAS f32x4*)(XCH + (16 * rt + fr) * 132 + 16 * e + 4 * fq); const f32x4 v = o[rt][e] * inv[rt] - x2; o[rt][e] = v;
                ssq += (v[0] * v[0] + v[1] * v[1]) + (v[2] * v[2] + v[3] * v[3]); }
            ssq = quad_sum(ssq);
            const float rs = 0.8f / sqrtf(ssq * (1.f / 128.f) + EPS);
            bf16* orow = OUT + (rowbase + row0 + 16 * rt + fr) * opitch + h * 128;
#pragma unroll
            for (int e = 0; e < 8; ++e) { const f32x4 dn = dnw[e]; v2u w;
                w.x = pk2(o[rt][e][0] * rs * dn[0], o[rt][e][1] * rs * dn[1]); w.y = pk2(o[rt][e][2] * rs * dn[2], o[rt][e][3] * rs * dn[3]);
                *(v2u*)(orow + 16 * e + 4 * fq) = w; } }
    }
    __syncthreads();
}

constexpr int SW_KS = 0, SW_VS = 36864, SW_BT = 73728;
__device__ __forceinline__ void swa_unit(ldsp lds, const bf16* PROJ1, bf16* OUT  , int opitch, const float* rel_bias, const float* sinks, int b, int blk, int g, int tid, int lane, int wave) {
    asm volatile("" : "+v"(tid), "+v"(lane));
    const int fr = lane & 15, fq = lane >> 4, trq = (lane & 15) >> 2, trp = lane & 3;
    const size_t rowbase = (size_t)b * SEQ; const int qi = 16 * wave + fr;
    const bf16* prow = PROJ1 + (rowbase + blk * 128 + qi) * NPROJ1; bf16* orow = OUT + (rowbase + blk * 128 + qi) * opitch;
    bf16x8 qn[2];
#pragma unroll
    for (int ks = 0; ks < 2; ++ks) qn[ks] = *(const bf16x8*)(prow + C1_SQ + (4 * g) * 64 + ks * 32 + fq * 8);
    LAS float* BT = (LAS float*)(lds + SW_BT);
    { const int r = tid >> 7, d = tid & 127; BT[tid] = rel_bias[t5_bucket(d) * 8 + 4 * g + r] * LOG2E; }
#pragma unroll
    for (int i = 0; i < 4; ++i) { const int idx = tid + 512 * i, key = idx >> 3, ch = idx & 7; const int kp = blk * 128 - 128 + key;
        v4u kv = {0u, 0u, 0u, 0u}, vv = kv;
        if (kp >= 0) { const bf16* p = PROJ1 + (rowbase + kp) * NPROJ1 + g * 64 + ch * 8; kv = *(const v4u*)(p + C1_SK); vv = *(const v4u*)(p + C1_SV); }
        *(LAS v4u*)(lds + SW_KS + key * 144 + ch * 16) = kv; *(LAS v4u*)(lds + SW_VS + key * 144 + ch * 16) = vv; }
    __syncthreads();
    const float SC = 0.125f * LOG2E;
#pragma unroll 1
    for (int r = 0; r < 4; ++r) {
        const float skr = sinks[4 * g + r] * LOG2E;
        bf16x8 qc[2] = {qn[0], qn[1]};
        if (r < 3) {
#pragma unroll
            for (int ks = 0; ks < 2; ++ks) qn[ks] = *(const bf16x8*)(prow + C1_SQ + (4 * g + r + 1) * 64 + ks * 32 + fq * 8); }
        f32x4 s[10];
#pragma unroll
        for (int nn = 0; nn < 9; ++nn) { const int n = wave + nn; bf16x8 kf[2];
#pragma unroll
            for (int ks = 0; ks < 2; ++ks) kf[ks] = lds_frag(lds + SW_KS + (16 * n + fr) * 144 + (ks * 32 + fq * 8) * 2);
            s[nn] = (f32x4){0.f, 0.f, 0.f, 0.f}; MFMA16(s[nn], qc[0], kf[0]); MFMA16(s[nn], qc[1], kf[1]); }
        s[9] = (f32x4){0.f, 0.f, 0.f, 0.f};
        float mx = skr;
#pragma unroll
        for (int nn = 0; nn < 9; ++nn)
#pragma unroll
            for (int i = 0; i < 4; ++i) { const int j = 16 * (wave + nn) + 4 * fq + i, dist = qi + 128 - j; const bool valid = (dist >= 0) && (dist < 128) && (blk * 128 - 128 + j >= 0);
                const float bb = BT[r * 128 + min(max(dist, 0), 127)]; const float pen = valid ? 0.f : -INFINITY; const float v = (s[nn][i] * SC + bb) + pen; s[nn][i] = v; mx = fmaxf(mx, v); }
        mx = quad_max(mx);
        float psum = 0.f;
#pragma unroll
        for (int nn = 0; nn < 9; ++nn)
#pragma unroll
            for (int i = 0; i < 4; ++i) { const float p = __builtin_amdgcn_exp2f(s[nn][i] - mx); s[nn][i] = p; psum += p; }
        const float il = 1.0f / (quad_sum(psum) + __builtin_amdgcn_exp2f(skr - mx));
        f32x4 o[4];
#pragma unroll
        for (int e = 0; e < 4; ++e) o[e] = (f32x4){0.f, 0.f, 0.f, 0.f};
#pragma unroll
        for (int k2 = 0; k2 < 5; ++k2) { v4u pkv; pkv.x = pk2(s[2 * k2][0] * il, s[2 * k2][1] * il); pkv.y = pk2(s[2 * k2][2] * il, s[2 * k2][3] * il);
            pkv.z = pk2(s[2 * k2 + 1][0] * il, s[2 * k2 + 1][1] * il); pkv.w = pk2(s[2 * k2 + 1][2] * il, s[2 * k2 + 1][3] * il);
            const int r0 = 16 * (wave + 2 * k2) + 4 * fq + trq, r1 = min(r0 + 16, 255);
#pragma unroll
            for (int e = 0; e < 4; ++e) { const bf16x8 vf = lds_frag_tr2(lds + SW_VS + r0 * 144 + (16 * e + 4 * trp) * 2, lds + SW_VS + r1 * 144 + (16 * e + 4 * trp) * 2);
                MFMA16(o[e], __builtin_bit_cast(bf16x8, pkv), vf); } }
#pragma unroll
        for (int e = 0; e < 4; ++e) { v2u w; w.x = pk2(o[e][0], o[e][1]); w.y = pk2(o[e][2], o[e][3]); *(v2u*)(orow + (4 * g + r) * 64 + 16 * e + 4 * fq) = w; }
    }
    __syncthreads();
}

__device__ __forceinline__ float ret_log2_gamma(int h) { return log2f(1.0f - exp2f(-5.0f - (float)h)); }
__device__ __forceinline__ void rope_row_store(const bf16* src  , const float* COS, const float* SIN, int pos, int q4, float scale, ldsp dst) {
    v4u lo[2], hi[2];
#pragma unroll
    for (int i = 0; i < 2; ++i) { lo[i] = *(const v4u*)(src + 16 * q4 + 8 * i); hi[i] = *(const v4u*)(src + 64 + 16 * q4 + 8 * i); }
    const float* cp = COS + (size_t)pos * 64 + 16 * q4; const float* sp = SIN + (size_t)pos * 64 + 16 * q4;
#pragma unroll
    for (int i = 0; i < 2; ++i) { v4u ol, oh;
#pragma unroll
        for (int j = 0; j < 4; ++j) { const f32x4 cc = *(const f32x4*)(cp + 8 * i + 4 * (j >> 1)), ss = *(const f32x4*)(sp + 8 * i + 4 * (j >> 1));
            const float c0 = cc[2 * (j & 1)], c1 = cc[2 * (j & 1) + 1], s0 = ss[2 * (j & 1)], s1 = ss[2 * (j & 1) + 1];
            const float a0 = __uint_as_float(lo[i][j] << 16), a1 = __uint_as_float(lo[i][j] & 0xffff0000u), b0 = __uint_as_float(hi[i][j] << 16), b1 = __uint_as_float(hi[i][j] & 0xffff0000u);
            ol[j] = pk2((a0 * c0 - b0 * s0) * scale, (a1 * c1 - b1 * s1) * scale); oh[j] = pk2((a0 * s0 + b0 * c0) * scale, (a1 * s1 + b1 * c1) * scale); }
        *(LAS v4u*)(dst + (16 * q4 + 8 * i) * 2) = ol; *(LAS v4u*)(dst + (64 + 16 * q4 + 8 * i) * 2) = oh; }
}
constexpr int RA_VS = 0, RA_KS = 67584;
__device__ __forceinline__ void retA_unit(ldsp lds, const bf16* PROJ1, const float* COS, const float* SIN, bf16* ST, int u, int tid, int lane, int wave) {
    asm volatile("" : "+v"(tid), "+v"(lane));
    const int h = u & 3, c = (u >> 2) & 63, b = u >> 8, t0 = b * SEQ + c * 128;
    const int fr = lane & 15, fq = lane >> 4, trq = (lane & 15) >> 2, trp = lane & 3;
    const float lg = ret_log2_gamma(h);
#pragma unroll
    for (int i = 0; i < 8; ++i) { const int idx = tid + 512 * i, rw = idx >> 5, ch = idx & 31;
        *(LAS v4u*)(lds + RA_VS + rw * 528 + ch * 16) = *(const v4u*)(PROJ1 + (size_t)(t0 + rw) * NPROJ1 + C1_RV + h * 256 + ch * 8); }
    { const int s = tid >> 2, q4 = tid & 3;
      rope_row_store(PROJ1 + (size_t)(t0 + s) * NPROJ1 + C1_RK + h * 128, COS, SIN, c * 128 + s, q4, 0.08838834764831845f * exp2f((float)(127 - s) * lg), lds + RA_KS + s * 272); }
    __syncthreads();
    f32x4 acc[2][8];
#pragma unroll
    for (int j = 0; j < 2; ++j)
#pragma unroll
        for (int n = 0; n < 8; ++n) acc[j][n] = (f32x4){0.f, 0.f, 0.f, 0.f};
    bf16x8 fa[2][2], fb[2][8];
#define RA_READ(ks_, buf_) do { _Pragma("unroll") for (int j = 0; j < 2; ++j) fa[buf_][j] = lds_frag_tr(lds + RA_VS + (32 * (ks_) + 8 * fq + trq) * 528 + ((2 * wave + j) * 16 + 4 * trp) * 2, 528); \
        _Pragma("unroll") for (int n = 0; n < 8; ++n) fb[buf_][n] = lds_frag_tr(lds + RA_KS + (32 * (ks_) + 8 * fq + trq) * 272 + (n * 16 + 4 * trp) * 2, 272); } while (0)
    RA_READ(0, 0);
#pragma unroll
    for (int ks = 0; ks < 4; ++ks) {
        if (ks < 3) RA_READ(ks + 1, (ks + 1) & 1);
        __builtin_amdgcn_sched_barrier(0);
#pragma unroll
        for (int n = 0; n < 8; ++n) { MFMA16(acc[0][n], fa[ks & 1][0], fb[ks & 1][n]); MFMA16(acc[1][n], fa[ks & 1][1], fb[ks & 1][n]); }
        __builtin_amdgcn_sched_barrier(0);
    }
#undef RA_READ
    bf16* so = ST + ((size_t)((b * 64 + c) * 4 + h) * 256) * 128;
#pragma unroll
    for (int j = 0; j < 2; ++j)
#pragma unroll
        for (int n = 0; n < 8; ++n) { v2u w; w.x = pk2(acc[j][n][0], acc[j][n][1]); w.y = pk2(acc[j][n][2], acc[j][n][3]);
            *(v2u*)(so + (size_t)((2 * wave + j) * 16 + fr) * 128 + n * 16 + 4 * fq) = w; }
    __syncthreads();
}
__device__ __forceinline__ void ret_scan(bf16* ST, int gtid, int gthreads) {
    for (int e = gtid; e < 131072; e += gthreads) {
        const int b = e >> 16, rem = e & 65535, h = rem >> 14, ed = rem & 16383;
        unsigned* p = (unsigned*)ST + ((size_t)(b * 64) * 4 + h) * 16384 + ed; const float dec = exp2f(128.0f * ret_log2_gamma(h));
        float c0 = 0.f, c1 = 0.f;
#pragma unroll 1
        for (int hf = 0; hf < 2; ++hf) {
            unsigned v[32]; unsigned* pb = p + (size_t)hf * 32 * 4 * 16384;
            { const unsigned* q = pb;
#pragma unroll
              for (int c = 0; c < 32; ++c) { v[c] = *q; q += 4 * 16384; asm volatile("" : "+v"(q)); } }
#pragma unroll
            for (int c = 0; c < 32; ++c) { const unsigned o = pk2(c0, c1); c0 = c0 * dec + __uint_as_float(v[c] << 16); c1 = c1 * dec + __uint_as_float(v[c] & 0xffff0000u); v[c] = o; }
            { unsigned* q = pb;
#pragma unroll
              for (int c = 0; c < 32; ++c) { *q = v[c]; q += 4 * 16384; asm volatile("" : "+v"(q)); } }
        }
    }
}
constexpr int RC_KS = 0, RC_VS = 34816, RC_SP = 102400;
template <int PV> __device__ __forceinline__ void retC_unit(ldsp lds, const bf16* PROJ1, bf16* OUT  , int opitch, const float* COS, const float* SIN, const bf16* ST, int u, int tid, int lane, int wave) {
    asm volatile("" : "+v"(tid), "+v"(lane));
    const int h = u & 3, c = (u >> 2) & 63, b = u >> 8, t0 = b * SEQ + c * 128;
    const int fr = lane & 15, fq = lane >> 4, trq = (lane & 15) >> 2, trp = lane & 3;
    const float lg = ret_log2_gamma(h);
    const int l = 16 * wave + fr; const bf16* prow = PROJ1 + (size_t)(t0 + l) * NPROJ1; bf16* orow = OUT + (size_t)(t0 + l) * opitch;
    if (!(PV & 1)) {
#pragma unroll
    for (int i = 0; i < 8; ++i) { const int idx = tid + 512 * i, rw = idx >> 5, ch = idx & 31;
        *(LAS v4u*)(lds + RC_VS + rw * 528 + ch * 16) = *(const v4u*)(PROJ1 + (size_t)(t0 + rw) * NPROJ1 + C1_RV + h * 256 + ch * 8); }
    }
    if (!(PV & 1)) { const int s = tid >> 2, q4 = tid & 3;
      rope_row_store(PROJ1 + (size_t)(t0 + s) * NPROJ1 + C1_RK + h * 128, COS, SIN, c * 128 + s, q4, 0.08838834764831845f, lds + RC_KS + s * 272); }
    bf16x8 qf[4], qx[4];
    { v4u raw[4];
#pragma unroll
      for (int ks = 0; ks < 4; ++ks) raw[ks] = *(const v4u*)(prow + C1_RQ + h * 128 + 32 * ks + 8 * fq);
      const float xi = exp2f((float)(l + 1) * lg);
#pragma unroll
      for (int k2 = 0; k2 < 2; ++k2) { const float* cp = COS + (size_t)(c * 128 + l) * 64 + 32 * k2 + 8 * fq; const float* sp = SIN + (size_t)(c * 128 + l) * 64 + 32 * k2 + 8 * fq;
          v4u o1, o2, x1, x2;
#pragma unroll
          for (int j = 0; j < 4; ++j) { const f32x4 cc = *(const f32x4*)(cp + 4 * (j >> 1)), ss = *(const f32x4*)(sp + 4 * (j >> 1));
              const float c0 = cc[2 * (j & 1)], c1 = cc[2 * (j & 1) + 1], s0 = ss[2 * (j & 1)], s1 = ss[2 * (j & 1) + 1];
              const float a0 = __uint_as_float(raw[k2][j] << 16), a1 = __uint_as_float(raw[k2][j] & 0xffff0000u), b0 = __uint_as_float(raw[k2 + 2][j] << 16), b1 = __uint_as_float(raw[k2 + 2][j] & 0xffff0000u);
              const float r10 = a0 * c0 - b0 * s0, r11 = a1 * c1 - b1 * s1, r20 = a0 * s0 + b0 * c0, r21 = a1 * s1 + b1 * c1;
              o1[j] = pk2(r10, r11); o2[j] = pk2(r20, r21); x1[j] = pk2(r10 * xi, r11 * xi); x2[j] = pk2(r20 * xi, r21 * xi); }
          qf[k2] = __builtin_bit_cast(bf16x8, o1); qf[k2 + 2] = __builtin_bit_cast(bf16x8, o2); qx[k2] = __builtin_bit_cast(bf16x8, x1); qx[k2 + 2] = __builtin_bit_cast(bf16x8, x2); } }
    __syncthreads();
    f32x4 sc[8];
#pragma unroll
    for (int n = 0; n < 8; ++n) { sc[n] = (f32x4){0.f, 0.f, 0.f, 0.f};
#pragma unroll
        for (int ks = 0; ks < 4; ++ks) { const bf16x8 kf = lds_frag(lds + RC_KS + (16 * n + fr) * 272 + 64 * ks + 16 * fq); MFMA16(sc[n], qf[ks], kf); } }
    __syncthreads();
#pragma unroll
    for (int n = 0; n < 8; ++n) { float mv[4];
#pragma unroll
        for (int i = 0; i < 4; ++i) { const int s = 16 * n + 4 * fq + i; mv[i] = (s <= l) ? sc[n][i] * __builtin_amdgcn_exp2f((float)(l - s) * lg) : 0.f; }
        v2u w; w.x = pk2(mv[0], mv[1]); w.y = pk2(mv[2], mv[3]); *(LAS v2u*)(lds + RC_KS + l * 272 + (16 * n + 4 * fq) * 2) = w; }
    f32x4 o[16];
#pragma unroll
    for (int e = 0; e < 16; ++e) o[e] = (f32x4){0.f, 0.f, 0.f, 0.f};
    v2u gts[16];
#pragma unroll
    for (int e = 0; e < 16; ++e) gts[e] = *(const v2u*)(prow + C1_RG + h * 256 + 16 * e + 4 * fq);
    const bf16* sp = ST + ((size_t)((b * 64 + c) * 4 + h) * 256) * 128;
    const int sprow = tid >> 2, spc = tid & 3;
    v4u spr[2];
#pragma unroll
    for (int i = 0; i < 2; ++i) spr[i] = *(const v4u*)(sp + (size_t)(sprow + 128 * i) * 128 + spc * 8);
#pragma unroll
    for (int ks = 0; ks < ((PV & 2) ? 0 : 4); ++ks) {
        const ldsp slot = lds + RC_SP + (ks & 1) * 20480;
#pragma unroll
        for (int i = 0; i < 2; ++i) *(LAS v4u*)(slot + (sprow + 128 * i) * 80 + spc * 16) = spr[i];
        if (ks < 3) {
#pragma unroll
            for (int i = 0; i < 2; ++i) spr[i] = *(const v4u*)(sp + (size_t)(sprow + 128 * i) * 128 + 32 * (ks + 1) + spc * 8); }
        __syncthreads();
        const bf16x8 mf = lds_frag(lds + RC_KS + l * 272 + 64 * ks + 16 * fq);
#pragma unroll
        for (int eh = 0; eh < 2; ++eh) { bf16x8 sf[8], vf[8];
#pragma unroll
            for (int e = 0; e < 8; ++e) { sf[e] = lds_frag(slot + (16 * (8 * eh + e) + fr) * 80 + 16 * fq);
                vf[e] = lds_frag_tr(lds + RC_VS + (32 * ks + 8 * fq + trq) * 528 + (16 * (8 * eh + e) + 4 * trp) * 2, 528); }
            __builtin_amdgcn_sched_barrier(0);
#pragma unroll
            for (int e = 0; e < 8; ++e) { MFMA16(o[8 * eh + e], qx[ks], sf[e]); MFMA16(o[8 * eh + e], mf, vf[e]); }
            __builtin_amdgcn_sched_barrier(0); }
    }
    float ssq = 0.f;
#pragma unroll
    for (int e = 0; e < 16; ++e) ssq += (o[e][0] * o[e][0] + o[e][1] * o[e][1]) + (o[e][2] * o[e][2] + o[e][3] * o[e][3]);
    ssq += __shfl_xor(ssq, 16); ssq += __shfl_xor(ssq, 32);
    const float rs = 1.0f / sqrtf(ssq * (1.f / 256.f) + EPS);
#pragma unroll
    for (int e = 0; e < 16; ++e) { const v2u gw_ = gts[e];
        const float g0 = __uint_as_float(gw_.x << 16), g1 = __uint_as_float(gw_.x & 0xffff0000u), g2 = __uint_as_float(gw_.y << 16), g3 = __uint_as_float(gw_.y & 0xffff0000u);
        v2u w; w.x = pk2(o[e][0] * rs * silu_f(g0), o[e][1] * rs * silu_f(g1)); w.y = pk2(o[e][2] * rs * silu_f(g2), o[e][3] * rs * silu_f(g3)); *(v2u*)(orow + h * 256 + 16 * e + 4 * fq) = w; }
    __syncthreads();
}

#ifndef MK_PER_PHASE
#define MK_PER_PHASE 0
#endif
constexpr int N_PHASES = 21;
#ifndef PROBE_G
#define PROBE_G 0u
#endif
#ifndef PROBE_BAR
#define PROBE_BAR 0
#endif
#ifndef PROBE_VAR
#define PROBE_VAR 0
#endif
#ifndef PROBE_REP
#define PROBE_REP 0u
#endif
struct Args { const float* in[N_IN]; float* out; unsigned char* ws; int ph_lo, ph_hi, pad0, pad1; };
__global__ void __launch_bounds__(NTHR, 2) trunk_fwd(Args args) {
    extern __shared__ __attribute__((aligned(16))) unsigned char lds_raw[];
    const ldsp lds = (ldsp)lds_raw;
    volatile LAS unsigned* MISC = (volatile LAS unsigned*)(lds + MISC_OFF);
    const int tid = threadIdx.x, lane = tid & 63, wave = __builtin_amdgcn_readfirstlane(tid >> 6);
    const int G = gridDim.x; const int bx = blockIdx.x; const int vcu = (G % 8 == 0) ? (bx % 8) * (G / 8) + bx / 8 : bx;
    const int gw = vcu * NWAVES + wave, NGW = G * NWAVES, gtid = vcu * NTHR + tid, gthreads = G * NTHR;
    unsigned char* ws = args.ws;
    gu32* ctl = (gu32*)(ws + WS_CTL);
    for (int u = tid; u < 64; u += NTHR) MISC[u] = 0u;
    __syncthreads();
    XcdBarrier bar; bar.bar = (unsigned*)(ctl + CW_BAR); bar.x = 0; bar.st = nullptr;
    if (!MK_PER_PHASE) bar = xcd_barrier_post((unsigned*)(ctl + CW_BAR), MISC + 8);
    const int lo = args.ph_lo, hi = args.ph_hi;
#define IN(k) (lo <= (k) && (k) < hi)
#define SEAM(k) do { if (IN(k) && IN((k) + 1)) { xcd_barrier<true>(bar); if (PROBE_BAR == 1) xcd_barrier<true>(bar); if (PROBE_BAR == 2) xcd_barrier<false>(bar); } } while (0)
#define REPS(k) (((PROBE_REP >> (k)) & 1u) ? 2 : 1)
    float* MOD = (float*)(ws + WS_MOD); bf16* WDT = (bf16*)(ws + WS_WDT); float* CHDEC = (float*)(ws + WS_CHDEC); float* SSQ = (float*)(ws + WS_SSQ);
    bf16* WMIX = (bf16*)(ws + WS_WMIX); bf16* WOUT0 = (bf16*)(ws + WS_WOUT0); bf16* WOUT1 = (bf16*)(ws + WS_WOUT1);
    bf16* PROJ0 = (bf16*)(ws + WS_PROJ0); bf16* XB = (bf16*)(ws + WS_XN2); bf16* XN2 = (bf16*)args.out;     bf16* W1T = (bf16*)(ws + WS_WMLP); bf16* W2T = (bf16*)(ws + WS_WMLP + 8 * MiB); bf16* W1T1 = (bf16*)((char*)args.out + 32 * MiB); bf16* W2T1 = (bf16*)(ws + WS_W2L1);
    bf16* HB = (bf16*)(ws + WS_H); bf16* PROJ1 = (bf16*)(ws + WS_H); bf16* SB = (bf16*)(ws + WS_S); float* DT = (float*)(ws + WS_DT);
    unsigned* KMAX = (unsigned*)(ws + WS_KMAX);
    float* COS = (float*)(ws + WS_ROPE); float* SIN = COS + 8192 * 64;
    const bool fuse = (G == 256) && !PROBE_REP && !PROBE_G;
    float* XCH1 = (float*)(ws + WS_XCH); float* XCH2 = (float*)(ws + WS_XCH + MiB); unsigned* TMO = (unsigned*)(ctl + CW_BAR) + XB_TMO;
    const float* x_in = args.in[I_X]; const float* ng = args.in[I_NG]; float* X = args.out;

    if (IN(0)) for (int rep0 = 0; rep0 < REPS(0); ++rep0) {
        const Seg segs[4] = { {args.in[I_EWIN], 6160, 0, 1024, 1024, WMIX, 0}, {args.in[I_EWIN], 6160, 3088, 3072, 1024, WMIX, 1024}, {args.in[I_EWIN], 6160, 1024, 2048, 1024, WMIX, 4096},
                              {args.in[I_EWOUT], 1024, 0, 1024, 2048, WOUT0, 0} };
        convert_set<4>(segs, lds, gw, NGW, wave, lane);
        for (int i = gtid; i < 16384; i += gthreads) { const int h = i >> 10, k = i & 1023; WDT[i] = f2bf(args.in[I_EWIN][(size_t)k * 6160 + 3072 + h]); }
        for (int i = gtid; i < 8192 * 64; i += gthreads) { const int t = i >> 6, f = i & 63; const float inv = powf(10000.0f, -(float)f * (1.0f / 64.0f)); const float ang = (float)t * inv;
            const double a = (double)ang; const double n = rint(a * 0.15915494309189535); const float r = (float)(a - n * 6.283185307179586); COS[i] = __cosf(r); SIN[i] = __sinf(r); }
        __syncthreads();
        mod_phase(args.in[I_C], args.in[I_MODW], args.in[I_MODB], MOD, lds, tid, lane, wave);
    }
    SEAM(0);
    if (IN(1)) for (int rep1 = 0; rep1 < REPS(1); ++rep1) norm_rows<-1, 0, false, 0>(x_in, nullptr, nullptr, SB, MOD, ng, gw, NGW, lane);
    SEAM(1);
    if (IN(2)) {
        pg8::Gemm g{SB, WMIX, MTOK, NPROJ0, DM, DM}; pg8::StaticOrder S; S.init(MTOK, NPROJ0, G, bx);
        pg8::EpiBf16<0> E{PROJ0, NPROJ0, nullptr, 0, 0, 1.f};
        if ((PROBE_G >> 2) & 1u) { pg8::gemm_phase<pg8::EpiBf16<0>, pg8::StaticOrder, true, true>(lds, g, S, E); __syncthreads(); } pg8::gemm_phase<pg8::EpiBf16<0>, pg8::StaticOrder, true, true>(lds, g, S, E);
        dt_phase(SB, WDT, args.in[I_EDTB], DT, gw, NGW, lane);
    }
    SEAM(2);
    if (IN(3)) { kmax_rows(PROJ0, KMAX, gw, NGW, lane);
        for (int rep = 0; rep < REPS(3); ++rep) for (int u = vcu; u < 512; u += G) ssdA_unit(lds, PROJ0, DT, args.in[I_ECONVW], args.in[I_ECONVB], args.in[I_EALOG], SB, CHDEC, u, tid, lane, wave); }
    SEAM(3);
    if (IN(4)) ssd_scan(SB, CHDEC, gtid, gthreads);
    SEAM(4);
    if (IN(5)) { for (int rep = 0; rep < REPS(5); ++rep) for (int u = vcu; u < 512; u += G) { if (rep + 1 < REPS(5)) ssdC_unit<(PROBE_VAR < 32 ? PROBE_VAR : 0)>(lds, PROJ0, (bf16*)args.out, 1024, DT, args.in[I_ECONVW], args.in[I_ECONVB], args.in[I_EALOG], args.in[I_ED], args.in[I_ESSDN], SB, SSQ, u, tid, lane, wave); else ssdC_unit<0>(lds, PROJ0, PROJ0 + C0_Z, NPROJ0, DT, args.in[I_ECONVW], args.in[I_ECONVB], args.in[I_EALOG], args.in[I_ED], args.in[I_ESSDN], SB, SSQ, u, tid, lane, wave); } }
    SEAM(5);
    if (IN(6)) {
        ssd_normalize_rows(PROJ0, SSQ, gw, NGW, lane);
        const float* lm = args.in[I_ELAM];
        const float lam = expf(wave_sum(lm[lane] * lm[64 + lane])) - expf(wave_sum(lm[128 + lane] * lm[192 + lane])) + 0.2f;
        __syncthreads();
        for (int rep = 0; rep < REPS(6); ++rep)
        for (int u = vcu; u < 1024; u += G) { const int v = u & 255, i = u >> 8, j = v & 15, bh = v >> 4; const int qb = i == 0 ? j : (i == 1 ? 63 - j : (i == 2 ? 16 + j : 47 - j));
            if (PROBE_VAR >= 16 && rep + 1 < REPS(6)) { }
            else if (rep + 1 < REPS(6)) dattn5_unit<PROBE_VAR < 16 ? PROBE_VAR : 0>(lds, PROJ0, (bf16*)args.out, 1024, args.in[I_RELB], args.in[I_EDIFFN], KMAX, lam, bh >> 3, bh & 7, qb, tid, lane, wave);
            else dattn5_unit<0>(lds, PROJ0, PROJ0 + C0_Q, NPROJ0, args.in[I_RELB], args.in[I_EDIFFN], KMAX, lam, bh >> 3, bh & 7, qb, tid, lane, wave); }
    }
    SEAM(6);
    if (IN(7)) {
        pg8::Gemm g{PROJ0, WOUT0, MTOK, DM, 2048, NPROJ0}; pg8::StaticOrder S; S.init(MTOK, DM, G, bx);
        if (fuse) { pg8::EpiNorm<0, 1, false, 1> EN{x_in, SB  , XN2, MOD, ng, {XCH1, (unsigned*)ctl + 0 * 512, TMO}, {XCH2, (unsigned*)ctl + 1 * 512, TMO}, EPS};
            pg8::gemm_phase<pg8::EpiNorm<0, 1, false, 1>, pg8::StaticOrder, true, true>(lds, g, S, EN); } else {
        pg8::EpiBf16<0> E{SB, DM, nullptr, 0, 0, 1.f};
        if ((PROBE_G >> 7) & 1u) { pg8::gemm_phase<pg8::EpiBf16<0>, pg8::StaticOrder, true, true>(lds, g, S, E); __syncthreads(); } pg8::gemm_phase<pg8::EpiBf16<0>, pg8::StaticOrder, true, true>(lds, g, S, E); }
    }
    SEAM(7);
    if (IN(8)) {
        const Seg segs[8] = { {args.in[I_W1], 4096, 0, 4096, 1024, W1T, 0}, {args.in[I_W2], 1024, 0, 1024, 4096, W2T, 0},
                              {args.in[I_OWIN], 3840, 2048, 1536, 1024, WMIX, 0}, {args.in[I_OWIN], 3840, 0, 2048, 1024, WMIX, 1536}, {args.in[I_OWIN], 3840, 3584, 256, 1024, WMIX, 3584},
                              {args.in[I_OWOUT], 1024, 0, 1024, 1536, WOUT1, 0},
                              {args.in[I_W1] + (size_t)DM * FF, 4096, 0, 4096, 1024, W1T1, 0}, {args.in[I_W2] + (size_t)DM * FF, 1024, 0, 1024, 4096, W2T1, 0} };
        convert_set<8>(segs, lds, gw, NGW, wave, lane);
        if (!fuse) norm_rows<0, 1, false, 1>(x_in, SB, XB, XN2, MOD, ng, gw, NGW, lane);
    }
    SEAM(8);
    if (IN(9)) {
        pg8::Gemm g{XN2, W1T, MTOK, FF, DM, DM}; pg8::StaticOrder S; S.init(MTOK, FF, G, bx);
        pg8::EpiBf16<2> E{HB, FF, nullptr, 0, 0, 1.f};
        if ((PROBE_G >> 9) & 1u) { pg8::gemm_phase<pg8::EpiBf16<2>, pg8::StaticOrder, true, true>(lds, g, S, E); __syncthreads(); } pg8::gemm_phase<pg8::EpiBf16<2>, pg8::StaticOrder, true, true>(lds, g, S, E);
    }
    SEAM(9);
    if (IN(10)) {
        pg8::Gemm g{HB, W2T, MTOK, DM, FF, FF}; pg8::StaticOrder S; S.init(MTOK, DM, G, bx);
        if (fuse) { pg8::EpiNorm<1, 2, true, 1> EN{SB, XB, XN2, MOD, ng, {XCH1, (unsigned*)ctl + 2 * 512, TMO}, {XCH2, (unsigned*)ctl + 3 * 512, TMO}, EPS};
            pg8::gemm_phase<pg8::EpiNorm<1, 2, true, 1>, pg8::StaticOrder, true, true>(lds, g, S, EN); } else {
        pg8::EpiBf16<0> E{SB, DM, nullptr, 0, 0, 1.f};
        if ((PROBE_G >> 10) & 1u) { pg8::gemm_phase<pg8::EpiBf16<0>, pg8::StaticOrder, true, true>(lds, g, S, E); __syncthreads(); } pg8::gemm_phase<pg8::EpiBf16<0>, pg8::StaticOrder, true, true>(lds, g, S, E); }
    }
    SEAM(10);
    if (!fuse) {
    if (IN(11)) norm_rows<1, 2, true, 1>(XB, SB, XB, XN2, MOD, ng, gw, NGW, lane);
    SEAM(11);
    }
    if (IN(12)) {
        pg8::Gemm g{XN2, WMIX, MTOK, NPROJ1, DM, DM}; pg8::StaticOrder S; S.init(MTOK, NPROJ1, G, bx);
        pg8::EpiBf16<0> E{PROJ1, NPROJ1, nullptr, 0, 0, 1.f};
        if ((PROBE_G >> 12) & 1u) { pg8::gemm_phase<pg8::EpiBf16<0>, pg8::StaticOrder, true, true>(lds, g, S, E); __syncthreads(); } pg8::gemm_phase<pg8::EpiBf16<0>, pg8::StaticOrder, true, true>(lds, g, S, E);
        }
    SEAM(12);
    if (IN(13)) {
        for (int rep = 0; rep < REPS(13); ++rep) {
        for (int u = vcu; u < 512; u += G) retA_unit(lds, PROJ1, COS, SIN, SB, u, tid, lane, wave);
        for (int u = vcu; u < 256; u += G) swa_unit(lds, PROJ1, (rep + 1 < REPS(13)) ? XN2 : PROJ1 + C1_SQ, (rep + 1 < REPS(13)) ? 1024 : NPROJ1, args.in[I_RELB], args.in[I_OSINK], u >> 7, (u >> 1) & 63, u & 1, tid, lane, wave); }
    }
    SEAM(13);
    if (IN(14)) ret_scan(SB, gtid, gthreads);
    SEAM(14);
    if (IN(15)) { for (int rep = 0; rep < REPS(15); ++rep) for (int u = vcu; u < 512; u += G) { if (rep + 1 < REPS(15)) retC_unit<(PROBE_VAR < 16 ? PROBE_VAR : 0)>(lds, PROJ1, XN2, 1024, COS, SIN, SB, u, tid, lane, wave); else retC_unit<0>(lds, PROJ1, PROJ1 + C1_RG, NPROJ1, COS, SIN, SB, u, tid, lane, wave); } }
    SEAM(15);
    if (IN(16)) {
        pg8::Gemm g{PROJ1, WOUT1, MTOK, DM, 1536, NPROJ1}; pg8::StaticOrder S; S.init(MTOK, DM, G, bx);
        if (fuse) { pg8::EpiNorm<2, 3, true, 1> EN{XB, XB, XN2, MOD, ng, {XCH1, (unsigned*)ctl + 4 * 512, TMO}, {XCH2, (unsigned*)ctl + 5 * 512, TMO}, EPS};
            pg8::gemm_phase<pg8::EpiNorm<2, 3, true, 1>, pg8::StaticOrder, true, true>(lds, g, S, EN); } else {
        pg8::EpiBf16<0> E{SB, DM, nullptr, 0, 0, 1.f};
        if ((PROBE_G >> 16) & 1u) { pg8::gemm_phase<pg8::EpiBf16<0>, pg8::StaticOrder, true, true>(lds, g, S, E); __syncthreads(); } pg8::gemm_phase<pg8::EpiBf16<0>, pg8::StaticOrder, true, true>(lds, g, S, E); }
    }
    SEAM(16);
    if (!fuse) {
    if (IN(17)) norm_rows<2, 3, true, 1>(XB, SB, XB, XN2, MOD, ng, gw, NGW, lane);
    SEAM(17);
    }
    if (IN(18)) {
        pg8::Gemm g{XN2, W1T1, MTOK, FF, DM, DM}; pg8::StaticOrder S; S.init(MTOK, FF, G, bx);
        pg8::EpiBf16<2> E{HB, FF, nullptr, 0, 0, 1.f};
        if ((PROBE_G >> 18) & 1u) { pg8::gemm_phase<pg8::EpiBf16<2>, pg8::StaticOrder, true, true>(lds, g, S, E); __syncthreads(); } pg8::gemm_phase<pg8::EpiBf16<2>, pg8::StaticOrder, true, true>(lds, g, S, E);
    }
    SEAM(18);
    if (IN(19)) {
        pg8::Gemm g{HB, W2T1, MTOK, DM, FF, FF}; pg8::StaticOrder S; S.init(MTOK, DM, G, bx);
        if (fuse) { pg8::EpiNorm<3, -1, true, 2> EN{XB, X, nullptr, MOD, ng, {XCH1, (unsigned*)ctl + 6 * 512, TMO}, {XCH2, (unsigned*)ctl + 7 * 512, TMO}, EPS};
            pg8::gemm_phase<pg8::EpiNorm<3, -1, true, 2>, pg8::StaticOrder, true, true>(lds, g, S, EN); } else {
        pg8::EpiBf16<0> E{SB, DM, nullptr, 0, 0, 1.f};
        if ((PROBE_G >> 19) & 1u) { pg8::gemm_phase<pg8::EpiBf16<0>, pg8::StaticOrder, true, true>(lds, g, S, E); __syncthreads(); } pg8::gemm_phase<pg8::EpiBf16<0>, pg8::StaticOrder, true, true>(lds, g, S, E); }
    }
    if (!fuse) {
    SEAM(19);
    if (IN(20)) norm_rows<3, -1, true, 2>(XB, SB, X, nullptr, MOD, ng, gw, NGW, lane);
    }
#undef IN
#undef SEAM
}

extern "C" void kernel_launch(void* const* d_in, const int* in_sizes, int n_in, void* d_out, int out_size, void* d_ws, size_t ws_size, hipStream_t stream) {
    static int grid = 0;
    if (grid == 0) {
        if (n_in != N_IN || out_size != MTOK * DM || ws_size < WS_END) { fprintf(stderr, "kernel_launch: unexpected shapes (n_in %d, out %d, ws %zu); nothing launched\n", n_in, out_size, ws_size); grid = -1; return; }
        int dev = 0, cus = 0, per_cu = 0;
        if (hipGetDevice(&dev) != hipSuccess || hipDeviceGetAttribute(&cus, hipDeviceAttributeMultiprocessorCount, dev) != hipSuccess) { grid = -1; return; }
        if (hipFuncSetAttribute((const void*)trunk_fwd, hipFuncAttributeMaxDynamicSharedMemorySize, LDS_BYTES) != hipSuccess) { fprintf(stderr, "kernel_launch: hipFuncSetAttribute failed\n"); grid = -1; return; }
        if (hipOccupancyMaxActiveBlocksPerMultiprocessor(&per_cu, (const void*)trunk_fwd, NTHR, LDS_BYTES) != hipSuccess || per_cu < 1) { fprintf(stderr, "kernel_launch: occupancy query says %d blocks per CU\n", per_cu); (void)hipGetLastError(); grid = -1; return; }
        grid = cus;
    }
    if (grid < 0) return;
    (void)hipMemsetAsync((char*)d_ws + WS_CTL, 0, CTL_ZERO_BYTES, stream);
    Args a{};
    for (int i = 0; i < N_IN; ++i) a.in[i] = (const float*)d_in[i];
    a.out = (float*)d_out; a.ws = (unsigned char*)d_ws;
#if MK_PER_PHASE
    for (int p = 0; p < N_PHASES; ++p) { a.ph_lo = p; a.ph_hi = p + 1; hipLaunchKernelGGL(trunk_fwd, dim3(grid), dim3(NTHR), LDS_BYTES, stream, a); }
#else
    a.ph_lo = 0; a.ph_hi = N_PHASES;
    hipLaunchKernelGGL(trunk_fwd, dim3(grid), dim3(NTHR), LDS_BYTES, stream, a);
#endif
}
```

```cpp
#include <hip/hip_runtime.h>
#include <cstdio>
#include <cstdint>
#include <cmath>
namespace pg8 {
#define PG8_LAS __attribute__((address_space(3)))
typedef unsigned short bf16_t;
typedef short bf16x8 __attribute__((ext_vector_type(8)));
typedef float f32x4 __attribute__((ext_vector_type(4)));
typedef unsigned u32x4 __attribute__((ext_vector_type(4)));
constexpr int BM = 256, BK = 64, HALF = 128, HTB = HALF * BK * 2  , STAGE_BYTES = 8 * HTB, NXCD = 8, WGM = 4;

__host__ __device__ __forceinline__ int lds_byte(int r, int c) { const int st = (r >> 4) * 2 + (c >> 5), rr = r & 15, cc = c & 31, ob = rr * 64 + cc * 2; return st * 1024 + (ob ^ (((ob >> 9) & 1) << 5)); }
__host__ __device__ __forceinline__ void stage_rc(int b, int& R, int& C) { const int st = b / 1024, sb = b % 1024, swz = sb ^ (((sb >> 9) & 1) << 5); R = (st >> 1) * 16 + swz / 64; C = (st & 1) * 32 + (swz % 64) / 2; }
__host__ __device__ __forceinline__ int perm32(int rho) { const int n = rho >> 4, i = rho & 15; return 8 * (i >> 2) + 4 * n + (i & 3); }

struct Unit { int pm, pn; };
struct Gemm { const bf16_t* A; const bf16_t* Bt; int M, N, K, lda; };

struct StaticOrder {
    int nM, nN, nwg, G, c;
    __host__ __device__ void init(int M, int N, int G_, int c_) { nM = M / BM; nN = N / BM; nwg = nM * nN; G = G_; c = c_; }
    __host__ __device__ bool next(int i, Unit& u) const {
        const long L = (long)i * G + c; if (L >= nwg) return false;
        int wgid = (int)L; { const int q = nwg / NXCD, r = nwg % NXCD, xcd = wgid % NXCD, off = wgid / NXCD; wgid = (xcd < r ? xcd * (q + 1) : r * (q + 1) + (xcd - r) * q) + off; }
        const int nig = WGM * nN, gid = wgid / nig, fm = gid * WGM, gsz = (nM - fm) < WGM ? (nM - fm) : WGM;
        u.pm = fm + ((wgid % nig) % gsz); u.pn = (wgid % nig) / gsz; return true;
    }
    __device__ __forceinline__ void a_ready(const Unit&) const {}
    __device__ __forceinline__ void done(const Unit&) const {}
};

__device__ __forceinline__ unsigned cvt_pk_bf16(float lo, float hi) { unsigned r; asm volatile("v_cvt_pk_bf16_f32 %0, %1, %2" : "=v"(r) : "v"(lo), "v"(hi)); return r; }
typedef float f32x2 __attribute__((ext_vector_type(2)));
__device__ __forceinline__ f32x2 gelu_pk(f32x2 v) {
    const f32x2 av = __builtin_elementwise_abs(v), d = av * 0.2316418882f + 1.0f;
    f32x2 t; t.x = __builtin_amdgcn_rcpf(d.x); t.y = __builtin_amdgcn_rcpf(d.y);
    f32x2 q = t * 0.5307027145f + (-0.7265760135f); q = q * t + 0.7107068705f; q = q * t + (-0.142248368f); q = q * t + 0.127414796f; q = q * t;
    const f32x2 s = (v * v) * (-0.72134752044f);
    f32x2 e; e.x = __builtin_amdgcn_exp2f(s.x); e.y = __builtin_amdgcn_exp2f(s.y);
    const f32x2 m = v * (q * e), r = v - m;
    f32x2 o; o.x = v.x < 0.f ? m.x : r.x; o.y = v.y < 0.f ? m.y : r.y; return o;
}

template <int ACT  > struct EpiBf16 {
    static constexpr bool PERM = true, AFTER_DRAIN = false; static_assert(ACT == 0 || ACT == 1 || ACT == 2, "EpiBf16: ACT is 0 (none), 1 (gelu_pk) or 2 (squared relu)");
    bf16_t* O; int ldc; const float* bias; int split_cols; size_t split_stride; float scale0;
    __device__ __forceinline__ void operator()(const f32x4 (&acc)[2][2][4][2], const Unit& u, int wr, int wc, int fr, int fq) const {
        const int row0 = u.pm * BM + wr * 64 + fr; int colt = u.pn * BM; bf16_t* base = O;
        float sc = 1.f; if (split_cols) { const int t = colt / split_cols; base += (size_t)t * split_stride; colt -= t * split_cols; if (t == 0) sc = scale0; }
        const int col0 = colt + wc * 32 + 8 * fq, bcol0 = u.pn * BM + wc * 32 + 8 * fq;
        f32x4 bv[2][2];
#pragma unroll
        for (int bj = 0; bj < 2; ++bj)
#pragma unroll
            for (int n = 0; n < 2; ++n) bv[bj][n] = bias ? *(const f32x4*)(bias + bcol0 + bj * HALF + 4 * n) : (f32x4){0.f, 0.f, 0.f, 0.f};
#pragma unroll
        for (int ai = 0; ai < 2; ++ai)
#pragma unroll
            for (int m = 0; m < 4; ++m) { bf16_t* rowp = base + (size_t)(row0 + ai * HALF + m * 16) * ldc + col0;
#pragma unroll
                for (int bj = 0; bj < 2; ++bj) { f32x4 v0 = acc[ai][bj][m][0] + bv[bj][0], v1 = acc[ai][bj][m][1] + bv[bj][1];
                    if (ACT == 1) { f32x2 a = gelu_pk((f32x2){v0[0], v0[1]}), b = gelu_pk((f32x2){v0[2], v0[3]}), c = gelu_pk((f32x2){v1[0], v1[1]}), d = gelu_pk((f32x2){v1[2], v1[3]});
                        v0 = (f32x4){a.x, a.y, b.x, b.y}; v1 = (f32x4){c.x, c.y, d.x, d.y}; }
                    if (ACT == 2) { v0 = __builtin_elementwise_max(v0, (f32x4){0.f,0.f,0.f,0.f}); v1 = __builtin_elementwise_max(v1, (f32x4){0.f,0.f,0.f,0.f}); v0 = v0 * v0; v1 = v1 * v1; }
                    v0 = v0 * sc; v1 = v1 * sc; u32x4 w; w.x = cvt_pk_bf16(v0[0], v0[1]); w.y = cvt_pk_bf16(v0[2], v0[3]); w.z = cvt_pk_bf16(v1[0], v1[1]); w.w = cvt_pk_bf16(v1[2], v1[3]);
                    *(u32x4*)(rowp + bj * HALF) = w; } }
    }
};

struct RowExch {
    float* slots;
    unsigned* cnt;
    unsigned* tmo;
    __device__ __forceinline__ void publish(const float (&ss)[2][4], const Unit& u, int wr, int wc, int fr, int fq, PG8_LAS unsigned char* lds, int wid, int lane) const {
        PG8_LAS float* P = (PG8_LAS float*)lds;
#pragma unroll
        for (int ai = 0; ai < 2; ++ai)
#pragma unroll
            for (int m = 0; m < 4; ++m) { float s = ss[ai][m]; s += __shfl_xor(s, 16); s += __shfl_xor(s, 32); if (fq == 0) P[(ai * HALF + wr * 64 + m * 16 + fr) * 4 + wc] = s; }
        asm volatile("s_waitcnt lgkmcnt(0)" ::: "memory"); __builtin_amdgcn_s_barrier(); asm volatile("" ::: "memory");
        const int row = wid * 32 + (lane & 31);
        if (lane < 32) { const f32x4 p = *(const PG8_LAS f32x4*)(P + row * 4);
            __hip_atomic_store((unsigned*)slots + ((size_t)(u.pm * BM + row) * 4 + u.pn), __float_as_uint((p[0] + p[1]) + (p[2] + p[3])), __ATOMIC_RELAXED, __HIP_MEMORY_SCOPE_AGENT); }
        asm volatile("s_waitcnt vmcnt(0)" ::: "memory");
        if (lane == 0) __hip_atomic_fetch_add(cnt + 8 * u.pm, 1u, __ATOMIC_RELAXED, __HIP_MEMORY_SCOPE_AGENT);
    }
    template <bool HW> __device__ __forceinline__ void collect(const Unit& u, int wr, int fr, PG8_LAS unsigned char* lds, int wid, int lane, float eps, float (&rinv)[2][4]) const {
        PG8_LAS float* S = (PG8_LAS float*)(lds + 4096);
        const int row = HW ? wid * 64 + lane : wid * 32 + (lane & 31);
        if (wid == 0) { unsigned sp = 0;
            while ((unsigned)__builtin_amdgcn_readfirstlane(__hip_atomic_load(cnt + 8 * u.pm, __ATOMIC_RELAXED, __HIP_MEMORY_SCOPE_AGENT)) < 32u) { __builtin_amdgcn_s_sleep(1);
                if ((++sp & 255u) == 0u) { if (__hip_atomic_load(tmo, __ATOMIC_RELAXED, __HIP_MEMORY_SCOPE_AGENT)) break; if (sp > (1u << 18)) { if (lane == 0) atomicAdd(tmo, 1u); break; } } } }
        asm volatile("s_waitcnt lgkmcnt(0)" ::: "memory"); __builtin_amdgcn_s_barrier(); asm volatile("" ::: "memory");
        if (HW ? wid < 4 : lane < 32) { const unsigned* sl = (const unsigned*)slots + (size_t)(u.pm * BM + row) * 4; float t = 0.f;
#pragma unroll
            for (int j = 0; j < 4; ++j) t += __uint_as_float(__hip_atomic_load(sl + j, __ATOMIC_RELAXED, __HIP_MEMORY_SCOPE_AGENT));
            S[row] = 1.0f / sqrtf(t * (1.0f / 1024.0f) + eps); }
        asm volatile("s_waitcnt lgkmcnt(0)" ::: "memory"); __builtin_amdgcn_s_barrier(); asm volatile("" ::: "memory");
#pragma unroll
        for (int ai = 0; ai < 2; ++ai)
#pragma unroll
            for (int m = 0; m < 4; ++m) rinv[ai][m] = S[ai * HALF + wr * 64 + m * 16 + fr];
        asm volatile("s_waitcnt lgkmcnt(0)" ::: "memory"); __builtin_amdgcn_s_barrier(); asm volatile("" ::: "memory");
    }
};
template <int SPOST, int SPRE, bool XINB, int XOUT> struct EpiNorm {
    static constexpr bool PERM = true, AFTER_DRAIN = true;
    const void* xin; void* xout; bf16_t* XN; const float* MOD; const float* ng; RowExch e1, e2; float eps;
    __device__ __forceinline__ void operator()(const f32x4 (&)[2][2][4][2], const Unit&, int, int, int, int) const {}
    __device__ __forceinline__ void fused(f32x4 (&acc)[2][2][4][2], const Unit& u, int wr, int wc, int fr, int fq, PG8_LAS unsigned char* lds, int wid, int lane) const {
        const int b = u.pm >> 5;
        const int col0 = u.pn * BM + wc * 32 + 8 * fq;
        const size_t off0 = (size_t)(u.pm * BM + wr * 64 + fr) * 1024 + col0;
#define EN_OFF(ai, m, bj) (off0 + (size_t)((ai) * HALF + (m) * 16) * 1024 + (bj) * HALF)
#define EN_UNPK_LO(q_) ((f32x4){__uint_as_float((q_)[0] << 16), __uint_as_float((q_)[0] & 0xffff0000u), __uint_as_float((q_)[1] << 16), __uint_as_float((q_)[1] & 0xffff0000u)})
#define EN_UNPK_HI(q_) ((f32x4){__uint_as_float((q_)[2] << 16), __uint_as_float((q_)[2] & 0xffff0000u), __uint_as_float((q_)[3] << 16), __uint_as_float((q_)[3] & 0xffff0000u)})
        float ss[2][4], r1[2][4];
#pragma unroll
        for (int ai = 0; ai < 2; ++ai)
#pragma unroll
            for (int m = 0; m < 4; ++m) { float s = 0.f;
#pragma unroll
                for (int bj = 0; bj < 2; ++bj)
#pragma unroll
                    for (int n = 0; n < 2; ++n) { const f32x4 x = acc[ai][bj][m][n]; s += (x[0] * x[0] + x[1] * x[1]) + (x[2] * x[2] + x[3] * x[3]); }
                ss[ai][m] = s; }
        e1.publish(ss, u, wr, wc, fr, fq, lds, wid, lane);
        u32x4 xb[2][4][2]; f32x4 xf[4][2][2];
        if constexpr (XINB) {
#pragma unroll
            for (int ai = 0; ai < 2; ++ai)
#pragma unroll
                for (int m = 0; m < 4; ++m)
#pragma unroll
                    for (int bj = 0; bj < 2; ++bj) xb[ai][m][bj] = *(const u32x4*)((const bf16_t*)xin + EN_OFF(ai, m, bj));
        } else {
#pragma unroll
            for (int m = 0; m < 4; ++m)
#pragma unroll
                for (int bj = 0; bj < 2; ++bj) { xf[m][bj][0] = *(const f32x4*)((const float*)xin + EN_OFF(0, m, bj)); xf[m][bj][1] = *(const f32x4*)((const float*)xin + EN_OFF(0, m, bj) + 4); }
        }
        f32x4 gp[2][2];
#pragma unroll
        for (int bj = 0; bj < 2; ++bj)
#pragma unroll
            for (int n = 0; n < 2; ++n) gp[bj][n] = *(const f32x4*)(MOD + (SPOST * 2 + b) * 3072 + 2048 + col0 + bj * HALF + 4 * n) * *(const f32x4*)(ng + (SPOST * 2 + 1) * 1024 + col0 + bj * HALF + 4 * n);
        e1.template collect<false>(u, wr, fr, lds, wid, lane, eps, r1);
#pragma unroll
        for (int ai = 0; ai < 2; ++ai) {
            if constexpr (!XINB) { if (ai == 1) {
#pragma unroll
                for (int m = 0; m < 4; ++m)
#pragma unroll
                    for (int bj = 0; bj < 2; ++bj) { xf[m][bj][0] = *(const f32x4*)((const float*)xin + EN_OFF(1, m, bj)); xf[m][bj][1] = *(const f32x4*)((const float*)xin + EN_OFF(1, m, bj) + 4); } } }
#pragma unroll
            for (int m = 0; m < 4; ++m) { const float r = r1[ai][m];
#pragma unroll
                for (int bj = 0; bj < 2; ++bj) { f32x4 x0, x1;
                    if constexpr (XINB) { x0 = EN_UNPK_LO(xb[ai][m][bj]); x1 = EN_UNPK_HI(xb[ai][m][bj]); } else { x0 = xf[m][bj][0]; x1 = xf[m][bj][1]; }
                    f32x4 v0 = x0 + gp[bj][0] * (acc[ai][bj][m][0] * r), v1 = x1 + gp[bj][1] * (acc[ai][bj][m][1] * r);
                    if constexpr (XOUT == 2) { *(f32x4*)((float*)xout + EN_OFF(ai, m, bj)) = v0; *(f32x4*)((float*)xout + EN_OFF(ai, m, bj) + 4) = v1; }
                    if constexpr (XOUT == 1) { u32x4 w; w.x = cvt_pk_bf16(v0[0], v0[1]); w.y = cvt_pk_bf16(v0[2], v0[3]); w.z = cvt_pk_bf16(v1[0], v1[1]); w.w = cvt_pk_bf16(v1[2], v1[3]);
                        v0 = EN_UNPK_LO(w); v1 = EN_UNPK_HI(w); }
                    acc[ai][bj][m][0] = v0; acc[ai][bj][m][1] = v1; } }
        }
        if constexpr (SPRE >= 0) {
            float r2[2][4];
#pragma unroll
            for (int ai = 0; ai < 2; ++ai)
#pragma unroll
                for (int m = 0; m < 4; ++m) { float s = 0.f;
#pragma unroll
                    for (int bj = 0; bj < 2; ++bj)
#pragma unroll
                        for (int n = 0; n < 2; ++n) { const f32x4 x = acc[ai][bj][m][n]; s += (x[0] * x[0] + x[1] * x[1]) + (x[2] * x[2] + x[3] * x[3]); }
                    ss[ai][m] = s; }
            e2.publish(ss, u, wr, wc, fr, fq, lds, wid, lane);
#define EN_STORE_X() do { _Pragma("unroll") for (int ai = 0; ai < 2; ++ai) _Pragma("unroll") for (int m = 0; m < 4; ++m) _Pragma("unroll") for (int bj = 0; bj < 2; ++bj) { const f32x4 v0 = acc[ai][bj][m][0], v1 = acc[ai][bj][m][1]; \
                u32x4 w; w.x = cvt_pk_bf16(v0[0], v0[1]); w.y = cvt_pk_bf16(v0[2], v0[3]); w.z = cvt_pk_bf16(v1[0], v1[1]); w.w = cvt_pk_bf16(v1[2], v1[3]); *(u32x4*)((bf16_t*)xout + EN_OFF(ai, m, bj)) = w; } } while (0)
            if constexpr (XOUT == 1) { if (wid >= 4) EN_STORE_X(); }
            f32x4 qc[2][2], sh[2][2];
#pragma unroll
            for (int bj = 0; bj < 2; ++bj)
#pragma unroll
                for (int n = 0; n < 2; ++n) { const int c = col0 + bj * HALF + 4 * n;
                    qc[bj][n] = *(const f32x4*)(ng + (SPRE * 2) * 1024 + c) * (*(const f32x4*)(MOD + (SPRE * 2 + b) * 3072 + 1024 + c) + 1.0f); sh[bj][n] = *(const f32x4*)(MOD + (SPRE * 2 + b) * 3072 + c); }
            e2.template collect<true>(u, wr, fr, lds, wid, lane, eps, r2);
            if constexpr (XOUT == 1) { if (wid < 4) EN_STORE_X(); }
#pragma unroll
            for (int ai = 0; ai < 2; ++ai)
#pragma unroll
                for (int m = 0; m < 4; ++m) { const float r = r2[ai][m];
#pragma unroll
                    for (int bj = 0; bj < 2; ++bj) { const f32x4 o0 = (acc[ai][bj][m][0] * r) * qc[bj][0] + sh[bj][0], o1 = (acc[ai][bj][m][1] * r) * qc[bj][1] + sh[bj][1];
                        u32x4 w; w.x = cvt_pk_bf16(o0[0], o0[1]); w.y = cvt_pk_bf16(o0[2], o0[3]); w.z = cvt_pk_bf16(o1[0], o1[1]); w.w = cvt_pk_bf16(o1[2], o1[3]);
                        *(u32x4*)(XN + EN_OFF(ai, m, bj)) = w; } }
        } else if constexpr (XOUT == 1) {
#pragma unroll
            for (int ai = 0; ai < 2; ++ai)
#pragma unroll
                for (int m = 0; m < 4; ++m)
#pragma unroll
                    for (int bj = 0; bj < 2; ++bj) { const f32x4 v0 = acc[ai][bj][m][0], v1 = acc[ai][bj][m][1];
                        u32x4 w; w.x = cvt_pk_bf16(v0[0], v0[1]); w.y = cvt_pk_bf16(v0[2], v0[3]); w.z = cvt_pk_bf16(v1[0], v1[1]); w.w = cvt_pk_bf16(v1[2], v1[3]);
                        *(u32x4*)((bf16_t*)xout + EN_OFF(ai, m, bj)) = w; }
        }
#undef EN_STORE_X
#undef EN_OFF
#undef EN_UNPK_LO
#undef EN_UNPK_HI
    }
};
template <class Epi, class Sched, bool ALIGN_EPI = false, bool SP2 = false>
__device__ __forceinline__ void gemm_phase(PG8_LAS unsigned char* lds, const Gemm g, const Sched& S, const Epi& E) {
    const int tid = threadIdx.x, wid = __builtin_amdgcn_readfirstlane(tid >> 6), lane = tid & 63, wr = wid >> 2, wc = wid & 3, fr = lane & 15, fq = lane >> 4;
    const int K = g.K, nt = K / BK;
    unsigned voffA[2], voffB[2];
#pragma unroll
    for (int i = 0; i < 2; ++i) { int R, C; stage_rc(tid * 16 + i * 8192, R, C); const int Rb = Epi::PERM ? ((R & ~31) + perm32(R & 31)) : R;
        voffA[i] = (unsigned)(R * g.lda + C) * 2u; voffB[i] = (unsigned)(Rb * K + C) * 2u; }
    const size_t kstep = (size_t)(BK * 2);
    const size_t hstepA = (size_t)HALF * g.lda * 2, hstepB = (size_t)HALF * K * 2;
    const size_t tstepA = 2 * hstepA, tstepB = 2 * hstepB;
    const unsigned ldsw = (unsigned)wid * 1024u;
    const int aoff = lds_byte(wr * 64 + fr, fq * 8), boff = lds_byte(wc * 32 + fr, fq * 8);
#define PG8_SA(b, h) (((b) * 2 + (h)) * HTB)
#define PG8_SB(b, h) ((4 + (b) * 2 + (h)) * HTB)
#define PG8_STAGE(bufoff, gbase, voff) do { _Pragma("unroll") for (int _i = 0; _i < 2; ++_i) \
        __builtin_amdgcn_global_load_lds((const unsigned*)((const char*)(gbase) + (voff)[_i]), (PG8_LAS unsigned*)(lds + (bufoff) + ldsw + _i * 8192), 16, 0, 0); } while (0)
#define PG8_LDA(dst, b, h) do { _Pragma("unroll") for (int m = 0; m < 4; ++m) _Pragma("unroll") for (int k = 0; k < 2; ++k) dst[m][k] = *(const PG8_LAS bf16x8*)(lds + PG8_SA(b, h) + aoff + m * 2048 + k * 1024); } while (0)
#define PG8_LDB(dst, b, h) do { _Pragma("unroll") for (int n = 0; n < 2; ++n) _Pragma("unroll") for (int k = 0; k < 2; ++k) dst[n][k] = *(const PG8_LAS bf16x8*)(lds + PG8_SB(b, h) + boff + n * 2048 + k * 1024); } while (0)
#define PG8_MMA(ai, bj, At, Bt) do { __builtin_amdgcn_s_setprio(1); _Pragma("unroll") for (int m = 0; m < 4; ++m) _Pragma("unroll") for (int n = 0; n < 2; ++n) _Pragma("unroll") for (int k = 0; k < 2; ++k) \
        acc[ai][bj][m][n] = __builtin_amdgcn_mfma_f32_16x16x32_bf16(Bt[n][k], At[m][k], acc[ai][bj][m][n], 0, 0, 0); __builtin_amdgcn_s_setprio(0); } while (0)
#define PG8_WAIT_V(n) asm volatile("s_waitcnt vmcnt(" #n ")" ::: "memory")
#define PG8_WAIT_L(n) asm volatile("s_waitcnt lgkmcnt(" #n ")" ::: "memory")
#define PG8_BAR __builtin_amdgcn_s_barrier()
#define PG8_SCHED __builtin_amdgcn_sched_barrier(0)
    Unit cur, nxt; int ui = 0;
    if (!S.next(0, cur)) return;
    f32x4 acc[2][2][4][2];
#pragma unroll
    for (int a = 0; a < 2; ++a)
#pragma unroll
        for (int b = 0; b < 2; ++b)
#pragma unroll
            for (int m = 0; m < 4; ++m)
#pragma unroll
                for (int n = 0; n < 2; ++n) acc[a][b][m][n] = (f32x4){0.f, 0.f, 0.f, 0.f};
    bf16x8 At[4][2], B0[2][2], B1[2][2];
    const char* cA = (const char*)g.A + (size_t)cur.pm * tstepA; const char* cB = (const char*)g.Bt + (size_t)cur.pn * tstepB;
    S.a_ready(cur);
    if constexpr (SP2) {
        PG8_STAGE(PG8_SB(0, 0), cB, voffB); PG8_STAGE(PG8_SB(0, 1), cB + hstepB, voffB); PG8_STAGE(PG8_SA(0, 0), cA, voffA); PG8_STAGE(PG8_SA(0, 1), cA + hstepA, voffA);
        if (wr == 1) PG8_BAR;
        PG8_WAIT_V(2); PG8_BAR;
        PG8_STAGE(PG8_SB(1, 0), cB + kstep, voffB); PG8_STAGE(PG8_SA(1, 0), cA + kstep, voffA); PG8_STAGE(PG8_SB(1, 1), cB + hstepB + kstep, voffB);
        PG8_WAIT_V(6); PG8_BAR;
    } else {
        PG8_STAGE(PG8_SB(0, 0), cB, voffB); PG8_STAGE(PG8_SA(0, 0), cA, voffA); PG8_STAGE(PG8_SB(0, 1), cB + hstepB, voffB); PG8_STAGE(PG8_SA(0, 1), cA + hstepA, voffA);
        if (wr == 1) PG8_BAR;
        PG8_WAIT_V(4); PG8_BAR;
        PG8_STAGE(PG8_SB(1, 0), cB + kstep, voffB); PG8_STAGE(PG8_SA(1, 0), cA + kstep, voffA); PG8_STAGE(PG8_SB(1, 1), cB + hstepB + kstep, voffB);
        PG8_WAIT_V(6); PG8_BAR;
    }
    for (;;) {
        const bool has_next = S.next(ui + 1, nxt);
        const char* nA = has_next ? (const char*)g.A + (size_t)nxt.pm * tstepA : cA; const char* nB = has_next ? (const char*)g.Bt + (size_t)nxt.pn * tstepB : cB;
        for (int t = 0; t < nt; t += 2) {
            const bool last = (t == nt - 2);
            const char* a1 = cA + (size_t)(t + 1) * kstep;
            const char* a2 = last ? nA : cA + (size_t)(t + 2) * kstep; const char* b2 = last ? nB : cB + (size_t)(t + 2) * kstep;
            const char* a3 = a2 + kstep; const char* b3 = b2 + kstep;
            if (last && has_next) S.a_ready(nxt);
            if constexpr (SP2) {
            PG8_LDB(B0, 0, 0); PG8_LDB(B1, 0, 1); PG8_SCHED; PG8_LDA(At, 0, 0); PG8_STAGE(PG8_SA(1, 1), a1 + hstepA, voffA);
            PG8_WAIT_V(8); PG8_WAIT_L(0); PG8_BAR; PG8_MMA(0, 0, At, B0); PG8_MMA(0, 1, At, B1); PG8_BAR; PG8_SCHED;
            PG8_LDA(At, 0, 1); PG8_STAGE(PG8_SB(0, 0), b2, voffB); PG8_STAGE(PG8_SB(0, 1), b2 + hstepB, voffB); PG8_STAGE(PG8_SA(0, 0), a2, voffA);
            PG8_WAIT_V(8); PG8_WAIT_L(0); PG8_BAR; PG8_MMA(1, 0, At, B0); PG8_MMA(1, 1, At, B1); PG8_BAR; PG8_SCHED;
            PG8_LDB(B0, 1, 0); PG8_LDB(B1, 1, 1); PG8_SCHED; PG8_LDA(At, 1, 0); PG8_STAGE(PG8_SA(0, 1), a2 + hstepA, voffA);
            PG8_WAIT_V(8); PG8_WAIT_L(0); PG8_BAR; PG8_MMA(0, 0, At, B0); PG8_MMA(0, 1, At, B1); PG8_BAR; PG8_SCHED;
            PG8_LDA(At, 1, 1); PG8_STAGE(PG8_SB(1, 0), b3, voffB); PG8_STAGE(PG8_SB(1, 1), b3 + hstepB, voffB); PG8_STAGE(PG8_SA(1, 0), a3, voffA);
            PG8_WAIT_V(8); PG8_WAIT_L(0); PG8_BAR; PG8_MMA(1, 0, At, B0); PG8_MMA(1, 1, At, B1); PG8_BAR; PG8_SCHED;
            } else {
            PG8_LDB(B0, 0, 0); PG8_SCHED; PG8_LDA(At, 0, 0); PG8_STAGE(PG8_SA(1, 1), a1 + hstepA, voffA);
            PG8_WAIT_L(8); PG8_BAR; PG8_WAIT_L(0); PG8_MMA(0, 0, At, B0); PG8_BAR; PG8_SCHED;
            PG8_LDB(B1, 0, 1); PG8_STAGE(PG8_SB(0, 0), b2, voffB);
            PG8_BAR; PG8_WAIT_L(0); PG8_MMA(0, 1, At, B1); PG8_BAR;
            PG8_LDA(At, 0, 1); PG8_STAGE(PG8_SA(0, 0), a2, voffA);
            PG8_BAR; PG8_WAIT_L(0); PG8_MMA(1, 0, At, B0); PG8_BAR; PG8_SCHED;
            PG8_STAGE(PG8_SB(0, 1), b2 + hstepB, voffB);
            PG8_WAIT_V(6); PG8_BAR; PG8_MMA(1, 1, At, B1); PG8_BAR;
            PG8_LDB(B0, 1, 0); PG8_SCHED; PG8_LDA(At, 1, 0); PG8_STAGE(PG8_SA(0, 1), a2 + hstepA, voffA);
            PG8_WAIT_L(8); PG8_BAR; PG8_WAIT_L(0); PG8_MMA(0, 0, At, B0); PG8_BAR; PG8_SCHED;
            PG8_LDB(B1, 1, 1); PG8_STAGE(PG8_SB(1, 0), b3, voffB);
            PG8_BAR; PG8_WAIT_L(0); PG8_MMA(0, 1, At, B1); PG8_BAR;
            PG8_LDA(At, 1, 1); PG8_STAGE(PG8_SA(1, 0), a3, voffA);
            PG8_BAR; PG8_WAIT_L(0); PG8_MMA(1, 0, At, B0); PG8_BAR; PG8_SCHED;
            PG8_STAGE(PG8_SB(1, 1), b3 + hstepB, voffB);
            PG8_WAIT_V(6); PG8_BAR; PG8_MMA(1, 1, At, B1); PG8_BAR;
            }
        }
        if constexpr (ALIGN_EPI) { if (wr == 0) PG8_BAR; }
        if constexpr (!Epi::AFTER_DRAIN) { E(acc, cur, wr, wc, fr, fq); S.done(cur); }
        if (!has_next) break;
#pragma unroll
        for (int a = 0; a < 2; ++a)
#pragma unroll
            for (int b = 0; b < 2; ++b)
#pragma unroll
                for (int m = 0; m < 4; ++m)
#pragma unroll
                    for (int n = 0; n < 2; ++n) acc[a][b][m][n] = (f32x4){0.f, 0.f, 0.f, 0.f};
        cur = nxt; cA = nA; cB = nB; ++ui;
        if constexpr (ALIGN_EPI) { if (wr == 1) PG8_BAR; }
    }
    PG8_WAIT_V(0);
    if constexpr (!ALIGN_EPI) { if (wr == 0) PG8_BAR; }
    PG8_BAR;
    if constexpr (Epi::AFTER_DRAIN) { E.fused(acc, cur, wr, wc, fr, fq, lds, wid, lane); S.done(cur); }
#undef PG8_SA
#undef PG8_SB
#undef PG8_STAGE
#undef PG8_LDA
#undef PG8_LDB
#undef PG8_MMA
#undef PG8_WAIT_V
#undef PG8_WAIT_L
#undef PG8_BAR
#undef PG8_SCHED
}
}

constexpr int NWAVES = 8, NTHR = NWAVES * 64;
constexpr int BATCH = 2, SEQ = 8192, DM = 1024, MTOK = BATCH * SEQ, FF = 4096;
constexpr int NPROJ0 = 6144, NPROJ1 = 3840;
constexpr float EPS = 1e-6f, LOG2E = 1.4426950408889634f;
constexpr int C0_Z = 0, C0_Q = 1024, C0_K = 2048, C0_V = 3072, C0_XBC = 4096;
constexpr int C1_RG = 0, C1_SQ = 1024, C1_RQ = 1536, C1_RK = 2048, C1_RV = 2560, C1_SK = 3584, C1_SV = 3712;
enum { I_X = 0, I_C, I_RELB, I_NG, I_MODW, I_MODB, I_W1, I_W2, I_EWIN, I_ECONVW, I_ECONVB, I_EDTB, I_EALOG, I_ED, I_ESSDN, I_ELAM, I_EDIFFN, I_EWOUT, I_OWIN, I_OSINK, I_OWOUT, N_IN };

constexpr size_t MiB = 1u << 20;
constexpr size_t WS_CTL = 0, CTL_ZERO_BYTES = 65536;
constexpr size_t WS_MOD = 256 * 1024;
constexpr size_t WS_WDT = 512 * 1024;
constexpr size_t WS_CHDEC = 576 * 1024;
constexpr size_t WS_SSQ = 640 * 1024;
constexpr size_t WS_WMIX = 1 * MiB;
constexpr size_t WS_WOUT0 = 13 * MiB, WS_WOUT1 = 9 * MiB;
constexpr size_t WS_PROJ0 = 17 * MiB;
constexpr size_t WS_XN2 = 17 * MiB;
constexpr size_t WS_WMLP = 49 * MiB;
constexpr size_t WS_H = 65 * MiB;
constexpr size_t WS_S = 209 * MiB;
constexpr size_t WS_DT = 241 * MiB;
constexpr size_t WS_ROPE = 244 * MiB;
constexpr size_t WS_XCH = 248 * MiB;
constexpr size_t WS_END = 250 * MiB;
constexpr int CW_BAR = 4096;

constexpr int LDS_BYTES = 163840 - 1024;
constexpr int MISC_OFF = LDS_BYTES - 256;

#define GAS __attribute__((address_space(1)))
#define LAS __attribute__((address_space(3)))
typedef unsigned short bf16;
typedef unsigned v4u __attribute__((ext_vector_type(4)));
typedef unsigned v2u __attribute__((ext_vector_type(2)));
typedef float f32x4 __attribute__((ext_vector_type(4)));
typedef short bf16x8 __attribute__((ext_vector_type(8)));
typedef short v4i16_t __attribute__((ext_vector_type(4)));
typedef GAS unsigned gu32;
typedef LAS unsigned char* ldsp;
#define RLX_AGENT __ATOMIC_RELAXED, __HIP_MEMORY_SCOPE_AGENT
#define LDS_WAIT() asm volatile("s_waitcnt lgkmcnt(0)" ::: "memory")
#define VM_WAIT() asm volatile("s_waitcnt vmcnt(0)" ::: "memory")

__device__ __forceinline__ float bf2f(unsigned h) { return __uint_as_float(h << 16); }
typedef float f32x2_t __attribute__((ext_vector_type(2))); typedef __bf16 bf16x2_t __attribute__((ext_vector_type(2)));
__device__ __forceinline__ unsigned pk2(float lo, float hi) { f32x2_t v = {lo, hi}; bf16x2_t b = __builtin_convertvector(v, bf16x2_t); return __builtin_bit_cast(unsigned, b); }
__device__ __forceinline__ unsigned short f2bf(float f) { return (unsigned short)(pk2(f, 0.f) & 0xffffu); }
__device__ __forceinline__ float silu_f(float x) { return x * __builtin_amdgcn_rcpf(1.f + __expf(-x)); }
__device__ __forceinline__ float wave_sum(float v) {
#pragma unroll
    for (int o = 1; o < 64; o <<= 1) v += __shfl_xor(v, o);
    return v;
}
#define MFMA16(acc, rowfrag, colfrag) acc = __builtin_amdgcn_mfma_f32_16x16x32_bf16(colfrag, rowfrag, acc, 0, 0, 0)
__device__ __forceinline__ bf16x8 lds_frag(ldsp p) { return *(const LAS bf16x8*)p; }
__device__ __forceinline__ bf16x8 lds_frag_tr(ldsp p, int stride) {
    const v4i16_t lo = __builtin_amdgcn_ds_read_tr16_b64_v4i16((LAS v4i16_t*)p);
    const v4i16_t hi = __builtin_amdgcn_ds_read_tr16_b64_v4i16((LAS v4i16_t*)(p + 4 * stride));
    return (bf16x8){lo[0], lo[1], lo[2], lo[3], hi[0], hi[1], hi[2], hi[3]};
}
__device__ __forceinline__ int t5_bucket(int d) {
    if (d < 16) return d;
    const int v = 16 + (int)(logf((float)d * 0.0625f) / 2.0794415416798357f * 16.0f);
    return v < 31 ? v : 31;
}

#define XB_TMO      128
#define XB_XCNT(j)  (256  + 64 * (j))
#define XB_XSUB(j)  (1280 + 64 * (j))
#define XB_XGEN(j)  (2304 + 64 * (j))
#define XB_TOP      3328
#define XB_TOPGEN   3392
#define XCD_BAR_WORDS 3456
#define XB_SPIN_CAP (1u << 18)

__device__ __forceinline__ unsigned xb_ld(unsigned* p)              { return __hip_atomic_load(p, __ATOMIC_RELAXED, __HIP_MEMORY_SCOPE_AGENT); }
__device__ __forceinline__ unsigned xb_add(unsigned* p, unsigned v) { return __hip_atomic_fetch_add(p, v, __ATOMIC_RELAXED, __HIP_MEMORY_SCOPE_AGENT); }
__device__ __forceinline__ unsigned xb_xcc_id() { return (unsigned)__builtin_amdgcn_s_getreg((3 << 11) | 20) & 0xFu; }
#define XB_SPIN(cond, bar) do { unsigned _sp = 0; while (cond) { __builtin_amdgcn_s_sleep(1); \
    if ((++_sp & 255u) == 0u) { if (xb_ld(&(bar)[XB_TMO])) break; if (_sp > XB_SPIN_CAP) { atomicAdd(&(bar)[XB_TMO], 1u); break; } } } } while (0)

struct XcdBarrier {
    unsigned* bar; unsigned x;
    volatile LAS unsigned* st;
};

__device__ __forceinline__ XcdBarrier xcd_barrier_post(unsigned* bar, volatile LAS unsigned* st) {
    XcdBarrier b; b.bar = bar; b.x = xb_xcc_id(); b.st = st;
    if (threadIdx.x == 0) (void)xb_add(&bar[XB_XCNT(b.x)], 1u);
    return b;
}
__device__ __forceinline__ void xcd_barrier_complete(unsigned* bar, unsigned x, unsigned& nloc, unsigned& nx) {
    const unsigned G = gridDim.x * gridDim.y * gridDim.z;
    unsigned sum, cnt, mine, sp = 0u;
    for (;;) {
        sum = 0u; cnt = 0u; mine = 0u;
#pragma unroll
        for (unsigned j = 0; j < 16; ++j) { const unsigned c = xb_ld(&bar[XB_XCNT(j)]); sum += c; cnt += (c > 0u) ? 1u : 0u; mine = (j == x) ? c : mine; }
        if (sum == G) break;
        __builtin_amdgcn_s_sleep(1);
        if ((++sp & 255u) == 0u) { if (xb_ld(&bar[XB_TMO])) break; if (sp > XB_SPIN_CAP) { atomicAdd(&bar[XB_TMO], 1u); break; } }
    }
    nloc = mine > 0u ? mine : 1u; nx = cnt > 0u ? cnt : 1u;
}

template <bool WB = true> __device__ __forceinline__ void xcd_barrier(const XcdBarrier& b) {
    asm volatile("s_waitcnt vmcnt(0)" ::: "memory");
    __syncthreads();
    if (threadIdx.x == 0) {
        unsigned* bar = b.bar;
        __builtin_amdgcn_s_waitcnt(0);
        unsigned nloc = b.st[0], nx = b.st[1];
        if (nloc == 0u) { xcd_barrier_complete(bar, b.x, nloc, nx); b.st[0] = nloc; b.st[1] = nx; }
        const unsigned old = xb_add(&bar[XB_XSUB(b.x)], 1u);
        const unsigned gen = old / nloc;
        if (old + 1u == (gen + 1u) * nloc) {
            if (WB) asm volatile("buffer_inv sc1\n\tbuffer_wbl2 sc1\n\ts_waitcnt vmcnt(0)" ::: "memory"); else asm volatile("buffer_inv sc1" ::: "memory");
            xb_add(&bar[XB_TOP], 1u);
        } else {
            asm volatile("buffer_inv sc1" ::: "memory");
        }
        XB_SPIN(xb_ld(&bar[XB_TOP]) < (gen + 1u) * nx, bar);
        asm volatile("s_waitcnt vmcnt(0)" ::: "memory");
    }
    __syncthreads();
}

struct Seg { const float* W; int ldw, col0, ncols, K; bf16* WT; int row_off; };
struct CvtItem { const float* src; bf16* dst; int ldw, K; bool valid; };
template <int NSEG> __device__ __forceinline__ CvtItem cvt_resolve(const Seg (&segs)[NSEG], int it, int total, int lane) {
    CvtItem c; c.src = nullptr; c.dst = nullptr; c.ldw = 0; c.K = 0; c.valid = false;
    int r = it < total ? it : -1;
#pragma unroll
    for (int s = 0; s < NSEG; ++s) { const int nblk = segs[s].ncols / 32, n = (segs[s].K / 64) * nblk;
        if (!c.valid && r >= 0 && r < n) { const int kb = r / nblk, nb = r % nblk, k0 = 64 * kb, n0 = 32 * nb;
            c.src = segs[s].W + (size_t)(k0 + (lane >> 5)) * segs[s].ldw + segs[s].col0 + n0 + (lane & 31);
            c.dst = segs[s].WT + (size_t)(segs[s].row_off + n0 + (lane >> 3)) * segs[s].K + k0 + 8 * (lane & 7); c.ldw = segs[s].ldw; c.K = segs[s].K; c.valid = true; }
        r -= n; }
    return c;
}
__device__ __forceinline__ void cvt_loads(const CvtItem& c, float (&wv)[32]) {
    if (c.valid) {
#pragma unroll
        for (int i = 0; i < 32; ++i) wv[i] = c.src[(size_t)(2 * i) * c.ldw]; }
}
__device__ __forceinline__ void cvt_finish(const CvtItem& c, const float (&wv)[32], LAS float* scr, int lane) {
    if (c.valid) {
#pragma unroll
        for (int i = 0; i < 32; ++i) scr[(2 * i + (lane >> 5)) * 33 + (lane & 31)] = wv[i];
        LDS_WAIT(); asm volatile("" ::: "memory");
        const int cc = lane & 7;
#pragma unroll
        for (int j = 0; j < 4; ++j) { const int n = (lane >> 3) + 8 * j; const LAS float* p = scr + (8 * cc) * 33 + n;
            v4u o; o.x = pk2(p[0 * 33], p[1 * 33]); o.y = pk2(p[2 * 33], p[3 * 33]); o.z = pk2(p[4 * 33], p[5 * 33]); o.w = pk2(p[6 * 33], p[7 * 33]);
            *(v4u*)(c.dst + (size_t)(8 * j) * c.K) = o; }
        LDS_WAIT(); asm volatile("" ::: "memory"); }
}
template <int NSEG> __device__ __forceinline__ void convert_set(const Seg (&segs)[NSEG], ldsp lds, int gw, int NGW, int wave, int lane) {
    LAS float* scr = (LAS float*)(lds + wave * 16384);
    int total = 0;
#pragma unroll
    for (int s = 0; s < NSEG; ++s) total += (segs[s].K / 64) * (segs[s].ncols / 32);
    for (int it = gw; it < total; it += 2 * NGW) {
        const CvtItem ca = cvt_resolve<NSEG>(segs, it, total, lane), cb = cvt_resolve<NSEG>(segs, it + NGW, total, lane);
        float wa[32], wb[32];
        cvt_loads(ca, wa); cvt_loads(cb, wb);
        cvt_finish(ca, wa, scr, lane); cvt_finish(cb, wb, scr, lane);
    }
}
__device__ __forceinline__ void mod_phase(const float* c, const float* mod_w, const float* mod_b, float* MOD, ldsp lds, int tid, int lane, int wave) {
    for (int item = blockIdx.x; item < 192; item += gridDim.x) {
        const int s = item / 48, j0 = (item % 48) * 64, kpart = wave * 4 + (lane >> 4), jl = lane & 15;
        const float* wp = mod_w + ((size_t)s * 1024 + kpart * 32) * 3072 + j0 + 4 * jl;
        f32x4 a0 = {0.f, 0.f, 0.f, 0.f}, a1 = a0;
#pragma unroll
        for (int kk = 0; kk < 32; ++kk) { const int k = kpart * 32 + kk; const f32x4 w = *(const f32x4*)(wp + (size_t)kk * 3072);
            const float c0 = c[k], c1 = c[1024 + k]; const float s0 = c0 / (1.f + expf(-c0)), s1 = c1 / (1.f + expf(-c1)); a0 += w * s0; a1 += w * s1; }
        LAS f32x4* red = (LAS f32x4*)lds;
        red[(kpart * 2 + 0) * 16 + jl] = a0; red[(kpart * 2 + 1) * 16 + jl] = a1;
        __syncthreads();
        if (tid < 128) { const int b = tid >> 6, col = tid & 63; float sum = mod_b[s * 3072 + j0 + col];
#pragma unroll
            for (int kp = 0; kp < 32; ++kp) sum += ((LAS float*)lds)[((kp * 2 + b) * 16 + (col >> 2)) * 4 + (col & 3)];
            MOD[(s * 2 + b) * 3072 + j0 + col] = sum; }
        __syncthreads();
    }
}

template <int SPOST, int SPRE, bool XINB, int XOUT, int R = 2> __device__ __forceinline__ void norm_rows(const void* xin_, const bf16* Y, void* xout_, bf16* XN, const float* MOD, const float* ng, int gw, int NGW, int lane) {
    const float* xinf = (const float*)xin_; const bf16* xinb = (const bf16*)xin_; float* xoutf = (float*)xout_; bf16* xoutb = (bf16*)xout_;
    const int half = NGW >> 1; const bool split = !(NGW & 1);
    const int b0 = split ? gw / half : 0, b1 = split ? b0 + 1 : BATCH, w = split ? gw % half : gw, W = split ? half : NGW;
#define NR_COL(q) (8 * lane + 512 * ((q) >> 1) + 4 * ((q) & 1))
#define NR_UNPK(w_) ((f32x4){__uint_as_float((w_).x << 16), __uint_as_float((w_).x & 0xffff0000u), __uint_as_float((w_).y << 16), __uint_as_float((w_).y & 0xffff0000u)})
#define NR_LOAD(vx, vxb, vy, m_) do { _Pragma("unroll") for (int j = 0; j < 2; ++j) { \
        if constexpr (XINB) vxb[j] = *(const v4u*)(xinb + (size_t)(m_) * DM + 8 * lane + 512 * j); \
        else { vx[2 * j] = *(const f32x4*)(xinf + (size_t)(m_) * DM + NR_COL(2 * j)); vx[2 * j + 1] = *(const f32x4*)(xinf + (size_t)(m_) * DM + NR_COL(2 * j + 1)); } \
        if constexpr (SPOST >= 0) vy[j] = *(const v4u*)(Y + (size_t)(m_) * DM + 8 * lane + 512 * j); } } while (0)
#pragma unroll 1
    for (int b = b0; b < b1; ++b) {
        f32x4 g4[4], p4[4], s4[4], c4[4], q4[4];
#pragma unroll
        for (int q = 0; q < 4; ++q) {
            if constexpr (SPOST >= 0) { g4[q] = *(const f32x4*)(MOD + (SPOST * 2 + b) * 3072 + 2048 + NR_COL(q)); p4[q] = *(const f32x4*)(ng + (SPOST * 2 + 1) * DM + NR_COL(q)); }
            if constexpr (SPRE >= 0) { s4[q] = *(const f32x4*)(MOD + (SPRE * 2 + b) * 3072 + NR_COL(q)); c4[q] = *(const f32x4*)(MOD + (SPRE * 2 + b) * 3072 + 1024 + NR_COL(q)) + 1.0f;
                q4[q] = *(const f32x4*)(ng + (SPRE * 2) * DM + NR_COL(q)); }
        }
        const int cnt = w < SEQ ? (SEQ - w + W - 1) / W : 0;
        f32x4 vx[R][4]; v4u vxb[R][2], vy[R][2];
#pragma unroll
        for (int r = 0; r < R; ++r) if (r < cnt) NR_LOAD(vx[r], vxb[r], vy[r], b * SEQ + w + r * W);
        for (int i0 = 0; i0 < cnt; i0 += R) {
            f32x4 nx[R][4]; v4u nxb[R][2], ny[R][2];
#pragma unroll
            for (int r = 0; r < R; ++r) if (i0 + R + r < cnt) NR_LOAD(nx[r], nxb[r], ny[r], b * SEQ + w + (i0 + R + r) * W);
#pragma unroll
            for (int r = 0; r < R; ++r) if (i0 + r < cnt) {
                const int m = b * SEQ + w + (i0 + r) * W;
                f32x4 v[4];
#pragma unroll
                for (int j = 0; j < 2; ++j) { if constexpr (XINB) { const v2u lo = {vxb[r][j].x, vxb[r][j].y}, hi = {vxb[r][j].z, vxb[r][j].w}; v[2 * j] = NR_UNPK(lo); v[2 * j + 1] = NR_UNPK(hi); }
                                              else { v[2 * j] = vx[r][2 * j]; v[2 * j + 1] = vx[r][2 * j + 1]; } }
                if constexpr (SPOST >= 0) {
                    f32x4 y[4]; float ss = 0.f;
#pragma unroll
                    for (int j = 0; j < 2; ++j) { const v2u lo = {vy[r][j].x, vy[r][j].y}, hi = {vy[r][j].z, vy[r][j].w}; y[2 * j] = NR_UNPK(lo); y[2 * j + 1] = NR_UNPK(hi); }
#pragma unroll
                    for (int q = 0; q < 4; ++q) ss += (y[q].x * y[q].x + y[q].y * y[q].y) + (y[q].z * y[q].z + y[q].w * y[q].w);
                    const float rr = 1.0f / sqrtf(wave_sum(ss) * (1.f / DM) + EPS);
#pragma unroll
                    for (int q = 0; q < 4; ++q) v[q] = v[q] + g4[q] * ((y[q] * rr) * p4[q]);
                    if constexpr (XOUT == 2) {
#pragma unroll
                        for (int q = 0; q < 4; ++q) *(f32x4*)(xoutf + (size_t)m * DM + NR_COL(q)) = v[q]; }
                    if constexpr (XOUT == 1) {
#pragma unroll
                        for (int j = 0; j < 2; ++j) { v4u o; o.x = pk2(v[2 * j].x, v[2 * j].y); o.y = pk2(v[2 * j].z, v[2 * j].w); o.z = pk2(v[2 * j + 1].x, v[2 * j + 1].y); o.w = pk2(v[2 * j + 1].z, v[2 * j + 1].w);
                            *(v4u*)(xoutb + (size_t)m * DM + 8 * lane + 512 * j) = o;
                            const v2u lo = {o.x, o.y}, hi = {o.z, o.w}; v[2 * j] = NR_UNPK(lo); v[2 * j + 1] = NR_UNPK(hi); } }
                }
                if constexpr (SPRE >= 0) {
                    float ss = 0.f;
#pragma unroll
                    for (int q = 0; q < 4; ++q) ss += (v[q].x * v[q].x + v[q].y * v[q].y) + (v[q].z * v[q].z + v[q].w * v[q].w);
                    const float rr = 1.0f / sqrtf(wave_sum(ss) * (1.f / DM) + EPS);
#pragma unroll
                    for (int j = 0; j < 2; ++j) { const f32x4 oa = ((v[2 * j] * rr) * q4[2 * j]) * c4[2 * j] + s4[2 * j], ob = ((v[2 * j + 1] * rr) * q4[2 * j + 1]) * c4[2 * j + 1] + s4[2 * j + 1];
                        v4u o; o.x = pk2(oa.x, oa.y); o.y = pk2(oa.z, oa.w); o.z = pk2(ob.x, ob.y); o.w = pk2(ob.z, ob.w);
                        *(v4u*)(XN + (size_t)m * DM + 8 * lane + 512 * j) = o; }
                }
            }
#pragma unroll
            for (int r = 0; r < R; ++r) {
#pragma unroll
                for (int q = 0; q < 4; ++q) vx[r][q] = nx[r][q];
#pragma unroll
                for (int j = 0; j < 2; ++j) { vxb[r][j] = nxb[r][j]; vy[r][j] = ny[r][j]; } }
        }
    }
#undef NR_LOAD
#undef NR_UNPK
#undef NR_COL
}

__device__ __forceinline__ void dt_phase(const bf16* XN, const bf16* WDT, const float* dt_bias, float* DT, int gw, int NGW, int lane) {
    const int fr = lane & 15, fq = lane >> 4;
    for (int tile = gw; tile < MTOK / 16; tile += NGW) {
        f32x4 acc = {0.f, 0.f, 0.f, 0.f};
        const bf16* arow = XN + (size_t)(tile * 16 + fr) * DM + 8 * fq; const bf16* brow = WDT + fr * DM + 8 * fq;
#pragma unroll 8
        for (int ks = 0; ks < 32; ++ks) { const bf16x8 a = *(const bf16x8*)(arow + 32 * ks), bb = *(const bf16x8*)(brow + 32 * ks); MFMA16(acc, a, bb); }
        const f32x4 bi = *(const f32x4*)(dt_bias + 4 * fq); f32x4 o;
#pragma unroll
        for (int i = 0; i < 4; ++i) { const float v = acc[i] + bi[i]; o[i] = v > 20.f ? v : log1pf(expf(v)); }
        *(f32x4*)(DT + (size_t)(tile * 16 + fr) * 16 + 4 * fq) = o;
    }
}

__device__ __forceinline__ void ssd_dt_acs(const float* DT, const float* A_log, int t0, int g, LAS float* ACS, LAS float* DTS, LAS float* TMP, int tid) {
    const int r = tid >> 7, s = tid & 127, ln = tid & 63;
    const float dt = DT[(size_t)(t0 + s) * 16 + g * 4 + r];
    float v = -expf(A_log[g * 4 + r]) * dt; DTS[r * 128 + s] = dt;
#pragma unroll
    for (int d = 1; d < 64; d <<= 1) { const float t = __shfl_up(v, d); if (ln >= d) v += t; }
    if (ln == 63) TMP[tid >> 6] = v;
    __syncthreads();
    if (s >= 64) v += TMP[(tid >> 6) - 1];
    ACS[r * 128 + s] = v;
    __syncthreads();
}
__device__ __forceinline__ void ssd_conv_group(const bf16* PROJ0, const float* conv_w, const float* conv_b, int t0, bool first_chunk, int cch0, int tg, int mode, ldsp dst  , int stride,
                                               const LAS float* ACSr, const LAS float* DTSr) {
    float w[4][8], cb[8];
#pragma unroll
    for (int j = 0; j < 4; ++j) { const f32x4 a = *(const f32x4*)(conv_w + j * 2048 + cch0), b = *(const f32x4*)(conv_w + j * 2048 + cch0 + 4);
        w[j][0] = a[0]; w[j][1] = a[1]; w[j][2] = a[2]; w[j][3] = a[3]; w[j][4] = b[0]; w[j][5] = b[1]; w[j][6] = b[2]; w[j][7] = b[3]; }
    { const f32x4 a = *(const f32x4*)(conv_b + cch0), b = *(const f32x4*)(conv_b + cch0 + 4); cb[0] = a[0]; cb[1] = a[1]; cb[2] = a[2]; cb[3] = a[3]; cb[4] = b[0]; cb[5] = b[1]; cb[6] = b[2]; cb[7] = b[3]; }
    v4u raw[19];
    const bf16* src = PROJ0 + ((size_t)t0 + 16 * tg) * NPROJ0 + C0_XBC + cch0;
    const bool pad = first_chunk && tg == 0;
#pragma unroll
    for (int i = 0; i < 19; ++i) { if (i < 3 && pad) raw[i] = (v4u){0u, 0u, 0u, 0u}; else raw[i] = *(const v4u*)(src + (ptrdiff_t)(i - 3) * NPROJ0); }
    const float alast = ACSr[127];
#pragma unroll
    for (int k = 0; k < 16; ++k) { const int s = 16 * tg + k;
        float sc = 1.f; if (mode == 0) sc = DTSr[s] * __expf(alast - ACSr[s]); else if (mode == 1) sc = DTSr[s];
        float o[8];
#pragma unroll
        for (int c = 0; c < 8; ++c) { float v = cb[c];
#pragma unroll
            for (int j = 0; j < 4; ++j) { const unsigned d = raw[k + j][c >> 1]; v += w[j][c] * ((c & 1) ? __uint_as_float(d & 0xffff0000u) : __uint_as_float(d << 16)); }
            o[c] = silu_f(v) * sc; }
        v4u ow; ow.x = pk2(o[0], o[1]); ow.y = pk2(o[2], o[3]); ow.z = pk2(o[4], o[5]); ow.w = pk2(o[6], o[7]);
        *(LAS v4u*)(dst + s * stride) = ow; }
}
constexpr int SA_BS = 0, SA_XS = 34816, SA_ACS = 102400, SA_DTS = 104448, SA_TMP = 106496;
__device__ __forceinline__ void ssdA_unit(ldsp lds, const bf16* PROJ0, const float* DT, const float* conv_w, const float* conv_b, const float* A_log, bf16* ST, float* CHDEC, int u, int tid, int lane, int wave) {
    asm volatile("" : "+v"(tid), "+v"(lane));
    const int g = u & 3, c = (u >> 2) & 63, b = u >> 8, t0 = b * SEQ + c * 128;
    const int fr = lane & 15, fq = lane >> 4, trq = (lane & 15) >> 2, trp = lane & 3;
    LAS float* ACS = (LAS float*)(lds + SA_ACS); LAS float* DTS = (LAS float*)(lds + SA_DTS); LAS float* TMP = (LAS float*)(lds + SA_TMP);
    ssd_dt_acs(DT, A_log, t0, g, ACS, DTS, TMP, tid);
    if (tid < 4) CHDEC[(b * 64 + c) * 16 + g * 4 + tid] = __expf(ACS[tid * 128 + 127]);
    if (tid < 384) { const int cg = tid % 48, tg = tid / 48; const bool isx = cg < 32; const int r = isx ? (cg >> 3) : 0;
        ssd_conv_group(PROJ0, conv_w, conv_b, t0, c == 0, isx ? g * 256 + 8 * cg : 1024 + g * 128 + 8 * (cg - 32), tg, isx ? 0 : 2,
                       isx ? lds + SA_XS + cg * 16 : lds + SA_BS + (cg - 32) * 16, isx ? 528 : 272, ACS + r * 128, DTS + r * 128); }
    __syncthreads();
    const int r = wave >> 1, half = wave & 1;
    f32x4 acc[2][8];
#pragma unroll
    for (int j = 0; j < 2; ++j)
#pragma unroll
        for (int n = 0; n < 8; ++n) acc[j][n] = (f32x4){0.f, 0.f, 0.f, 0.f};
    bf16x8 fa[2][2], fb[2][8];
#define SA_READ(ks_, buf_) do { _Pragma("unroll") for (int j = 0; j < 2; ++j) fa[buf_][j] = lds_frag_tr(lds + SA_XS + (32 * (ks_) + 8 * fq + trq) * 528 + (r * 64 + (2 * half + j) * 16 + 4 * trp) * 2, 528); \
        _Pragma("unroll") for (int n = 0; n < 8; ++n) fb[buf_][n] = lds_frag_tr(lds + SA_BS + (32 * (ks_) + 8 * fq + trq) * 272 + (n * 16 + 4 * trp) * 2, 272); } while (0)
    SA_READ(0, 0);
#pragma unroll
    for (int ks = 0; ks < 4; ++ks) {
        if (ks < 3) SA_READ(ks + 1, (ks + 1) & 1);
        __builtin_amdgcn_sched_barrier(0);
#pragma unroll
        for (int n = 0; n < 8; ++n) { MFMA16(acc[0][n], fa[ks & 1][0], fb[ks & 1][n]); MFMA16(acc[1][n], fa[ks & 1][1], fb[ks & 1][n]); }
        __builtin_amdgcn_sched_barrier(0);
    }
#undef SA_READ
    bf16* so = ST + ((size_t)((b * 64 + c) * 16 + g * 4 + r) * 64) * 128;
#pragma unroll
    for (int j = 0; j < 2; ++j)
#pragma unroll
        for (int n = 0; n < 8; ++n) { v2u w; w.x = pk2(acc[j][n][0], acc[j][n][1]); w.y = pk2(acc[j][n][2], acc[j][n][3]);
            *(v2u*)(so + (size_t)((2 * half + j) * 16 + fr) * 128 + n * 16 + 4 * fq) = w; }
    __syncthreads();
}
__device__ __forceinline__ void ssd_scan(bf16* ST, const float* CHDEC, int gtid, int gthreads) {
    for (int e = gtid; e < 131072; e += gthreads) {
        const int b = e >> 16, rem = e & 65535, h = rem >> 12, pn = rem & 4095;
        unsigned* p = (unsigned*)ST + ((size_t)(b * 64) * 16 + h) * 4096 + pn; const float* dp = CHDEC + (b * 64) * 16 + h;
        float c0 = 0.f, c1 = 0.f;
#pragma unroll 1
        for (int hf = 0; hf < 2; ++hf) {
            unsigned v[32]; unsigned* pb = p + (size_t)hf * 32 * 16 * 4096;
            { const unsigned* q = pb;
#pragma unroll
              for (int c = 0; c < 32; ++c) { v[c] = *q; q += 16 * 4096; asm volatile("" : "+v"(q)); } }
#pragma unroll
            for (int c = 0; c < 32; ++c) { const float dec = dp[(hf * 32 + c) * 16]; const unsigned o = pk2(c0, c1); c0 = c0 * dec + __uint_as_float(v[c] << 16); c1 = c1 * dec + __uint_as_float(v[c] & 0xffff0000u); v[c] = o; }
            { unsigned* q = pb;
#pragma unroll
              for (int c = 0; c < 32; ++c) { *q = v[c]; q += 16 * 4096; asm volatile("" : "+v"(q)); } }
        }
    }
}
constexpr int SC_CS = 0, SC_BS = 34816, SC_XS = 69632, SC_ACS = 137216, SC_DTS = 139264, SC_TMP = 141312, SC_SP = 143360;
template <int PV> __device__ __forceinline__ void ssdC_unit(ldsp lds, const bf16* PROJ0, bf16* OUT  , int opitch, const float* DT, const float* conv_w, const float* conv_b, const float* A_log, const float* Dskip, const float* ssd_norm,
                                          const bf16* ST, float* SSQ, int u, int tid, int lane, int wave) {
    asm volatile("" : "+v"(tid), "+v"(lane));
    const int g = u & 3, c = (u >> 2) & 63, b = u >> 8, t0 = b * SEQ + c * 128;
    const int fr = lane & 15, fq = lane >> 4, trq = (lane & 15) >> 2, trp = lane & 3;
    LAS float* ACS = (LAS float*)(lds + SC_ACS); LAS float* DTS = (LAS float*)(lds + SC_DTS); LAS float* TMP = (LAS float*)(lds + SC_TMP);
    if (!(PV & 1)) ssd_dt_acs(DT, A_log, t0, g, ACS, DTS, TMP, tid);
    if (!(PV & 2)) { const int cg = tid & 63, tg = tid >> 6; const bool isx = cg < 32, isb = cg < 48; const int r = isx ? (cg >> 3) : 0;
      ssd_conv_group(PROJ0, conv_w, conv_b, t0, c == 0, isx ? g * 256 + 8 * cg : (isb ? 1024 + g * 128 + 8 * (cg - 32) : 1536 + g * 128 + 8 * (cg - 48)), tg, isx ? 1 : 2,
                     isx ? lds + SC_XS + cg * 16 : (isb ? lds + SC_BS + (cg - 32) * 16 : lds + SC_CS + (cg - 48) * 16), isx ? 528 : 272, ACS + r * 128, DTS + r * 128); }
    __syncthreads();
    const int l = 16 * wave + fr;
    const ldsp crow = lds + SC_CS + l * 272 + 16 * fq, mrow = lds + SC_BS + l * 272 + 16 * fq;
    const bf16* prow = PROJ0 + (size_t)(t0 + l) * NPROJ0; bf16* orow = OUT + (size_t)(t0 + l) * opitch;
    v2u zw[4]; f32x4 nwn[4]; float dskn;
    v4u spr[2];
    const int sprow = tid >> 3, spch = tid & 7;
    { const bf16* sp = ST + ((size_t)((b * 64 + c) * 16 + g * 4) * 64) * 128;
#pragma unroll
      for (int i = 0; i < 2; ++i) spr[i] = *(const v4u*)(sp + (size_t)(sprow) * 128 + (spch + 8 * i) * 8);
#pragma unroll
      for (int p = 0; p < 4; ++p) { zw[p] = *(const v2u*)(prow + C0_Z + (g * 4) * 64 + 16 * p + 4 * fq); nwn[p] = *(const f32x4*)(ssd_norm + (g * 4) * 64 + 16 * p + 4 * fq); }
      dskn = Dskip[g * 4]; }
    f32x4 cb[8];
#pragma unroll
    for (int n = 0; n < 8; ++n) cb[n] = (f32x4){0.f, 0.f, 0.f, 0.f};
#pragma unroll
    for (int ks = 0; ks < 4; ++ks) { const bf16x8 af = lds_frag(crow + 64 * ks); bf16x8 bfr[8];
#pragma unroll
        for (int n = 0; n < 8; ++n) bfr[n] = lds_frag(lds + SC_BS + (16 * n + fr) * 272 + 64 * ks + 16 * fq);
        __builtin_amdgcn_sched_barrier(0);
#pragma unroll
        for (int n = 0; n < 8; ++n) MFMA16(cb[n], af, bfr[n]);
        __builtin_amdgcn_sched_barrier(0); }
    __syncthreads();
    float ssq = 0.f;
#pragma unroll 1
    for (int r = 0; r < ((PV & 4) ? 0 : 4); ++r) {
        const int h = g * 4 + r; const float al = ACS[r * 128 + l];
#pragma unroll
        for (int i = 0; i < 2; ++i) *(LAS v4u*)(lds + SC_SP + sprow * 272 + (spch + 8 * i) * 16) = spr[i];
        v2u zc[4]; f32x4 nwc[4]; const float dskc = dskn;
#pragma unroll
        for (int p = 0; p < 4; ++p) { zc[p] = zw[p]; nwc[p] = nwn[p]; }
        if (r < 3 && !(PV & 8)) {
            const bf16* sp = ST + ((size_t)((b * 64 + c) * 16 + h + 1) * 64) * 128;
#pragma unroll
            for (int i = 0; i < 2; ++i) spr[i] = *(const v4u*)(sp + (size_t)(sprow) * 128 + (spch + 8 * i) * 8);
#pragma unroll
            for (int p = 0; p < 4; ++p) { zw[p] = *(const v2u*)(prow + C0_Z + (h + 1) * 64 + 16 * p + 4 * fq); nwn[p] = *(const f32x4*)(ssd_norm + (h + 1) * 64 + 16 * p + 4 * fq); }
            dskn = Dskip[h + 1];
        }
        __syncthreads();
#pragma unroll
        for (int n = 0; n < 8; ++n) { const f32x4 as = *(const LAS f32x4*)(ACS + r * 128 + 16 * n + 4 * fq); float mv[4];
#pragma unroll
            for (int i = 0; i < 4; ++i) { const int s = 16 * n + 4 * fq + i; mv[i] = (s <= l) ? cb[n][i] * __expf(al - as[i]) : 0.f; }
            v2u w; w.x = pk2(mv[0], mv[1]); w.y = pk2(mv[2], mv[3]); *(LAS v2u*)(lds + SC_BS + l * 272 + (16 * n + 4 * fq) * 2) = w; }
        f32x4 y[4], yo[4];
#pragma unroll
        for (int p = 0; p < 4; ++p) { y[p] = (f32x4){0.f, 0.f, 0.f, 0.f}; yo[p] = y[p]; }
#pragma unroll
        for (int ks = 0; ks < 4; ++ks) { const bf16x8 af = lds_frag(mrow + 64 * ks);
            bf16x8 xf[4];
#pragma unroll
            for (int p = 0; p < 4; ++p) xf[p] = lds_frag_tr(lds + SC_XS + (32 * ks + 8 * fq + trq) * 528 + (r * 64 + 16 * p + 4 * trp) * 2, 528);
#pragma unroll
            for (int p = 0; p < 4; ++p) MFMA16(y[p], af, xf[p]); }
#pragma unroll
        for (int ks = 0; ks < 4; ++ks) { const bf16x8 cf = lds_frag(crow + 64 * ks); bf16x8 sf[4];
#pragma unroll
            for (int p = 0; p < 4; ++p) sf[p] = lds_frag(lds + SC_SP + (16 * p + fr) * 272 + 64 * ks + 16 * fq);
#pragma unroll
            for (int p = 0; p < 4; ++p) MFMA16(yo[p], cf, sf[p]); }
        __syncthreads();
        const float el = __expf(al), rdt = dskc / DTS[r * 128 + l];
#pragma unroll
        for (int p = 0; p < 4; ++p) { const int ch = h * 64 + 16 * p + 4 * fq;
            const v2u xw = *(const LAS v2u*)(lds + SC_XS + l * 528 + (r * 64 + 16 * p + 4 * fq) * 2); const f32x4 nw = nwc[p];
            const float z[4] = {__uint_as_float(zc[p].x << 16), __uint_as_float(zc[p].x & 0xffff0000u), __uint_as_float(zc[p].y << 16), __uint_as_float(zc[p].y & 0xffff0000u)};
            const float xs[4] = {__uint_as_float(xw.x << 16), __uint_as_float(xw.x & 0xffff0000u), __uint_as_float(xw.y << 16), __uint_as_float(xw.y & 0xffff0000u)};
            float o[4];
#pragma unroll
            for (int i = 0; i < 4; ++i) { float v = y[p][i] + el * yo[p][i] + rdt * xs[i]; v *= silu_f(z[i]); ssq += v * v; o[i] = v * nw[i]; }
            v2u w; w.x = pk2(o[0], o[1]); w.y = pk2(o[2], o[3]); if (!(PV & 16)) *(v2u*)(orow + ch) = w; else asm volatile("" :: "v"(w.x), "v"(w.y)); }
    }
    ssq += __shfl_xor(ssq, 16); ssq += __shfl_xor(ssq, 32);
    if (fq == 0) SSQ[(size_t)(t0 + l) * 4 + g] = ssq;
    __syncthreads();
}
__device__ __forceinline__ void ssd_normalize_rows(bf16* PROJ0, const float* SSQ, int gw, int NGW, int lane) {
    for (int m = gw; m < MTOK; m += NGW) {
        const f32x4 q = *(const f32x4*)(SSQ + (size_t)m * 4); const float r = 1.0f / sqrtf(((q.x + q.y) + (q.z + q.w)) * (1.f / 1024.f) + EPS);
        v4u* p = (v4u*)(PROJ0 + (size_t)m * NPROJ0 + C0_Z + 8 * lane); v4u w0 = p[0], w1 = p[64];
#pragma unroll
        for (int i = 0; i < 4; ++i) { w0[i] = pk2(__uint_as_float(w0[i] << 16) * r, __uint_as_float(w0[i] & 0xffff0000u) * r); w1[i] = pk2(__uint_as_float(w1[i] << 16) * r, __uint_as_float(w1[i] & 0xffff0000u) * r); }
        p[0] = w0; p[64] = w1;
    }
}

__device__ __forceinline__ float quad_max(float v) {
    auto a = __builtin_amdgcn_permlane16_swap(__float_as_uint(v), __float_as_uint(v), false, false); v = fmaxf(__uint_as_float(a[0]), __uint_as_float(a[1]));
    auto b = __builtin_amdgcn_permlane32_swap(__float_as_uint(v), __float_as_uint(v), false, false); return fmaxf(__uint_as_float(b[0]), __uint_as_float(b[1]));
}
__device__ __forceinline__ float quad_sum(float v) {
    auto a = __builtin_amdgcn_permlane16_swap(__float_as_uint(v), __float_as_uint(v), false, false); v = __uint_as_float(a[0]) + __uint_as_float(a[1]);
    auto b = __builtin_amdgcn_permlane32_swap(__float_as_uint(v), __float_as_uint(v), false, false); return __uint_as_float(b[0]) + __uint_as_float(b[1]);
}
__device__ __forceinline__ void glds16_asm(const void* gsrc, unsigned lds_dst) { unsigned keep;
    asm volatile("s_mov_b32 %0, m0\n\ts_mov_b32 m0, %2\n\ts_nop 0\n\tglobal_load_lds_dwordx4 %1, off\n\ts_mov_b32 m0, %0" : "=&s"(keep) : "v"(gsrc), "s"(lds_dst) : "memory"); }
#ifndef DA_NOFAST
#define DA_NOFAST 0
#endif
#ifndef DA_SGB
#define DA_SGB true
#endif
#ifndef DA_PAR
#define DA_PAR 0
#endif
constexpr int DB_K = 0, DB_V = 65536, DB_TSZ = 16384, DB_BT = 147456, DB_XCH = 0;
__device__ __forceinline__ bf16x8 lds_frag_tr2(ldsp p0, ldsp p1) {
    const v4i16_t lo = __builtin_amdgcn_ds_read_tr16_b64_v4i16((LAS v4i16_t*)p0);
    const v4i16_t hi = __builtin_amdgcn_ds_read_tr16_b64_v4i16((LAS v4i16_t*)p1);
    return (bf16x8){lo[0], lo[1], lo[2], lo[3], hi[0], hi[1], hi[2], hi[3]};
}
#define DB_BAR() do { __builtin_amdgcn_sched_barrier(0); asm volatile("s_waitcnt lgkmcnt(0)" ::: "memory"); __builtin_amdgcn_s_barrier(); asm volatile("" ::: "memory"); __builtin_amdgcn_sched_barrier(0); } while (0)
constexpr size_t WS_KMAX = 32 * 1024;
__device__ __forceinline__ void kmax_rows(const bf16* PROJ0, unsigned* KMAX, int gw, int NGW, int lane) {
#pragma unroll 1
    for (int b = 0; b < BATCH; ++b) {
        float mx = 0.f; int m = b * SEQ + (gw % NGW); while (m < b * SEQ) m += NGW;
        for (; m < (b + 1) * SEQ; m += NGW) {
            const v4u* p = (const v4u*)(PROJ0 + (size_t)m * NPROJ0 + C0_K + 16 * lane); const v4u w0 = p[0], w1 = p[1]; float ss = 0.f;
#pragma unroll
            for (int i = 0; i < 4; ++i) { const float a0 = __uint_as_float(w0[i] << 16), a1 = __uint_as_float(w0[i] & 0xffff0000u), b0 = __uint_as_float(w1[i] << 16), b1 = __uint_as_float(w1[i] & 0xffff0000u);
                ss += (a0 * a0 + a1 * a1) + (b0 * b0 + b1 * b1); }
            ss += __shfl_xor(ss, 1); ss += __shfl_xor(ss, 2); mx = fmaxf(mx, ss);
        }
        if ((lane & 3) == 0) atomicMax(KMAX + b * 16 + (lane >> 2), __float_as_uint(mx));
    }
}
template <int PVAR> __device__ __forceinline__ void dattn5_unit(ldsp lds, const bf16* PROJ0, bf16* OUT  , int opitch, const float* rel_bias, const float* diff_norm, const unsigned* KMAX, float lam,
                                                                int b, int h, int qb, int tid, int lane, int wave) {
    asm volatile("" : "+v"(tid), "+v"(lane));
    const int fr = lane & 15, fq = lane >> 4, trq = (lane & 15) >> 2, trp = lane & 3;
    const int m = wave >> 2, rg = wave & 3;
    const size_t rowbase = (size_t)b * SEQ; const int q0 = qb * 128, row0 = q0 + 32 * rg;
    const int nt = 2 * qb + 2;
    const bf16* kvb = PROJ0 + rowbase * NPROJ0 + h * 128;
    const bf16* ksrc[2]; const bf16* vsrc[2];
#pragma unroll
    for (int i = 0; i < 2; ++i) { const int key = 4 * (wave + 8 * i) + (lane >> 4), slot = lane & 15;
        ksrc[i] = kvb + (size_t)key * NPROJ0 + C0_K + ((slot ^ (key & 15)) * 8); vsrc[i] = kvb + (size_t)key * NPROJ0 + C0_V + ((slot ^ ((key & 7) << 1)) * 8); }
    int kw = 0, vw = 0;
    const unsigned lds0 = (unsigned)(size_t)lds;
#define DB_DMAK(t) do { _Pragma("unroll") for (int i_ = 0; i_ < 2; ++i_) \
        glds16_asm(ksrc[i_] + (size_t)(64 * (t)) * NPROJ0, (unsigned)__builtin_amdgcn_readfirstlane((int)(lds0 + DB_K + kw * DB_TSZ + (wave + 8 * i_) * 1024))); \
        kw = (kw + 1) & 3; } while (0)
#define DB_DMAV(t) do { _Pragma("unroll") for (int i_ = 0; i_ < 2; ++i_) \
        glds16_asm(vsrc[i_] + (size_t)(64 * (t)) * NPROJ0, (unsigned)__builtin_amdgcn_readfirstlane((int)(lds0 + DB_V + vw * DB_TSZ + (wave + 8 * i_) * 1024))); \
        vw = (vw == 4) ? 0 : vw + 1; } while (0)
    DB_DMAK(0); DB_DMAV(0); DB_DMAK(1); DB_DMAV(1); if (nt > 2) { DB_DMAK(2); DB_DMAV(2); } if (nt > 3) DB_DMAK(3);
    const float SC = 0.125f * LOG2E, c31 = rel_bias[31 * 8 + h] * LOG2E;
    bf16x8 qf[2][2]; float qss[2] = {0.f, 0.f};
#pragma unroll
    for (int rt = 0; rt < 2; ++rt)
#pragma unroll
        for (int ks = 0; ks < 2; ++ks) { const v4u raw = *(const v4u*)(PROJ0 + (rowbase + row0 + 16 * rt + fr) * NPROJ0 + C0_Q + h * 128 + m * 64 + ks * 32 + fq * 8); v4u sc;
#pragma unroll
            for (int i = 0; i < 4; ++i) { sc[i] = pk2(__uint_as_float(raw[i] << 16) * SC, __uint_as_float(raw[i] & 0xffff0000u) * SC);
                const float r0 = __uint_as_float(sc[i] << 16), r1 = __uint_as_float(sc[i] & 0xffff0000u); qss[rt] += r0 * r0 + r1 * r1; }
            qf[rt][ks] = __builtin_bit_cast(bf16x8, sc); }
    LAS float* BT = (LAS float*)(lds + DB_BT);
    if (tid < 128) BT[tid] = (rel_bias[t5_bucket(tid) * 8 + h] - rel_bias[31 * 8 + h]) * LOG2E;
    float bmax = rel_bias[h];
#pragma unroll 1
    for (int k = 1; k < 32; ++k) bmax = fmaxf(bmax, rel_bias[k * 8 + h]);
    const float kmx = sqrtf(__uint_as_float(KMAX[(b * 8 + h) * 2 + m]));
    f32x4 cmv[2];
#pragma unroll
    for (int rt = 0; rt < 2; ++rt) { const float c = c31 - (sqrtf(quad_sum(qss[rt])) * kmx * 1.001f + bmax * LOG2E + 0.01f); cmv[rt] = (f32x4){c, c, c, c}; }
    f32x4 o[2][9], s[2][4], sn[2][4]; v4u pk[2][2];
#pragma unroll
    for (int rt = 0; rt < 2; ++rt) {
#pragma unroll
        for (int e = 0; e < 9; ++e) o[rt][e] = (f32x4){0.f, 0.f, 0.f, 0.f};
#pragma unroll
        for (int k2 = 0; k2 < 2; ++k2) pk[rt][k2] = (v4u){0u, 0u, 0u, 0u}; }
    const bf16x8 ones = {0x3F80, 0x3F80, 0x3F80, 0x3F80, 0x3F80, 0x3F80, 0x3F80, 0x3F80};
    const int vswz = ((4 * (fq & 1) + trq) << 1);
    const int vlane = (4 * fq + trq) * 256 + trp * 8;
    int vco[8], kx[2];
#pragma unroll
    for (int e = 0; e < 8; ++e) vco[e] = vlane + (((2 * e) ^ vswz) * 16);
#pragma unroll
    for (int ks = 0; ks < 2; ++ks) kx[ks] = fr * 256 + (((m * 8 + ks * 4 + fq) ^ fr) * 16);
    asm volatile("s_waitcnt vmcnt(0)" ::: "memory");
    DB_BAR();
    int kr = 0, vr = 0;
#define DA_SMAT(DST) do { const ldsp kbuf_ = lds + DB_K + kr * DB_TSZ; kr = (kr + 1) & 3; \
        _Pragma("unroll") for (int n_ = 0; n_ < 4; ++n_) { \
            const bf16x8 k0_ = lds_frag(kbuf_ + kx[0] + n_ * 4096), k1_ = lds_frag(kbuf_ + kx[1] + n_ * 4096); \
            _Pragma("unroll") for (int rt_ = 0; rt_ < 2; ++rt_) { DST[rt_][n_] = __builtin_amdgcn_mfma_f32_16x16x32_bf16(k0_, qf[rt_][0], cmv[rt_], 0, 0, 0); MFMA16(DST[rt_][n_], qf[rt_][1], k1_); } } } while (0)
    DA_SMAT(s);
#define DA_BODY(T_, FAR_, PV_, SN_, SA, SB) do { \
        const bool dmak_ = ((T_) + 4 < nt) && !(PVAR & 1), dmav_ = ((T_) + 3 < nt) && !(PVAR & 1); \
        if (dmak_) DB_DMAK((T_) + 4); \
        if (dmav_) DB_DMAV((T_) + 3); \
        if ((SN_) && !(PVAR & 4)) DA_SMAT(SB); \
        if ((PV_) && !(PVAR & 4)) { \
            const ldsp vb_ = lds + DB_V + vr * DB_TSZ; vr = (vr == 4) ? 0 : vr + 1; \
            _Pragma("unroll") for (int k2 = 0; k2 < 2; ++k2) { \
                _Pragma("unroll") for (int e = 0; e < 8; ++e) { const bf16x8 vf = lds_frag_tr2(vb_ + vco[e] + (32 * k2) * 256, vb_ + vco[e] + (32 * k2 + 16) * 256); \
                    MFMA16(o[0][e], __builtin_bit_cast(bf16x8, pk[0][k2]), vf); MFMA16(o[1][e], __builtin_bit_cast(bf16x8, pk[1][k2]), vf); } \
                MFMA16(o[0][8], __builtin_bit_cast(bf16x8, pk[0][k2]), ones); MFMA16(o[1][8], __builtin_bit_cast(bf16x8, pk[1][k2]), ones); } \
        } \
        if (!(PVAR & 2)) { \
            const int k0 = 64 * (T_); \
            _Pragma("unroll") for (int rt = 0; rt < 2; ++rt) { \
                if (FAR_) { \
                    _Pragma("unroll") for (int n = 0; n < 4; ++n) \
                        _Pragma("unroll") for (int i = 0; i < 4; ++i) SA[rt][n][i] = __builtin_amdgcn_exp2f(SA[rt][n][i]); \
                } else { \
                    const int row = row0 + 16 * rt + fr; \
                    _Pragma("unroll") for (int n = 0; n < 4; ++n) \
                        _Pragma("unroll") for (int i = 0; i < 4; ++i) { const int dist = row - (k0 + 16 * n + 4 * fq + i); const int di = min(max(dist, 0), 127); const float bb = BT[di]; \
                            const float pen = dist < 0 ? -INFINITY : 0.f; SA[rt][n][i] = __builtin_amdgcn_exp2f((SA[rt][n][i] + bb) + pen); } \
                } \
            } \
        } \
        _Pragma("unroll") for (int rt = 0; rt < 2; ++rt) \
            _Pragma("unroll") for (int k2 = 0; k2 < 2; ++k2) { pk[rt][k2].x = pk2(SA[rt][2 * k2][0], SA[rt][2 * k2][1]); pk[rt][k2].y = pk2(SA[rt][2 * k2][2], SA[rt][2 * k2][3]); \
                pk[rt][k2].z = pk2(SA[rt][2 * k2 + 1][0], SA[rt][2 * k2 + 1][1]); pk[rt][k2].w = pk2(SA[rt][2 * k2 + 1][2], SA[rt][2 * k2 + 1][3]); } \
        if (dmak_) asm volatile("s_waitcnt vmcnt(10)" ::: "memory"); else asm volatile("s_waitcnt vmcnt(0)" ::: "memory"); \
        asm volatile("s_waitcnt lgkmcnt(0)" ::: "memory"); __builtin_amdgcn_s_barrier(); asm volatile("" ::: "memory"); \
    } while (0)
#define DA_FAST(T_, SA, SB) do { \
        if (!(PVAR & 1)) { DB_DMAK((T_) + 4); DB_DMAV((T_) + 3); } \
        const ldsp vb_ = lds + DB_V + vr * DB_TSZ; vr = (vr == 4) ? 0 : vr + 1; \
        const ldsp kb_ = lds + DB_K + kr * DB_TSZ; kr = (kr + 1) & 3; \
        bf16x8 vfr[3], kfr[4]; \
        vfr[0] = lds_frag_tr2(vb_ + vco[0], vb_ + vco[0] + 16 * 256); vfr[1] = lds_frag_tr2(vb_ + vco[1], vb_ + vco[1] + 16 * 256); \
        __builtin_amdgcn_sched_barrier(0); \
        _Pragma("unroll") for (int g = 0; g < 52; ++g) { \
            if (g < 32) { const int f = g >> 1, rt = g & 1, k2 = f >> 3, e = f & 7; MFMA16(o[rt][e], __builtin_bit_cast(bf16x8, pk[rt][k2]), vfr[f % 3]); } \
            else if (g < 36) { const int jj = g - 32, rt = jj & 1, k2 = jj >> 1; MFMA16(o[rt][8], __builtin_bit_cast(bf16x8, pk[rt][k2]), ones); } \
            else { const int jj = g - 36, n = jj >> 2, ks = (jj >> 1) & 1, rt = jj & 1; \
                if (ks == 0) SB[rt][n] = __builtin_amdgcn_mfma_f32_16x16x32_bf16(kfr[(n * 2 + ks) & 3], qf[rt][ks], cmv[rt], 0, 0, 0); \
                else MFMA16(SB[rt][n], qf[rt][ks], kfr[(n * 2 + ks) & 3]); } \
            if (g >= 2 && g < 34) { const int jj = g - 2, rt = jj >> 4, n = (jj >> 2) & 3, i = jj & 3; SA[rt][n][i] = __builtin_amdgcn_exp2f(SA[rt][n][i]); } \
            if (g >= 36) { const int q_ = g - 36, rt = q_ >> 3, k2 = (q_ >> 2) & 1, w = q_ & 3; pk[rt][k2][w] = pk2(SA[rt][2 * k2 + (w >> 1)][2 * (w & 1)], SA[rt][2 * k2 + (w >> 1)][2 * (w & 1) + 1]); } \
            if (g < 32 && !(g & 1) && (g >> 1) + 2 < 16) { const int f = (g >> 1) + 2, k2 = f >> 3, e = f & 7; vfr[f % 3] = lds_frag_tr2(vb_ + vco[e] + (32 * k2) * 256, vb_ + vco[e] + (32 * k2 + 16) * 256); } \
            if (g >= 30 && g < 46 && !(g & 1)) { const int c_ = (g - 30) >> 1, n = c_ >> 1, ks = c_ & 1; kfr[c_ & 3] = lds_frag(kb_ + kx[ks] + n * 4096); } \
            __builtin_amdgcn_sched_barrier(0); \
        } \
        if (!(PVAR & 1)) asm volatile("s_waitcnt vmcnt(10)" ::: "memory"); \
        asm volatile("s_waitcnt lgkmcnt(0)" ::: "memory"); __builtin_amdgcn_s_barrier(); asm volatile("" ::: "memory"); \
    } while (0)
    int t = 0;
#define DA_COPY() do { _Pragma("unroll") for (int rt = 0; rt < 2; ++rt) _Pragma("unroll") for (int n = 0; n < 4; ++n) s[rt][n] = sn[rt][n]; } while (0)
    if (nt >= 6) {
        DA_BODY(0, true, false, true, s, sn); DA_COPY();
        for (t = 1; t + 1 <= nt - 5; t += 2) { DA_FAST(t, s, sn); DA_FAST(t + 1, sn, s); }
        if (t <= nt - 5) { DA_FAST(t, s, sn); DA_COPY(); ++t; }
    }
    for (; t < nt; ++t) { const bool far = (q0 - 64 * t - 63) >= 113; DA_BODY(t, far, t > 0, t + 1 < nt, s, sn); DA_COPY(); }
#undef DA_COPY
#undef DA_BODY
#undef DA_FAST
    if (!(PVAR & 4)) {
        const ldsp vb_ = lds + DB_V + vr * DB_TSZ;
#pragma unroll
        for (int k2 = 0; k2 < 2; ++k2) {
#pragma unroll
            for (int e = 0; e < 8; ++e) { const bf16x8 vf = lds_frag_tr2(vb_ + vco[e] + (32 * k2) * 256, vb_ + vco[e] + (32 * k2 + 16) * 256);
                MFMA16(o[0][e], __builtin_bit_cast(bf16x8, pk[0][k2]), vf); MFMA16(o[1][e], __builtin_bit_cast(bf16x8, pk[1][k2]), vf); }
            MFMA16(o[0][8], __builtin_bit_cast(bf16x8, pk[0][k2]), ones); MFMA16(o[1][8], __builtin_bit_cast(bf16x8, pk[1][k2]), ones); }
    }
    asm volatile("s_waitcnt lgkmcnt(0)" ::: "memory"); __builtin_amdgcn_s_barrier(); asm volatile("" ::: "memory");
#undef DB_DMAK
#undef DB_DMAV
#undef DA_SMAT
    float inv[2];
#pragma unroll
    for (int rt = 0; rt < 2; ++rt) inv[rt] = 1.0f / o[rt][8][0];
    LAS float* XCH = (LAS float*)(lds + DB_XCH) + rg * (32 * 132);
    if (m == 1) {
#pragma unroll
        for (int rt = 0; rt < 2; ++rt) { const float f = lam * inv[rt];
#pragma unroll
            for (int e = 0; e < 8; ++e) *(LAS f32x4*)(XCH + (16 * rt + fr) * 132 + 16 * e + 4 * fq) = o[rt][e] * f; }
    }
    __syncthreads();
    if (m == 0) {
        f32x4 dnw[8];
#pragma unroll
        for (int e = 0; e < 8; ++e) dnw[e] = *(const f32x4*)(diff_norm + 16 * e + 4 * fq);
#pragma unroll
        for (int rt = 0; rt < 2; ++rt) { float ssq = 0.f;
#pragma unroll
            for (int e = 0; e < 8; ++e) { const f32x4 x2 = *(const LAS f32x4*)(XCH + (16 * rt + fr) * 132 + 16 * e + 4 * fq); const f32x4 v = o[rt][e] * inv[rt] - x2; o[rt][e] = v;
                ssq += (v[0] * v[0] + v[1] * v[1]) + (v[2] * v[2] + v[3] * v[3]); }
            ssq = quad_sum(ssq);
            const float rs = 0.8f / sqrtf(ssq * (1.f / 128.f) + EPS);
            bf16* orow = OUT + (rowbase + row0 + 16 * rt + fr) * opitch + h * 128;
#pragma unroll
            for (int e = 0; e < 8; ++e) { const f32x4 dn = dnw[e]; v2u w;
                w.x = pk2(o[rt][e][0] * rs * dn[0], o[rt][e][1] * rs * dn[1]); w.y = pk2(o[rt][e][2] * rs * dn[2], o[rt][e][3] * rs * dn[3]);
                *(v2u*)(orow + 16 * e + 4 * fq) = w; } }
    }
    __syncthreads();
}

constexpr int SW_KS = 0, SW_VS = 36864, SW_BT = 73728;
__device__ __forceinline__ void swa_unit(ldsp lds, const bf16* PROJ1, bf16* OUT  , int opitch, const float* rel_bias, const float* sinks, int b, int blk, int g, int tid, int lane, int wave) {
    asm volatile("" : "+v"(tid), "+v"(lane));
    const int fr = lane & 15, fq = lane >> 4, trq = (lane & 15) >> 2, trp = lane & 3;
    const size_t rowbase = (size_t)b * SEQ; const int qi = 16 * wave + fr;
    const bf16* prow = PROJ1 + (rowbase + blk * 128 + qi) * NPROJ1; bf16* orow = OUT + (rowbase + blk * 128 + qi) * opitch;
    bf16x8 qn[2];
#pragma unroll
    for (int ks = 0; ks < 2; ++ks) qn[ks] = *(const bf16x8*)(prow + C1_SQ + (4 * g) * 64 + ks * 32 + fq * 8);
    LAS float* BT = (LAS float*)(lds + SW_BT);
    { const int r = tid >> 7, d = tid & 127; BT[tid] = rel_bias[t5_bucket(d) * 8 + 4 * g + r] * LOG2E; }
#pragma unroll
    for (int i = 0; i < 4; ++i) { const int idx = tid + 512 * i, key = idx >> 3, ch = idx & 7; const int kp = blk * 128 - 128 + key;
        v4u kv = {0u, 0u, 0u, 0u}, vv = kv;
        if (kp >= 0) { const bf16* p = PROJ1 + (rowbase + kp) * NPROJ1 + g * 64 + ch * 8; kv = *(const v4u*)(p + C1_SK); vv = *(const v4u*)(p + C1_SV); }
        *(LAS v4u*)(lds + SW_KS + key * 144 + ch * 16) = kv; *(LAS v4u*)(lds + SW_VS + key * 144 + ch * 16) = vv; }
    __syncthreads();
    const float SC = 0.125f * LOG2E;
#pragma unroll 1
    for (int r = 0; r < 4; ++r) {
        const float skr = sinks[4 * g + r] * LOG2E;
        bf16x8 qc[2] = {qn[0], qn[1]};
        if (r < 3) {
#pragma unroll
            for (int ks = 0; ks < 2; ++ks) qn[ks] = *(const bf16x8*)(prow + C1_SQ + (4 * g + r + 1) * 64 + ks * 32 + fq * 8); }
        f32x4 s[10];
#pragma unroll
        for (int nn = 0; nn < 9; ++nn) { const int n = wave + nn; bf16x8 kf[2];
#pragma unroll
            for (int ks = 0; ks < 2; ++ks) kf[ks] = lds_frag(lds + SW_KS + (16 * n + fr) * 144 + (ks * 32 + fq * 8) * 2);
            s[nn] = (f32x4){0.f, 0.f, 0.f, 0.f}; MFMA16(s[nn], qc[0], kf[0]); MFMA16(s[nn], qc[1], kf[1]); }
        s[9] = (f32x4){0.f, 0.f, 0.f, 0.f};
        float mx = skr;
#pragma unroll
        for (int nn = 0; nn < 9; ++nn)
#pragma unroll
            for (int i = 0; i < 4; ++i) { const int j = 16 * (wave + nn) + 4 * fq + i, dist = qi + 128 - j; const bool valid = (dist >= 0) && (dist < 128) && (blk * 128 - 128 + j >= 0);
                const float bb = BT[r * 128 + min(max(dist, 0), 127)]; const float pen = valid ? 0.f : -INFINITY; const float v = (s[nn][i] * SC + bb) + pen; s[nn][i] = v; mx = fmaxf(mx, v); }
        mx = quad_max(mx);
        float psum = 0.f;
#pragma unroll
        for (int nn = 0; nn < 9; ++nn)
#pragma unroll
            for (int i = 0; i < 4; ++i) { const float p = __builtin_amdgcn_exp2f(s[nn][i] - mx); s[nn][i] = p; psum += p; }
        const float il = 1.0f / (quad_sum(psum) + __builtin_amdgcn_exp2f(skr - mx));
        f32x4 o[4];
#pragma unroll
        for (int e = 0; e < 4; ++e) o[e] = (f32x4){0.f, 0.f, 0.f, 0.f};
#pragma unroll
        for (int k2 = 0; k2 < 5; ++k2) { v4u pkv; pkv.x = pk2(s[2 * k2][0] * il, s[2 * k2][1] * il); pkv.y = pk2(s[2 * k2][2] * il, s[2 * k2][3] * il);
            pkv.z = pk2(s[2 * k2 + 1][0] * il, s[2 * k2 + 1][1] * il); pkv.w = pk2(s[2 * k2 + 1][2] * il, s[2 * k2 + 1][3] * il);
            const int r0 = 16 * (wave + 2 * k2) + 4 * fq + trq, r1 = min(r0 + 16, 255);
#pragma unroll
            for (int e = 0; e < 4; ++e) { const bf16x8 vf = lds_frag_tr2(lds + SW_VS + r0 * 144 + (16 * e + 4 * trp) * 2, lds + SW_VS + r1 * 144 + (16 * e + 4 * trp) * 2);
                MFMA16(o[e], __builtin_bit_cast(bf16x8, pkv), vf); } }
#pragma unroll
        for (int e = 0; e < 4; ++e) { v2u w; w.x = pk2(o[e][0], o[e][1]); w.y = pk2(o[e][2], o[e][3]); *(v2u*)(orow + (4 * g + r) * 64 + 16 * e + 4 * fq) = w; }
    }
    __syncthreads();
}

__device__ __forceinline__ float ret_log2_gamma(int h) { return log2f(1.0f - exp2f(-5.0f - (float)h)); }
__device__ __forceinline__ void rope_row_store(const bf16* src  , const float* COS, const float* SIN, int pos, int q4, float scale, ldsp dst) {
    v4u lo[2], hi[2];
#pragma unroll
    for (int i = 0; i < 2; ++i) { lo[i] = *(const v4u*)(src + 16 * q4 + 8 * i); hi[i] = *(const v4u*)(src + 64 + 16 * q4 + 8 * i); }
    const float* cp = COS + (size_t)pos * 64 + 16 * q4; const float* sp = SIN + (size_t)pos * 64 + 16 * q4;
#pragma unroll
    for (int i = 0; i < 2; ++i) { v4u ol, oh;
#pragma unroll
        for (int j = 0; j < 4; ++j) { const f32x4 cc = *(const f32x4*)(cp + 8 * i + 4 * (j >> 1)), ss = *(const f32x4*)(sp + 8 * i + 4 * (j >> 1));
            const float c0 = cc[2 * (j & 1)], c1 = cc[2 * (j & 1) + 1], s0 = ss[2 * (j & 1)], s1 = ss[2 * (j & 1) + 1];
            const float a0 = __uint_as_float(lo[i][j] << 16), a1 = __uint_as_float(lo[i][j] & 0xffff0000u), b0 = __uint_as_float(hi[i][j] << 16), b1 = __uint_as_float(hi[i][j] & 0xffff0000u);
            ol[j] = pk2((a0 * c0 - b0 * s0) * scale, (a1 * c1 - b1 * s1) * scale); oh[j] = pk2((a0 * s0 + b0 * c0) * scale, (a1 * s1 + b1 * c1) * scale); }
        *(LAS v4u*)(dst + (16 * q4 + 8 * i) * 2) = ol; *(LAS v4u*)(dst + (64 + 16 * q4 + 8 * i) * 2) = oh; }
}
constexpr int RA_VS = 0, RA_KS = 67584;
__device__ __forceinline__ void retA_unit(ldsp lds, const bf16* PROJ1, const float* COS, const float* SIN, bf16* ST, int u, int tid, int lane, int wave) {
    asm volatile("" : "+v"(tid), "+v"(lane));
    const int h = u & 3, c = (u >> 2) & 63, b = u >> 8, t0 = b * SEQ + c * 128;
    const int fr = lane & 15, fq = lane >> 4, trq = (lane & 15) >> 2, trp = lane & 3;
    const float lg = ret_log2_gamma(h);
#pragma unroll
    for (int i = 0; i < 8; ++i) { const int idx = tid + 512 * i, rw = idx >> 5, ch = idx & 31;
        *(LAS v4u*)(lds + RA_VS + rw * 528 + ch * 16) = *(const v4u*)(PROJ1 + (size_t)(t0 + rw) * NPROJ1 + C1_RV + h * 256 + ch * 8); }
    { const int s = tid >> 2, q4 = tid & 3;
      rope_row_store(PROJ1 + (size_t)(t0 + s) * NPROJ1 + C1_RK + h * 128, COS, SIN, c * 128 + s, q4, 0.08838834764831845f * exp2f((float)(127 - s) * lg), lds + RA_KS + s * 272); }
    __syncthreads();
    f32x4 acc[2][8];
#pragma unroll
    for (int j = 0; j < 2; ++j)
#pragma unroll
        for (int n = 0; n < 8; ++n) acc[j][n] = (f32x4){0.f, 0.f, 0.f, 0.f};
    bf16x8 fa[2][2], fb[2][8];
#define RA_READ(ks_, buf_) do { _Pragma("unroll") for (int j = 0; j < 2; ++j) fa[buf_][j] = lds_frag_tr(lds + RA_VS + (32 * (ks_) + 8 * fq + trq) * 528 + ((2 * wave + j) * 16 + 4 * trp) * 2, 528); \
        _Pragma("unroll") for (int n = 0; n < 8; ++n) fb[buf_][n] = lds_frag_tr(lds + RA_KS + (32 * (ks_) + 8 * fq + trq) * 272 + (n * 16 + 4 * trp) * 2, 272); } while (0)
    RA_READ(0, 0);
#pragma unroll
    for (int ks = 0; ks < 4; ++ks) {
        if (ks < 3) RA_READ(ks + 1, (ks + 1) & 1);
        __builtin_amdgcn_sched_barrier(0);
#pragma unroll
        for (int n = 0; n < 8; ++n) { MFMA16(acc[0][n], fa[ks & 1][0], fb[ks & 1][n]); MFMA16(acc[1][n], fa[ks & 1][1], fb[ks & 1][n]); }
        __builtin_amdgcn_sched_barrier(0);
    }
#undef RA_READ
    bf16* so = ST + ((size_t)((b * 64 + c) * 4 + h) * 256) * 128;
#pragma unroll
    for (int j = 0; j < 2; ++j)
#pragma unroll
        for (int n = 0; n < 8; ++n) { v2u w; w.x = pk2(acc[j][n][0], acc[j][n][1]); w.y = pk2(acc[j][n][2], acc[j][n][3]);
            *(v2u*)(so + (size_t)((2 * wave + j) * 16 + fr) * 128 + n * 16 + 4 * fq) = w; }
    __syncthreads();
}
__device__ __forceinline__ void ret_scan(bf16* ST, int gtid, int gthreads) {
    for (int e = gtid; e < 131072; e += gthreads) {
        const int b = e >> 16, rem = e & 65535, h = rem >> 14, ed = rem & 16383;
        unsigned* p = (unsigned*)ST + ((size_t)(b * 64) * 4 + h) * 16384 + ed; const float dec = exp2f(128.0f * ret_log2_gamma(h));
        float c0 = 0.f, c1 = 0.f;
#pragma unroll 1
        for (int hf = 0; hf < 2; ++hf) {
            unsigned v[32]; unsigned* pb = p + (size_t)hf * 32 * 4 * 16384;
            { const unsigned* q = pb;
#pragma unroll
              for (int c = 0; c < 32; ++c) { v[c] = *q; q += 4 * 16384; asm volatile("" : "+v"(q)); } }
#pragma unroll
            for (int c = 0; c < 32; ++c) { const unsigned o = pk2(c0, c1); c0 = c0 * dec + __uint_as_float(v[c] << 16); c1 = c1 * dec + __uint_as_float(v[c] & 0xffff0000u); v[c] = o; }
            { unsigned* q = pb;
#pragma unroll
              for (int c = 0; c < 32; ++c) { *q = v[c]; q += 4 * 16384; asm volatile("" : "+v"(q)); } }
        }
    }
}
constexpr int RC_KS = 0, RC_VS = 34816, RC_SP = 102400;
template <int PV> __device__ __forceinline__ void retC_unit(ldsp lds, const bf16* PROJ1, bf16* OUT  , int opitch, const float* COS, const float* SIN, const bf16* ST, int u, int tid, int lane, int wave) {
    asm volatile("" : "+v"(tid), "+v"(lane));
    const int h = u & 3, c = (u >> 2) & 63, b = u >> 8, t0 = b * SEQ + c * 128;
    const int fr = lane & 15, fq = lane >> 4, trq = (lane & 15) >> 2, trp = lane & 3;
    const float lg = ret_log2_gamma(h);
    const int l = 16 * wave + fr; const bf16* prow = PROJ1 + (size_t)(t0 + l) * NPROJ1; bf16* orow = OUT + (size_t)(t0 + l) * opitch;
    if (!(PV & 1)) {
#pragma unroll
    for (int i = 0; i < 8; ++i) { const int idx = tid + 512 * i, rw = idx >> 5, ch = idx & 31;
        *(LAS v4u*)(lds + RC_VS + rw * 528 + ch * 16) = *(const v4u*)(PROJ1 + (size_t)(t0 + rw) * NPROJ1 + C1_RV + h * 256 + ch * 8); }
    }
    if (!(PV & 1)) { const int s = tid >> 2, q4 = tid & 3;
      rope_row_store(PROJ1 + (size_t)(t0 + s) * NPROJ1 + C1_RK + h * 128, COS, SIN, c * 128 + s, q4, 0.08838834764831845f, lds + RC_KS + s * 272); }
    bf16x8 qf[4], qx[4];
    { v4u raw[4];
#pragma unroll
      for (int ks = 0; ks < 4; ++ks) raw[ks] = *(const v4u*)(prow + C1_RQ + h * 128 + 32 * ks + 8 * fq);
      const float xi = exp2f((float)(l + 1) * lg);
#pragma unroll
      for (int k2 = 0; k2 < 2; ++k2) { const float* cp = COS + (size_t)(c * 128 + l) * 64 + 32 * k2 + 8 * fq; const float* sp = SIN + (size_t)(c * 128 + l) * 64 + 32 * k2 + 8 * fq;
          v4u o1, o2, x1, x2;
#pragma unroll
          for (int j = 0; j < 4; ++j) { const f32x4 cc = *(const f32x4*)(cp + 4 * (j >> 1)), ss = *(const f32x4*)(sp + 4 * (j >> 1));
              const float c0 = cc[2 * (j & 1)], c1 = cc[2 * (j & 1) + 1], s0 = ss[2 * (j & 1)], s1 = ss[2 * (j & 1) + 1];
              const float a0 = __uint_as_float(raw[k2][j] << 16), a1 = __uint_as_float(raw[k2][j] & 0xffff0000u), b0 = __uint_as_float(raw[k2 + 2][j] << 16), b1 = __uint_as_float(raw[k2 + 2][j] & 0xffff0000u);
              const float r10 = a0 * c0 - b0 * s0, r11 = a1 * c1 - b1 * s1, r20 = a0 * s0 + b0 * c0, r21 = a1 * s1 + b1 * c1;
              o1[j] = pk2(r10, r11); o2[j] = pk2(r20, r21); x1[j] = pk2(r10 * xi, r11 * xi); x2[j] = pk2(r20 * xi, r21 * xi); }
          qf[k2] = __builtin_bit_cast(bf16x8, o1); qf[k2 + 2] = __builtin_bit_cast(bf16x8, o2); qx[k2] = __builtin_bit_cast(bf16x8, x1); qx[k2 + 2] = __builtin_bit_cast(bf16x8, x2); } }
    __syncthreads();
    f32x4 sc[8];
#pragma unroll
    for (int n = 0; n < 8; ++n) { sc[n] = (f32x4){0.f, 0.f, 0.f, 0.f};
#pragma unroll
        for (int ks = 0; ks < 4; ++ks) { const bf16x8 kf = lds_frag(lds + RC_KS + (16 * n + fr) * 272 + 64 * ks + 16 * fq); MFMA16(sc[n], qf[ks], kf); } }
    __syncthreads();
#pragma unroll
    for (int n = 0; n < 8; ++n) { float mv[4];
#pragma unroll
        for (int i = 0; i < 4; ++i) { const int s = 16 * n + 4 * fq + i; mv[i] = (s <= l) ? sc[n][i] * __builtin_amdgcn_exp2f((float)(l - s) * lg) : 0.f; }
        v2u w; w.x = pk2(mv[0], mv[1]); w.y = pk2(mv[2], mv[3]); *(LAS v2u*)(lds + RC_KS + l * 272 + (16 * n + 4 * fq) * 2) = w; }
    f32x4 o[16];
#pragma unroll
    for (int e = 0; e < 16; ++e) o[e] = (f32x4){0.f, 0.f, 0.f, 0.f};
    v2u gts[16];
#pragma unroll
    for (int e = 0; e < 16; ++e) gts[e] = *(const v2u*)(prow + C1_RG + h * 256 + 16 * e + 4 * fq);
    const bf16* sp = ST + ((size_t)((b * 64 + c) * 4 + h) * 256) * 128;
    const int sprow = tid >> 2, spc = tid & 3;
    v4u spr[2];
#pragma unroll
    for (int i = 0; i < 2; ++i) spr[i] = *(const v4u*)(sp + (size_t)(sprow + 128 * i) * 128 + spc * 8);
#pragma unroll
    for (int ks = 0; ks < ((PV & 2) ? 0 : 4); ++ks) {
        const ldsp slot = lds + RC_SP + (ks & 1) * 20480;
#pragma unroll
        for (int i = 0; i < 2; ++i) *(LAS v4u*)(slot + (sprow + 128 * i) * 80 + spc * 16) = spr[i];
        if (ks < 3) {
#pragma unroll
            for (int i = 0; i < 2; ++i) spr[i] = *(const v4u*)(sp + (size_t)(sprow + 128 * i) * 128 + 32 * (ks + 1) + spc * 8); }
        __syncthreads();
        const bf16x8 mf = lds_frag(lds + RC_KS + l * 272 + 64 * ks + 16 * fq);
#pragma unroll
        for (int eh = 0; eh < 2; ++eh) { bf16x8 sf[8], vf[8];
#pragma unroll
            for (int e = 0; e < 8; ++e) { sf[e] = lds_frag(slot + (16 * (8 * eh + e) + fr) * 80 + 16 * fq);
                vf[e] = lds_frag_tr(lds + RC_VS + (32 * ks + 8 * fq + trq) * 528 + (16 * (8 * eh + e) + 4 * trp) * 2, 528); }
            __builtin_amdgcn_sched_barrier(0);
#pragma unroll
            for (int e = 0; e < 8; ++e) { MFMA16(o[8 * eh + e], qx[ks], sf[e]); MFMA16(o[8 * eh + e], mf, vf[e]); }
            __builtin_amdgcn_sched_barrier(0); }
    }
    float ssq = 0.f;
#pragma unroll
    for (int e = 0; e < 16; ++e) ssq += (o[e][0] * o[e][0] + o[e][1] * o[e][1]) + (o[e][2] * o[e][2] + o[e][3] * o[e][3]);
    ssq += __shfl_xor(ssq, 16); ssq += __shfl_xor(ssq, 32);
    const float rs = 1.0f / sqrtf(ssq * (1.f / 256.f) + EPS);
#pragma unroll
    for (int e = 0; e < 16; ++e) { const v2u gw_ = gts[e];
        const float g0 = __uint_as_float(gw_.x << 16), g1 = __uint_as_float(gw_.x & 0xffff0000u), g2 = __uint_as_float(gw_.y << 16), g3 = __uint_as_float(gw_.y & 0xffff0000u);
        v2u w; w.x = pk2(o[e][0] * rs * silu_f(g0), o[e][1] * rs * silu_f(g1)); w.y = pk2(o[e][2] * rs * silu_f(g2), o[e][3] * rs * silu_f(g3)); *(v2u*)(orow + h * 256 + 16 * e + 4 * fq) = w; }
    __syncthreads();
}

#ifndef PROBE_CV
#define PROBE_CV 0
#endif
#ifndef MK_PER_PHASE
#define MK_PER_PHASE 0
#endif
constexpr int N_PHASES = 21;
#ifndef PROBE_G
#define PROBE_G 0u
#endif
#ifndef PROBE_BAR
#define PROBE_BAR 0
#endif
#ifndef PROBE_VAR
#define PROBE_VAR 0
#endif
#ifndef PROBE_REP
#define PROBE_REP 0u
#endif
struct Args { const float* in[N_IN]; float* out; unsigned char* ws; int ph_lo, ph_hi, pad0, pad1; };
__global__ void __launch_bounds__(NTHR, 2) trunk_fwd(Args args) {
    extern __shared__ __attribute__((aligned(16))) unsigned char lds_raw[];
    const ldsp lds = (ldsp)lds_raw;
    volatile LAS unsigned* MISC = (volatile LAS unsigned*)(lds + MISC_OFF);
    const int tid = threadIdx.x, lane = tid & 63, wave = __builtin_amdgcn_readfirstlane(tid >> 6);
    const int G = gridDim.x; const int bx = blockIdx.x; const int vcu = (G % 8 == 0) ? (bx % 8) * (G / 8) + bx / 8 : bx;
    const int gw = vcu * NWAVES + wave, NGW = G * NWAVES, gtid = vcu * NTHR + tid, gthreads = G * NTHR;
    unsigned char* ws = args.ws;
    gu32* ctl = (gu32*)(ws + WS_CTL);
    for (int u = tid; u < 64; u += NTHR) MISC[u] = 0u;
    __syncthreads();
    XcdBarrier bar; bar.bar = (unsigned*)(ctl + CW_BAR); bar.x = 0; bar.st = nullptr;
    if (!MK_PER_PHASE) bar = xcd_barrier_post((unsigned*)(ctl + CW_BAR), MISC + 8);
    const int lo = args.ph_lo, hi = args.ph_hi;
#define IN(k) (lo <= (k) && (k) < hi)
#define SEAM(k) do { if (IN(k) && IN((k) + 1)) { xcd_barrier<true>(bar); if (PROBE_BAR == 1) xcd_barrier<true>(bar); if (PROBE_BAR == 2) xcd_barrier<false>(bar); } } while (0)
#define REPS(k) (((PROBE_REP >> (k)) & 1u) ? 2 : 1)
    float* MOD = (float*)(ws + WS_MOD); bf16* WDT = (bf16*)(ws + WS_WDT); float* CHDEC = (float*)(ws + WS_CHDEC); float* SSQ = (float*)(ws + WS_SSQ);
    bf16* WMIX = (bf16*)(ws + WS_WMIX); bf16* WOUT0 = (bf16*)(ws + WS_WOUT0); bf16* WOUT1 = (bf16*)(ws + WS_WOUT1);
    bf16* PROJ0 = (bf16*)(ws + WS_PROJ0); bf16* XB = (bf16*)(ws + WS_XN2); bf16* XN2 = (bf16*)args.out;     bf16* W1T = (bf16*)(ws + WS_WMLP); bf16* W2T = (bf16*)(ws + WS_WMLP + 8 * MiB);
    bf16* HB = (bf16*)(ws + WS_H); bf16* PROJ1 = (bf16*)(ws + WS_H); bf16* SB = (bf16*)(ws + WS_S); float* DT = (float*)(ws + WS_DT);
    unsigned* KMAX = (unsigned*)(ws + WS_KMAX);
    float* COS = (float*)(ws + WS_ROPE); float* SIN = COS + 8192 * 64;
    const bool fuse = (G == 256) && !PROBE_REP && !PROBE_G;
    float* XCH1 = (float*)(ws + WS_XCH); float* XCH2 = (float*)(ws + WS_XCH + MiB); unsigned* TMO = (unsigned*)(ctl + CW_BAR) + XB_TMO;
    const float* x_in = args.in[I_X]; const float* ng = args.in[I_NG]; float* X = args.out;

    if (IN(0)) for (int rep0 = 0; rep0 < REPS(0); ++rep0) {
        const Seg segs[4] = { {args.in[I_EWIN], 6160, 0, 1024, 1024, WMIX, 0}, {args.in[I_EWIN], 6160, 3088, 3072, 1024, WMIX, 1024}, {args.in[I_EWIN], 6160, 1024, 2048, 1024, WMIX, 4096},
                              {args.in[I_EWOUT], 1024, 0, 1024, 2048, WOUT0, 0} };
        convert_set<4>(segs, lds, gw, NGW, wave, lane);
        for (int i = gtid; i < 16384; i += gthreads) { const int h = i >> 10, k = i & 1023; WDT[i] = f2bf(args.in[I_EWIN][(size_t)k * 6160 + 3072 + h]); }
        for (int i = gtid; i < 8192 * 64; i += gthreads) { const int t = i >> 6, f = i & 63; const float inv = powf(10000.0f, -(float)f * (1.0f / 64.0f)); const float ang = (float)t * inv;
            const double a = (double)ang; const double n = rint(a * 0.15915494309189535); const float r = (float)(a - n * 6.283185307179586); COS[i] = __cosf(r); SIN[i] = __sinf(r); }
        __syncthreads();
        mod_phase(args.in[I_C], args.in[I_MODW], args.in[I_MODB], MOD, lds, tid, lane, wave);
    }
    SEAM(0);
    if (IN(1)) for (int rep1 = 0; rep1 < REPS(1); ++rep1) norm_rows<-1, 0, false, 0>(x_in, nullptr, nullptr, SB, MOD, ng, gw, NGW, lane);
    SEAM(1);
    if (IN(2)) {
        pg8::Gemm g{SB, WMIX, MTOK, NPROJ0, DM, DM}; pg8::StaticOrder S; S.init(MTOK, NPROJ0, G, bx);
        pg8::EpiBf16<0> E{PROJ0, NPROJ0, nullptr, 0, 0, 1.f};
        if ((PROBE_G >> 2) & 1u) { pg8::gemm_phase<pg8::EpiBf16<0>, pg8::StaticOrder, true, true>(lds, g, S, E); __syncthreads(); } pg8::gemm_phase<pg8::EpiBf16<0>, pg8::StaticOrder, true, true>(lds, g, S, E);
        dt_phase(SB, WDT, args.in[I_EDTB], DT, gw, NGW, lane);
    }
    SEAM(2);
    if (IN(3)) { kmax_rows(PROJ0, KMAX, gw, NGW, lane);
        for (int rep = 0; rep < REPS(3); ++rep) for (int u = vcu; u < 512; u += G) ssdA_unit(lds, PROJ0, DT, args.in[I_ECONVW], args.in[I_ECONVB], args.in[I_EALOG], SB, CHDEC, u, tid, lane, wave); }
    SEAM(3);
    if (IN(4)) ssd_scan(SB, CHDEC, gtid, gthreads);
    SEAM(4);
    if (IN(5)) { for (int rep = 0; rep < REPS(5); ++rep) for (int u = vcu; u < 512; u += G) { if (rep + 1 < REPS(5)) ssdC_unit<(PROBE_VAR < 32 ? PROBE_VAR : 0)>(lds, PROJ0, (bf16*)args.out, 1024, DT, args.in[I_ECONVW], args.in[I_ECONVB], args.in[I_EALOG], args.in[I_ED], args.in[I_ESSDN], SB, SSQ, u, tid, lane, wave); else ssdC_unit<0>(lds, PROJ0, PROJ0 + C0_Z, NPROJ0, DT, args.in[I_ECONVW], args.in[I_ECONVB], args.in[I_EALOG], args.in[I_ED], args.in[I_ESSDN], SB, SSQ, u, tid, lane, wave); } }
    SEAM(5);
    if (IN(6)) {
        ssd_normalize_rows(PROJ0, SSQ, gw, NGW, lane);
        const float* lm = args.in[I_ELAM];
        const float lam = expf(wave_sum(lm[lane] * lm[64 + lane])) - expf(wave_sum(lm[128 + lane] * lm[192 + lane])) + 0.2f;
        __syncthreads();
        for (int rep = 0; rep < REPS(6); ++rep)
        for (int u = vcu; u < 1024; u += G) { const int v = u & 255, i = u >> 8, j = v & 15, bh = v >> 4; const int qb = i == 0 ? j : (i == 1 ? 63 - j : (i == 2 ? 16 + j : 47 - j));
            if (PROBE_VAR >= 16 && rep + 1 < REPS(6)) { }
            else if (rep + 1 < REPS(6)) dattn5_unit<PROBE_VAR < 16 ? PROBE_VAR : 0>(lds, PROJ0, (bf16*)args.out, 1024, args.in[I_RELB], args.in[I_EDIFFN], KMAX, lam, bh >> 3, bh & 7, qb, tid, lane, wave);
            else dattn5_unit<0>(lds, PROJ0, PROJ0 + C0_Q, NPROJ0, args.in[I_RELB], args.in[I_EDIFFN], KMAX, lam, bh >> 3, bh & 7, qb, tid, lane, wave); }
    }
    SEAM(6);
    if (IN(7)) {
        pg8::Gemm g{PROJ0, WOUT0, MTOK, DM, 2048, NPROJ0}; pg8::StaticOrder S; S.init(MTOK, DM, G, bx);
        if (fuse) { pg8::EpiNorm<0, 1, false, 1> EN{x_in, SB  , XN2, MOD, ng, {XCH1, (unsigned*)ctl + 0 * 512, TMO}, {XCH2, (unsigned*)ctl + 1 * 512, TMO}, EPS};
            pg8::gemm_phase<pg8::EpiNorm<0, 1, false, 1>, pg8::StaticOrder, true, true>(lds, g, S, EN); } else {
        pg8::EpiBf16<0> E{SB, DM, nullptr, 0, 0, 1.f};
        if ((PROBE_G >> 7) & 1u) { pg8::gemm_phase<pg8::EpiBf16<0>, pg8::StaticOrder, true, true>(lds, g, S, E); __syncthreads(); } pg8::gemm_phase<pg8::EpiBf16<0>, pg8::StaticOrder, true, true>(lds, g, S, E); }
    }
    SEAM(7);
    if (IN(8)) {
        const Seg segs[2] = { {args.in[I_W1], 4096, 0, 4096, 1024, W1T, 0}, {args.in[I_W2], 1024, 0, 1024, 4096, W2T, 0} };
        convert_set<2>(segs, lds, gw, NGW, wave, lane); if (PROBE_CV) convert_set<2>(segs, lds, gw, NGW, wave, lane);
        if (!fuse) norm_rows<0, 1, false, 1>(x_in, SB, XB, XN2, MOD, ng, gw, NGW, lane);
    }
    SEAM(8);
    if (IN(9)) {
        pg8::Gemm g{XN2, W1T, MTOK, FF, DM, DM}; pg8::StaticOrder S; S.init(MTOK, FF, G, bx);
        pg8::EpiBf16<2> E{HB, FF, nullptr, 0, 0, 1.f};
        if ((PROBE_G >> 9) & 1u) { pg8::gemm_phase<pg8::EpiBf16<2>, pg8::StaticOrder, true, true>(lds, g, S, E); __syncthreads(); } pg8::gemm_phase<pg8::EpiBf16<2>, pg8::StaticOrder, true, true>(lds, g, S, E);
    }
    SEAM(9);
    if (IN(10)) {
        pg8::Gemm g{HB, W2T, MTOK, DM, FF, FF}; pg8::StaticOrder S; S.init(MTOK, DM, G, bx);
        if (fuse) { pg8::EpiNorm<1, 2, true, 1> EN{SB, XB, XN2, MOD, ng, {XCH1, (unsigned*)ctl + 2 * 512, TMO}, {XCH2, (unsigned*)ctl + 3 * 512, TMO}, EPS};
            pg8::gemm_phase<pg8::EpiNorm<1, 2, true, 1>, pg8::StaticOrder, true, true>(lds, g, S, EN); } else {
        pg8::EpiBf16<0> E{SB, DM, nullptr, 0, 0, 1.f};
        if ((PROBE_G >> 10) & 1u) { pg8::gemm_phase<pg8::EpiBf16<0>, pg8::StaticOrder, true, true>(lds, g, S, E); __syncthreads(); } pg8::gemm_phase<pg8::EpiBf16<0>, pg8::StaticOrder, true, true>(lds, g, S, E); }
    }
    SEAM(10);
    if (IN(11)) {
        const Seg segs[4] = { {args.in[I_OWIN], 3840, 2048, 1536, 1024, WMIX, 0}, {args.in[I_OWIN], 3840, 0, 2048, 1024, WMIX, 1536}, {args.in[I_OWIN], 3840, 3584, 256, 1024, WMIX, 3584},
                              {args.in[I_OWOUT], 1024, 0, 1024, 1536, WOUT1, 0} };
        convert_set<4>(segs, lds, gw, NGW, wave, lane); if (PROBE_CV) convert_set<4>(segs, lds, gw, NGW, wave, lane);
        if (!fuse) norm_rows<1, 2, true, 1>(XB, SB, XB, XN2, MOD, ng, gw, NGW, lane);
    }
    SEAM(11);
    if (IN(12)) {
        pg8::Gemm g{XN2, WMIX, MTOK, NPROJ1, DM, DM}; pg8::StaticOrder S; S.init(MTOK, NPROJ1, G, bx);
        pg8::EpiBf16<0> E{PROJ1, NPROJ1, nullptr, 0, 0, 1.f};
        if ((PROBE_G >> 12) & 1u) { pg8::gemm_phase<pg8::EpiBf16<0>, pg8::StaticOrder, true, true>(lds, g, S, E); __syncthreads(); } pg8::gemm_phase<pg8::EpiBf16<0>, pg8::StaticOrder, true, true>(lds, g, S, E);
        }
    SEAM(12);
    if (IN(13)) {
        for (int rep = 0; rep < REPS(13); ++rep) {
        for (int u = vcu; u < 512; u += G) retA_unit(lds, PROJ1, COS, SIN, SB, u, tid, lane, wave);
        for (int u = vcu; u < 256; u += G) swa_unit(lds, PROJ1, (rep + 1 < REPS(13)) ? XN2 : PROJ1 + C1_SQ, (rep + 1 < REPS(13)) ? 1024 : NPROJ1, args.in[I_RELB], args.in[I_OSINK], u >> 7, (u >> 1) & 63, u & 1, tid, lane, wave); }
    }
    SEAM(13);
    if (IN(14)) ret_scan(SB, gtid, gthreads);
    SEAM(14);
    if (IN(15)) { for (int rep = 0; rep < REPS(15); ++rep) for (int u = vcu; u < 512; u += G) { if (rep + 1 < REPS(15)) retC_unit<(PROBE_VAR < 16 ? PROBE_VAR : 0)>(lds, PROJ1, XN2, 1024, COS, SIN, SB, u, tid, lane, wave); else retC_unit<0>(lds, PROJ1, PROJ1 + C1_RG, NPROJ1, COS, SIN, SB, u, tid, lane, wave); } }
    SEAM(15);
    if (IN(16)) {
        pg8::Gemm g{PROJ1, WOUT1, MTOK, DM, 1536, NPROJ1}; pg8::StaticOrder S; S.init(MTOK, DM, G, bx);
        if (fuse) { pg8::EpiNorm<2, 3, true, 1> EN{XB, XB, XN2, MOD, ng, {XCH1, (unsigned*)ctl + 4 * 512, TMO}, {XCH2, (unsigned*)ctl + 5 * 512, TMO}, EPS};
            pg8::gemm_phase<pg8::EpiNorm<2, 3, true, 1>, pg8::StaticOrder, true, true>(lds, g, S, EN); } else {
        pg8::EpiBf16<0> E{SB, DM, nullptr, 0, 0, 1.f};
        if ((PROBE_G >> 16) & 1u) { pg8::gemm_phase<pg8::EpiBf16<0>, pg8::StaticOrder, true, true>(lds, g, S, E); __syncthreads(); } pg8::gemm_phase<pg8::EpiBf16<0>, pg8::StaticOrder, true, true>(lds, g, S, E); }
    }
    SEAM(16);
    if (IN(17)) {
        const Seg segs[2] = { {args.in[I_W1] + (size_t)DM * FF, 4096, 0, 4096, 1024, W1T, 0}, {args.in[I_W2] + (size_t)DM * FF, 1024, 0, 1024, 4096, W2T, 0} };
        convert_set<2>(segs, lds, gw, NGW, wave, lane); if (PROBE_CV) convert_set<2>(segs, lds, gw, NGW, wave, lane);
        if (!fuse) norm_rows<2, 3, true, 1>(XB, SB, XB, XN2, MOD, ng, gw, NGW, lane);
    }
    SEAM(17);
    if (IN(18)) {
        pg8::Gemm g{XN2, W1T, MTOK, FF, DM, DM}; pg8::StaticOrder S; S.init(MTOK, FF, G, bx);
        pg8::EpiBf16<2> E{HB, FF, nullptr, 0, 0, 1.f};
        if ((PROBE_G >> 18) & 1u) { pg8::gemm_phase<pg8::EpiBf16<2>, pg8::StaticOrder, true, true>(lds, g, S, E); __syncthreads(); } pg8::gemm_phase<pg8::EpiBf16<2>, pg8::StaticOrder, true, true>(lds, g, S, E);
    }
    SEAM(18);
    if (IN(19)) {
        pg8::Gemm g{HB, W2T, MTOK, DM, FF, FF}; pg8::StaticOrder S; S.init(MTOK, DM, G, bx);
        if (fuse) { pg8::EpiNorm<3, -1, true, 2> EN{XB, X, nullptr, MOD, ng, {XCH1, (unsigned*)ctl + 6 * 512, TMO}, {XCH2, (unsigned*)ctl + 7 * 512, TMO}, EPS};
            pg8::gemm_phase<pg8::EpiNorm<3, -1, true, 2>, pg8::StaticOrder, true, true>(lds, g, S, EN); } else {
        pg8::EpiBf16<0> E{SB, DM, nullptr, 0, 0, 1.f};
        if ((PROBE_G >> 19) & 1u) { pg8::gemm_phase<pg8::EpiBf16<0>, pg8::StaticOrder, true, true>(lds, g, S, E); __syncthreads(); } pg8::gemm_phase<pg8::EpiBf16<0>, pg8::StaticOrder, true, true>(lds, g, S, E); }
    }
    if (!fuse) {
    SEAM(19);
    if (IN(20)) norm_rows<3, -1, true, 2>(XB, SB, X, nullptr, MOD, ng, gw, NGW, lane);
    }
#undef IN
#undef SEAM
}

extern "C" void kernel_launch(void* const* d_in, const int* in_sizes, int n_in, void* d_out, int out_size, void* d_ws, size_t ws_size, hipStream_t stream) {
    static int grid = 0;
    if (grid == 0) {
        if (n_in != N_IN || out_size != MTOK * DM || ws_size < WS_END) { fprintf(stderr, "kernel_launch: unexpected shapes (n_in %d, out %d, ws %zu); nothing launched\n", n_in, out_size, ws_size); grid = -1; return; }
        int dev = 0, cus = 0, per_cu = 0;
        if (hipGetDevice(&dev) != hipSuccess || hipDeviceGetAttribute(&cus, hipDeviceAttributeMultiprocessorCount, dev) != hipSuccess) { grid = -1; return; }
        if (hipFuncSetAttribute((const void*)trunk_fwd, hipFuncAttributeMaxDynamicSharedMemorySize, LDS_BYTES) != hipSuccess) { fprintf(stderr, "kernel_launch: hipFuncSetAttribute failed\n"); grid = -1; return; }
        if (hipOccupancyMaxActiveBlocksPerMultiprocessor(&per_cu, (const void*)trunk_fwd, NTHR, LDS_BYTES) != hipSuccess || per_cu < 1) { fprintf(stderr, "kernel_launch: occupancy query says %d blocks per CU\n", per_cu); (void)hipGetLastError(); grid = -1; return; }
        grid = cus;
    }
    if (grid < 0) return;
    (void)hipMemsetAsync((char*)d_ws + WS_CTL, 0, CTL_ZERO_BYTES, stream);
    Args a{};
    for (int i = 0; i < N_IN; ++i) a.in[i] = (const float*)d_in[i];
    a.out = (float*)d_out; a.ws = (unsigned char*)d_ws;
#if MK_PER_PHASE
    for (int p = 0; p < N_PHASES; ++p) { a.ph_lo = p; a.ph_hi = p + 1; hipLaunchKernelGGL(trunk_fwd, dim3(grid), dim3(NTHR), LDS_BYTES, stream, a); }
#else
    a.ph_lo = 0; a.ph_hi = N_PHASES;
    hipLaunchKernelGGL(trunk_fwd, dim3(grid), dim3(NTHR), LDS_BYTES, stream, a);
#endif
}
```

```cpp
#include <hip/hip_runtime.h>
#include <cstdio>
#include <cstdint>
#include <cmath>
namespace pg8 {
#define PG8_LAS __attribute__((address_space(3)))
typedef unsigned short bf16_t;
typedef short bf16x8 __attribute__((ext_vector_type(8)));
typedef float f32x4 __attribute__((ext_vector_type(4)));
typedef unsigned u32x4 __attribute__((ext_vector_type(4)));
constexpr int BM = 256, BK = 64, HALF = 128, HTB = HALF * BK * 2  , STAGE_BYTES = 8 * HTB, NXCD = 8, WGM = 4;

__host__ __device__ __forceinline__ int lds_byte(int r, int c) { const int st = (r >> 4) * 2 + (c >> 5), rr = r & 15, cc = c & 31, ob = rr * 64 + cc * 2; return st * 1024 + (ob ^ (((ob >> 9) & 1) << 5)); }
__host__ __device__ __forceinline__ void stage_rc(int b, int& R, int& C) { const int st = b / 1024, sb = b % 1024, swz = sb ^ (((sb >> 9) & 1) << 5); R = (st >> 1) * 16 + swz / 64; C = (st & 1) * 32 + (swz % 64) / 2; }
__host__ __device__ __forceinline__ int perm32(int rho) { const int n = rho >> 4, i = rho & 15; return 8 * (i >> 2) + 4 * n + (i & 3); }

struct Unit { int pm, pn; };
struct Gemm { const bf16_t* A; const bf16_t* Bt; int M, N, K, lda; };

struct StaticOrder {
    int nM, nN, nwg, G, c;
    __host__ __device__ void init(int M, int N, int G_, int c_) { nM = M / BM; nN = N / BM; nwg = nM * nN; G = G_; c = c_; }
    __host__ __device__ bool next(int i, Unit& u) const {
        const long L = (long)i * G + c; if (L >= nwg) return false;
        int wgid = (int)L; { const int q = nwg / NXCD, r = nwg % NXCD, xcd = wgid % NXCD, off = wgid / NXCD; wgid = (xcd < r ? xcd * (q + 1) : r * (q + 1) + (xcd - r) * q) + off; }
        const int nig = WGM * nN, gid = wgid / nig, fm = gid * WGM, gsz = (nM - fm) < WGM ? (nM - fm) : WGM;
        u.pm = fm + ((wgid % nig) % gsz); u.pn = (wgid % nig) / gsz; return true;
    }
    __device__ __forceinline__ void a_ready(const Unit&) const {}
    __device__ __forceinline__ void done(const Unit&) const {}
};

__device__ __forceinline__ unsigned cvt_pk_bf16(float lo, float hi) { unsigned r; asm volatile("v_cvt_pk_bf16_f32 %0, %1, %2" : "=v"(r) : "v"(lo), "v"(hi)); return r; }
typedef float f32x2 __attribute__((ext_vector_type(2)));
__device__ __forceinline__ f32x2 gelu_pk(f32x2 v) {
    const f32x2 av = __builtin_elementwise_abs(v), d = av * 0.2316418882f + 1.0f;
    f32x2 t; t.x = __builtin_amdgcn_rcpf(d.x); t.y = __builtin_amdgcn_rcpf(d.y);
    f32x2 q = t * 0.5307027145f + (-0.7265760135f); q = q * t + 0.7107068705f; q = q * t + (-0.142248368f); q = q * t + 0.127414796f; q = q * t;
    const f32x2 s = (v * v) * (-0.72134752044f);
    f32x2 e; e.x = __builtin_amdgcn_exp2f(s.x); e.y = __builtin_amdgcn_exp2f(s.y);
    const f32x2 m = v * (q * e), r = v - m;
    f32x2 o; o.x = v.x < 0.f ? m.x : r.x; o.y = v.y < 0.f ? m.y : r.y; return o;
}

template <int ACT  > struct EpiBf16 {
    static constexpr bool PERM = true, AFTER_DRAIN = false; static_assert(ACT == 0 || ACT == 1 || ACT == 2, "EpiBf16: ACT is 0 (none), 1 (gelu_pk) or 2 (squared relu)");
    bf16_t* O; int ldc; const float* bias; int split_cols; size_t split_stride; float scale0;
    __device__ __forceinline__ void operator()(const f32x4 (&acc)[2][2][4][2], const Unit& u, int wr, int wc, int fr, int fq) const {
        const int row0 = u.pm * BM + wr * 64 + fr; int colt = u.pn * BM; bf16_t* base = O;
        float sc = 1.f; if (split_cols) { const int t = colt / split_cols; base += (size_t)t * split_stride; colt -= t * split_cols; if (t == 0) sc = scale0; }
        const int col0 = colt + wc * 32 + 8 * fq, bcol0 = u.pn * BM + wc * 32 + 8 * fq;
        f32x4 bv[2][2];
#pragma unroll
        for (int bj = 0; bj < 2; ++bj)
#pragma unroll
            for (int n = 0; n < 2; ++n) bv[bj][n] = bias ? *(const f32x4*)(bias + bcol0 + bj * HALF + 4 * n) : (f32x4){0.f, 0.f, 0.f, 0.f};
#pragma unroll
        for (int ai = 0; ai < 2; ++ai)
#pragma unroll
            for (int m = 0; m < 4; ++m) { bf16_t* rowp = base + (size_t)(row0 + ai * HALF + m * 16) * ldc + col0;
#pragma unroll
                for (int bj = 0; bj < 2; ++bj) { f32x4 v0 = acc[ai][bj][m][0] + bv[bj][0], v1 = acc[ai][bj][m][1] + bv[bj][1];
                    if (ACT == 1) { f32x2 a = gelu_pk((f32x2){v0[0], v0[1]}), b = gelu_pk((f32x2){v0[2], v0[3]}), c = gelu_pk((f32x2){v1[0], v1[1]}), d = gelu_pk((f32x2){v1[2], v1[3]});
                        v0 = (f32x4){a.x, a.y, b.x, b.y}; v1 = (f32x4){c.x, c.y, d.x, d.y}; }
                    if (ACT == 2) { v0 = __builtin_elementwise_max(v0, (f32x4){0.f,0.f,0.f,0.f}); v1 = __builtin_elementwise_max(v1, (f32x4){0.f,0.f,0.f,0.f}); v0 = v0 * v0; v1 = v1 * v1; }
                    v0 = v0 * sc; v1 = v1 * sc; u32x4 w; w.x = cvt_pk_bf16(v0[0], v0[1]); w.y = cvt_pk_bf16(v0[2], v0[3]); w.z = cvt_pk_bf16(v1[0], v1[1]); w.w = cvt_pk_bf16(v1[2], v1[3]);
                    *(u32x4*)(rowp + bj * HALF) = w; } }
    }
};

struct RowExch {
    float* slots;
    unsigned* cnt;
    unsigned* tmo;
    __device__ __forceinline__ void publish(const float (&ss)[2][4], const Unit& u, int wr, int wc, int fr, int fq, PG8_LAS unsigned char* lds, int wid, int lane) const {
        PG8_LAS float* P = (PG8_LAS float*)lds;
#pragma unroll
        for (int ai = 0; ai < 2; ++ai)
#pragma unroll
            for (int m = 0; m < 4; ++m) { float s = ss[ai][m]; s += __shfl_xor(s, 16); s += __shfl_xor(s, 32); if (fq == 0) P[(ai * HALF + wr * 64 + m * 16 + fr) * 4 + wc] = s; }
        asm volatile("s_waitcnt lgkmcnt(0)" ::: "memory"); __builtin_amdgcn_s_barrier(); asm volatile("" ::: "memory");
        const int row = wid * 32 + (lane & 31);
        if (lane < 32) { const f32x4 p = *(const PG8_LAS f32x4*)(P + row * 4);
            __hip_atomic_store((unsigned*)slots + ((size_t)(u.pm * BM + row) * 4 + u.pn), __float_as_uint((p[0] + p[1]) + (p[2] + p[3])), __ATOMIC_RELAXED, __HIP_MEMORY_SCOPE_AGENT); }
        asm volatile("s_waitcnt vmcnt(0)" ::: "memory");
        if (lane == 0) __hip_atomic_fetch_add(cnt + 8 * u.pm, 1u, __ATOMIC_RELAXED, __HIP_MEMORY_SCOPE_AGENT);
    }
    __device__ __forceinline__ void collect(const Unit& u, int wr, int fr, PG8_LAS unsigned char* lds, int wid, int lane, float eps, float (&rinv)[2][4]) const {
        PG8_LAS float* S = (PG8_LAS float*)(lds + 4096);
        const int row = wid * 32 + (lane & 31);
        if (wid == 0) { unsigned sp = 0;
            while ((unsigned)__builtin_amdgcn_readfirstlane(__hip_atomic_load(cnt + 8 * u.pm, __ATOMIC_RELAXED, __HIP_MEMORY_SCOPE_AGENT)) < 32u) { __builtin_amdgcn_s_sleep(1);
                if ((++sp & 255u) == 0u) { if (__hip_atomic_load(tmo, __ATOMIC_RELAXED, __HIP_MEMORY_SCOPE_AGENT)) break; if (sp > (1u << 18)) { if (lane == 0) atomicAdd(tmo, 1u); break; } } } }
        asm volatile("s_waitcnt lgkmcnt(0)" ::: "memory"); __builtin_amdgcn_s_barrier(); asm volatile("" ::: "memory");
        if (lane < 32) { const unsigned* sl = (const unsigned*)slots + (size_t)(u.pm * BM + row) * 4; float t = 0.f;
#pragma unroll
            for (int j = 0; j < 4; ++j) t += __uint_as_float(__hip_atomic_load(sl + j, __ATOMIC_RELAXED, __HIP_MEMORY_SCOPE_AGENT));
            S[row] = 1.0f / sqrtf(t * (1.0f / 1024.0f) + eps); }
        asm volatile("s_waitcnt lgkmcnt(0)" ::: "memory"); __builtin_amdgcn_s_barrier(); asm volatile("" ::: "memory");
#pragma unroll
        for (int ai = 0; ai < 2; ++ai)
#pragma unroll
            for (int m = 0; m < 4; ++m) rinv[ai][m] = S[ai * HALF + wr * 64 + m * 16 + fr];
        asm volatile("s_waitcnt lgkmcnt(0)" ::: "memory"); __builtin_amdgcn_s_barrier(); asm volatile("" ::: "memory");
    }
};
template <int SPOST, int SPRE, bool XINB, int XOUT, bool RS = false> struct EpiNorm {
    static constexpr bool PERM = true, AFTER_DRAIN = true;
    const void* xin; void* xout; bf16_t* XN; const float* MOD; const float* ng; RowExch e1, e2; float eps; const float* rowsq;
    __device__ __forceinline__ void operator()(const f32x4 (&)[2][2][4][2], const Unit&, int, int, int, int) const {}
    __device__ __forceinline__ void fused(f32x4 (&acc)[2][2][4][2], const Unit& u, int wr, int wc, int fr, int fq, PG8_LAS unsigned char* lds, int wid, int lane) const {
        const int b = u.pm >> 5;
        const int col0 = u.pn * BM + wc * 32 + 8 * fq;
        const size_t off0 = (size_t)(u.pm * BM + wr * 64 + fr) * 1024 + col0;
#define EN_OFF(ai, m, bj) (off0 + (size_t)((ai) * HALF + (m) * 16) * 1024 + (bj) * HALF)
#define EN_UNPK_LO(q_) ((f32x4){__uint_as_float((q_)[0] << 16), __uint_as_float((q_)[0] & 0xffff0000u), __uint_as_float((q_)[1] << 16), __uint_as_float((q_)[1] & 0xffff0000u)})
#define EN_UNPK_HI(q_) ((f32x4){__uint_as_float((q_)[2] << 16), __uint_as_float((q_)[2] & 0xffff0000u), __uint_as_float((q_)[3] << 16), __uint_as_float((q_)[3] & 0xffff0000u)})
        float ss[2][4], r1[2][4];
        if constexpr (RS) {
            f32x4 q[2][4];
#pragma unroll
            for (int ai = 0; ai < 2; ++ai)
#pragma unroll
                for (int m = 0; m < 4; ++m) q[ai][m] = *(const f32x4*)(rowsq + (size_t)(u.pm * BM + ai * HALF + wr * 64 + m * 16 + fr) * 4);
#pragma unroll
            for (int ai = 0; ai < 2; ++ai)
#pragma unroll
                for (int m = 0; m < 4; ++m) { const float r = 1.0f / sqrtf(((q[ai][m][0] + q[ai][m][1]) + (q[ai][m][2] + q[ai][m][3])) * (1.0f / 1024.0f) + eps);
#pragma unroll
                    for (int bj = 0; bj < 2; ++bj)
#pragma unroll
                        for (int n = 0; n < 2; ++n) acc[ai][bj][m][n] = acc[ai][bj][m][n] * r; }
        }
#pragma unroll
        for (int ai = 0; ai < 2; ++ai)
#pragma unroll
            for (int m = 0; m < 4; ++m) { float s = 0.f;
#pragma unroll
                for (int bj = 0; bj < 2; ++bj)
#pragma unroll
                    for (int n = 0; n < 2; ++n) { const f32x4 x = acc[ai][bj][m][n]; s += (x[0] * x[0] + x[1] * x[1]) + (x[2] * x[2] + x[3] * x[3]); }
                ss[ai][m] = s; }
        e1.publish(ss, u, wr, wc, fr, fq, lds, wid, lane);
        u32x4 xb[2][4][2]; f32x4 xf[4][2][2];
        if constexpr (XINB) {
#pragma unroll
            for (int ai = 0; ai < 2; ++ai)
#pragma unroll
                for (int m = 0; m < 4; ++m)
#pragma unroll
                    for (int bj = 0; bj < 2; ++bj) xb[ai][m][bj] = *(const u32x4*)((const bf16_t*)xin + EN_OFF(ai, m, bj));
        } else {
#pragma unroll
            for (int m = 0; m < 4; ++m)
#pragma unroll
                for (int bj = 0; bj < 2; ++bj) { xf[m][bj][0] = *(const f32x4*)((const float*)xin + EN_OFF(0, m, bj)); xf[m][bj][1] = *(const f32x4*)((const float*)xin + EN_OFF(0, m, bj) + 4); }
        }
        f32x4 gp[2][2];
#pragma unroll
        for (int bj = 0; bj < 2; ++bj)
#pragma unroll
            for (int n = 0; n < 2; ++n) gp[bj][n] = *(const f32x4*)(MOD + (SPOST * 2 + b) * 3072 + 2048 + col0 + bj * HALF + 4 * n) * *(const f32x4*)(ng + (SPOST * 2 + 1) * 1024 + col0 + bj * HALF + 4 * n);
        e1.collect(u, wr, fr, lds, wid, lane, eps, r1);
#pragma unroll
        for (int ai = 0; ai < 2; ++ai) {
            if constexpr (!XINB) { if (ai == 1) {
#pragma unroll
                for (int m = 0; m < 4; ++m)
#pragma unroll
                    for (int bj = 0; bj < 2; ++bj) { xf[m][bj][0] = *(const f32x4*)((const float*)xin + EN_OFF(1, m, bj)); xf[m][bj][1] = *(const f32x4*)((const float*)xin + EN_OFF(1, m, bj) + 4); } } }
#pragma unroll
            for (int m = 0; m < 4; ++m) { const float r = r1[ai][m];
#pragma unroll
                for (int bj = 0; bj < 2; ++bj) { f32x4 x0, x1;
                    if constexpr (XINB) { x0 = EN_UNPK_LO(xb[ai][m][bj]); x1 = EN_UNPK_HI(xb[ai][m][bj]); } else { x0 = xf[m][bj][0]; x1 = xf[m][bj][1]; }
                    f32x4 v0 = x0 + gp[bj][0] * (acc[ai][bj][m][0] * r), v1 = x1 + gp[bj][1] * (acc[ai][bj][m][1] * r);
                    if constexpr (XOUT == 2) { *(f32x4*)((float*)xout + EN_OFF(ai, m, bj)) = v0; *(f32x4*)((float*)xout + EN_OFF(ai, m, bj) + 4) = v1; }
                    if constexpr (XOUT == 1) { u32x4 w; w.x = cvt_pk_bf16(v0[0], v0[1]); w.y = cvt_pk_bf16(v0[2], v0[3]); w.z = cvt_pk_bf16(v1[0], v1[1]); w.w = cvt_pk_bf16(v1[2], v1[3]);
                        v0 = EN_UNPK_LO(w); v1 = EN_UNPK_HI(w); }
                    acc[ai][bj][m][0] = v0; acc[ai][bj][m][1] = v1; } }
        }
        if constexpr (SPRE >= 0) {
            float r2[2][4];
#pragma unroll
            for (int ai = 0; ai < 2; ++ai)
#pragma unroll
                for (int m = 0; m < 4; ++m) { float s = 0.f;
#pragma unroll
                    for (int bj = 0; bj < 2; ++bj)
#pragma unroll
                        for (int n = 0; n < 2; ++n) { const f32x4 x = acc[ai][bj][m][n]; s += (x[0] * x[0] + x[1] * x[1]) + (x[2] * x[2] + x[3] * x[3]); }
                    ss[ai][m] = s; }
            e2.publish(ss, u, wr, wc, fr, fq, lds, wid, lane);
            if constexpr (XOUT == 1) {
#pragma unroll
                for (int ai = 0; ai < 2; ++ai)
#pragma unroll
                    for (int m = 0; m < 4; ++m)
#pragma unroll
                        for (int bj = 0; bj < 2; ++bj) { const f32x4 v0 = acc[ai][bj][m][0], v1 = acc[ai][bj][m][1];
                            u32x4 w; w.x = cvt_pk_bf16(v0[0], v0[1]); w.y = cvt_pk_bf16(v0[2], v0[3]); w.z = cvt_pk_bf16(v1[0], v1[1]); w.w = cvt_pk_bf16(v1[2], v1[3]);
                            *(u32x4*)((bf16_t*)xout + EN_OFF(ai, m, bj)) = w; }
            }
            f32x4 qc[2][2], sh[2][2];
#pragma unroll
            for (int bj = 0; bj < 2; ++bj)
#pragma unroll
                for (int n = 0; n < 2; ++n) { const int c = col0 + bj * HALF + 4 * n;
                    qc[bj][n] = *(const f32x4*)(ng + (SPRE * 2) * 1024 + c) * (*(const f32x4*)(MOD + (SPRE * 2 + b) * 3072 + 1024 + c) + 1.0f); sh[bj][n] = *(const f32x4*)(MOD + (SPRE * 2 + b) * 3072 + c); }
            e2.collect(u, wr, fr, lds, wid, lane, eps, r2);
#pragma unroll
            for (int ai = 0; ai < 2; ++ai)
#pragma unroll
                for (int m = 0; m < 4; ++m) { const float r = r2[ai][m];
#pragma unroll
                    for (int bj = 0; bj < 2; ++bj) { const f32x4 o0 = (acc[ai][bj][m][0] * r) * qc[bj][0] + sh[bj][0], o1 = (acc[ai][bj][m][1] * r) * qc[bj][1] + sh[bj][1];
                        u32x4 w; w.x = cvt_pk_bf16(o0[0], o0[1]); w.y = cvt_pk_bf16(o0[2], o0[3]); w.z = cvt_pk_bf16(o1[0], o1[1]); w.w = cvt_pk_bf16(o1[2], o1[3]);
                        *(u32x4*)(XN + EN_OFF(ai, m, bj)) = w; } }
        } else if constexpr (XOUT == 1) {
#pragma unroll
            for (int ai = 0; ai < 2; ++ai)
#pragma unroll
                for (int m = 0; m < 4; ++m)
#pragma unroll
                    for (int bj = 0; bj < 2; ++bj) { const f32x4 v0 = acc[ai][bj][m][0], v1 = acc[ai][bj][m][1];
                        u32x4 w; w.x = cvt_pk_bf16(v0[0], v0[1]); w.y = cvt_pk_bf16(v0[2], v0[3]); w.z = cvt_pk_bf16(v1[0], v1[1]); w.w = cvt_pk_bf16(v1[2], v1[3]);
                        *(u32x4*)((bf16_t*)xout + EN_OFF(ai, m, bj)) = w; }
        }
#undef EN_OFF
#undef EN_UNPK_LO
#undef EN_UNPK_HI
    }
};
template <class Epi, class Sched, bool ALIGN_EPI = false, bool SP2 = false>
__device__ __forceinline__ void gemm_phase(PG8_LAS unsigned char* lds, const Gemm g, const Sched& S, const Epi& E) {
    const int tid = threadIdx.x, wid = __builtin_amdgcn_readfirstlane(tid >> 6), lane = tid & 63, wr = wid >> 2, wc = wid & 3, fr = lane & 15, fq = lane >> 4;
    const int K = g.K, nt = K / BK;
    unsigned voffA[2], voffB[2];
#pragma unroll
    for (int i = 0; i < 2; ++i) { int R, C; stage_rc(tid * 16 + i * 8192, R, C); const int Rb = Epi::PERM ? ((R & ~31) + perm32(R & 31)) : R;
        voffA[i] = (unsigned)(R * g.lda + C) * 2u; voffB[i] = (unsigned)(Rb * K + C) * 2u; }
    const size_t kstep = (size_t)(BK * 2);
    const size_t hstepA = (size_t)HALF * g.lda * 2, hstepB = (size_t)HALF * K * 2;
    const size_t tstepA = 2 * hstepA, tstepB = 2 * hstepB;
    const unsigned ldsw = (unsigned)wid * 1024u;
    const int aoff = lds_byte(wr * 64 + fr, fq * 8), boff = lds_byte(wc * 32 + fr, fq * 8);
#define PG8_SA(b, h) (((b) * 2 + (h)) * HTB)
#define PG8_SB(b, h) ((4 + (b) * 2 + (h)) * HTB)
#define PG8_STAGE(bufoff, gbase, voff) do { _Pragma("unroll") for (int _i = 0; _i < 2; ++_i) \
        __builtin_amdgcn_global_load_lds((const unsigned*)((const char*)(gbase) + (voff)[_i]), (PG8_LAS unsigned*)(lds + (bufoff) + ldsw + _i * 8192), 16, 0, 0); } while (0)
#define PG8_LDA(dst, b, h) do { _Pragma("unroll") for (int m = 0; m < 4; ++m) _Pragma("unroll") for (int k = 0; k < 2; ++k) dst[m][k] = *(const PG8_LAS bf16x8*)(lds + PG8_SA(b, h) + aoff + m * 2048 + k * 1024); } while (0)
#define PG8_LDB(dst, b, h) do { _Pragma("unroll") for (int n = 0; n < 2; ++n) _Pragma("unroll") for (int k = 0; k < 2; ++k) dst[n][k] = *(const PG8_LAS bf16x8*)(lds + PG8_SB(b, h) + boff + n * 2048 + k * 1024); } while (0)
#define PG8_MMA(ai, bj, At, Bt) do { __builtin_amdgcn_s_setprio(1); _Pragma("unroll") for (int m = 0; m < 4; ++m) _Pragma("unroll") for (int n = 0; n < 2; ++n) _Pragma("unroll") for (int k = 0; k < 2; ++k) \
        acc[ai][bj][m][n] = __builtin_amdgcn_mfma_f32_16x16x32_bf16(Bt[n][k], At[m][k], acc[ai][bj][m][n], 0, 0, 0); __builtin_amdgcn_s_setprio(0); } while (0)
#define PG8_WAIT_V(n) asm volatile("s_waitcnt vmcnt(" #n ")" ::: "memory")
#define PG8_WAIT_L(n) asm volatile("s_waitcnt lgkmcnt(" #n ")" ::: "memory")
#define PG8_BAR __builtin_amdgcn_s_barrier()
#define PG8_SCHED __builtin_amdgcn_sched_barrier(0)
    Unit cur, nxt; int ui = 0;
    if (!S.next(0, cur)) return;
    f32x4 acc[2][2][4][2];
#pragma unroll
    for (int a = 0; a < 2; ++a)
#pragma unroll
        for (int b = 0; b < 2; ++b)
#pragma unroll
            for (int m = 0; m < 4; ++m)
#pragma unroll
                for (int n = 0; n < 2; ++n) acc[a][b][m][n] = (f32x4){0.f, 0.f, 0.f, 0.f};
    bf16x8 At[4][2], B0[2][2], B1[2][2];
    const char* cA = (const char*)g.A + (size_t)cur.pm * tstepA; const char* cB = (const char*)g.Bt + (size_t)cur.pn * tstepB;
    S.a_ready(cur);
    if constexpr (SP2) {
        PG8_STAGE(PG8_SB(0, 0), cB, voffB); PG8_STAGE(PG8_SB(0, 1), cB + hstepB, voffB); PG8_STAGE(PG8_SA(0, 0), cA, voffA); PG8_STAGE(PG8_SA(0, 1), cA + hstepA, voffA);
        if (wr == 1) PG8_BAR;
        PG8_WAIT_V(2); PG8_BAR;
        PG8_STAGE(PG8_SB(1, 0), cB + kstep, voffB); PG8_STAGE(PG8_SA(1, 0), cA + kstep, voffA); PG8_STAGE(PG8_SB(1, 1), cB + hstepB + kstep, voffB);
        PG8_WAIT_V(6); PG8_BAR;
    } else {
        PG8_STAGE(PG8_SB(0, 0), cB, voffB); PG8_STAGE(PG8_SA(0, 0), cA, voffA); PG8_STAGE(PG8_SB(0, 1), cB + hstepB, voffB); PG8_STAGE(PG8_SA(0, 1), cA + hstepA, voffA);
        if (wr == 1) PG8_BAR;
        PG8_WAIT_V(4); PG8_BAR;
        PG8_STAGE(PG8_SB(1, 0), cB + kstep, voffB); PG8_STAGE(PG8_SA(1, 0), cA + kstep, voffA); PG8_STAGE(PG8_SB(1, 1), cB + hstepB + kstep, voffB);
        PG8_WAIT_V(6); PG8_BAR;
    }
    for (;;) {
        const bool has_next = S.next(ui + 1, nxt);
        const char* nA = has_next ? (const char*)g.A + (size_t)nxt.pm * tstepA : cA; const char* nB = has_next ? (const char*)g.Bt + (size_t)nxt.pn * tstepB : cB;
        for (int t = 0; t < nt; t += 2) {
            const bool last = (t == nt - 2);
            const char* a1 = cA + (size_t)(t + 1) * kstep;
            const char* a2 = last ? nA : cA + (size_t)(t + 2) * kstep; const char* b2 = last ? nB : cB + (size_t)(t + 2) * kstep;
            const char* a3 = a2 + kstep; const char* b3 = b2 + kstep;
            if (last && has_next) S.a_ready(nxt);
            if constexpr (SP2) {
            PG8_LDB(B0, 0, 0); PG8_LDB(B1, 0, 1); PG8_SCHED; PG8_LDA(At, 0, 0); PG8_STAGE(PG8_SA(1, 1), a1 + hstepA, voffA);
            PG8_WAIT_V(8); PG8_WAIT_L(0); PG8_BAR; PG8_MMA(0, 0, At, B0); PG8_MMA(0, 1, At, B1); PG8_BAR; PG8_SCHED;
            PG8_LDA(At, 0, 1); PG8_STAGE(PG8_SB(0, 0), b2, voffB); PG8_STAGE(PG8_SB(0, 1), b2 + hstepB, voffB); PG8_STAGE(PG8_SA(0, 0), a2, voffA);
            PG8_WAIT_V(8); PG8_WAIT_L(0); PG8_BAR; PG8_MMA(1, 0, At, B0); PG8_MMA(1, 1, At, B1); PG8_BAR; PG8_SCHED;
            PG8_LDB(B0, 1, 0); PG8_LDB(B1, 1, 1); PG8_SCHED; PG8_LDA(At, 1, 0); PG8_STAGE(PG8_SA(0, 1), a2 + hstepA, voffA);
            PG8_WAIT_V(8); PG8_WAIT_L(0); PG8_BAR; PG8_MMA(0, 0, At, B0); PG8_MMA(0, 1, At, B1); PG8_BAR; PG8_SCHED;
            PG8_LDA(At, 1, 1); PG8_STAGE(PG8_SB(1, 0), b3, voffB); PG8_STAGE(PG8_SB(1, 1), b3 + hstepB, voffB); PG8_STAGE(PG8_SA(1, 0), a3, voffA);
            PG8_WAIT_V(8); PG8_WAIT_L(0); PG8_BAR; PG8_MMA(1, 0, At, B0); PG8_MMA(1, 1, At, B1); PG8_BAR; PG8_SCHED;
            } else {
            PG8_LDB(B0, 0, 0); PG8_SCHED; PG8_LDA(At, 0, 0); PG8_STAGE(PG8_SA(1, 1), a1 + hstepA, voffA);
            PG8_WAIT_L(8); PG8_BAR; PG8_WAIT_L(0); PG8_MMA(0, 0, At, B0); PG8_BAR; PG8_SCHED;
            PG8_LDB(B1, 0, 1); PG8_STAGE(PG8_SB(0, 0), b2, voffB);
            PG8_BAR; PG8_WAIT_L(0); PG8_MMA(0, 1, At, B1); PG8_BAR;
            PG8_LDA(At, 0, 1); PG8_STAGE(PG8_SA(0, 0), a2, voffA);
            PG8_BAR; PG8_WAIT_L(0); PG8_MMA(1, 0, At, B0); PG8_BAR; PG8_SCHED;
            PG8_STAGE(PG8_SB(0, 1), b2 + hstepB, voffB);
            PG8_WAIT_V(6); PG8_BAR; PG8_MMA(1, 1, At, B1); PG8_BAR;
            PG8_LDB(B0, 1, 0); PG8_SCHED; PG8_LDA(At, 1, 0); PG8_STAGE(PG8_SA(0, 1), a2 + hstepA, voffA);
            PG8_WAIT_L(8); PG8_BAR; PG8_WAIT_L(0); PG8_MMA(0, 0, At, B0); PG8_BAR; PG8_SCHED;
            PG8_LDB(B1, 1, 1); PG8_STAGE(PG8_SB(1, 0), b3, voffB);
            PG8_BAR; PG8_WAIT_L(0); PG8_MMA(0, 1, At, B1); PG8_BAR;
            PG8_LDA(At, 1, 1); PG8_STAGE(PG8_SA(1, 0), a3, voffA);
            PG8_BAR; PG8_WAIT_L(0); PG8_MMA(1, 0, At, B0); PG8_BAR; PG8_SCHED;
            PG8_STAGE(PG8_SB(1, 1), b3 + hstepB, voffB);
            PG8_WAIT_V(6); PG8_BAR; PG8_MMA(1, 1, At, B1); PG8_BAR;
            }
        }
        if constexpr (ALIGN_EPI) { if (wr == 0) PG8_BAR; }
        if constexpr (!Epi::AFTER_DRAIN) { E(acc, cur, wr, wc, fr, fq); S.done(cur); }
        if (!has_next) break;
#pragma unroll
        for (int a = 0; a < 2; ++a)
#pragma unroll
            for (int b = 0; b < 2; ++b)
#pragma unroll
                for (int m = 0; m < 4; ++m)
#pragma unroll
                    for (int n = 0; n < 2; ++n) acc[a][b][m][n] = (f32x4){0.f, 0.f, 0.f, 0.f};
        cur = nxt; cA = nA; cB = nB; ++ui;
        if constexpr (ALIGN_EPI) { if (wr == 1) PG8_BAR; }
    }
    PG8_WAIT_V(0);
    if constexpr (!ALIGN_EPI) { if (wr == 0) PG8_BAR; }
    PG8_BAR;
    if constexpr (Epi::AFTER_DRAIN) { E.fused(acc, cur, wr, wc, fr, fq, lds, wid, lane); S.done(cur); }
#undef PG8_SA
#undef PG8_SB
#undef PG8_STAGE
#undef PG8_LDA
#undef PG8_LDB
#undef PG8_MMA
#undef PG8_WAIT_V
#undef PG8_WAIT_L
#undef PG8_BAR
#undef PG8_SCHED
}
}

constexpr int NWAVES = 8, NTHR = NWAVES * 64;
constexpr int BATCH = 2, SEQ = 8192, DM = 1024, MTOK = BATCH * SEQ, FF = 4096;
constexpr int NPROJ0 = 6144, NPROJ1 = 3840;
constexpr float EPS = 1e-6f, LOG2E = 1.4426950408889634f;
constexpr int C0_Z = 0, C0_Q = 1024, C0_K = 2048, C0_V = 3072, C0_XBC = 4096;
constexpr int C1_RG = 0, C1_SQ = 1024, C1_RQ = 1536, C1_RK = 2048, C1_RV = 2560, C1_SK = 3584, C1_SV = 3712;
enum { I_X = 0, I_C, I_RELB, I_NG, I_MODW, I_MODB, I_W1, I_W2, I_EWIN, I_ECONVW, I_ECONVB, I_EDTB, I_EALOG, I_ED, I_ESSDN, I_ELAM, I_EDIFFN, I_EWOUT, I_OWIN, I_OSINK, I_OWOUT, N_IN };

constexpr size_t MiB = 1u << 20;
constexpr size_t WS_CTL = 0, CTL_ZERO_BYTES = 65536;
constexpr size_t WS_MOD = 256 * 1024;
constexpr size_t WS_WDT = 512 * 1024;
constexpr size_t WS_CHDEC = 576 * 1024;
constexpr size_t WS_SSQ = 640 * 1024;
constexpr size_t WS_WMIX = 1 * MiB;
constexpr size_t WS_WOUT0 = 13 * MiB, WS_WOUT1 = 9 * MiB;
constexpr size_t WS_PROJ0 = 17 * MiB;
constexpr size_t WS_XN2 = 17 * MiB;
constexpr size_t WS_WMLP = 49 * MiB;
constexpr size_t WS_H = 65 * MiB;
constexpr size_t WS_S = 209 * MiB;
constexpr size_t WS_DT = 241 * MiB;
constexpr size_t WS_ROPE = 244 * MiB;
constexpr size_t WS_XCH = 248 * MiB;
constexpr size_t WS_END = 250 * MiB;
constexpr int CW_BAR = 4096;

constexpr int LDS_BYTES = 163840 - 1024;
constexpr int MISC_OFF = LDS_BYTES - 256;

#define GAS __attribute__((address_space(1)))
#define LAS __attribute__((address_space(3)))
typedef unsigned short bf16;
typedef unsigned v4u __attribute__((ext_vector_type(4)));
typedef unsigned v2u __attribute__((ext_vector_type(2)));
typedef float f32x4 __attribute__((ext_vector_type(4)));
typedef short bf16x8 __attribute__((ext_vector_type(8)));
typedef short v4i16_t __attribute__((ext_vector_type(4)));
typedef GAS unsigned gu32;
typedef LAS unsigned char* ldsp;
#define RLX_AGENT __ATOMIC_RELAXED, __HIP_MEMORY_SCOPE_AGENT
#define LDS_WAIT() asm volatile("s_waitcnt lgkmcnt(0)" ::: "memory")
#define VM_WAIT() asm volatile("s_waitcnt vmcnt(0)" ::: "memory")

__device__ __forceinline__ float bf2f(unsigned h) { return __uint_as_float(h << 16); }
typedef float f32x2_t __attribute__((ext_vector_type(2))); typedef __bf16 bf16x2_t __attribute__((ext_vector_type(2)));
__device__ __forceinline__ unsigned pk2(float lo, float hi) { f32x2_t v = {lo, hi}; bf16x2_t b = __builtin_convertvector(v, bf16x2_t); return __builtin_bit_cast(unsigned, b); }
__device__ __forceinline__ unsigned short f2bf(float f) { return (unsigned short)(pk2(f, 0.f) & 0xffffu); }
__device__ __forceinline__ float silu_f(float x) { return x * __builtin_amdgcn_rcpf(1.f + __expf(-x)); }
__device__ __forceinline__ float wave_sum(float v) {
#pragma unroll
    for (int o = 1; o < 64; o <<= 1) v += __shfl_xor(v, o);
    return v;
}
#define MFMA16(acc, rowfrag, colfrag) acc = __builtin_amdgcn_mfma_f32_16x16x32_bf16(colfrag, rowfrag, acc, 0, 0, 0)
__device__ __forceinline__ bf16x8 lds_frag(ldsp p) { return *(const LAS bf16x8*)p; }
__device__ __forceinline__ bf16x8 lds_frag_tr(ldsp p, int stride) {
    const v4i16_t lo = __builtin_amdgcn_ds_read_tr16_b64_v4i16((LAS v4i16_t*)p);
    const v4i16_t hi = __builtin_amdgcn_ds_read_tr16_b64_v4i16((LAS v4i16_t*)(p + 4 * stride));
    return (bf16x8){lo[0], lo[1], lo[2], lo[3], hi[0], hi[1], hi[2], hi[3]};
}
__device__ __forceinline__ int t5_bucket(int d) {
    if (d < 16) return d;
    const int v = 16 + (int)(logf((float)d * 0.0625f) / 2.0794415416798357f * 16.0f);
    return v < 31 ? v : 31;
}

#define XB_TMO      128
#define XB_XCNT(j)  (256  + 64 * (j))
#define XB_XSUB(j)  (1280 + 64 * (j))
#define XB_XGEN(j)  (2304 + 64 * (j))
#define XB_TOP      3328
#define XB_TOPGEN   3392
#define XCD_BAR_WORDS 3456
#define XB_SPIN_CAP (1u << 18)

__device__ __forceinline__ unsigned xb_ld(unsigned* p)              { return __hip_atomic_load(p, __ATOMIC_RELAXED, __HIP_MEMORY_SCOPE_AGENT); }
__device__ __forceinline__ unsigned xb_add(unsigned* p, unsigned v) { return __hip_atomic_fetch_add(p, v, __ATOMIC_RELAXED, __HIP_MEMORY_SCOPE_AGENT); }
__device__ __forceinline__ unsigned xb_xcc_id() { return (unsigned)__builtin_amdgcn_s_getreg((3 << 11) | 20) & 0xFu; }
#define XB_SPIN(cond, bar) do { unsigned _sp = 0; while (cond) { __builtin_amdgcn_s_sleep(1); \
    if ((++_sp & 255u) == 0u) { if (xb_ld(&(bar)[XB_TMO])) break; if (_sp > XB_SPIN_CAP) { atomicAdd(&(bar)[XB_TMO], 1u); break; } } } } while (0)

struct XcdBarrier {
    unsigned* bar; unsigned x;
    volatile LAS unsigned* st;
};

__device__ __forceinline__ XcdBarrier xcd_barrier_post(unsigned* bar, volatile LAS unsigned* st) {
    XcdBarrier b; b.bar = bar; b.x = xb_xcc_id(); b.st = st;
    if (threadIdx.x == 0) (void)xb_add(&bar[XB_XCNT(b.x)], 1u);
    return b;
}
__device__ __forceinline__ void xcd_barrier_complete(unsigned* bar, unsigned x, unsigned& nloc, unsigned& nx) {
    const unsigned G = gridDim.x * gridDim.y * gridDim.z;
    unsigned sum, cnt, mine, sp = 0u;
    for (;;) {
        sum = 0u; cnt = 0u; mine = 0u;
#pragma unroll
        for (unsigned j = 0; j < 16; ++j) { const unsigned c = xb_ld(&bar[XB_XCNT(j)]); sum += c; cnt += (c > 0u) ? 1u : 0u; mine = (j == x) ? c : mine; }
        if (sum == G) break;
        __builtin_amdgcn_s_sleep(1);
        if ((++sp & 255u) == 0u) { if (xb_ld(&bar[XB_TMO])) break; if (sp > XB_SPIN_CAP) { atomicAdd(&bar[XB_TMO], 1u); break; } }
    }
    nloc = mine > 0u ? mine : 1u; nx = cnt > 0u ? cnt : 1u;
}

template <bool WB = true> __device__ __forceinline__ void xcd_barrier(const XcdBarrier& b) {
    asm volatile("s_waitcnt vmcnt(0)" ::: "memory");
    __syncthreads();
    if (threadIdx.x == 0) {
        unsigned* bar = b.bar;
        __builtin_amdgcn_s_waitcnt(0);
        unsigned nloc = b.st[0], nx = b.st[1];
        if (nloc == 0u) { xcd_barrier_complete(bar, b.x, nloc, nx); b.st[0] = nloc; b.st[1] = nx; }
        const unsigned old = xb_add(&bar[XB_XSUB(b.x)], 1u);
        const unsigned gen = old / nloc;
        if (old + 1u == (gen + 1u) * nloc) {
            if (WB) asm volatile("buffer_inv sc1\n\tbuffer_wbl2 sc1\n\ts_waitcnt vmcnt(0)" ::: "memory"); else asm volatile("buffer_inv sc1" ::: "memory");
            xb_add(&bar[XB_TOP], 1u);
        } else {
            asm volatile("buffer_inv sc1" ::: "memory");
        }
        XB_SPIN(xb_ld(&bar[XB_TOP]) < (gen + 1u) * nx, bar);
        asm volatile("s_waitcnt vmcnt(0)" ::: "memory");
    }
    __syncthreads();
}

struct Seg { const float* W; int ldw, col0, ncols, K; bf16* WT; int row_off; };
struct CvtItem { const float* src; bf16* dst; int ldw, K; bool valid; };
template <int NSEG> __device__ __forceinline__ CvtItem cvt_resolve(const Seg (&segs)[NSEG], int it, int total, int lane) {
    CvtItem c; c.src = nullptr; c.dst = nullptr; c.ldw = 0; c.K = 0; c.valid = false;
    int r = it < total ? it : -1;
#pragma unroll
    for (int s = 0; s < NSEG; ++s) { const int nblk = segs[s].ncols / 32, n = (segs[s].K / 64) * nblk;
        if (!c.valid && r >= 0 && r < n) { const int kb = r / nblk, nb = r % nblk, k0 = 64 * kb, n0 = 32 * nb;
            c.src = segs[s].W + (size_t)(k0 + (lane >> 5)) * segs[s].ldw + segs[s].col0 + n0 + (lane & 31);
            c.dst = segs[s].WT + (size_t)(segs[s].row_off + n0 + (lane >> 3)) * segs[s].K + k0 + 8 * (lane & 7); c.ldw = segs[s].ldw; c.K = segs[s].K; c.valid = true; }
        r -= n; }
    return c;
}
__device__ __forceinline__ void cvt_loads(const CvtItem& c, float (&wv)[32]) {
    if (c.valid) {
#pragma unroll
        for (int i = 0; i < 32; ++i) wv[i] = c.src[(size_t)(2 * i) * c.ldw]; }
}
__device__ __forceinline__ void cvt_finish(const CvtItem& c, const float (&wv)[32], LAS float* scr, int lane) {
    if (c.valid) {
#pragma unroll
        for (int i = 0; i < 32; ++i) scr[(2 * i + (lane >> 5)) * 33 + (lane & 31)] = wv[i];
        LDS_WAIT(); asm volatile("" ::: "memory");
        const int cc = lane & 7;
#pragma unroll
        for (int j = 0; j < 4; ++j) { const int n = (lane >> 3) + 8 * j; const LAS float* p = scr + (8 * cc) * 33 + n;
            v4u o; o.x = pk2(p[0 * 33], p[1 * 33]); o.y = pk2(p[2 * 33], p[3 * 33]); o.z = pk2(p[4 * 33], p[5 * 33]); o.w = pk2(p[6 * 33], p[7 * 33]);
            *(v4u*)(c.dst + (size_t)(8 * j) * c.K) = o; }
        LDS_WAIT(); asm volatile("" ::: "memory"); }
}
template <int NSEG> __device__ __forceinline__ void convert_set(const Seg (&segs)[NSEG], ldsp lds, int gw, int NGW, int wave, int lane) {
    LAS float* scr = (LAS float*)(lds + wave * 16384);
    int total = 0;
#pragma unroll
    for (int s = 0; s < NSEG; ++s) total += (segs[s].K / 64) * (segs[s].ncols / 32);
    for (int it = gw; it < total; it += 2 * NGW) {
        const CvtItem ca = cvt_resolve<NSEG>(segs, it, total, lane), cb = cvt_resolve<NSEG>(segs, it + NGW, total, lane);
        float wa[32], wb[32];
        cvt_loads(ca, wa); cvt_loads(cb, wb);
        cvt_finish(ca, wa, scr, lane); cvt_finish(cb, wb, scr, lane);
    }
}
__device__ __forceinline__ void mod_phase(const float* c, const float* mod_w, const float* mod_b, float* MOD, ldsp lds, int tid, int lane, int wave) {
    for (int item = blockIdx.x; item < 192; item += gridDim.x) {
        const int s = item / 48, j0 = (item % 48) * 64, kpart = wave * 4 + (lane >> 4), jl = lane & 15;
        const float* wp = mod_w + ((size_t)s * 1024 + kpart * 32) * 3072 + j0 + 4 * jl;
        f32x4 a0 = {0.f, 0.f, 0.f, 0.f}, a1 = a0;
#pragma unroll
        for (int kk = 0; kk < 32; ++kk) { const int k = kpart * 32 + kk; const f32x4 w = *(const f32x4*)(wp + (size_t)kk * 3072);
            const float c0 = c[k], c1 = c[1024 + k]; const float s0 = c0 / (1.f + expf(-c0)), s1 = c1 / (1.f + expf(-c1)); a0 += w * s0; a1 += w * s1; }
        LAS f32x4* red = (LAS f32x4*)lds;
        red[(kpart * 2 + 0) * 16 + jl] = a0; red[(kpart * 2 + 1) * 16 + jl] = a1;
        __syncthreads();
        if (tid < 128) { const int b = tid >> 6, col = tid & 63; float sum = mod_b[s * 3072 + j0 + col];
#pragma unroll
            for (int kp = 0; kp < 32; ++kp) sum += ((LAS float*)lds)[((kp * 2 + b) * 16 + (col >> 2)) * 4 + (col & 3)];
            MOD[(s * 2 + b) * 3072 + j0 + col] = sum; }
        __syncthreads();
    }
}

template <int SPOST, int SPRE, bool XINB, int XOUT, int R = 2> __device__ __forceinline__ void norm_rows(const void* xin_, const bf16* Y, void* xout_, bf16* XN, const float* MOD, const float* ng, int gw, int NGW, int lane) {
    const float* xinf = (const float*)xin_; const bf16* xinb = (const bf16*)xin_; float* xoutf = (float*)xout_; bf16* xoutb = (bf16*)xout_;
    const int half = NGW >> 1; const bool split = !(NGW & 1);
    const int b0 = split ? gw / half : 0, b1 = split ? b0 + 1 : BATCH, w = split ? gw % half : gw, W = split ? half : NGW;
#define NR_COL(q) (8 * lane + 512 * ((q) >> 1) + 4 * ((q) & 1))
#define NR_UNPK(w_) ((f32x4){__uint_as_float((w_).x << 16), __uint_as_float((w_).x & 0xffff0000u), __uint_as_float((w_).y << 16), __uint_as_float((w_).y & 0xffff0000u)})
#define NR_LOAD(vx, vxb, vy, m_) do { _Pragma("unroll") for (int j = 0; j < 2; ++j) { \
        if constexpr (XINB) vxb[j] = *(const v4u*)(xinb + (size_t)(m_) * DM + 8 * lane + 512 * j); \
        else { vx[2 * j] = *(const f32x4*)(xinf + (size_t)(m_) * DM + NR_COL(2 * j)); vx[2 * j + 1] = *(const f32x4*)(xinf + (size_t)(m_) * DM + NR_COL(2 * j + 1)); } \
        if constexpr (SPOST >= 0) vy[j] = *(const v4u*)(Y + (size_t)(m_) * DM + 8 * lane + 512 * j); } } while (0)
#pragma unroll 1
    for (int b = b0; b < b1; ++b) {
        f32x4 g4[4], p4[4], s4[4], c4[4], q4[4];
#pragma unroll
        for (int q = 0; q < 4; ++q) {
            if constexpr (SPOST >= 0) { g4[q] = *(const f32x4*)(MOD + (SPOST * 2 + b) * 3072 + 2048 + NR_COL(q)); p4[q] = *(const f32x4*)(ng + (SPOST * 2 + 1) * DM + NR_COL(q)); }
            if constexpr (SPRE >= 0) { s4[q] = *(const f32x4*)(MOD + (SPRE * 2 + b) * 3072 + NR_COL(q)); c4[q] = *(const f32x4*)(MOD + (SPRE * 2 + b) * 3072 + 1024 + NR_COL(q)) + 1.0f;
                q4[q] = *(const f32x4*)(ng + (SPRE * 2) * DM + NR_COL(q)); }
        }
        const int cnt = w < SEQ ? (SEQ - w + W - 1) / W : 0;
        f32x4 vx[R][4]; v4u vxb[R][2], vy[R][2];
#pragma unroll
        for (int r = 0; r < R; ++r) if (r < cnt) NR_LOAD(vx[r], vxb[r], vy[r], b * SEQ + w + r * W);
        for (int i0 = 0; i0 < cnt; i0 += R) {
            f32x4 nx[R][4]; v4u nxb[R][2], ny[R][2];
#pragma unroll
            for (int r = 0; r < R; ++r) if (i0 + R + r < cnt) NR_LOAD(nx[r], nxb[r], ny[r], b * SEQ + w + (i0 + R + r) * W);
#pragma unroll
            for (int r = 0; r < R; ++r) if (i0 + r < cnt) {
                const int m = b * SEQ + w + (i0 + r) * W;
                f32x4 v[4];
#pragma unroll
                for (int j = 0; j < 2; ++j) { if constexpr (XINB) { const v2u lo = {vxb[r][j].x, vxb[r][j].y}, hi = {vxb[r][j].z, vxb[r][j].w}; v[2 * j] = NR_UNPK(lo); v[2 * j + 1] = NR_UNPK(hi); }
                                              else { v[2 * j] = vx[r][2 * j]; v[2 * j + 1] = vx[r][2 * j + 1]; } }
                if constexpr (SPOST >= 0) {
                    f32x4 y[4]; float ss = 0.f;
#pragma unroll
                    for (int j = 0; j < 2; ++j) { const v2u lo = {vy[r][j].x, vy[r][j].y}, hi = {vy[r][j].z, vy[r][j].w}; y[2 * j] = NR_UNPK(lo); y[2 * j + 1] = NR_UNPK(hi); }
#pragma unroll
                    for (int q = 0; q < 4; ++q) ss += (y[q].x * y[q].x + y[q].y * y[q].y) + (y[q].z * y[q].z + y[q].w * y[q].w);
                    const float rr = 1.0f / sqrtf(wave_sum(ss) * (1.f / DM) + EPS);
#pragma unroll
                    for (int q = 0; q < 4; ++q) v[q] = v[q] + g4[q] * ((y[q] * rr) * p4[q]);
                    if constexpr (XOUT == 2) {
#pragma unroll
                        for (int q = 0; q < 4; ++q) *(f32x4*)(xoutf + (size_t)m * DM + NR_COL(q)) = v[q]; }
                    if constexpr (XOUT == 1) {
#pragma unroll
                        for (int j = 0; j < 2; ++j) { v4u o; o.x = pk2(v[2 * j].x, v[2 * j].y); o.y = pk2(v[2 * j].z, v[2 * j].w); o.z = pk2(v[2 * j + 1].x, v[2 * j + 1].y); o.w = pk2(v[2 * j + 1].z, v[2 * j + 1].w);
                            *(v4u*)(xoutb + (size_t)m * DM + 8 * lane + 512 * j) = o;
                            const v2u lo = {o.x, o.y}, hi = {o.z, o.w}; v[2 * j] = NR_UNPK(lo); v[2 * j + 1] = NR_UNPK(hi); } }
                }
                if constexpr (SPRE >= 0) {
                    float ss = 0.f;
#pragma unroll
                    for (int q = 0; q < 4; ++q) ss += (v[q].x * v[q].x + v[q].y * v[q].y) + (v[q].z * v[q].z + v[q].w * v[q].w);
                    const float rr = 1.0f / sqrtf(wave_sum(ss) * (1.f / DM) + EPS);
#pragma unroll
                    for (int j = 0; j < 2; ++j) { const f32x4 oa = ((v[2 * j] * rr) * q4[2 * j]) * c4[2 * j] + s4[2 * j], ob = ((v[2 * j + 1] * rr) * q4[2 * j + 1]) * c4[2 * j + 1] + s4[2 * j + 1];
                        v4u o; o.x = pk2(oa.x, oa.y); o.y = pk2(oa.z, oa.w); o.z = pk2(ob.x, ob.y); o.w = pk2(ob.z, ob.w);
                        *(v4u*)(XN + (size_t)m * DM + 8 * lane + 512 * j) = o; }
                }
            }
#pragma unroll
            for (int r = 0; r < R; ++r) {
#pragma unroll
                for (int q = 0; q < 4; ++q) vx[r][q] = nx[r][q];
#pragma unroll
                for (int j = 0; j < 2; ++j) { vxb[r][j] = nxb[r][j]; vy[r][j] = ny[r][j]; } }
        }
    }
#undef NR_LOAD
#undef NR_UNPK
#undef NR_COL
}

__device__ __forceinline__ void dt_phase(const bf16* XN, const bf16* WDT, const float* dt_bias, float* DT, int gw, int NGW, int lane) {
    const int fr = lane & 15, fq = lane >> 4;
    for (int tile = gw; tile < MTOK / 16; tile += NGW) {
        f32x4 acc = {0.f, 0.f, 0.f, 0.f};
        const bf16* arow = XN + (size_t)(tile * 16 + fr) * DM + 8 * fq; const bf16* brow = WDT + fr * DM + 8 * fq;
#pragma unroll 8
        for (int ks = 0; ks < 32; ++ks) { const bf16x8 a = *(const bf16x8*)(arow + 32 * ks), bb = *(const bf16x8*)(brow + 32 * ks); MFMA16(acc, a, bb); }
        const f32x4 bi = *(const f32x4*)(dt_bias + 4 * fq); f32x4 o;
#pragma unroll
        for (int i = 0; i < 4; ++i) { const float v = acc[i] + bi[i]; o[i] = v > 20.f ? v : log1pf(expf(v)); }
        *(f32x4*)(DT + (size_t)(tile * 16 + fr) * 16 + 4 * fq) = o;
    }
}

__device__ __forceinline__ void ssd_dt_acs(const float* DT, const float* A_log, int t0, int g, LAS float* ACS, LAS float* DTS, LAS float* TMP, int tid) {
    const int r = tid >> 7, s = tid & 127, ln = tid & 63;
    const float dt = DT[(size_t)(t0 + s) * 16 + g * 4 + r];
    float v = -expf(A_log[g * 4 + r]) * dt; DTS[r * 128 + s] = dt;
#pragma unroll
    for (int d = 1; d < 64; d <<= 1) { const float t = __shfl_up(v, d); if (ln >= d) v += t; }
    if (ln == 63) TMP[tid >> 6] = v;
    __syncthreads();
    if (s >= 64) v += TMP[(tid >> 6) - 1];
    ACS[r * 128 + s] = v;
    __syncthreads();
}
__device__ __forceinline__ void ssd_conv_group(const bf16* PROJ0, const float* conv_w, const float* conv_b, int t0, bool first_chunk, int cch0, int tg, int mode, ldsp dst  , int stride,
                                               const LAS float* ACSr, const LAS float* DTSr) {
    float w[4][8], cb[8];
#pragma unroll
    for (int j = 0; j < 4; ++j) { const f32x4 a = *(const f32x4*)(conv_w + j * 2048 + cch0), b = *(const f32x4*)(conv_w + j * 2048 + cch0 + 4);
        w[j][0] = a[0]; w[j][1] = a[1]; w[j][2] = a[2]; w[j][3] = a[3]; w[j][4] = b[0]; w[j][5] = b[1]; w[j][6] = b[2]; w[j][7] = b[3]; }
    { const f32x4 a = *(const f32x4*)(conv_b + cch0), b = *(const f32x4*)(conv_b + cch0 + 4); cb[0] = a[0]; cb[1] = a[1]; cb[2] = a[2]; cb[3] = a[3]; cb[4] = b[0]; cb[5] = b[1]; cb[6] = b[2]; cb[7] = b[3]; }
    v4u raw[19];
    const bf16* src = PROJ0 + ((size_t)t0 + 16 * tg) * NPROJ0 + C0_XBC + cch0;
    const bool pad = first_chunk && tg == 0;
#pragma unroll
    for (int i = 0; i < 19; ++i) { if (i < 3 && pad) raw[i] = (v4u){0u, 0u, 0u, 0u}; else raw[i] = *(const v4u*)(src + (ptrdiff_t)(i - 3) * NPROJ0); }
    const float alast = ACSr[127];
#pragma unroll
    for (int k = 0; k < 16; ++k) { const int s = 16 * tg + k;
        float sc = 1.f; if (mode == 0) sc = DTSr[s] * __expf(alast - ACSr[s]); else if (mode == 1) sc = DTSr[s];
        float o[8];
#pragma unroll
        for (int c = 0; c < 8; ++c) { float v = cb[c];
#pragma unroll
            for (int j = 0; j < 4; ++j) { const unsigned d = raw[k + j][c >> 1]; v += w[j][c] * ((c & 1) ? __uint_as_float(d & 0xffff0000u) : __uint_as_float(d << 16)); }
            o[c] = silu_f(v) * sc; }
        v4u ow; ow.x = pk2(o[0], o[1]); ow.y = pk2(o[2], o[3]); ow.z = pk2(o[4], o[5]); ow.w = pk2(o[6], o[7]);
        *(LAS v4u*)(dst + s * stride) = ow; }
}
constexpr int SA_BS = 0, SA_XS = 34816, SA_ACS = 102400, SA_DTS = 104448, SA_TMP = 106496;
__device__ __forceinline__ void ssdA_unit(ldsp lds, const bf16* PROJ0, const float* DT, const float* conv_w, const float* conv_b, const float* A_log, bf16* ST, float* CHDEC, int u, int tid, int lane, int wave) {
    asm volatile("" : "+v"(tid), "+v"(lane));
    const int g = u & 3, c = (u >> 2) & 63, b = u >> 8, t0 = b * SEQ + c * 128;
    const int fr = lane & 15, fq = lane >> 4, trq = (lane & 15) >> 2, trp = lane & 3;
    LAS float* ACS = (LAS float*)(lds + SA_ACS); LAS float* DTS = (LAS float*)(lds + SA_DTS); LAS float* TMP = (LAS float*)(lds + SA_TMP);
    ssd_dt_acs(DT, A_log, t0, g, ACS, DTS, TMP, tid);
    if (tid < 4) CHDEC[(b * 64 + c) * 16 + g * 4 + tid] = __expf(ACS[tid * 128 + 127]);
    if (tid < 384) { const int cg = tid % 48, tg = tid / 48; const bool isx = cg < 32; const int r = isx ? (cg >> 3) : 0;
        ssd_conv_group(PROJ0, conv_w, conv_b, t0, c == 0, isx ? g * 256 + 8 * cg : 1024 + g * 128 + 8 * (cg - 32), tg, isx ? 0 : 2,
                       isx ? lds + SA_XS + cg * 16 : lds + SA_BS + (cg - 32) * 16, isx ? 528 : 272, ACS + r * 128, DTS + r * 128); }
    __syncthreads();
    const int r = wave >> 1, half = wave & 1;
    f32x4 acc[2][8];
#pragma unroll
    for (int j = 0; j < 2; ++j)
#pragma unroll
        for (int n = 0; n < 8; ++n) acc[j][n] = (f32x4){0.f, 0.f, 0.f, 0.f};
    bf16x8 fa[2][2], fb[2][8];
#define SA_READ(ks_, buf_) do { _Pragma("unroll") for (int j = 0; j < 2; ++j) fa[buf_][j] = lds_frag_tr(lds + SA_XS + (32 * (ks_) + 8 * fq + trq) * 528 + (r * 64 + (2 * half + j) * 16 + 4 * trp) * 2, 528); \
        _Pragma("unroll") for (int n = 0; n < 8; ++n) fb[buf_][n] = lds_frag_tr(lds + SA_BS + (32 * (ks_) + 8 * fq + trq) * 272 + (n * 16 + 4 * trp) * 2, 272); } while (0)
    SA_READ(0, 0);
#pragma unroll
    for (int ks = 0; ks < 4; ++ks) {
        if (ks < 3) SA_READ(ks + 1, (ks + 1) & 1);
        __builtin_amdgcn_sched_barrier(0);
#pragma unroll
        for (int n = 0; n < 8; ++n) { MFMA16(acc[0][n], fa[ks & 1][0], fb[ks & 1][n]); MFMA16(acc[1][n], fa[ks & 1][1], fb[ks & 1][n]); }
        __builtin_amdgcn_sched_barrier(0);
    }
#undef SA_READ
    bf16* so = ST + ((size_t)((b * 64 + c) * 16 + g * 4 + r) * 64) * 128;
#pragma unroll
    for (int j = 0; j < 2; ++j)
#pragma unroll
        for (int n = 0; n < 8; ++n) { v2u w; w.x = pk2(acc[j][n][0], acc[j][n][1]); w.y = pk2(acc[j][n][2], acc[j][n][3]);
            *(v2u*)(so + (size_t)((2 * half + j) * 16 + fr) * 128 + n * 16 + 4 * fq) = w; }
    __syncthreads();
}
__device__ __forceinline__ void ssd_scan(bf16* ST, const float* CHDEC, int gtid, int gthreads) {
    for (int e = gtid; e < 131072; e += gthreads) {
        const int b = e >> 16, rem = e & 65535, h = rem >> 12, pn = rem & 4095;
        unsigned* p = (unsigned*)ST + ((size_t)(b * 64) * 16 + h) * 4096 + pn; const float* dp = CHDEC + (b * 64) * 16 + h;
        float c0 = 0.f, c1 = 0.f;
#pragma unroll 1
        for (int hf = 0; hf < 2; ++hf) {
            unsigned v[32]; unsigned* pb = p + (size_t)hf * 32 * 16 * 4096;
            { const unsigned* q = pb;
#pragma unroll
              for (int c = 0; c < 32; ++c) { v[c] = *q; q += 16 * 4096; asm volatile("" : "+v"(q)); } }
#pragma unroll
            for (int c = 0; c < 32; ++c) { const float dec = dp[(hf * 32 + c) * 16]; const unsigned o = pk2(c0, c1); c0 = c0 * dec + __uint_as_float(v[c] << 16); c1 = c1 * dec + __uint_as_float(v[c] & 0xffff0000u); v[c] = o; }
            { unsigned* q = pb;
#pragma unroll
              for (int c = 0; c < 32; ++c) { *q = v[c]; q += 16 * 4096; asm volatile("" : "+v"(q)); } }
        }
    }
}
constexpr int SC_CS = 0, SC_BS = 34816, SC_XS = 69632, SC_ACS = 137216, SC_DTS = 139264, SC_TMP = 141312, SC_SP = 143360;
template <int PV> __device__ __forceinline__ void ssdC_unit(ldsp lds, const bf16* PROJ0, bf16* OUT  , int opitch, const float* DT, const float* conv_w, const float* conv_b, const float* A_log, const float* Dskip, const float* ssd_norm,
                                          const bf16* ST, float* SSQ, int u, int tid, int lane, int wave) {
    asm volatile("" : "+v"(tid), "+v"(lane));
    const int g = u & 3, c = (u >> 2) & 63, b = u >> 8, t0 = b * SEQ + c * 128;
    const int fr = lane & 15, fq = lane >> 4, trq = (lane & 15) >> 2, trp = lane & 3;
    LAS float* ACS = (LAS float*)(lds + SC_ACS); LAS float* DTS = (LAS float*)(lds + SC_DTS); LAS float* TMP = (LAS float*)(lds + SC_TMP);
    if (!(PV & 1)) ssd_dt_acs(DT, A_log, t0, g, ACS, DTS, TMP, tid);
    if (!(PV & 2)) { const int cg = tid & 63, tg = tid >> 6; const bool isx = cg < 32, isb = cg < 48; const int r = isx ? (cg >> 3) : 0;
      ssd_conv_group(PROJ0, conv_w, conv_b, t0, c == 0, isx ? g * 256 + 8 * cg : (isb ? 1024 + g * 128 + 8 * (cg - 32) : 1536 + g * 128 + 8 * (cg - 48)), tg, isx ? 1 : 2,
                     isx ? lds + SC_XS + cg * 16 : (isb ? lds + SC_BS + (cg - 32) * 16 : lds + SC_CS + (cg - 48) * 16), isx ? 528 : 272, ACS + r * 128, DTS + r * 128); }
    __syncthreads();
    const int l = 16 * wave + fr;
    const ldsp crow = lds + SC_CS + l * 272 + 16 * fq, mrow = lds + SC_BS + l * 272 + 16 * fq;
    const bf16* prow = PROJ0 + (size_t)(t0 + l) * NPROJ0; bf16* orow = OUT + (size_t)(t0 + l) * opitch;
    v2u zw[4]; f32x4 nwn[4]; float dskn;
    v4u spr[2];
    const int sprow = tid >> 3, spch = tid & 7;
    { const bf16* sp = ST + ((size_t)((b * 64 + c) * 16 + g * 4) * 64) * 128;
#pragma unroll
      for (int i = 0; i < 2; ++i) spr[i] = *(const v4u*)(sp + (size_t)(sprow) * 128 + (spch + 8 * i) * 8);
#pragma unroll
      for (int p = 0; p < 4; ++p) { zw[p] = *(const v2u*)(prow + C0_Z + (g * 4) * 64 + 16 * p + 4 * fq); nwn[p] = *(const f32x4*)(ssd_norm + (g * 4) * 64 + 16 * p + 4 * fq); }
      dskn = Dskip[g * 4]; }
    f32x4 cb[8];
#pragma unroll
    for (int n = 0; n < 8; ++n) cb[n] = (f32x4){0.f, 0.f, 0.f, 0.f};
#pragma unroll
    for (int ks = 0; ks < 4; ++ks) { const bf16x8 af = lds_frag(crow + 64 * ks); bf16x8 bfr[8];
#pragma unroll
        for (int n = 0; n < 8; ++n) bfr[n] = lds_frag(lds + SC_BS + (16 * n + fr) * 272 + 64 * ks + 16 * fq);
        __builtin_amdgcn_sched_barrier(0);
#pragma unroll
        for (int n = 0; n < 8; ++n) MFMA16(cb[n], af, bfr[n]);
        __builtin_amdgcn_sched_barrier(0); }
    __syncthreads();
    float ssq = 0.f;
#pragma unroll 1
    for (int r = 0; r < ((PV & 4) ? 0 : 4); ++r) {
        const int h = g * 4 + r; const float al = ACS[r * 128 + l];
#pragma unroll
        for (int i = 0; i < 2; ++i) *(LAS v4u*)(lds + SC_SP + sprow * 272 + (spch + 8 * i) * 16) = spr[i];
        v2u zc[4]; f32x4 nwc[4]; const float dskc = dskn;
#pragma unroll
        for (int p = 0; p < 4; ++p) { zc[p] = zw[p]; nwc[p] = nwn[p]; }
        if (r < 3 && !(PV & 8)) {
            const bf16* sp = ST + ((size_t)((b * 64 + c) * 16 + h + 1) * 64) * 128;
#pragma unroll
            for (int i = 0; i < 2; ++i) spr[i] = *(const v4u*)(sp + (size_t)(sprow) * 128 + (spch + 8 * i) * 8);
#pragma unroll
            for (int p = 0; p < 4; ++p) { zw[p] = *(const v2u*)(prow + C0_Z + (h + 1) * 64 + 16 * p + 4 * fq); nwn[p] = *(const f32x4*)(ssd_norm + (h + 1) * 64 + 16 * p + 4 * fq); }
            dskn = Dskip[h + 1];
        }
        __syncthreads();
#pragma unroll
        for (int n = 0; n < 8; ++n) { const f32x4 as = *(const LAS f32x4*)(ACS + r * 128 + 16 * n + 4 * fq); float mv[4];
#pragma unroll
            for (int i = 0; i < 4; ++i) { const int s = 16 * n + 4 * fq + i; mv[i] = (s <= l) ? cb[n][i] * __expf(al - as[i]) : 0.f; }
            v2u w; w.x = pk2(mv[0], mv[1]); w.y = pk2(mv[2], mv[3]); *(LAS v2u*)(lds + SC_BS + l * 272 + (16 * n + 4 * fq) * 2) = w; }
        f32x4 y[4], yo[4];
#pragma unroll
        for (int p = 0; p < 4; ++p) { y[p] = (f32x4){0.f, 0.f, 0.f, 0.f}; yo[p] = y[p]; }
#pragma unroll
        for (int ks = 0; ks < 4; ++ks) { const bf16x8 af = lds_frag(mrow + 64 * ks);
            bf16x8 xf[4];
#pragma unroll
            for (int p = 0; p < 4; ++p) xf[p] = lds_frag_tr(lds + SC_XS + (32 * ks + 8 * fq + trq) * 528 + (r * 64 + 16 * p + 4 * trp) * 2, 528);
#pragma unroll
            for (int p = 0; p < 4; ++p) MFMA16(y[p], af, xf[p]); }
#pragma unroll
        for (int ks = 0; ks < 4; ++ks) { const bf16x8 cf = lds_frag(crow + 64 * ks); bf16x8 sf[4];
#pragma unroll
            for (int p = 0; p < 4; ++p) sf[p] = lds_frag(lds + SC_SP + (16 * p + fr) * 272 + 64 * ks + 16 * fq);
#pragma unroll
            for (int p = 0; p < 4; ++p) MFMA16(yo[p], cf, sf[p]); }
        __syncthreads();
        const float el = __expf(al), rdt = dskc / DTS[r * 128 + l];
#pragma unroll
        for (int p = 0; p < 4; ++p) { const int ch = h * 64 + 16 * p + 4 * fq;
            const v2u xw = *(const LAS v2u*)(lds + SC_XS + l * 528 + (r * 64 + 16 * p + 4 * fq) * 2); const f32x4 nw = nwc[p];
            const float z[4] = {__uint_as_float(zc[p].x << 16), __uint_as_float(zc[p].x & 0xffff0000u), __uint_as_float(zc[p].y << 16), __uint_as_float(zc[p].y & 0xffff0000u)};
            const float xs[4] = {__uint_as_float(xw.x << 16), __uint_as_float(xw.x & 0xffff0000u), __uint_as_float(xw.y << 16), __uint_as_float(xw.y & 0xffff0000u)};
            float o[4];
#pragma unroll
            for (int i = 0; i < 4; ++i) { float v = y[p][i] + el * yo[p][i] + rdt * xs[i]; v *= silu_f(z[i]); ssq += v * v; o[i] = v * nw[i]; }
            v2u w; w.x = pk2(o[0], o[1]); w.y = pk2(o[2], o[3]); if (!(PV & 16)) *(v2u*)(orow + ch) = w; else asm volatile("" :: "v"(w.x), "v"(w.y)); }
    }
    ssq += __shfl_xor(ssq, 16); ssq += __shfl_xor(ssq, 32);
    if (fq == 0) SSQ[(size_t)(t0 + l) * 4 + g] = ssq;
    __syncthreads();
}
__device__ __forceinline__ void ssd_normalize_rows(bf16* PROJ0, const float* SSQ, int gw, int NGW, int lane) {
    for (int m = gw; m < MTOK; m += NGW) {
        const f32x4 q = *(const f32x4*)(SSQ + (size_t)m * 4); const float r = 1.0f / sqrtf(((q.x + q.y) + (q.z + q.w)) * (1.f / 1024.f) + EPS);
        v4u* p = (v4u*)(PROJ0 + (size_t)m * NPROJ0 + C0_Z + 8 * lane); v4u w0 = p[0], w1 = p[64];
#pragma unroll
        for (int i = 0; i < 4; ++i) { w0[i] = pk2(__uint_as_float(w0[i] << 16) * r, __uint_as_float(w0[i] & 0xffff0000u) * r); w1[i] = pk2(__uint_as_float(w1[i] << 16) * r, __uint_as_float(w1[i] & 0xffff0000u) * r); }
        p[0] = w0; p[64] = w1;
    }
}

__device__ __forceinline__ float quad_max(float v) {
    auto a = __builtin_amdgcn_permlane16_swap(__float_as_uint(v), __float_as_uint(v), false, false); v = fmaxf(__uint_as_float(a[0]), __uint_as_float(a[1]));
    auto b = __builtin_amdgcn_permlane32_swap(__float_as_uint(v), __float_as_uint(v), false, false); return fmaxf(__uint_as_float(b[0]), __uint_as_float(b[1]));
}
__device__ __forceinline__ float quad_sum(float v) {
    auto a = __builtin_amdgcn_permlane16_swap(__float_as_uint(v), __float_as_uint(v), false, false); v = __uint_as_float(a[0]) + __uint_as_float(a[1]);
    auto b = __builtin_amdgcn_permlane32_swap(__float_as_uint(v), __float_as_uint(v), false, false); return __uint_as_float(b[0]) + __uint_as_float(b[1]);
}
__device__ __forceinline__ void glds16_asm(const void* gsrc, unsigned lds_dst) { unsigned keep;
    asm volatile("s_mov_b32 %0, m0\n\ts_mov_b32 m0, %2\n\ts_nop 0\n\tglobal_load_lds_dwordx4 %1, off\n\ts_mov_b32 m0, %0" : "=&s"(keep) : "v"(gsrc), "s"(lds_dst) : "memory"); }
#ifndef DA_NOFAST
#define DA_NOFAST 0
#endif
#ifndef DA_SGB
#define DA_SGB true
#endif
#ifndef DA_PAR
#define DA_PAR 0
#endif
constexpr int DB_K = 0, DB_V = 65536, DB_TSZ = 16384, DB_BT = 147456, DB_XCH = 0;
__device__ __forceinline__ bf16x8 lds_frag_tr2(ldsp p0, ldsp p1) {
    const v4i16_t lo = __builtin_amdgcn_ds_read_tr16_b64_v4i16((LAS v4i16_t*)p0);
    const v4i16_t hi = __builtin_amdgcn_ds_read_tr16_b64_v4i16((LAS v4i16_t*)p1);
    return (bf16x8){lo[0], lo[1], lo[2], lo[3], hi[0], hi[1], hi[2], hi[3]};
}
#define DB_BAR() do { __builtin_amdgcn_sched_barrier(0); asm volatile("s_waitcnt lgkmcnt(0)" ::: "memory"); __builtin_amdgcn_s_barrier(); asm volatile("" ::: "memory"); __builtin_amdgcn_sched_barrier(0); } while (0)
constexpr size_t WS_KMAX = 32 * 1024;
__device__ __forceinline__ void kmax_rows(const bf16* PROJ0, unsigned* KMAX, int gw, int NGW, int lane) {
#pragma unroll 1
    for (int b = 0; b < BATCH; ++b) {
        float mx = 0.f; int m = b * SEQ + (gw % NGW); while (m < b * SEQ) m += NGW;
        for (; m < (b + 1) * SEQ; m += NGW) {
            const v4u* p = (const v4u*)(PROJ0 + (size_t)m * NPROJ0 + C0_K + 16 * lane); const v4u w0 = p[0], w1 = p[1]; float ss = 0.f;
#pragma unroll
            for (int i = 0; i < 4; ++i) { const float a0 = __uint_as_float(w0[i] << 16), a1 = __uint_as_float(w0[i] & 0xffff0000u), b0 = __uint_as_float(w1[i] << 16), b1 = __uint_as_float(w1[i] & 0xffff0000u);
                ss += (a0 * a0 + a1 * a1) + (b0 * b0 + b1 * b1); }
            ss += __shfl_xor(ss, 1); ss += __shfl_xor(ss, 2); mx = fmaxf(mx, ss);
        }
        if ((lane & 3) == 0) atomicMax(KMAX + b * 16 + (lane >> 2), __float_as_uint(mx));
    }
}
template <int PVAR> __device__ __forceinline__ void dattn5_unit(ldsp lds, const bf16* PROJ0, bf16* OUT  , int opitch, const float* rel_bias, const float* diff_norm, const unsigned* KMAX, float lam,
                                                                int b, int h, int qb, int tid, int lane, int wave, const float* SSQ  ) {
    asm volatile("" : "+v"(tid), "+v"(lane));
    const int fr = lane & 15, fq = lane >> 4, trq = (lane & 15) >> 2, trp = lane & 3;
    const int m = wave >> 2, rg = wave & 3;
    const size_t rowbase = (size_t)b * SEQ; const int q0 = qb * 128, row0 = q0 + 32 * rg;
    const int nt = 2 * qb + 2;
    const bf16* kvb = PROJ0 + rowbase * NPROJ0 + h * 128;
    const bf16* ksrc[2]; const bf16* vsrc[2];
#pragma unroll
    for (int i = 0; i < 2; ++i) { const int key = 4 * (wave + 8 * i) + (lane >> 4), slot = lane & 15;
        ksrc[i] = kvb + (size_t)key * NPROJ0 + C0_K + ((slot ^ (key & 15)) * 8); vsrc[i] = kvb + (size_t)key * NPROJ0 + C0_V + ((slot ^ ((key & 7) << 1)) * 8); }
    int kw = 0, vw = 0;
    const unsigned lds0 = (unsigned)(size_t)lds;
#define DB_DMAK(t) do { _Pragma("unroll") for (int i_ = 0; i_ < 2; ++i_) \
        glds16_asm(ksrc[i_] + (size_t)(64 * (t)) * NPROJ0, (unsigned)__builtin_amdgcn_readfirstlane((int)(lds0 + DB_K + kw * DB_TSZ + (wave + 8 * i_) * 1024))); \
        kw = (kw + 1) & 3; } while (0)
#define DB_DMAV(t) do { _Pragma("unroll") for (int i_ = 0; i_ < 2; ++i_) \
        glds16_asm(vsrc[i_] + (size_t)(64 * (t)) * NPROJ0, (unsigned)__builtin_amdgcn_readfirstlane((int)(lds0 + DB_V + vw * DB_TSZ + (wave + 8 * i_) * 1024))); \
        vw = (vw == 4) ? 0 : vw + 1; } while (0)
    DB_DMAK(0); DB_DMAV(0); DB_DMAK(1); DB_DMAV(1); if (nt > 2) { DB_DMAK(2); DB_DMAV(2); } if (nt > 3) DB_DMAK(3);
    const float SC = 0.125f * LOG2E, c31 = rel_bias[31 * 8 + h] * LOG2E;
    bf16x8 qf[2][2]; float qss[2] = {0.f, 0.f};
#pragma unroll
    for (int rt = 0; rt < 2; ++rt)
#pragma unroll
        for (int ks = 0; ks < 2; ++ks) { const v4u raw = *(const v4u*)(PROJ0 + (rowbase + row0 + 16 * rt + fr) * NPROJ0 + C0_Q + h * 128 + m * 64 + ks * 32 + fq * 8); v4u sc;
#pragma unroll
            for (int i = 0; i < 4; ++i) { sc[i] = pk2(__uint_as_float(raw[i] << 16) * SC, __uint_as_float(raw[i] & 0xffff0000u) * SC);
                const float r0 = __uint_as_float(sc[i] << 16), r1 = __uint_as_float(sc[i] & 0xffff0000u); qss[rt] += r0 * r0 + r1 * r1; }
            qf[rt][ks] = __builtin_bit_cast(bf16x8, sc); }
    LAS float* BT = (LAS float*)(lds + DB_BT);
    if (tid < 128) BT[tid] = (rel_bias[t5_bucket(tid) * 8 + h] - rel_bias[31 * 8 + h]) * LOG2E;
    float bmax = rel_bias[h];
#pragma unroll 1
    for (int k = 1; k < 32; ++k) bmax = fmaxf(bmax, rel_bias[k * 8 + h]);
    const float kmx = sqrtf(__uint_as_float(KMAX[(b * 8 + h) * 2 + m]));
    f32x4 cmv[2];
#pragma unroll
    for (int rt = 0; rt < 2; ++rt) { const float c = c31 - (sqrtf(quad_sum(qss[rt])) * kmx * 1.001f + bmax * LOG2E + 0.01f); cmv[rt] = (f32x4){c, c, c, c}; }
    f32x4 o[2][9], s[2][4], sn[2][4]; v4u pk[2][2];
#pragma unroll
    for (int rt = 0; rt < 2; ++rt) {
#pragma unroll
        for (int e = 0; e < 9; ++e) o[rt][e] = (f32x4){0.f, 0.f, 0.f, 0.f};
#pragma unroll
        for (int k2 = 0; k2 < 2; ++k2) pk[rt][k2] = (v4u){0u, 0u, 0u, 0u}; }
    const bf16x8 ones = {0x3F80, 0x3F80, 0x3F80, 0x3F80, 0x3F80, 0x3F80, 0x3F80, 0x3F80};
    const int vswz = ((4 * (fq & 1) + trq) << 1);
    const int vlane = (4 * fq + trq) * 256 + trp * 8;
    int vco[8], kx[2];
#pragma unroll
    for (int e = 0; e < 8; ++e) vco[e] = vlane + (((2 * e) ^ vswz) * 16);
#pragma unroll
    for (int ks = 0; ks < 2; ++ks) kx[ks] = fr * 256 + (((m * 8 + ks * 4 + fq) ^ fr) * 16);
    asm volatile("s_waitcnt vmcnt(0)" ::: "memory");
    DB_BAR();
    int kr = 0, vr = 0;
#define DA_SMAT(DST) do { const ldsp kbuf_ = lds + DB_K + kr * DB_TSZ; kr = (kr + 1) & 3; \
        _Pragma("unroll") for (int n_ = 0; n_ < 4; ++n_) { \
            const bf16x8 k0_ = lds_frag(kbuf_ + kx[0] + n_ * 4096), k1_ = lds_frag(kbuf_ + kx[1] + n_ * 4096); \
            _Pragma("unroll") for (int rt_ = 0; rt_ < 2; ++rt_) { DST[rt_][n_] = __builtin_amdgcn_mfma_f32_16x16x32_bf16(k0_, qf[rt_][0], cmv[rt_], 0, 0, 0); MFMA16(DST[rt_][n_], qf[rt_][1], k1_); } } } while (0)
    DA_SMAT(s);
#define DA_BODY(T_, FAR_, PV_, SN_, SA, SB) do { \
        const bool dmak_ = ((T_) + 4 < nt) && !(PVAR & 1), dmav_ = ((T_) + 3 < nt) && !(PVAR & 1); \
        if (dmak_) DB_DMAK((T_) + 4); \
        if (dmav_) DB_DMAV((T_) + 3); \
        if ((SN_) && !(PVAR & 4)) DA_SMAT(SB); \
        if ((PV_) && !(PVAR & 4)) { \
            const ldsp vb_ = lds + DB_V + vr * DB_TSZ; vr = (vr == 4) ? 0 : vr + 1; \
            _Pragma("unroll") for (int k2 = 0; k2 < 2; ++k2) { \
                _Pragma("unroll") for (int e = 0; e < 8; ++e) { const bf16x8 vf = lds_frag_tr2(vb_ + vco[e] + (32 * k2) * 256, vb_ + vco[e] + (32 * k2 + 16) * 256); \
                    MFMA16(o[0][e], __builtin_bit_cast(bf16x8, pk[0][k2]), vf); MFMA16(o[1][e], __builtin_bit_cast(bf16x8, pk[1][k2]), vf); } \
                MFMA16(o[0][8], __builtin_bit_cast(bf16x8, pk[0][k2]), ones); MFMA16(o[1][8], __builtin_bit_cast(bf16x8, pk[1][k2]), ones); } \
        } \
        if (!(PVAR & 2)) { \
            const int k0 = 64 * (T_); \
            _Pragma("unroll") for (int rt = 0; rt < 2; ++rt) { \
                if (FAR_) { \
                    _Pragma("unroll") for (int n = 0; n < 4; ++n) \
                        _Pragma("unroll") for (int i = 0; i < 4; ++i) SA[rt][n][i] = __builtin_amdgcn_exp2f(SA[rt][n][i]); \
                } else { \
                    const int row = row0 + 16 * rt + fr; \
                    _Pragma("unroll") for (int n = 0; n < 4; ++n) \
                        _Pragma("unroll") for (int i = 0; i < 4; ++i) { const int dist = row - (k0 + 16 * n + 4 * fq + i); const int di = min(max(dist, 0), 127); const float bb = BT[di]; \
                            const float pen = dist < 0 ? -INFINITY : 0.f; SA[rt][n][i] = __builtin_amdgcn_exp2f((SA[rt][n][i] + bb) + pen); } \
                } \
            } \
        } \
        _Pragma("unroll") for (int rt = 0; rt < 2; ++rt) \
            _Pragma("unroll") for (int k2 = 0; k2 < 2; ++k2) { pk[rt][k2].x = pk2(SA[rt][2 * k2][0], SA[rt][2 * k2][1]); pk[rt][k2].y = pk2(SA[rt][2 * k2][2], SA[rt][2 * k2][3]); \
                pk[rt][k2].z = pk2(SA[rt][2 * k2 + 1][0], SA[rt][2 * k2 + 1][1]); pk[rt][k2].w = pk2(SA[rt][2 * k2 + 1][2], SA[rt][2 * k2 + 1][3]); } \
        if (dmak_) asm volatile("s_waitcnt vmcnt(10)" ::: "memory"); else asm volatile("s_waitcnt vmcnt(0)" ::: "memory"); \
        asm volatile("s_waitcnt lgkmcnt(0)" ::: "memory"); __builtin_amdgcn_s_barrier(); asm volatile("" ::: "memory"); \
    } while (0)
#define DA_FAST(T_, SA, SB) do { \
        if (!(PVAR & 1)) { DB_DMAK((T_) + 4); DB_DMAV((T_) + 3); } \
        const ldsp vb_ = lds + DB_V + vr * DB_TSZ; vr = (vr == 4) ? 0 : vr + 1; \
        const ldsp kb_ = lds + DB_K + kr * DB_TSZ; kr = (kr + 1) & 3; \
        bf16x8 vfr[3], kfr[4]; \
        vfr[0] = lds_frag_tr2(vb_ + vco[0], vb_ + vco[0] + 16 * 256); vfr[1] = lds_frag_tr2(vb_ + vco[1], vb_ + vco[1] + 16 * 256); \
        __builtin_amdgcn_sched_barrier(0); \
        _Pragma("unroll") for (int g = 0; g < 52; ++g) { \
            if (g < 32) { const int f = g >> 1, rt = g & 1, k2 = f >> 3, e = f & 7; MFMA16(o[rt][e], __builtin_bit_cast(bf16x8, pk[rt][k2]), vfr[f % 3]); } \
            else if (g < 36) { const int jj = g - 32, rt = jj & 1, k2 = jj >> 1; MFMA16(o[rt][8], __builtin_bit_cast(bf16x8, pk[rt][k2]), ones); } \
            else { const int jj = g - 36, n = jj >> 2, ks = (jj >> 1) & 1, rt = jj & 1; \
                if (ks == 0) SB[rt][n] = __builtin_amdgcn_mfma_f32_16x16x32_bf16(kfr[(n * 2 + ks) & 3], qf[rt][ks], cmv[rt], 0, 0, 0); \
                else MFMA16(SB[rt][n], qf[rt][ks], kfr[(n * 2 + ks) & 3]); } \
            if (g >= 2 && g < 34) { const int jj = g - 2, rt = jj >> 4, n = (jj >> 2) & 3, i = jj & 3; SA[rt][n][i] = __builtin_amdgcn_exp2f(SA[rt][n][i]); } \
            if (g >= 36) { const int q_ = g - 36, rt = q_ >> 3, k2 = (q_ >> 2) & 1, w = q_ & 3; pk[rt][k2][w] = pk2(SA[rt][2 * k2 + (w >> 1)][2 * (w & 1)], SA[rt][2 * k2 + (w >> 1)][2 * (w & 1) + 1]); } \
            if (g < 32 && !(g & 1) && (g >> 1) + 2 < 16) { const int f = (g >> 1) + 2, k2 = f >> 3, e = f & 7; vfr[f % 3] = lds_frag_tr2(vb_ + vco[e] + (32 * k2) * 256, vb_ + vco[e] + (32 * k2 + 16) * 256); } \
            if (g >= 30 && g < 46 && !(g & 1)) { const int c_ = (g - 30) >> 1, n = c_ >> 1, ks = c_ & 1; kfr[c_ & 3] = lds_frag(kb_ + kx[ks] + n * 4096); } \
            __builtin_amdgcn_sched_barrier(0); \
        } \
        if (!(PVAR & 1)) asm volatile("s_waitcnt vmcnt(10)" ::: "memory"); \
        asm volatile("s_waitcnt lgkmcnt(0)" ::: "memory"); __builtin_amdgcn_s_barrier(); asm volatile("" ::: "memory"); \
    } while (0)
    int t = 0;
#define DA_COPY() do { _Pragma("unroll") for (int rt = 0; rt < 2; ++rt) _Pragma("unroll") for (int n = 0; n < 4; ++n) s[rt][n] = sn[rt][n]; } while (0)
    if (nt >= 6) {
        DA_BODY(0, true, false, true, s, sn); DA_COPY();
        for (t = 1; t + 1 <= nt - 5; t += 2) { DA_FAST(t, s, sn); DA_FAST(t + 1, sn, s); }
        if (t <= nt - 5) { DA_FAST(t, s, sn); DA_COPY(); ++t; }
    }
    for (; t < nt; ++t) { const bool far = (q0 - 64 * t - 63) >= 113; DA_BODY(t, far, t > 0, t + 1 < nt, s, sn); DA_COPY(); }
#undef DA_COPY
#undef DA_BODY
#undef DA_FAST
    if (!(PVAR & 4)) {
        const ldsp vb_ = lds + DB_V + vr * DB_TSZ;
#pragma unroll
        for (int k2 = 0; k2 < 2; ++k2) {
#pragma unroll
            for (int e = 0; e < 8; ++e) { const bf16x8 vf = lds_frag_tr2(vb_ + vco[e] + (32 * k2) * 256, vb_ + vco[e] + (32 * k2 + 16) * 256);
                MFMA16(o[0][e], __builtin_bit_cast(bf16x8, pk[0][k2]), vf); MFMA16(o[1][e], __builtin_bit_cast(bf16x8, pk[1][k2]), vf); }
            MFMA16(o[0][8], __builtin_bit_cast(bf16x8, pk[0][k2]), ones); MFMA16(o[1][8], __builtin_bit_cast(bf16x8, pk[1][k2]), ones); }
    }
    asm volatile("s_waitcnt lgkmcnt(0)" ::: "memory"); __builtin_amdgcn_s_barrier(); asm volatile("" ::: "memory");
#undef DB_DMAK
#undef DB_DMAV
#undef DA_SMAT
    float inv[2];
#pragma unroll
    for (int rt = 0; rt < 2; ++rt) inv[rt] = 1.0f / o[rt][8][0];
    LAS float* XCH = (LAS float*)(lds + DB_XCH) + rg * (32 * 132);
    if (m == 1) {
#pragma unroll
        for (int rt = 0; rt < 2; ++rt) { const float f = lam * inv[rt];
#pragma unroll
            for (int e = 0; e < 8; ++e) *(LAS f32x4*)(XCH + (16 * rt + fr) * 132 + 16 * e + 4 * fq) = o[rt][e] * f; }
    }
    __syncthreads();
    if (m == 0) {
        f32x4 dnw[8];
#pragma unroll
        for (int e = 0; e < 8; ++e) dnw[e] = *(const f32x4*)(diff_norm + 16 * e + 4 * fq);
        f32x4 sq[2] = {(f32x4){0.f, 0.f, 0.f, 0.f}, (f32x4){0.f, 0.f, 0.f, 0.f}};
        if (SSQ) {
#pragma unroll
            for (int rt = 0; rt < 2; ++rt) sq[rt] = *(const f32x4*)(SSQ + (size_t)(rowbase + row0 + 16 * rt + fr) * 4); }
#pragma unroll
        for (int rt = 0; rt < 2; ++rt) { float ssq = 0.f;
#pragma unroll
            for (int e = 0; e < 8; ++e) { const f32x4 x2 = *(const LAS f32x4*)(XCH + (16 * rt + fr) * 132 + 16 * e + 4 * fq); const f32x4 v = o[rt][e] * inv[rt] - x2; o[rt][e] = v;
                ssq += (v[0] * v[0] + v[1] * v[1]) + (v[2] * v[2] + v[3] * v[3]); }
            ssq = quad_sum(ssq);
            float rs = 0.8f / sqrtf(ssq * (1.f / 128.f) + EPS);
            if (SSQ) rs *= sqrtf(((sq[rt][0] + sq[rt][1]) + (sq[rt][2] + sq[rt][3])) * (1.f / 1024.f) + EPS);
            bf16* orow = OUT + (rowbase + row0 + 16 * rt + fr) * opitch + h * 128;
#pragma unroll
            for (int e = 0; e < 8; ++e) { const f32x4 dn = dnw[e]; v2u w;
                w.x = pk2(o[rt][e][0] * rs * dn[0], o[rt][e][1] * rs * dn[1]); w.y = pk2(o[rt][e][2] * rs * dn[2], o[rt][e][3] * rs * dn[3]);
                *(v2u*)(orow + 16 * e + 4 * fq) = w; } }
    }
    __syncthreads();
}

constexpr int SW_KS = 0, SW_VS = 36864, SW_BT = 73728;
__device__ __forceinline__ void swa_unit(ldsp lds, const bf16* PROJ1, bf16* OUT  , int opitch, const float* rel_bias, const float* sinks, int b, int blk, int g, int tid, int lane, int wave) {
    asm volatile("" : "+v"(tid), "+v"(lane));
    const int fr = lane & 15, fq = lane >> 4, trq = (lane & 15) >> 2, trp = lane & 3;
    const size_t rowbase = (size_t)b * SEQ; const int qi = 16 * wave + fr;
    const bf16* prow = PROJ1 + (rowbase + blk * 128 + qi) * NPROJ1; bf16* orow = OUT + (rowbase + blk * 128 + qi) * opitch;
    bf16x8 qn[2];
#pragma unroll
    for (int ks = 0; ks < 2; ++ks) qn[ks] = *(const bf16x8*)(prow + C1_SQ + (4 * g) * 64 + ks * 32 + fq * 8);
    LAS float* BT = (LAS float*)(lds + SW_BT);
    { const int r = tid >> 7, d = tid & 127; BT[tid] = rel_bias[t5_bucket(d) * 8 + 4 * g + r] * LOG2E; }
#pragma unroll
    for (int i = 0; i < 4; ++i) { const int idx = tid + 512 * i, key = idx >> 3, ch = idx & 7; const int kp = blk * 128 - 128 + key;
        v4u kv = {0u, 0u, 0u, 0u}, vv = kv;
        if (kp >= 0) { const bf16* p = PROJ1 + (rowbase + kp) * NPROJ1 + g * 64 + ch * 8; kv = *(const v4u*)(p + C1_SK); vv = *(const v4u*)(p + C1_SV); }
        *(LAS v4u*)(lds + SW_KS + key * 144 + ch * 16) = kv; *(LAS v4u*)(lds + SW_VS + key * 144 + ch * 16) = vv; }
    __syncthreads();
    const float SC = 0.125f * LOG2E;
#pragma unroll 1
    for (int r = 0; r < 4; ++r) {
        const float skr = sinks[4 * g + r] * LOG2E;
        bf16x8 qc[2] = {qn[0], qn[1]};
        if (r < 3) {
#pragma unroll
            for (int ks = 0; ks < 2; ++ks) qn[ks] = *(const bf16x8*)(prow + C1_SQ + (4 * g + r + 1) * 64 + ks * 32 + fq * 8); }
        f32x4 s[10];
#pragma unroll
        for (int nn = 0; nn < 9; ++nn) { const int n = wave + nn; bf16x8 kf[2];
#pragma unroll
            for (int ks = 0; ks < 2; ++ks) kf[ks] = lds_frag(lds + SW_KS + (16 * n + fr) * 144 + (ks * 32 + fq * 8) * 2);
            s[nn] = (f32x4){0.f, 0.f, 0.f, 0.f}; MFMA16(s[nn], qc[0], kf[0]); MFMA16(s[nn], qc[1], kf[1]); }
        s[9] = (f32x4){0.f, 0.f, 0.f, 0.f};
        float mx = skr;
#pragma unroll
        for (int nn = 0; nn < 9; ++nn)
#pragma unroll
            for (int i = 0; i < 4; ++i) { const int j = 16 * (wave + nn) + 4 * fq + i, dist = qi + 128 - j; const bool valid = (dist >= 0) && (dist < 128) && (blk * 128 - 128 + j >= 0);
                const float bb = BT[r * 128 + min(max(dist, 0), 127)]; const float pen = valid ? 0.f : -INFINITY; const float v = (s[nn][i] * SC + bb) + pen; s[nn][i] = v; mx = fmaxf(mx, v); }
        mx = quad_max(mx);
        float psum = 0.f;
#pragma unroll
        for (int nn = 0; nn < 9; ++nn)
#pragma unroll
            for (int i = 0; i < 4; ++i) { const float p = __builtin_amdgcn_exp2f(s[nn][i] - mx); s[nn][i] = p; psum += p; }
        const float il = 1.0f / (quad_sum(psum) + __builtin_amdgcn_exp2f(skr - mx));
        f32x4 o[4];
#pragma unroll
        for (int e = 0; e < 4; ++e) o[e] = (f32x4){0.f, 0.f, 0.f, 0.f};
#pragma unroll
        for (int k2 = 0; k2 < 5; ++k2) { v4u pkv; pkv.x = pk2(s[2 * k2][0] * il, s[2 * k2][1] * il); pkv.y = pk2(s[2 * k2][2] * il, s[2 * k2][3] * il);
            pkv.z = pk2(s[2 * k2 + 1][0] * il, s[2 * k2 + 1][1] * il); pkv.w = pk2(s[2 * k2 + 1][2] * il, s[2 * k2 + 1][3] * il);
            const int r0 = 16 * (wave + 2 * k2) + 4 * fq + trq, r1 = min(r0 + 16, 255);
#pragma unroll
            for (int e = 0; e < 4; ++e) { const bf16x8 vf = lds_frag_tr2(lds + SW_VS + r0 * 144 + (16 * e + 4 * trp) * 2, lds + SW_VS + r1 * 144 + (16 * e + 4 * trp) * 2);
                MFMA16(o[e], __builtin_bit_cast(bf16x8, pkv), vf); } }
#pragma unroll
        for (int e = 0; e < 4; ++e) { v2u w; w.x = pk2(o[e][0], o[e][1]); w.y = pk2(o[e][2], o[e][3]); *(v2u*)(orow + (4 * g + r) * 64 + 16 * e + 4 * fq) = w; }
    }
    __syncthreads();
}

__device__ __forceinline__ float ret_log2_gamma(int h) { return log2f(1.0f - exp2f(-5.0f - (float)h)); }
__device__ __forceinline__ void rope_row_store(const bf16* src  , const float* COS, const float* SIN, int pos, int q4, float scale, ldsp dst) {
    v4u lo[2], hi[2];
#pragma unroll
    for (int i = 0; i < 2; ++i) { lo[i] = *(const v4u*)(src + 16 * q4 + 8 * i); hi[i] = *(const v4u*)(src + 64 + 16 * q4 + 8 * i); }
    const float* cp = COS + (size_t)pos * 64 + 16 * q4; const float* sp = SIN + (size_t)pos * 64 + 16 * q4;
#pragma unroll
    for (int i = 0; i < 2; ++i) { v4u ol, oh;
#pragma unroll
        for (int j = 0; j < 4; ++j) { const f32x4 cc = *(const f32x4*)(cp + 8 * i + 4 * (j >> 1)), ss = *(const f32x4*)(sp + 8 * i + 4 * (j >> 1));
            const float c0 = cc[2 * (j & 1)], c1 = cc[2 * (j & 1) + 1], s0 = ss[2 * (j & 1)], s1 = ss[2 * (j & 1) + 1];
            const float a0 = __uint_as_float(lo[i][j] << 16), a1 = __uint_as_float(lo[i][j] & 0xffff0000u), b0 = __uint_as_float(hi[i][j] << 16), b1 = __uint_as_float(hi[i][j] & 0xffff0000u);
            ol[j] = pk2((a0 * c0 - b0 * s0) * scale, (a1 * c1 - b1 * s1) * scale); oh[j] = pk2((a0 * s0 + b0 * c0) * scale, (a1 * s1 + b1 * c1) * scale); }
        *(LAS v4u*)(dst + (16 * q4 + 8 * i) * 2) = ol; *(LAS v4u*)(dst + (64 + 16 * q4 + 8 * i) * 2) = oh; }
}
constexpr int RA_VS = 0, RA_KS = 67584;
__device__ __forceinline__ void retA_unit(ldsp lds, const bf16* PROJ1, const float* COS, const float* SIN, bf16* ST, int u, int tid, int lane, int wave) {
    asm volatile("" : "+v"(tid), "+v"(lane));
    const int h = u & 3, c = (u >> 2) & 63, b = u >> 8, t0 = b * SEQ + c * 128;
    const int fr = lane & 15, fq = lane >> 4, trq = (lane & 15) >> 2, trp = lane & 3;
    const float lg = ret_log2_gamma(h);
#pragma unroll
    for (int i = 0; i < 8; ++i) { const int idx = tid + 512 * i, rw = idx >> 5, ch = idx & 31;
        *(LAS v4u*)(lds + RA_VS + rw * 528 + ch * 16) = *(const v4u*)(PROJ1 + (size_t)(t0 + rw) * NPROJ1 + C1_RV + h * 256 + ch * 8); }
    { const int s = tid >> 2, q4 = tid & 3;
      rope_row_store(PROJ1 + (size_t)(t0 + s) * NPROJ1 + C1_RK + h * 128, COS, SIN, c * 128 + s, q4, 0.08838834764831845f * exp2f((float)(127 - s) * lg), lds + RA_KS + s * 272); }
    __syncthreads();
    f32x4 acc[2][8];
#pragma unroll
    for (int j = 0; j < 2; ++j)
#pragma unroll
        for (int n = 0; n < 8; ++n) acc[j][n] = (f32x4){0.f, 0.f, 0.f, 0.f};
    bf16x8 fa[2][2], fb[2][8];
#define RA_READ(ks_, buf_) do { _Pragma("unroll") for (int j = 0; j < 2; ++j) fa[buf_][j] = lds_frag_tr(lds + RA_VS + (32 * (ks_) + 8 * fq + trq) * 528 + ((2 * wave + j) * 16 + 4 * trp) * 2, 528); \
        _Pragma("unroll") for (int n = 0; n < 8; ++n) fb[buf_][n] = lds_frag_tr(lds + RA_KS + (32 * (ks_) + 8 * fq + trq) * 272 + (n * 16 + 4 * trp) * 2, 272); } while (0)
    RA_READ(0, 0);
#pragma unroll
    for (int ks = 0; ks < 4; ++ks) {
        if (ks < 3) RA_READ(ks + 1, (ks + 1) & 1);
        __builtin_amdgcn_sched_barrier(0);
#pragma unroll
        for (int n = 0; n < 8; ++n) { MFMA16(acc[0][n], fa[ks & 1][0], fb[ks & 1][n]); MFMA16(acc[1][n], fa[ks & 1][1], fb[ks & 1][n]); }
        __builtin_amdgcn_sched_barrier(0);
    }
#undef RA_READ
    bf16* so = ST + ((size_t)((b * 64 + c) * 4 + h) * 256) * 128;
#pragma unroll
    for (int j = 0; j < 2; ++j)
#pragma unroll
        for (int n = 0; n < 8; ++n) { v2u w; w.x = pk2(acc[j][n][0], acc[j][n][1]); w.y = pk2(acc[j][n][2], acc[j][n][3]);
            *(v2u*)(so + (size_t)((2 * wave + j) * 16 + fr) * 128 + n * 16 + 4 * fq) = w; }
    __syncthreads();
}
__device__ __forceinline__ void ret_scan(bf16* ST, int gtid, int gthreads) {
    for (int e = gtid; e < 131072; e += gthreads) {
        const int b = e >> 16, rem = e & 65535, h = rem >> 14, ed = rem & 16383;
        unsigned* p = (unsigned*)ST + ((size_t)(b * 64) * 4 + h) * 16384 + ed; const float dec = exp2f(128.0f * ret_log2_gamma(h));
        float c0 = 0.f, c1 = 0.f;
#pragma unroll 1
        for (int hf = 0; hf < 2; ++hf) {
            unsigned v[32]; unsigned* pb = p + (size_t)hf * 32 * 4 * 16384;
            { const unsigned* q = pb;
#pragma unroll
              for (int c = 0; c < 32; ++c) { v[c] = *q; q += 4 * 16384; asm volatile("" : "+v"(q)); } }
#pragma unroll
            for (int c = 0; c < 32; ++c) { const unsigned o = pk2(c0, c1); c0 = c0 * dec + __uint_as_float(v[c] << 16); c1 = c1 * dec + __uint_as_float(v[c] & 0xffff0000u); v[c] = o; }
            { unsigned* q = pb;
#pragma unroll
              for (int c = 0; c < 32; ++c) { *q = v[c]; q += 4 * 16384; asm volatile("" : "+v"(q)); } }
        }
    }
}
constexpr int RC_KS = 0, RC_VS = 34816, RC_SP = 102400;
template <int PV> __device__ __forceinline__ void retC_unit(ldsp lds, const bf16* PROJ1, bf16* OUT  , int opitch, const float* COS, const float* SIN, const bf16* ST, int u, int tid, int lane, int wave) {
    asm volatile("" : "+v"(tid), "+v"(lane));
    const int h = u & 3, c = (u >> 2) & 63, b = u >> 8, t0 = b * SEQ + c * 128;
    const int fr = lane & 15, fq = lane >> 4, trq = (lane & 15) >> 2, trp = lane & 3;
    const float lg = ret_log2_gamma(h);
    const int l = 16 * wave + fr; const bf16* prow = PROJ1 + (size_t)(t0 + l) * NPROJ1; bf16* orow = OUT + (size_t)(t0 + l) * opitch;
    if (!(PV & 1)) {
#pragma unroll
    for (int i = 0; i < 8; ++i) { const int idx = tid + 512 * i, rw = idx >> 5, ch = idx & 31;
        *(LAS v4u*)(lds + RC_VS + rw * 528 + ch * 16) = *(const v4u*)(PROJ1 + (size_t)(t0 + rw) * NPROJ1 + C1_RV + h * 256 + ch * 8); }
    }
    if (!(PV & 1)) { const int s = tid >> 2, q4 = tid & 3;
      rope_row_store(PROJ1 + (size_t)(t0 + s) * NPROJ1 + C1_RK + h * 128, COS, SIN, c * 128 + s, q4, 0.08838834764831845f, lds + RC_KS + s * 272); }
    bf16x8 qf[4], qx[4];
    { v4u raw[4];
#pragma unroll
      for (int ks = 0; ks < 4; ++ks) raw[ks] = *(const v4u*)(prow + C1_RQ + h * 128 + 32 * ks + 8 * fq);
      const float xi = exp2f((float)(l + 1) * lg);
#pragma unroll
      for (int k2 = 0; k2 < 2; ++k2) { const float* cp = COS + (size_t)(c * 128 + l) * 64 + 32 * k2 + 8 * fq; const float* sp = SIN + (size_t)(c * 128 + l) * 64 + 32 * k2 + 8 * fq;
          v4u o1, o2, x1, x2;
#pragma unroll
          for (int j = 0; j < 4; ++j) { const f32x4 cc = *(const f32x4*)(cp + 4 * (j >> 1)), ss = *(const f32x4*)(sp + 4 * (j >> 1));
              const float c0 = cc[2 * (j & 1)], c1 = cc[2 * (j & 1) + 1], s0 = ss[2 * (j & 1)], s1 = ss[2 * (j & 1) + 1];
              const float a0 = __uint_as_float(raw[k2][j] << 16), a1 = __uint_as_float(raw[k2][j] & 0xffff0000u), b0 = __uint_as_float(raw[k2 + 2][j] << 16), b1 = __uint_as_float(raw[k2 + 2][j] & 0xffff0000u);
              const float r10 = a0 * c0 - b0 * s0, r11 = a1 * c1 - b1 * s1, r20 = a0 * s0 + b0 * c0, r21 = a1 * s1 + b1 * c1;
              o1[j] = pk2(r10, r11); o2[j] = pk2(r20, r21); x1[j] = pk2(r10 * xi, r11 * xi); x2[j] = pk2(r20 * xi, r21 * xi); }
          qf[k2] = __builtin_bit_cast(bf16x8, o1); qf[k2 + 2] = __builtin_bit_cast(bf16x8, o2); qx[k2] = __builtin_bit_cast(bf16x8, x1); qx[k2 + 2] = __builtin_bit_cast(bf16x8, x2); } }
    __syncthreads();
    f32x4 sc[8];
#pragma unroll
    for (int n = 0; n < 8; ++n) { sc[n] = (f32x4){0.f, 0.f, 0.f, 0.f};
#pragma unroll
        for (int ks = 0; ks < 4; ++ks) { const bf16x8 kf = lds_frag(lds + RC_KS + (16 * n + fr) * 272 + 64 * ks + 16 * fq); MFMA16(sc[n], qf[ks], kf); } }
    __syncthreads();
#pragma unroll
    for (int n = 0; n < 8; ++n) { float mv[4];
#pragma unroll
        for (int i = 0; i < 4; ++i) { const int s = 16 * n + 4 * fq + i; mv[i] = (s <= l) ? sc[n][i] * __builtin_amdgcn_exp2f((float)(l - s) * lg) : 0.f; }
        v2u w; w.x = pk2(mv[0], mv[1]); w.y = pk2(mv[2], mv[3]); *(LAS v2u*)(lds + RC_KS + l * 272 + (16 * n + 4 * fq) * 2) = w; }
    f32x4 o[16];
#pragma unroll
    for (int e = 0; e < 16; ++e) o[e] = (f32x4){0.f, 0.f, 0.f, 0.f};
    v2u gts[16];
#pragma unroll
    for (int e = 0; e < 16; ++e) gts[e] = *(const v2u*)(prow + C1_RG + h * 256 + 16 * e + 4 * fq);
    const bf16* sp = ST + ((size_t)((b * 64 + c) * 4 + h) * 256) * 128;
    const int sprow = tid >> 2, spc = tid & 3;
    v4u spr[2];
#pragma unroll
    for (int i = 0; i < 2; ++i) spr[i] = *(const v4u*)(sp + (size_t)(sprow + 128 * i) * 128 + spc * 8);
#pragma unroll
    for (int ks = 0; ks < ((PV & 2) ? 0 : 4); ++ks) {
        const ldsp slot = lds + RC_SP + (ks & 1) * 20480;
#pragma unroll
        for (int i = 0; i < 2; ++i) *(LAS v4u*)(slot + (sprow + 128 * i) * 80 + spc * 16) = spr[i];
        if (ks < 3) {
#pragma unroll
            for (int i = 0; i < 2; ++i) spr[i] = *(const v4u*)(sp + (size_t)(sprow + 128 * i) * 128 + 32 * (ks + 1) + spc * 8); }
        __syncthreads();
        const bf16x8 mf = lds_frag(lds + RC_KS + l * 272 + 64 * ks + 16 * fq);
#pragma unroll
        for (int eh = 0; eh < 2; ++eh) { bf16x8 sf[8], vf[8];
#pragma unroll
            for (int e = 0; e < 8; ++e) { sf[e] = lds_frag(slot + (16 * (8 * eh + e) + fr) * 80 + 16 * fq);
                vf[e] = lds_frag_tr(lds + RC_VS + (32 * ks + 8 * fq + trq) * 528 + (16 * (8 * eh + e) + 4 * trp) * 2, 528); }
            __builtin_amdgcn_sched_barrier(0);
#pragma unroll
            for (int e = 0; e < 8; ++e) { MFMA16(o[8 * eh + e], qx[ks], sf[e]); MFMA16(o[8 * eh + e], mf, vf[e]); }
            __builtin_amdgcn_sched_barrier(0); }
    }
    float ssq = 0.f;
#pragma unroll
    for (int e = 0; e < 16; ++e) ssq += (o[e][0] * o[e][0] + o[e][1] * o[e][1]) + (o[e][2] * o[e][2] + o[e][3] * o[e][3]);
    ssq += __shfl_xor(ssq, 16); ssq += __shfl_xor(ssq, 32);
    const float rs = 1.0f / sqrtf(ssq * (1.f / 256.f) + EPS);
#pragma unroll
    for (int e = 0; e < 16; ++e) { const v2u gw_ = gts[e];
        const float g0 = __uint_as_float(gw_.x << 16), g1 = __uint_as_float(gw_.x & 0xffff0000u), g2 = __uint_as_float(gw_.y << 16), g3 = __uint_as_float(gw_.y & 0xffff0000u);
        v2u w; w.x = pk2(o[e][0] * rs * silu_f(g0), o[e][1] * rs * silu_f(g1)); w.y = pk2(o[e][2] * rs * silu_f(g2), o[e][3] * rs * silu_f(g3)); *(v2u*)(orow + h * 256 + 16 * e + 4 * fq) = w; }
    __syncthreads();
}

#ifndef PROBE_CV
#define PROBE_CV 0
#endif
#ifndef MK_PER_PHASE
#define MK_PER_PHASE 0
#endif
constexpr int N_PHASES = 21;
#ifndef PROBE_G
#define PROBE_G 0u
#endif
#ifndef PROBE_BAR
#define PROBE_BAR 0
#endif
#ifndef PROBE_VAR
#define PROBE_VAR 0
#endif
#ifndef PROBE_REP
#define PROBE_REP 0u
#endif
struct Args { const float* in[N_IN]; float* out; unsigned char* ws; int ph_lo, ph_hi, pad0, pad1; };
__global__ void __launch_bounds__(NTHR, 2) trunk_fwd(Args args) {
    extern __shared__ __attribute__((aligned(16))) unsigned char lds_raw[];
    const ldsp lds = (ldsp)lds_raw;
    volatile LAS unsigned* MISC = (volatile LAS unsigned*)(lds + MISC_OFF);
    const int tid = threadIdx.x, lane = tid & 63, wave = __builtin_amdgcn_readfirstlane(tid >> 6);
    const int G = gridDim.x; const int bx = blockIdx.x; const int vcu = (G % 8 == 0) ? (bx % 8) * (G / 8) + bx / 8 : bx;
    const int gw = vcu * NWAVES + wave, NGW = G * NWAVES, gtid = vcu * NTHR + tid, gthreads = G * NTHR;
    unsigned char* ws = args.ws;
    gu32* ctl = (gu32*)(ws + WS_CTL);
    for (int u = tid; u < 64; u += NTHR) MISC[u] = 0u;
    __syncthreads();
    XcdBarrier bar; bar.bar = (unsigned*)(ctl + CW_BAR); bar.x = 0; bar.st = nullptr;
    if (!MK_PER_PHASE) bar = xcd_barrier_post((unsigned*)(ctl + CW_BAR), MISC + 8);
    const int lo = args.ph_lo, hi = args.ph_hi;
#define IN(k) (lo <= (k) && (k) < hi)
#define SEAM(k) do { if (IN(k) && IN((k) + 1)) { xcd_barrier<true>(bar); if (PROBE_BAR == 1) xcd_barrier<true>(bar); if (PROBE_BAR == 2) xcd_barrier<false>(bar); } } while (0)
#define REPS(k) (((PROBE_REP >> (k)) & 1u) ? 2 : 1)
    float* MOD = (float*)(ws + WS_MOD); bf16* WDT = (bf16*)(ws + WS_WDT); float* CHDEC = (float*)(ws + WS_CHDEC); float* SSQ = (float*)(ws + WS_SSQ);
    bf16* WMIX = (bf16*)(ws + WS_WMIX); bf16* WOUT0 = (bf16*)(ws + WS_WOUT0); bf16* WOUT1 = (bf16*)(ws + WS_WOUT1);
    bf16* PROJ0 = (bf16*)(ws + WS_PROJ0); bf16* XB = (bf16*)(ws + WS_XN2); bf16* XN2 = (bf16*)args.out;     bf16* W1T = (bf16*)(ws + WS_WMLP); bf16* W2T = (bf16*)(ws + WS_WMLP + 8 * MiB);
    bf16* HB = (bf16*)(ws + WS_H); bf16* PROJ1 = (bf16*)(ws + WS_H); bf16* SB = (bf16*)(ws + WS_S); float* DT = (float*)(ws + WS_DT);
    unsigned* KMAX = (unsigned*)(ws + WS_KMAX);
    float* COS = (float*)(ws + WS_ROPE); float* SIN = COS + 8192 * 64;
    const bool fuse = (G == 256) && !PROBE_REP && !PROBE_G;
    float* XCH1 = (float*)(ws + WS_XCH); float* XCH2 = (float*)(ws + WS_XCH + MiB); unsigned* TMO = (unsigned*)(ctl + CW_BAR) + XB_TMO;
    const float* x_in = args.in[I_X]; const float* ng = args.in[I_NG]; float* X = args.out;

    if (IN(0)) for (int rep0 = 0; rep0 < REPS(0); ++rep0) {
        const Seg segs[4] = { {args.in[I_EWIN], 6160, 0, 1024, 1024, WMIX, 0}, {args.in[I_EWIN], 6160, 3088, 3072, 1024, WMIX, 1024}, {args.in[I_EWIN], 6160, 1024, 2048, 1024, WMIX, 4096},
                              {args.in[I_EWOUT], 1024, 0, 1024, 2048, WOUT0, 0} };
        convert_set<4>(segs, lds, gw, NGW, wave, lane);
        for (int i = gtid; i < 16384; i += gthreads) { const int h = i >> 10, k = i & 1023; WDT[i] = f2bf(args.in[I_EWIN][(size_t)k * 6160 + 3072 + h]); }
        for (int i = gtid; i < 8192 * 64; i += gthreads) { const int t = i >> 6, f = i & 63; const float inv = powf(10000.0f, -(float)f * (1.0f / 64.0f)); const float ang = (float)t * inv;
            const double a = (double)ang; const double n = rint(a * 0.15915494309189535); const float r = (float)(a - n * 6.283185307179586); COS[i] = __cosf(r); SIN[i] = __sinf(r); }
        __syncthreads();
        mod_phase(args.in[I_C], args.in[I_MODW], args.in[I_MODB], MOD, lds, tid, lane, wave);
    }
    SEAM(0);
    if (IN(1)) for (int rep1 = 0; rep1 < REPS(1); ++rep1) norm_rows<-1, 0, false, 0>(x_in, nullptr, nullptr, SB, MOD, ng, gw, NGW, lane);
    SEAM(1);
    if (IN(2)) {
        pg8::Gemm g{SB, WMIX, MTOK, NPROJ0, DM, DM}; pg8::StaticOrder S; S.init(MTOK, NPROJ0, G, bx);
        pg8::EpiBf16<0> E{PROJ0, NPROJ0, nullptr, 0, 0, 1.f};
        if ((PROBE_G >> 2) & 1u) { pg8::gemm_phase<pg8::EpiBf16<0>, pg8::StaticOrder, true, true>(lds, g, S, E); __syncthreads(); } pg8::gemm_phase<pg8::EpiBf16<0>, pg8::StaticOrder, true, true>(lds, g, S, E);
        dt_phase(SB, WDT, args.in[I_EDTB], DT, gw, NGW, lane);
    }
    SEAM(2);
    if (IN(3)) { kmax_rows(PROJ0, KMAX, gw, NGW, lane);
        for (int rep = 0; rep < REPS(3); ++rep) for (int u = vcu; u < 512; u += G) ssdA_unit(lds, PROJ0, DT, args.in[I_ECONVW], args.in[I_ECONVB], args.in[I_EALOG], SB, CHDEC, u, tid, lane, wave); }
    SEAM(3);
    if (IN(4)) ssd_scan(SB, CHDEC, gtid, gthreads);
    SEAM(4);
    if (IN(5)) { for (int rep = 0; rep < REPS(5); ++rep) for (int u = vcu; u < 512; u += G) { if (rep + 1 < REPS(5)) ssdC_unit<(PROBE_VAR < 32 ? PROBE_VAR : 0)>(lds, PROJ0, (bf16*)args.out, 1024, DT, args.in[I_ECONVW], args.in[I_ECONVB], args.in[I_EALOG], args.in[I_ED], args.in[I_ESSDN], SB, SSQ, u, tid, lane, wave); else ssdC_unit<0>(lds, PROJ0, PROJ0 + C0_Z, NPROJ0, DT, args.in[I_ECONVW], args.in[I_ECONVB], args.in[I_EALOG], args.in[I_ED], args.in[I_ESSDN], SB, SSQ, u, tid, lane, wave); } }
    SEAM(5);
    if (IN(6)) {
        if (!fuse) ssd_normalize_rows(PROJ0, SSQ, gw, NGW, lane);
        const float* lm = args.in[I_ELAM];
        const float lam = expf(wave_sum(lm[lane] * lm[64 + lane])) - expf(wave_sum(lm[128 + lane] * lm[192 + lane])) + 0.2f;
        __syncthreads();
        for (int rep = 0; rep < REPS(6); ++rep)
        for (int u = vcu; u < 1024; u += G) { const int v = u & 255, i = u >> 8, j = v & 15, bh = v >> 4; const int qb = i == 0 ? j : (i == 1 ? 63 - j : (i == 2 ? 16 + j : 47 - j));
            if (PROBE_VAR >= 16 && rep + 1 < REPS(6)) { }
            else if (rep + 1 < REPS(6)) dattn5_unit<PROBE_VAR < 16 ? PROBE_VAR : 0>(lds, PROJ0, (bf16*)args.out, 1024, args.in[I_RELB], args.in[I_EDIFFN], KMAX, lam, bh >> 3, bh & 7, qb, tid, lane, wave, nullptr);
            else dattn5_unit<0>(lds, PROJ0, PROJ0 + C0_Q, NPROJ0, args.in[I_RELB], args.in[I_EDIFFN], KMAX, lam, bh >> 3, bh & 7, qb, tid, lane, wave, fuse ? SSQ : nullptr); }
    }
    SEAM(6);
    if (IN(7)) {
        pg8::Gemm g{PROJ0, WOUT0, MTOK, DM, 2048, NPROJ0}; pg8::StaticOrder S; S.init(MTOK, DM, G, bx);
        if (fuse) { pg8::EpiNorm<0, 1, false, 1, true> EN{x_in, SB  , XN2, MOD, ng, {XCH1, (unsigned*)ctl + 0 * 512, TMO}, {XCH2, (unsigned*)ctl + 1 * 512, TMO}, EPS, SSQ};
            pg8::gemm_phase<pg8::EpiNorm<0, 1, false, 1, true>, pg8::StaticOrder, true, true>(lds, g, S, EN); } else {
        pg8::EpiBf16<0> E{SB, DM, nullptr, 0, 0, 1.f};
        if ((PROBE_G >> 7) & 1u) { pg8::gemm_phase<pg8::EpiBf16<0>, pg8::StaticOrder, true, true>(lds, g, S, E); __syncthreads(); } pg8::gemm_phase<pg8::EpiBf16<0>, pg8::StaticOrder, true, true>(lds, g, S, E); }
    }
    SEAM(7);
    if (IN(8)) {
        const Seg segs[2] = { {args.in[I_W1], 4096, 0, 4096, 1024, W1T, 0}, {args.in[I_W2], 1024, 0, 1024, 4096, W2T, 0} };
        convert_set<2>(segs, lds, gw, NGW, wave, lane); if (PROBE_CV) convert_set<2>(segs, lds, gw, NGW, wave, lane);
        if (!fuse) norm_rows<0, 1, false, 1>(x_in, SB, XB, XN2, MOD, ng, gw, NGW, lane);
    }
    SEAM(8);
    if (IN(9)) {
        pg8::Gemm g{XN2, W1T, MTOK, FF, DM, DM}; pg8::StaticOrder S; S.init(MTOK, FF, G, bx);
        pg8::EpiBf16<2> E{HB, FF, nullptr, 0, 0, 1.f};
        if ((PROBE_G >> 9) & 1u) { pg8::gemm_phase<pg8::EpiBf16<2>, pg8::StaticOrder, true, true>(lds, g, S, E); __syncthreads(); } pg8::gemm_phase<pg8::EpiBf16<2>, pg8::StaticOrder, true, true>(lds, g, S, E);
    }
    SEAM(9);
    if (IN(10)) {
        pg8::Gemm g{HB, W2T, MTOK, DM, FF, FF}; pg8::StaticOrder S; S.init(MTOK, DM, G, bx);
        if (fuse) { pg8::EpiNorm<1, 2, true, 1> EN{SB, XB, XN2, MOD, ng, {XCH1, (unsigned*)ctl + 2 * 512, TMO}, {XCH2, (unsigned*)ctl + 3 * 512, TMO}, EPS};
            pg8::gemm_phase<pg8::EpiNorm<1, 2, true, 1>, pg8::StaticOrder, true, true>(lds, g, S, EN); } else {
        pg8::EpiBf16<0> E{SB, DM, nullptr, 0, 0, 1.f};
        if ((PROBE_G >> 10) & 1u) { pg8::gemm_phase<pg8::EpiBf16<0>, pg8::StaticOrder, true, true>(lds, g, S, E); __syncthreads(); } pg8::gemm_phase<pg8::EpiBf16<0>, pg8::StaticOrder, true, true>(lds, g, S, E); }
    }
    SEAM(10);
    if (IN(11)) {
        const Seg segs[4] = { {args.in[I_OWIN], 3840, 2048, 1536, 1024, WMIX, 0}, {args.in[I_OWIN], 3840, 0, 2048, 1024, WMIX, 1536}, {args.in[I_OWIN], 3840, 3584, 256, 1024, WMIX, 3584},
                              {args.in[I_OWOUT], 1024, 0, 1024, 1536, WOUT1, 0} };
        convert_set<4>(segs, lds, gw, NGW, wave, lane); if (PROBE_CV) convert_set<4>(segs, lds, gw, NGW, wave, lane);
        if (!fuse) norm_rows<1, 2, true, 1>(XB, SB, XB, XN2, MOD, ng, gw, NGW, lane);
    }
    SEAM(11);
    if (IN(12)) {
        pg8::Gemm g{XN2, WMIX, MTOK, NPROJ1, DM, DM}; pg8::StaticOrder S; S.init(MTOK, NPROJ1, G, bx);
        pg8::EpiBf16<0> E{PROJ1, NPROJ1, nullptr, 0, 0, 1.f};
        if ((PROBE_G >> 12) & 1u) { pg8::gemm_phase<pg8::EpiBf16<0>, pg8::StaticOrder, true, true>(lds, g, S, E); __syncthreads(); } pg8::gemm_phase<pg8::EpiBf16<0>, pg8::StaticOrder, true, true>(lds, g, S, E);
        }
    SEAM(12);
    if (IN(13)) {
        for (int rep = 0; rep < REPS(13); ++rep) {
        for (int u = vcu; u < 512; u += G) retA_unit(lds, PROJ1, COS, SIN, SB, u, tid, lane, wave);
        for (int u = vcu; u < 256; u += G) swa_unit(lds, PROJ1, (rep + 1 < REPS(13)) ? XN2 : PROJ1 + C1_SQ, (rep + 1 < REPS(13)) ? 1024 : NPROJ1, args.in[I_RELB], args.in[I_OSINK], u >> 7, (u >> 1) & 63, u & 1, tid, lane, wave); }
    }
    SEAM(13);
    if (IN(14)) ret_scan(SB, gtid, gthreads);
    SEAM(14);
    if (IN(15)) { for (int rep = 0; rep < REPS(15); ++rep) for (int u = vcu; u < 512; u += G) { if (rep + 1 < REPS(15)) retC_unit<(PROBE_VAR < 16 ? PROBE_VAR : 0)>(lds, PROJ1, XN2, 1024, COS, SIN, SB, u, tid, lane, wave); else retC_unit<0>(lds, PROJ1, PROJ1 + C1_RG, NPROJ1, COS, SIN, SB, u, tid, lane, wave); } }
    SEAM(15);
    if (IN(16)) {
        pg8::Gemm g{PROJ1, WOUT1, MTOK, DM, 1536, NPROJ1}; pg8::StaticOrder S; S.init(MTOK, DM, G, bx);
        if (fuse) { pg8::EpiNorm<2, 3, true, 1> EN{XB, XB, XN2, MOD, ng, {XCH1, (unsigned*)ctl + 4 * 512, TMO}, {XCH2, (unsigned*)ctl + 5 * 512, TMO}, EPS};
            pg8::gemm_phase<pg8::EpiNorm<2, 3, true, 1>, pg8::StaticOrder, true, true>(lds, g, S, EN); } else {
        pg8::EpiBf16<0> E{SB, DM, nullptr, 0, 0, 1.f};
        if ((PROBE_G >> 16) & 1u) { pg8::gemm_phase<pg8::EpiBf16<0>, pg8::StaticOrder, true, true>(lds, g, S, E); __syncthreads(); } pg8::gemm_phase<pg8::EpiBf16<0>, pg8::StaticOrder, true, true>(lds, g, S, E); }
    }
    SEAM(16);
    if (IN(17)) {
        const Seg segs[2] = { {args.in[I_W1] + (size_t)DM * FF, 4096, 0, 4096, 1024, W1T, 0}, {args.in[I_W2] + (size_t)DM * FF, 1024, 0, 1024, 4096, W2T, 0} };
        convert_set<2>(segs, lds, gw, NGW, wave, lane); if (PROBE_CV) convert_set<2>(segs, lds, gw, NGW, wave, lane);
        if (!fuse) norm_rows<2, 3, true, 1>(XB, SB, XB, XN2, MOD, ng, gw, NGW, lane);
    }
    SEAM(17);
    if (IN(18)) {
        pg8::Gemm g{XN2, W1T, MTOK, FF, DM, DM}; pg8::StaticOrder S; S.init(MTOK, FF, G, bx);
        pg8::EpiBf16<2> E{HB, FF, nullptr, 0, 0, 1.f};
        if ((PROBE_G >> 18) & 1u) { pg8::gemm_phase<pg8::EpiBf16<2>, pg8::StaticOrder, true, true>(lds, g, S, E); __syncthreads(); } pg8::gemm_phase<pg8::EpiBf16<2>, pg8::StaticOrder, true, true>(lds, g, S, E);
    }
    SEAM(18);
    if (IN(19)) {
        pg8::Gemm g{HB, W2T, MTOK, DM, FF, FF}; pg8::StaticOrder S; S.init(MTOK, DM, G, bx);
        if (fuse) { pg8::EpiNorm<3, -1, true, 2> EN{XB, X, nullptr, MOD, ng, {XCH1, (unsigned*)ctl + 6 * 512, TMO}, {XCH2, (unsigned*)ctl + 7 * 512, TMO}, EPS};
            pg8::gemm_phase<pg8::EpiNorm<3, -1, true, 2>, pg8::StaticOrder, true, true>(lds, g, S, EN); } else {
        pg8::EpiBf16<0> E{SB, DM, nullptr, 0, 0, 1.f};
        if ((PROBE_G >> 19) & 1u) { pg8::gemm_phase<pg8::EpiBf16<0>, pg8::StaticOrder, true, true>(lds, g, S, E); __syncthreads(); } pg8::gemm_phase<pg8::EpiBf16<0>, pg8::StaticOrder, true, true>(lds, g, S, E); }
    }
    if (!fuse) {
    SEAM(19);
    if (IN(20)) norm_rows<3, -1, true, 2>(XB, SB, X, nullptr, MOD, ng, gw, NGW, lane);
    }
#undef IN
#undef SEAM
}

extern "C" void kernel_launch(void* const* d_in, const int* in_sizes, int n_in, void* d_out, int out_size, void* d_ws, size_t ws_size, hipStream_t stream) {
    static int grid = 0;
    if (grid == 0) {
        if (n_in != N_IN || out_size != MTOK * DM || ws_size < WS_END) { fprintf(stderr, "kernel_launch: unexpected shapes (n_in %d, out %d, ws %zu); nothing launched\n", n_in, out_size, ws_size); grid = -1; return; }
        int dev = 0, cus = 0, per_cu = 0;
        if (hipGetDevice(&dev) != hipSuccess || hipDeviceGetAttribute(&cus, hipDeviceAttributeMultiprocessorCount, dev) != hipSuccess) { grid = -1; return; }
        if (hipFuncSetAttribute((const void*)trunk_fwd, hipFuncAttributeMaxDynamicSharedMemorySize, LDS_BYTES) != hipSuccess) { fprintf(stderr, "kernel_launch: hipFuncSetAttribute failed\n"); grid = -1; return; }
        if (hipOccupancyMaxActiveBlocksPerMultiprocessor(&per_cu, (const void*)trunk_fwd, NTHR, LDS_BYTES) != hipSuccess || per_cu < 1) { fprintf(stderr, "kernel_launch: occupancy query says %d blocks per CU\n", per_cu); (void)hipGetLastError(); grid = -1; return; }
        grid = cus;
    }
    if (grid < 0) return;
    (void)hipMemsetAsync((char*)d_ws + WS_CTL, 0, CTL_ZERO_BYTES, stream);
    Args a{};
    for (int i = 0; i < N_IN; ++i) a.in[i] = (const float*)d_in[i];
    a.out = (float*)d_out; a.ws = (unsigned char*)d_ws;
#if MK_PER_PHASE
    for (int p = 0; p < N_PHASES; ++p) { a.ph_lo = p; a.ph_hi = p + 1; hipLaunchKernelGGL(trunk_fwd, dim3(grid), dim3(NTHR), LDS_BYTES, stream, a); }
#else
    a.ph_lo = 0; a.ph_hi = N_PHASES;
    hipLaunchKernelGGL(trunk_fwd, dim3(grid), dim3(NTHR), LDS_BYTES, stream, a);
#endif
}
```

```cpp
#include <hip/hip_runtime.h>
#include <cstdio>
#include <cstdint>
#include <cmath>
namespace pg8 {
#define PG8_LAS __attribute__((address_space(3)))
typedef unsigned short bf16_t;
typedef short bf16x8 __attribute__((ext_vector_type(8)));
typedef float f32x4 __attribute__((ext_vector_type(4)));
typedef unsigned u32x4 __attribute__((ext_vector_type(4)));
constexpr int BM = 256, BK = 64, HALF = 128, HTB = HALF * BK * 2  , STAGE_BYTES = 8 * HTB, NXCD = 8, WGM = 4;

__host__ __device__ __forceinline__ int lds_byte(int r, int c) { const int st = (r >> 4) * 2 + (c >> 5), rr = r & 15, cc = c & 31, ob = rr * 64 + cc * 2; return st * 1024 + (ob ^ (((ob >> 9) & 1) << 5)); }
__host__ __device__ __forceinline__ void stage_rc(int b, int& R, int& C) { const int st = b / 1024, sb = b % 1024, swz = sb ^ (((sb >> 9) & 1) << 5); R = (st >> 1) * 16 + swz / 64; C = (st & 1) * 32 + (swz % 64) / 2; }
__host__ __device__ __forceinline__ int perm32(int rho) { const int n = rho >> 4, i = rho & 15; return 8 * (i >> 2) + 4 * n + (i & 3); }

struct Unit { int pm, pn; };
struct Gemm { const bf16_t* A; const bf16_t* Bt; int M, N, K, lda; };

struct StaticOrder {
    int nM, nN, nwg, G, c;
    __host__ __device__ void init(int M, int N, int G_, int c_) { nM = M / BM; nN = N / BM; nwg = nM * nN; G = G_; c = c_; }
    __host__ __device__ bool next(int i, Unit& u) const {
        const long L = (long)i * G + c; if (L >= nwg) return false;
        int wgid = (int)L; { const int q = nwg / NXCD, r = nwg % NXCD, xcd = wgid % NXCD, off = wgid / NXCD; wgid = (xcd < r ? xcd * (q + 1) : r * (q + 1) + (xcd - r) * q) + off; }
        const int nig = WGM * nN, gid = wgid / nig, fm = gid * WGM, gsz = (nM - fm) < WGM ? (nM - fm) : WGM;
        u.pm = fm + ((wgid % nig) % gsz); u.pn = (wgid % nig) / gsz; return true;
    }
    __device__ __forceinline__ void a_ready(const Unit&) const {}
    __device__ __forceinline__ void done(const Unit&) const {}
};

__device__ __forceinline__ unsigned cvt_pk_bf16(float lo, float hi) { unsigned r; asm volatile("v_cvt_pk_bf16_f32 %0, %1, %2" : "=v"(r) : "v"(lo), "v"(hi)); return r; }
typedef float f32x2 __attribute__((ext_vector_type(2)));
__device__ __forceinline__ f32x2 gelu_pk(f32x2 v) {
    const f32x2 av = __builtin_elementwise_abs(v), d = av * 0.2316418882f + 1.0f;
    f32x2 t; t.x = __builtin_amdgcn_rcpf(d.x); t.y = __builtin_amdgcn_rcpf(d.y);
    f32x2 q = t * 0.5307027145f + (-0.7265760135f); q = q * t + 0.7107068705f; q = q * t + (-0.142248368f); q = q * t + 0.127414796f; q = q * t;
    const f32x2 s = (v * v) * (-0.72134752044f);
    f32x2 e; e.x = __builtin_amdgcn_exp2f(s.x); e.y = __builtin_amdgcn_exp2f(s.y);
    const f32x2 m = v * (q * e), r = v - m;
    f32x2 o; o.x = v.x < 0.f ? m.x : r.x; o.y = v.y < 0.f ? m.y : r.y; return o;
}

template <int ACT  > struct EpiBf16 {
    static constexpr bool PERM = true, AFTER_DRAIN = false; static_assert(ACT == 0 || ACT == 1 || ACT == 2, "EpiBf16: ACT is 0 (none), 1 (gelu_pk) or 2 (squared relu)");
    bf16_t* O; int ldc; const float* bias; int split_cols; size_t split_stride; float scale0;
    __device__ __forceinline__ void operator()(const f32x4 (&acc)[2][2][4][2], const Unit& u, int wr, int wc, int fr, int fq) const {
        const int row0 = u.pm * BM + wr * 64 + fr; int colt = u.pn * BM; bf16_t* base = O;
        float sc = 1.f; if (split_cols) { const int t = colt / split_cols; base += (size_t)t * split_stride; colt -= t * split_cols; if (t == 0) sc = scale0; }
        const int col0 = colt + wc * 32 + 8 * fq, bcol0 = u.pn * BM + wc * 32 + 8 * fq;
        f32x4 bv[2][2];
#pragma unroll
        for (int bj = 0; bj < 2; ++bj)
#pragma unroll
            for (int n = 0; n < 2; ++n) bv[bj][n] = bias ? *(const f32x4*)(bias + bcol0 + bj * HALF + 4 * n) : (f32x4){0.f, 0.f, 0.f, 0.f};
#pragma unroll
        for (int ai = 0; ai < 2; ++ai)
#pragma unroll
            for (int m = 0; m < 4; ++m) { bf16_t* rowp = base + (size_t)(row0 + ai * HALF + m * 16) * ldc + col0;
#pragma unroll
                for (int bj = 0; bj < 2; ++bj) { f32x4 v0 = acc[ai][bj][m][0] + bv[bj][0], v1 = acc[ai][bj][m][1] + bv[bj][1];
                    if (ACT == 1) { f32x2 a = gelu_pk((f32x2){v0[0], v0[1]}), b = gelu_pk((f32x2){v0[2], v0[3]}), c = gelu_pk((f32x2){v1[0], v1[1]}), d = gelu_pk((f32x2){v1[2], v1[3]});
                        v0 = (f32x4){a.x, a.y, b.x, b.y}; v1 = (f32x4){c.x, c.y, d.x, d.y}; }
                    if (ACT == 2) { v0 = __builtin_elementwise_max(v0, (f32x4){0.f,0.f,0.f,0.f}); v1 = __builtin_elementwise_max(v1, (f32x4){0.f,0.f,0.f,0.f}); v0 = v0 * v0; v1 = v1 * v1; }
                    v0 = v0 * sc; v1 = v1 * sc; u32x4 w; w.x = cvt_pk_bf16(v0[0], v0[1]); w.y = cvt_pk_bf16(v0[2], v0[3]); w.z = cvt_pk_bf16(v1[0], v1[1]); w.w = cvt_pk_bf16(v1[2], v1[3]);
                    *(u32x4*)(rowp + bj * HALF) = w; } }
    }
};

struct RowExch {
    float* slots;
    unsigned* cnt;
    unsigned* tmo;
    __device__ __forceinline__ void publish(const float (&ss)[2][4], const Unit& u, int wr, int wc, int fr, int fq, PG8_LAS unsigned char* lds, int wid, int lane) const {
        PG8_LAS float* P = (PG8_LAS float*)lds;
#pragma unroll
        for (int ai = 0; ai < 2; ++ai)
#pragma unroll
            for (int m = 0; m < 4; ++m) { float s = ss[ai][m]; s += __shfl_xor(s, 16); s += __shfl_xor(s, 32); if (fq == 0) P[(ai * HALF + wr * 64 + m * 16 + fr) * 4 + wc] = s; }
        asm volatile("s_waitcnt lgkmcnt(0)" ::: "memory"); __builtin_amdgcn_s_barrier(); asm volatile("" ::: "memory");
        const int row = wid * 32 + (lane & 31);
        if (lane < 32) { const f32x4 p = *(const PG8_LAS f32x4*)(P + row * 4);
            __hip_atomic_store((unsigned*)slots + ((size_t)(u.pm * BM + row) * 4 + u.pn), __float_as_uint((p[0] + p[1]) + (p[2] + p[3])), __ATOMIC_RELAXED, __HIP_MEMORY_SCOPE_AGENT); }
        asm volatile("s_waitcnt vmcnt(0)" ::: "memory");
        if (lane == 0) __hip_atomic_fetch_add(cnt + 8 * u.pm, 1u, __ATOMIC_RELAXED, __HIP_MEMORY_SCOPE_AGENT);
    }
    __device__ __forceinline__ void collect(const Unit& u, int wr, int fr, PG8_LAS unsigned char* lds, int wid, int lane, float eps, float (&rinv)[2][4]) const {
        PG8_LAS float* S = (PG8_LAS float*)(lds + 4096);
        const int row = wid * 32 + (lane & 31);
        if (wid == 0) { unsigned sp = 0;
            while ((unsigned)__builtin_amdgcn_readfirstlane(__hip_atomic_load(cnt + 8 * u.pm, __ATOMIC_RELAXED, __HIP_MEMORY_SCOPE_AGENT)) < 32u) { __builtin_amdgcn_s_sleep(1);
                if ((++sp & 255u) == 0u) { if (__hip_atomic_load(tmo, __ATOMIC_RELAXED, __HIP_MEMORY_SCOPE_AGENT)) break; if (sp > (1u << 18)) { if (lane == 0) atomicAdd(tmo, 1u); break; } } } }
        asm volatile("s_waitcnt lgkmcnt(0)" ::: "memory"); __builtin_amdgcn_s_barrier(); asm volatile("" ::: "memory");
        if (lane < 32) { const unsigned* sl = (const unsigned*)slots + (size_t)(u.pm * BM + row) * 4; float t = 0.f;
#pragma unroll
            for (int j = 0; j < 4; ++j) t += __uint_as_float(__hip_atomic_load(sl + j, __ATOMIC_RELAXED, __HIP_MEMORY_SCOPE_AGENT));
            S[row] = 1.0f / sqrtf(t * (1.0f / 1024.0f) + eps); }
        asm volatile("s_waitcnt lgkmcnt(0)" ::: "memory"); __builtin_amdgcn_s_barrier(); asm volatile("" ::: "memory");
#pragma unroll
        for (int ai = 0; ai < 2; ++ai)
#pragma unroll
            for (int m = 0; m < 4; ++m) rinv[ai][m] = S[ai * HALF + wr * 64 + m * 16 + fr];
        asm volatile("s_waitcnt lgkmcnt(0)" ::: "memory"); __builtin_amdgcn_s_barrier(); asm volatile("" ::: "memory");
    }
};
template <int SPOST, int SPRE, bool XINB, int XOUT, bool RS = false> struct EpiNorm {
    static constexpr bool PERM = true, AFTER_DRAIN = true;
    const void* xin; void* xout; bf16_t* XN; const float* MOD; const float* ng; RowExch e1, e2; float eps; const float* rowsq;
    __device__ __forceinline__ void operator()(const f32x4 (&)[2][2][4][2], const Unit&, int, int, int, int) const {}
    __device__ __forceinline__ void fused(f32x4 (&acc)[2][2][4][2], const Unit& u, int wr, int wc, int fr, int fq, PG8_LAS unsigned char* lds, int wid, int lane) const {
        const int b = u.pm >> 5;
        const int col0 = u.pn * BM + wc * 32 + 8 * fq;
        const size_t off0 = (size_t)(u.pm * BM + wr * 64 + fr) * 1024 + col0;
#define EN_OFF(ai, m, bj) (off0 + (size_t)((ai) * HALF + (m) * 16) * 1024 + (bj) * HALF)
#define EN_UNPK_LO(q_) ((f32x4){__uint_as_float((q_)[0] << 16), __uint_as_float((q_)[0] & 0xffff0000u), __uint_as_float((q_)[1] << 16), __uint_as_float((q_)[1] & 0xffff0000u)})
#define EN_UNPK_HI(q_) ((f32x4){__uint_as_float((q_)[2] << 16), __uint_as_float((q_)[2] & 0xffff0000u), __uint_as_float((q_)[3] << 16), __uint_as_float((q_)[3] & 0xffff0000u)})
        float ss[2][4], r1[2][4];
        if constexpr (RS) {
            f32x4 q[2][4];
#pragma unroll
            for (int ai = 0; ai < 2; ++ai)
#pragma unroll
                for (int m = 0; m < 4; ++m) q[ai][m] = *(const f32x4*)(rowsq + (size_t)(u.pm * BM + ai * HALF + wr * 64 + m * 16 + fr) * 4);
#pragma unroll
            for (int ai = 0; ai < 2; ++ai)
#pragma unroll
                for (int m = 0; m < 4; ++m) { const float r = 1.0f / sqrtf(((q[ai][m][0] + q[ai][m][1]) + (q[ai][m][2] + q[ai][m][3])) * (1.0f / 1024.0f) + eps);
#pragma unroll
                    for (int bj = 0; bj < 2; ++bj)
#pragma unroll
                        for (int n = 0; n < 2; ++n) acc[ai][bj][m][n] = acc[ai][bj][m][n] * r; }
        }
#pragma unroll
        for (int ai = 0; ai < 2; ++ai)
#pragma unroll
            for (int m = 0; m < 4; ++m) { float s = 0.f;
#pragma unroll
                for (int bj = 0; bj < 2; ++bj)
#pragma unroll
                    for (int n = 0; n < 2; ++n) { const f32x4 x = acc[ai][bj][m][n]; s += (x[0] * x[0] + x[1] * x[1]) + (x[2] * x[2] + x[3] * x[3]); }
                ss[ai][m] = s; }
        e1.publish(ss, u, wr, wc, fr, fq, lds, wid, lane);
        u32x4 xb[2][4][2]; f32x4 xf[4][2][2];
        if constexpr (XINB) {
#pragma unroll
            for (int ai = 0; ai < 2; ++ai)
#pragma unroll
                for (int m = 0; m < 4; ++m)
#pragma unroll
                    for (int bj = 0; bj < 2; ++bj) xb[ai][m][bj] = *(const u32x4*)((const bf16_t*)xin + EN_OFF(ai, m, bj));
        } else {
#pragma unroll
            for (int m = 0; m < 4; ++m)
#pragma unroll
                for (int bj = 0; bj < 2; ++bj) { xf[m][bj][0] = *(const f32x4*)((const float*)xin + EN_OFF(0, m, bj)); xf[m][bj][1] = *(const f32x4*)((const float*)xin + EN_OFF(0, m, bj) + 4); }
        }
        f32x4 gp[2][2];
#pragma unroll
        for (int bj = 0; bj < 2; ++bj)
#pragma unroll
            for (int n = 0; n < 2; ++n) gp[bj][n] = *(const f32x4*)(MOD + (SPOST * 2 + b) * 3072 + 2048 + col0 + bj * HALF + 4 * n) * *(const f32x4*)(ng + (SPOST * 2 + 1) * 1024 + col0 + bj * HALF + 4 * n);
        e1.collect(u, wr, fr, lds, wid, lane, eps, r1);
#pragma unroll
        for (int ai = 0; ai < 2; ++ai) {
            if constexpr (!XINB) { if (ai == 1) {
#pragma unroll
                for (int m = 0; m < 4; ++m)
#pragma unroll
                    for (int bj = 0; bj < 2; ++bj) { xf[m][bj][0] = *(const f32x4*)((const float*)xin + EN_OFF(1, m, bj)); xf[m][bj][1] = *(const f32x4*)((const float*)xin + EN_OFF(1, m, bj) + 4); } } }
#pragma unroll
            for (int m = 0; m < 4; ++m) { const float r = r1[ai][m];
#pragma unroll
                for (int bj = 0; bj < 2; ++bj) { f32x4 x0, x1;
                    if constexpr (XINB) { x0 = EN_UNPK_LO(xb[ai][m][bj]); x1 = EN_UNPK_HI(xb[ai][m][bj]); } else { x0 = xf[m][bj][0]; x1 = xf[m][bj][1]; }
                    f32x4 v0 = x0 + gp[bj][0] * (acc[ai][bj][m][0] * r), v1 = x1 + gp[bj][1] * (acc[ai][bj][m][1] * r);
                    if constexpr (XOUT == 2) { *(f32x4*)((float*)xout + EN_OFF(ai, m, bj)) = v0; *(f32x4*)((float*)xout + EN_OFF(ai, m, bj) + 4) = v1; }
                    if constexpr (XOUT == 1) { u32x4 w; w.x = cvt_pk_bf16(v0[0], v0[1]); w.y = cvt_pk_bf16(v0[2], v0[3]); w.z = cvt_pk_bf16(v1[0], v1[1]); w.w = cvt_pk_bf16(v1[2], v1[3]);
                        v0 = EN_UNPK_LO(w); v1 = EN_UNPK_HI(w); }
                    acc[ai][bj][m][0] = v0; acc[ai][bj][m][1] = v1; } }
        }
        if constexpr (SPRE >= 0) {
            float r2[2][4];
#pragma unroll
            for (int ai = 0; ai < 2; ++ai)
#pragma unroll
                for (int m = 0; m < 4; ++m) { float s = 0.f;
#pragma unroll
                    for (int bj = 0; bj < 2; ++bj)
#pragma unroll
                        for (int n = 0; n < 2; ++n) { const f32x4 x = acc[ai][bj][m][n]; s += (x[0] * x[0] + x[1] * x[1]) + (x[2] * x[2] + x[3] * x[3]); }
                    ss[ai][m] = s; }
            e2.publish(ss, u, wr, wc, fr, fq, lds, wid, lane);
            if constexpr (XOUT == 1) {
#pragma unroll
                for (int ai = 0; ai < 2; ++ai)
#pragma unroll
                    for (int m = 0; m < 4; ++m)
#pragma unroll
                        for (int bj = 0; bj < 2; ++bj) { const f32x4 v0 = acc[ai][bj][m][0], v1 = acc[ai][bj][m][1];
                            u32x4 w; w.x = cvt_pk_bf16(v0[0], v0[1]); w.y = cvt_pk_bf16(v0[2], v0[3]); w.z = cvt_pk_bf16(v1[0], v1[1]); w.w = cvt_pk_bf16(v1[2], v1[3]);
                            *(u32x4*)((bf16_t*)xout + EN_OFF(ai, m, bj)) = w; }
            }
            f32x4 qc[2][2], sh[2][2];
#pragma unroll
            for (int bj = 0; bj < 2; ++bj)
#pragma unroll
                for (int n = 0; n < 2; ++n) { const int c = col0 + bj * HALF + 4 * n;
                    qc[bj][n] = *(const f32x4*)(ng + (SPRE * 2) * 1024 + c) * (*(const f32x4*)(MOD + (SPRE * 2 + b) * 3072 + 1024 + c) + 1.0f); sh[bj][n] = *(const f32x4*)(MOD + (SPRE * 2 + b) * 3072 + c); }
            e2.collect(u, wr, fr, lds, wid, lane, eps, r2);
#pragma unroll
            for (int ai = 0; ai < 2; ++ai)
#pragma unroll
                for (int m = 0; m < 4; ++m) { const float r = r2[ai][m];
#pragma unroll
                    for (int bj = 0; bj < 2; ++bj) { const f32x4 o0 = (acc[ai][bj][m][0] * r) * qc[bj][0] + sh[bj][0], o1 = (acc[ai][bj][m][1] * r) * qc[bj][1] + sh[bj][1];
                        u32x4 w; w.x = cvt_pk_bf16(o0[0], o0[1]); w.y = cvt_pk_bf16(o0[2], o0[3]); w.z = cvt_pk_bf16(o1[0], o1[1]); w.w = cvt_pk_bf16(o1[2], o1[3]);
                        *(u32x4*)(XN + EN_OFF(ai, m, bj)) = w; } }
        } else if constexpr (XOUT == 1) {
#pragma unroll
            for (int ai = 0; ai < 2; ++ai)
#pragma unroll
                for (int m = 0; m < 4; ++m)
#pragma unroll
                    for (int bj = 0; bj < 2; ++bj) { const f32x4 v0 = acc[ai][bj][m][0], v1 = acc[ai][bj][m][1];
                        u32x4 w; w.x = cvt_pk_bf16(v0[0], v0[1]); w.y = cvt_pk_bf16(v0[2], v0[3]); w.z = cvt_pk_bf16(v1[0], v1[1]); w.w = cvt_pk_bf16(v1[2], v1[3]);
                        *(u32x4*)((bf16_t*)xout + EN_OFF(ai, m, bj)) = w; }
        }
#undef EN_OFF
#undef EN_UNPK_LO
#undef EN_UNPK_HI
    }
};
template <class Epi, class Sched, bool ALIGN_EPI = false, bool SP2 = false>
__device__ __forceinline__ void gemm_phase(PG8_LAS unsigned char* lds, const Gemm g, const Sched& S, const Epi& E) {
    const int tid = threadIdx.x, wid = __builtin_amdgcn_readfirstlane(tid >> 6), lane = tid & 63, wr = wid >> 2, wc = wid & 3, fr = lane & 15, fq = lane >> 4;
    const int K = g.K, nt = K / BK;
    unsigned voffA[2], voffB[2];
#pragma unroll
    for (int i = 0; i < 2; ++i) { int R, C; stage_rc(tid * 16 + i * 8192, R, C); const int Rb = Epi::PERM ? ((R & ~31) + perm32(R & 31)) : R;
        voffA[i] = (unsigned)(R * g.lda + C) * 2u; voffB[i] = (unsigned)(Rb * K + C) * 2u; }
    const size_t kstep = (size_t)(BK * 2);
    const size_t hstepA = (size_t)HALF * g.lda * 2, hstepB = (size_t)HALF * K * 2;
    const size_t tstepA = 2 * hstepA, tstepB = 2 * hstepB;
    const unsigned ldsw = (unsigned)wid * 1024u;
    const int aoff = lds_byte(wr * 64 + fr, fq * 8), boff = lds_byte(wc * 32 + fr, fq * 8);
#define PG8_SA(b, h) (((b) * 2 + (h)) * HTB)
#define PG8_SB(b, h) ((4 + (b) * 2 + (h)) * HTB)
#define PG8_STAGE(bufoff, gbase, voff) do { _Pragma("unroll") for (int _i = 0; _i < 2; ++_i) \
        __builtin_amdgcn_global_load_lds((const unsigned*)((const char*)(gbase) + (voff)[_i]), (PG8_LAS unsigned*)(lds + (bufoff) + ldsw + _i * 8192), 16, 0, 0); } while (0)
#define PG8_LDA(dst, b, h) do { _Pragma("unroll") for (int m = 0; m < 4; ++m) _Pragma("unroll") for (int k = 0; k < 2; ++k) dst[m][k] = *(const PG8_LAS bf16x8*)(lds + PG8_SA(b, h) + aoff + m * 2048 + k * 1024); } while (0)
#define PG8_LDB(dst, b, h) do { _Pragma("unroll") for (int n = 0; n < 2; ++n) _Pragma("unroll") for (int k = 0; k < 2; ++k) dst[n][k] = *(const PG8_LAS bf16x8*)(lds + PG8_SB(b, h) + boff + n * 2048 + k * 1024); } while (0)
#define PG8_MMA(ai, bj, At, Bt) do { __builtin_amdgcn_s_setprio(1); _Pragma("unroll") for (int m = 0; m < 4; ++m) _Pragma("unroll") for (int n = 0; n < 2; ++n) _Pragma("unroll") for (int k = 0; k < 2; ++k) \
        acc[ai][bj][m][n] = __builtin_amdgcn_mfma_f32_16x16x32_bf16(Bt[n][k], At[m][k], acc[ai][bj][m][n], 0, 0, 0); __builtin_amdgcn_s_setprio(0); } while (0)
#define PG8_WAIT_V(n) asm volatile("s_waitcnt vmcnt(" #n ")" ::: "memory")
#define PG8_WAIT_L(n) asm volatile("s_waitcnt lgkmcnt(" #n ")" ::: "memory")
#define PG8_BAR __builtin_amdgcn_s_barrier()
#define PG8_SCHED __builtin_amdgcn_sched_barrier(0)
    Unit cur, nxt; int ui = 0;
    if (!S.next(0, cur)) return;
    f32x4 acc[2][2][4][2];
#pragma unroll
    for (int a = 0; a < 2; ++a)
#pragma unroll
        for (int b = 0; b < 2; ++b)
#pragma unroll
            for (int m = 0; m < 4; ++m)
#pragma unroll
                for (int n = 0; n < 2; ++n) acc[a][b][m][n] = (f32x4){0.f, 0.f, 0.f, 0.f};
    bf16x8 At[4][2], B0[2][2], B1[2][2];
    const char* cA = (const char*)g.A + (size_t)cur.pm * tstepA; const char* cB = (const char*)g.Bt + (size_t)cur.pn * tstepB;
    S.a_ready(cur);
    if constexpr (SP2) {
        PG8_STAGE(PG8_SB(0, 0), cB, voffB); PG8_STAGE(PG8_SB(0, 1), cB + hstepB, voffB); PG8_STAGE(PG8_SA(0, 0), cA, voffA); PG8_STAGE(PG8_SA(0, 1), cA + hstepA, voffA);
        if (wr == 1) PG8_BAR;
        PG8_WAIT_V(2); PG8_BAR;
        PG8_STAGE(PG8_SB(1, 0), cB + kstep, voffB); PG8_STAGE(PG8_SA(1, 0), cA + kstep, voffA); PG8_STAGE(PG8_SB(1, 1), cB + hstepB + kstep, voffB);
        PG8_WAIT_V(6); PG8_BAR;
    } else {
        PG8_STAGE(PG8_SB(0, 0), cB, voffB); PG8_STAGE(PG8_SA(0, 0), cA, voffA); PG8_STAGE(PG8_SB(0, 1), cB + hstepB, voffB); PG8_STAGE(PG8_SA(0, 1), cA + hstepA, voffA);
        if (wr == 1) PG8_BAR;
        PG8_WAIT_V(4); PG8_BAR;
        PG8_STAGE(PG8_SB(1, 0), cB + kstep, voffB); PG8_STAGE(PG8_SA(1, 0), cA + kstep, voffA); PG8_STAGE(PG8_SB(1, 1), cB + hstepB + kstep, voffB);
        PG8_WAIT_V(6); PG8_BAR;
    }
    for (;;) {
        const bool has_next = S.next(ui + 1, nxt);
        const char* nA = has_next ? (const char*)g.A + (size_t)nxt.pm * tstepA : cA; const char* nB = has_next ? (const char*)g.Bt + (size_t)nxt.pn * tstepB : cB;
        for (int t = 0; t < nt; t += 2) {
            const bool last = (t == nt - 2);
            const char* a1 = cA + (size_t)(t + 1) * kstep;
            const char* a2 = last ? nA : cA + (size_t)(t + 2) * kstep; const char* b2 = last ? nB : cB + (size_t)(t + 2) * kstep;
            const char* a3 = a2 + kstep; const char* b3 = b2 + kstep;
            if (last && has_next) S.a_ready(nxt);
            if constexpr (SP2) {
            PG8_LDB(B0, 0, 0); PG8_LDB(B1, 0, 1); PG8_SCHED; PG8_LDA(At, 0, 0); PG8_STAGE(PG8_SA(1, 1), a1 + hstepA, voffA);
            PG8_WAIT_V(8); PG8_WAIT_L(0); PG8_BAR; PG8_MMA(0, 0, At, B0); PG8_MMA(0, 1, At, B1); PG8_BAR; PG8_SCHED;
            PG8_LDA(At, 0, 1); PG8_STAGE(PG8_SB(0, 0), b2, voffB); PG8_STAGE(PG8_SB(0, 1), b2 + hstepB, voffB); PG8_STAGE(PG8_SA(0, 0), a2, voffA);
            PG8_WAIT_V(8); PG8_WAIT_L(0); PG8_BAR; PG8_MMA(1, 0, At, B0); PG8_MMA(1, 1, At, B1); PG8_BAR; PG8_SCHED;
            PG8_LDB(B0, 1, 0); PG8_LDB(B1, 1, 1); PG8_SCHED; PG8_LDA(At, 1, 0); PG8_STAGE(PG8_SA(0, 1), a2 + hstepA, voffA);
            PG8_WAIT_V(8); PG8_WAIT_L(0); PG8_BAR; PG8_MMA(0, 0, At, B0); PG8_MMA(0, 1, At, B1); PG8_BAR; PG8_SCHED;
            PG8_LDA(At, 1, 1); PG8_STAGE(PG8_SB(1, 0), b3, voffB); PG8_STAGE(PG8_SB(1, 1), b3 + hstepB, voffB); PG8_STAGE(PG8_SA(1, 0), a3, voffA);
            PG8_WAIT_V(8); PG8_WAIT_L(0); PG8_BAR; PG8_MMA(1, 0, At, B0); PG8_MMA(1, 1, At, B1); PG8_BAR; PG8_SCHED;
            } else {
            PG8_LDB(B0, 0, 0); PG8_SCHED; PG8_LDA(At, 0, 0); PG8_STAGE(PG8_SA(1, 1), a1 + hstepA, voffA);
            PG8_WAIT_L(8); PG8_BAR; PG8_WAIT_L(0); PG8_MMA(0, 0, At, B0); PG8_BAR; PG8_SCHED;
            PG8_LDB(B1, 0, 1); PG8_STAGE(PG8_SB(0, 0), b2, voffB);
            PG8_BAR; PG8_WAIT_L(0); PG8_MMA(0, 1, At, B1); PG8_BAR;
            PG8_LDA(At, 0, 1); PG8_STAGE(PG8_SA(0, 0), a2, voffA);
            PG8_BAR; PG8_WAIT_L(0); PG8_MMA(1, 0, At, B0); PG8_BAR; PG8_SCHED;
            PG8_STAGE(PG8_SB(0, 1), b2 + hstepB, voffB);
            PG8_WAIT_V(6); PG8_BAR; PG8_MMA(1, 1, At, B1); PG8_BAR;
            PG8_LDB(B0, 1, 0); PG8_SCHED; PG8_LDA(At, 1, 0); PG8_STAGE(PG8_SA(0, 1), a2 + hstepA, voffA);
            PG8_WAIT_L(8); PG8_BAR; PG8_WAIT_L(0); PG8_MMA(0, 0, At, B0); PG8_BAR; PG8_SCHED;
            PG8_LDB(B1, 1, 1); PG8_STAGE(PG8_SB(1, 0), b3, voffB);
            PG8_BAR; PG8_WAIT_L(0); PG8_MMA(0, 1, At, B1); PG8_BAR;
            PG8_LDA(At, 1, 1); PG8_STAGE(PG8_SA(1, 0), a3, voffA);
            PG8_BAR; PG8_WAIT_L(0); PG8_MMA(1, 0, At, B0); PG8_BAR; PG8_SCHED;
            PG8_STAGE(PG8_SB(1, 1), b3 + hstepB, voffB);
            PG8_WAIT_V(6); PG8_BAR; PG8_MMA(1, 1, At, B1); PG8_BAR;
            }
        }
        if constexpr (ALIGN_EPI) { if (wr == 0) PG8_BAR; }
        if constexpr (!Epi::AFTER_DRAIN) { E(acc, cur, wr, wc, fr, fq); S.done(cur); }
        if (!has_next) break;
#pragma unroll
        for (int a = 0; a < 2; ++a)
#pragma unroll
            for (int b = 0; b < 2; ++b)
#pragma unroll
                for (int m = 0; m < 4; ++m)
#pragma unroll
                    for (int n = 0; n < 2; ++n) acc[a][b][m][n] = (f32x4){0.f, 0.f, 0.f, 0.f};
        cur = nxt; cA = nA; cB = nB; ++ui;
        if constexpr (ALIGN_EPI) { if (wr == 1) PG8_BAR; }
    }
    PG8_WAIT_V(0);
    if constexpr (!ALIGN_EPI) { if (wr == 0) PG8_BAR; }
    PG8_BAR;
    if constexpr (Epi::AFTER_DRAIN) { E.fused(acc, cur, wr, wc, fr, fq, lds, wid, lane); S.done(cur); }
#undef PG8_SA
#undef PG8_SB
#undef PG8_STAGE
#undef PG8_LDA
#undef PG8_LDB
#undef PG8_MMA
#undef PG8_WAIT_V
#undef PG8_WAIT_L
#undef PG8_BAR
#undef PG8_SCHED
}
}

constexpr int NWAVES = 8, NTHR = NWAVES * 64;
constexpr int BATCH = 2, SEQ = 8192, DM = 1024, MTOK = BATCH * SEQ, FF = 4096;
constexpr int NPROJ0 = 6144, NPROJ1 = 3840;
constexpr float EPS = 1e-6f, LOG2E = 1.4426950408889634f;
constexpr int C0_Z = 0, C0_Q = 1024, C0_K = 2048, C0_V = 3072, C0_XBC = 4096;
constexpr int C1_RG = 0, C1_SQ = 1024, C1_RQ = 1536, C1_RK = 2048, C1_RV = 2560, C1_SK = 3584, C1_SV = 3712;
enum { I_X = 0, I_C, I_RELB, I_NG, I_MODW, I_MODB, I_W1, I_W2, I_EWIN, I_ECONVW, I_ECONVB, I_EDTB, I_EALOG, I_ED, I_ESSDN, I_ELAM, I_EDIFFN, I_EWOUT, I_OWIN, I_OSINK, I_OWOUT, N_IN };

constexpr size_t MiB = 1u << 20;
constexpr size_t WS_CTL = 0, CTL_ZERO_BYTES = 65536;
constexpr size_t WS_MOD = 256 * 1024;
constexpr size_t WS_WDT = 512 * 1024;
constexpr size_t WS_CHDEC = 576 * 1024;
constexpr size_t WS_SSQ = 640 * 1024;
constexpr size_t WS_WMIX = 1 * MiB;
constexpr size_t WS_WOUT0 = 13 * MiB, WS_WOUT1 = 9 * MiB;
constexpr size_t WS_PROJ0 = 17 * MiB;
constexpr size_t WS_XN2 = 17 * MiB;
constexpr size_t WS_WMLP = 49 * MiB;
constexpr size_t WS_H = 65 * MiB;
constexpr size_t WS_S = 209 * MiB;
constexpr size_t WS_DT = 241 * MiB;
constexpr size_t WS_ROPE = 244 * MiB;
constexpr size_t WS_XCH = 248 * MiB;
constexpr size_t WS_END = 250 * MiB;
constexpr int CW_BAR = 4096;

constexpr int LDS_BYTES = 163840 - 1024;
constexpr int MISC_OFF = LDS_BYTES - 256;

#define GAS __attribute__((address_space(1)))
#define LAS __attribute__((address_space(3)))
typedef unsigned short bf16;
typedef unsigned v4u __attribute__((ext_vector_type(4)));
typedef unsigned v2u __attribute__((ext_vector_type(2)));
typedef float f32x4 __attribute__((ext_vector_type(4)));
typedef short bf16x8 __attribute__((ext_vector_type(8)));
typedef short v4i16_t __attribute__((ext_vector_type(4)));
typedef GAS unsigned gu32;
typedef LAS unsigned char* ldsp;
#define RLX_AGENT __ATOMIC_RELAXED, __HIP_MEMORY_SCOPE_AGENT
#define LDS_WAIT() asm volatile("s_waitcnt lgkmcnt(0)" ::: "memory")
#define VM_WAIT() asm volatile("s_waitcnt vmcnt(0)" ::: "memory")

__device__ __forceinline__ float bf2f(unsigned h) { return __uint_as_float(h << 16); }
typedef float f32x2_t __attribute__((ext_vector_type(2))); typedef __bf16 bf16x2_t __attribute__((ext_vector_type(2)));
__device__ __forceinline__ unsigned pk2(float lo, float hi) { f32x2_t v = {lo, hi}; bf16x2_t b = __builtin_convertvector(v, bf16x2_t); return __builtin_bit_cast(unsigned, b); }
__device__ __forceinline__ unsigned short f2bf(float f) { return (unsigned short)(pk2(f, 0.f) & 0xffffu); }
__device__ __forceinline__ float silu_f(float x) { return x * __builtin_amdgcn_rcpf(1.f + __expf(-x)); }
__device__ __forceinline__ float wave_sum(float v) {
#pragma unroll
    for (int o = 1; o < 64; o <<= 1) v += __shfl_xor(v, o);
    return v;
}
#define MFMA16(acc, rowfrag, colfrag) acc = __builtin_amdgcn_mfma_f32_16x16x32_bf16(colfrag, rowfrag, acc, 0, 0, 0)
__device__ __forceinline__ bf16x8 lds_frag(ldsp p) { return *(const LAS bf16x8*)p; }
__device__ __forceinline__ bf16x8 lds_frag_tr(ldsp p, int stride) {
    const v4i16_t lo = __builtin_amdgcn_ds_read_tr16_b64_v4i16((LAS v4i16_t*)p);
    const v4i16_t hi = __builtin_amdgcn_ds_read_tr16_b64_v4i16((LAS v4i16_t*)(p + 4 * stride));
    return (bf16x8){lo[0], lo[1], lo[2], lo[3], hi[0], hi[1], hi[2], hi[3]};
}
__device__ __forceinline__ int t5_bucket(int d) {
    if (d < 16) return d;
    const int v = 16 + (int)(logf((float)d * 0.0625f) / 2.0794415416798357f * 16.0f);
    return v < 31 ? v : 31;
}

#define XB_TMO      128
#define XB_XCNT(j)  (256  + 64 * (j))
#define XB_XSUB(j)  (1280 + 64 * (j))
#define XB_XGEN(j)  (2304 + 64 * (j))
#define XB_TOP      3328
#define XB_TOPGEN   3392
#define XCD_BAR_WORDS 3456
#define XB_SPIN_CAP (1u << 18)

__device__ __forceinline__ unsigned xb_ld(unsigned* p)              { return __hip_atomic_load(p, __ATOMIC_RELAXED, __HIP_MEMORY_SCOPE_AGENT); }
__device__ __forceinline__ unsigned xb_add(unsigned* p, unsigned v) { return __hip_atomic_fetch_add(p, v, __ATOMIC_RELAXED, __HIP_MEMORY_SCOPE_AGENT); }
__device__ __forceinline__ unsigned xb_xcc_id() { return (unsigned)__builtin_amdgcn_s_getreg((3 << 11) | 20) & 0xFu; }
#define XB_SPIN(cond, bar) do { unsigned _sp = 0; while (cond) { __builtin_amdgcn_s_sleep(1); \
    if ((++_sp & 255u) == 0u) { if (xb_ld(&(bar)[XB_TMO])) break; if (_sp > XB_SPIN_CAP) { atomicAdd(&(bar)[XB_TMO], 1u); break; } } } } while (0)

struct XcdBarrier {
    unsigned* bar; unsigned x;
    volatile LAS unsigned* st;
};

__device__ __forceinline__ XcdBarrier xcd_barrier_post(unsigned* bar, volatile LAS unsigned* st) {
    XcdBarrier b; b.bar = bar; b.x = xb_xcc_id(); b.st = st;
    if (threadIdx.x == 0) (void)xb_add(&bar[XB_XCNT(b.x)], 1u);
    return b;
}
__device__ __forceinline__ void xcd_barrier_complete(unsigned* bar, unsigned x, unsigned& nloc, unsigned& nx) {
    const unsigned G = gridDim.x * gridDim.y * gridDim.z;
    unsigned sum, cnt, mine, sp = 0u;
    for (;;) {
        sum = 0u; cnt = 0u; mine = 0u;
#pragma unroll
        for (unsigned j = 0; j < 16; ++j) { const unsigned c = xb_ld(&bar[XB_XCNT(j)]); sum += c; cnt += (c > 0u) ? 1u : 0u; mine = (j == x) ? c : mine; }
        if (sum == G) break;
        __builtin_amdgcn_s_sleep(1);
        if ((++sp & 255u) == 0u) { if (xb_ld(&bar[XB_TMO])) break; if (sp > XB_SPIN_CAP) { atomicAdd(&bar[XB_TMO], 1u); break; } }
    }
    nloc = mine > 0u ? mine : 1u; nx = cnt > 0u ? cnt : 1u;
}

template <bool WB = true> __device__ __forceinline__ void xcd_barrier(const XcdBarrier& b) {
    asm volatile("s_waitcnt vmcnt(0)" ::: "memory");
    __syncthreads();
    if (threadIdx.x == 0) {
        unsigned* bar = b.bar;
        __builtin_amdgcn_s_waitcnt(0);
        unsigned nloc = b.st[0], nx = b.st[1];
        if (nloc == 0u) { xcd_barrier_complete(bar, b.x, nloc, nx); b.st[0] = nloc; b.st[1] = nx; }
        const unsigned old = xb_add(&bar[XB_XSUB(b.x)], 1u);
        const unsigned gen = old / nloc;
        if (old + 1u == (gen + 1u) * nloc) {
            if (WB) asm volatile("buffer_inv sc1\n\tbuffer_wbl2 sc1\n\ts_waitcnt vmcnt(0)" ::: "memory"); else asm volatile("buffer_inv sc1" ::: "memory");
            xb_add(&bar[XB_TOP], 1u);
        } else {
            asm volatile("buffer_inv sc1" ::: "memory");
        }
        XB_SPIN(xb_ld(&bar[XB_TOP]) < (gen + 1u) * nx, bar);
        asm volatile("s_waitcnt vmcnt(0)" ::: "memory");
    }
    __syncthreads();
}

struct Seg { const float* W; int ldw, col0, ncols, K; bf16* WT; int row_off; };
struct CvtItem { const float* src; bf16* dst; int ldw, K; bool valid; };
template <int NSEG> __device__ __forceinline__ CvtItem cvt_resolve(const Seg (&segs)[NSEG], int it, int total, int lane) {
    CvtItem c; c.src = nullptr; c.dst = nullptr; c.ldw = 0; c.K = 0; c.valid = false;
    int r = it < total ? it : -1;
#pragma unroll
    for (int s = 0; s < NSEG; ++s) { const int nblk = segs[s].ncols / 32, n = (segs[s].K / 64) * nblk;
        if (!c.valid && r >= 0 && r < n) { const int kb = r / nblk, nb = r % nblk, k0 = 64 * kb, n0 = 32 * nb;
            c.src = segs[s].W + (size_t)(k0 + (lane >> 5)) * segs[s].ldw + segs[s].col0 + n0 + (lane & 31);
            c.dst = segs[s].WT + (size_t)(segs[s].row_off + n0 + (lane >> 3)) * segs[s].K + k0 + 8 * (lane & 7); c.ldw = segs[s].ldw; c.K = segs[s].K; c.valid = true; }
        r -= n; }
    return c;
}
__device__ __forceinline__ void cvt_loads(const CvtItem& c, float (&wv)[32]) {
    if (c.valid) {
#pragma unroll
        for (int i = 0; i < 32; ++i) wv[i] = c.src[(size_t)(2 * i) * c.ldw]; }
}
__device__ __forceinline__ void cvt_finish(const CvtItem& c, const float (&wv)[32], LAS float* scr, int lane) {
    if (c.valid) {
#pragma unroll
        for (int i = 0; i < 32; ++i) scr[(2 * i + (lane >> 5)) * 33 + (lane & 31)] = wv[i];
        LDS_WAIT(); asm volatile("" ::: "memory");
        const int cc = lane & 7;
#pragma unroll
        for (int j = 0; j < 4; ++j) { const int n = (lane >> 3) + 8 * j; const LAS float* p = scr + (8 * cc) * 33 + n;
            v4u o; o.x = pk2(p[0 * 33], p[1 * 33]); o.y = pk2(p[2 * 33], p[3 * 33]); o.z = pk2(p[4 * 33], p[5 * 33]); o.w = pk2(p[6 * 33], p[7 * 33]);
            *(v4u*)(c.dst + (size_t)(8 * j) * c.K) = o; }
        LDS_WAIT(); asm volatile("" ::: "memory"); }
}
template <int NSEG> __device__ __forceinline__ void convert_set(const Seg (&segs)[NSEG], ldsp lds, int gw, int NGW, int wave, int lane) {
    LAS float* scr = (LAS float*)(lds + wave * 16384);
    int total = 0;
#pragma unroll
    for (int s = 0; s < NSEG; ++s) total += (segs[s].K / 64) * (segs[s].ncols / 32);
    for (int it = gw; it < total; it += 2 * NGW) {
        const CvtItem ca = cvt_resolve<NSEG>(segs, it, total, lane), cb = cvt_resolve<NSEG>(segs, it + NGW, total, lane);
        float wa[32], wb[32];
        cvt_loads(ca, wa); cvt_loads(cb, wb);
        cvt_finish(ca, wa, scr, lane); cvt_finish(cb, wb, scr, lane);
    }
}
__device__ __forceinline__ void mod_phase(const float* c, const float* mod_w, const float* mod_b, float* MOD, ldsp lds, int tid, int lane, int wave) {
    for (int item = blockIdx.x; item < 192; item += gridDim.x) {
        const int s = item / 48, j0 = (item % 48) * 64, kpart = wave * 4 + (lane >> 4), jl = lane & 15;
        const float* wp = mod_w + ((size_t)s * 1024 + kpart * 32) * 3072 + j0 + 4 * jl;
        f32x4 a0 = {0.f, 0.f, 0.f, 0.f}, a1 = a0;
#pragma unroll
        for (int kk = 0; kk < 32; ++kk) { const int k = kpart * 32 + kk; const f32x4 w = *(const f32x4*)(wp + (size_t)kk * 3072);
            const float c0 = c[k], c1 = c[1024 + k]; const float s0 = c0 / (1.f + expf(-c0)), s1 = c1 / (1.f + expf(-c1)); a0 += w * s0; a1 += w * s1; }
        LAS f32x4* red = (LAS f32x4*)lds;
        red[(kpart * 2 + 0) * 16 + jl] = a0; red[(kpart * 2 + 1) * 16 + jl] = a1;
        __syncthreads();
        if (tid < 128) { const int b = tid >> 6, col = tid & 63; float sum = mod_b[s * 3072 + j0 + col];
#pragma unroll
            for (int kp = 0; kp < 32; ++kp) sum += ((LAS float*)lds)[((kp * 2 + b) * 16 + (col >> 2)) * 4 + (col & 3)];
            MOD[(s * 2 + b) * 3072 + j0 + col] = sum; }
        __syncthreads();
    }
}

template <int SPOST, int SPRE, bool XINB, int XOUT, int R = 2> __device__ __forceinline__ void norm_rows(const void* xin_, const bf16* Y, void* xout_, bf16* XN, const float* MOD, const float* ng, int gw, int NGW, int lane) {
    const float* xinf = (const float*)xin_; const bf16* xinb = (const bf16*)xin_; float* xoutf = (float*)xout_; bf16* xoutb = (bf16*)xout_;
    const int half = NGW >> 1; const bool split = !(NGW & 1);
    const int b0 = split ? gw / half : 0, b1 = split ? b0 + 1 : BATCH, w = split ? gw % half : gw, W = split ? half : NGW;
#define NR_COL(q) (8 * lane + 512 * ((q) >> 1) + 4 * ((q) & 1))
#define NR_UNPK(w_) ((f32x4){__uint_as_float((w_).x << 16), __uint_as_float((w_).x & 0xffff0000u), __uint_as_float((w_).y << 16), __uint_as_float((w_).y & 0xffff0000u)})
#define NR_LOAD(vx, vxb, vy, m_) do { _Pragma("unroll") for (int j = 0; j < 2; ++j) { \
        if constexpr (XINB) vxb[j] = *(const v4u*)(xinb + (size_t)(m_) * DM + 8 * lane + 512 * j); \
        else { vx[2 * j] = *(const f32x4*)(xinf + (size_t)(m_) * DM + NR_COL(2 * j)); vx[2 * j + 1] = *(const f32x4*)(xinf + (size_t)(m_) * DM + NR_COL(2 * j + 1)); } \
        if constexpr (SPOST >= 0) vy[j] = *(const v4u*)(Y + (size_t)(m_) * DM + 8 * lane + 512 * j); } } while (0)
#pragma unroll 1
    for (int b = b0; b < b1; ++b) {
        f32x4 g4[4], p4[4], s4[4], c4[4], q4[4];
#pragma unroll
        for (int q = 0; q < 4; ++q) {
            if constexpr (SPOST >= 0) { g4[q] = *(const f32x4*)(MOD + (SPOST * 2 + b) * 3072 + 2048 + NR_COL(q)); p4[q] = *(const f32x4*)(ng + (SPOST * 2 + 1) * DM + NR_COL(q)); }
            if constexpr (SPRE >= 0) { s4[q] = *(const f32x4*)(MOD + (SPRE * 2 + b) * 3072 + NR_COL(q)); c4[q] = *(const f32x4*)(MOD + (SPRE * 2 + b) * 3072 + 1024 + NR_COL(q)) + 1.0f;
                q4[q] = *(const f32x4*)(ng + (SPRE * 2) * DM + NR_COL(q)); }
        }
        const int cnt = w < SEQ ? (SEQ - w + W - 1) / W : 0;
        f32x4 vx[R][4]; v4u vxb[R][2], vy[R][2];
#pragma unroll
        for (int r = 0; r < R; ++r) if (r < cnt) NR_LOAD(vx[r], vxb[r], vy[r], b * SEQ + w + r * W);
        for (int i0 = 0; i0 < cnt; i0 += R) {
            f32x4 nx[R][4]; v4u nxb[R][2], ny[R][2];
#pragma unroll
            for (int r = 0; r < R; ++r) if (i0 + R + r < cnt) NR_LOAD(nx[r], nxb[r], ny[r], b * SEQ + w + (i0 + R + r) * W);
#pragma unroll
            for (int r = 0; r < R; ++r) if (i0 + r < cnt) {
                const int m = b * SEQ + w + (i0 + r) * W;
                f32x4 v[4];
#pragma unroll
                for (int j = 0; j < 2; ++j) { if constexpr (XINB) { const v2u lo = {vxb[r][j].x, vxb[r][j].y}, hi = {vxb[r][j].z, vxb[r][j].w}; v[2 * j] = NR_UNPK(lo); v[2 * j + 1] = NR_UNPK(hi); }
                                              else { v[2 * j] = vx[r][2 * j]; v[2 * j + 1] = vx[r][2 * j + 1]; } }
                if constexpr (SPOST >= 0) {
                    f32x4 y[4]; float ss = 0.f;
#pragma unroll
                    for (int j = 0; j < 2; ++j) { const v2u lo = {vy[r][j].x, vy[r][j].y}, hi = {vy[r][j].z, vy[r][j].w}; y[2 * j] = NR_UNPK(lo); y[2 * j + 1] = NR_UNPK(hi); }
#pragma unroll
                    for (int q = 0; q < 4; ++q) ss += (y[q].x * y[q].x + y[q].y * y[q].y) + (y[q].z * y[q].z + y[q].w * y[q].w);
                    const float rr = 1.0f / sqrtf(wave_sum(ss) * (1.f / DM) + EPS);
#pragma unroll
                    for (int q = 0; q < 4; ++q) v[q] = v[q] + g4[q] * ((y[q] * rr) * p4[q]);
                    if constexpr (XOUT == 2) {
#pragma unroll
                        for (int q = 0; q < 4; ++q) *(f32x4*)(xoutf + (size_t)m * DM + NR_COL(q)) = v[q]; }
                    if constexpr (XOUT == 1) {
#pragma unroll
                        for (int j = 0; j < 2; ++j) { v4u o; o.x = pk2(v[2 * j].x, v[2 * j].y); o.y = pk2(v[2 * j].z, v[2 * j].w); o.z = pk2(v[2 * j + 1].x, v[2 * j + 1].y); o.w = pk2(v[2 * j + 1].z, v[2 * j + 1].w);
                            *(v4u*)(xoutb + (size_t)m * DM + 8 * lane + 512 * j) = o;
                            const v2u lo = {o.x, o.y}, hi = {o.z, o.w}; v[2 * j] = NR_UNPK(lo); v[2 * j + 1] = NR_UNPK(hi); } }
                }
                if constexpr (SPRE >= 0) {
                    float ss = 0.f;
#pragma unroll
                    for (int q = 0; q < 4; ++q) ss += (v[q].x * v[q].x + v[q].y * v[q].y) + (v[q].z * v[q].z + v[q].w * v[q].w);
                    const float rr = 1.0f / sqrtf(wave_sum(ss) * (1.f / DM) + EPS);
#pragma unroll
                    for (int j = 0; j < 2; ++j) { const f32x4 oa = ((v[2 * j] * rr) * q4[2 * j]) * c4[2 * j] + s4[2 * j], ob = ((v[2 * j + 1] * rr) * q4[2 * j + 1]) * c4[2 * j + 1] + s4[2 * j + 1];
                        v4u o; o.x = pk2(oa.x, oa.y); o.y = pk2(oa.z, oa.w); o.z = pk2(ob.x, ob.y); o.w = pk2(ob.z, ob.w);
                        *(v4u*)(XN + (size_t)m * DM + 8 * lane + 512 * j) = o; }
                }
            }
#pragma unroll
            for (int r = 0; r < R; ++r) {
#pragma unroll
                for (int q = 0; q < 4; ++q) vx[r][q] = nx[r][q];
#pragma unroll
                for (int j = 0; j < 2; ++j) { vxb[r][j] = nxb[r][j]; vy[r][j] = ny[r][j]; } }
        }
    }
#undef NR_LOAD
#undef NR_UNPK
#undef NR_COL
}

__device__ __forceinline__ void dt_phase(const bf16* XN, const bf16* WDT, const float* dt_bias, float* DT, int gw, int NGW, int lane) {
    const int fr = lane & 15, fq = lane >> 4;
    for (int tile = gw; tile < MTOK / 16; tile += NGW) {
        f32x4 acc = {0.f, 0.f, 0.f, 0.f};
        const bf16* arow = XN + (size_t)(tile * 16 + fr) * DM + 8 * fq; const bf16* brow = WDT + fr * DM + 8 * fq;
#pragma unroll 8
        for (int ks = 0; ks < 32; ++ks) { const bf16x8 a = *(const bf16x8*)(arow + 32 * ks), bb = *(const bf16x8*)(brow + 32 * ks); MFMA16(acc, a, bb); }
        const f32x4 bi = *(const f32x4*)(dt_bias + 4 * fq); f32x4 o;
#pragma unroll
        for (int i = 0; i < 4; ++i) { const float v = acc[i] + bi[i]; o[i] = v > 20.f ? v : log1pf(expf(v)); }
        *(f32x4*)(DT + (size_t)(tile * 16 + fr) * 16 + 4 * fq) = o;
    }
}

__device__ __forceinline__ void ssd_dt_acs(const float* DT, const float* A_log, int t0, int g, LAS float* ACS, LAS float* DTS, LAS float* TMP, int tid) {
    const int r = tid >> 7, s = tid & 127, ln = tid & 63;
    const float dt = DT[(size_t)(t0 + s) * 16 + g * 4 + r];
    float v = -expf(A_log[g * 4 + r]) * dt; DTS[r * 128 + s] = dt;
#pragma unroll
    for (int d = 1; d < 64; d <<= 1) { const float t = __shfl_up(v, d); if (ln >= d) v += t; }
    if (ln == 63) TMP[tid >> 6] = v;
    __syncthreads();
    if (s >= 64) v += TMP[(tid >> 6) - 1];
    ACS[r * 128 + s] = v;
    __syncthreads();
}
__device__ __forceinline__ void ssd_conv_group(const bf16* PROJ0, const float* conv_w, const float* conv_b, int t0, bool first_chunk, int cch0, int tg, int mode, ldsp dst  , int stride,
                                               const LAS float* ACSr, const LAS float* DTSr) {
    float w[4][8], cb[8];
#pragma unroll
    for (int j = 0; j < 4; ++j) { const f32x4 a = *(const f32x4*)(conv_w + j * 2048 + cch0), b = *(const f32x4*)(conv_w + j * 2048 + cch0 + 4);
        w[j][0] = a[0]; w[j][1] = a[1]; w[j][2] = a[2]; w[j][3] = a[3]; w[j][4] = b[0]; w[j][5] = b[1]; w[j][6] = b[2]; w[j][7] = b[3]; }
    { const f32x4 a = *(const f32x4*)(conv_b + cch0), b = *(const f32x4*)(conv_b + cch0 + 4); cb[0] = a[0]; cb[1] = a[1]; cb[2] = a[2]; cb[3] = a[3]; cb[4] = b[0]; cb[5] = b[1]; cb[6] = b[2]; cb[7] = b[3]; }
    v4u raw[19];
    const bf16* src = PROJ0 + ((size_t)t0 + 16 * tg) * NPROJ0 + C0_XBC + cch0;
    const bool pad = first_chunk && tg == 0;
#pragma unroll
    for (int i = 0; i < 19; ++i) { if (i < 3 && pad) raw[i] = (v4u){0u, 0u, 0u, 0u}; else raw[i] = *(const v4u*)(src + (ptrdiff_t)(i - 3) * NPROJ0); }
    const float alast = ACSr[127];
#pragma unroll
    for (int k = 0; k < 16; ++k) { const int s = 16 * tg + k;
        float sc = 1.f; if (mode == 0) sc = DTSr[s] * __expf(alast - ACSr[s]); else if (mode == 1) sc = DTSr[s];
        float o[8];
#pragma unroll
        for (int c = 0; c < 8; ++c) { float v = cb[c];
#pragma unroll
            for (int j = 0; j < 4; ++j) { const unsigned d = raw[k + j][c >> 1]; v += w[j][c] * ((c & 1) ? __uint_as_float(d & 0xffff0000u) : __uint_as_float(d << 16)); }
            o[c] = silu_f(v) * sc; }
        v4u ow; ow.x = pk2(o[0], o[1]); ow.y = pk2(o[2], o[3]); ow.z = pk2(o[4], o[5]); ow.w = pk2(o[6], o[7]);
        *(LAS v4u*)(dst + s * stride) = ow; }
}
constexpr int SA_BS = 0, SA_XS = 34816, SA_ACS = 102400, SA_DTS = 104448, SA_TMP = 106496;
__device__ __forceinline__ void ssdA_unit(ldsp lds, const bf16* PROJ0, const float* DT, const float* conv_w, const float* conv_b, const float* A_log, bf16* ST, float* CHDEC, int u, int tid, int lane, int wave) {
    asm volatile("" : "+v"(tid), "+v"(lane));
    const int g = u & 3, c = (u >> 2) & 63, b = u >> 8, t0 = b * SEQ + c * 128;
    const int fr = lane & 15, fq = lane >> 4, trq = (lane & 15) >> 2, trp = lane & 3;
    LAS float* ACS = (LAS float*)(lds + SA_ACS); LAS float* DTS = (LAS float*)(lds + SA_DTS); LAS float* TMP = (LAS float*)(lds + SA_TMP);
    ssd_dt_acs(DT, A_log, t0, g, ACS, DTS, TMP, tid);
    if (tid < 4) CHDEC[(b * 64 + c) * 16 + g * 4 + tid] = __expf(ACS[tid * 128 + 127]);
    if (tid < 384) { const int cg = tid % 48, tg = tid / 48; const bool isx = cg < 32; const int r = isx ? (cg >> 3) : 0;
        ssd_conv_group(PROJ0, conv_w, conv_b, t0, c == 0, isx ? g * 256 + 8 * cg : 1024 + g * 128 + 8 * (cg - 32), tg, isx ? 0 : 2,
                       isx ? lds + SA_XS + cg * 16 : lds + SA_BS + (cg - 32) * 16, isx ? 528 : 272, ACS + r * 128, DTS + r * 128); }
    __syncthreads();
    const int r = wave >> 1, half = wave & 1;
    f32x4 acc[2][8];
#pragma unroll
    for (int j = 0; j < 2; ++j)
#pragma unroll
        for (int n = 0; n < 8; ++n) acc[j][n] = (f32x4){0.f, 0.f, 0.f, 0.f};
    bf16x8 fa[2][2], fb[2][8];
#define SA_READ(ks_, buf_) do { _Pragma("unroll") for (int j = 0; j < 2; ++j) fa[buf_][j] = lds_frag_tr(lds + SA_XS + (32 * (ks_) + 8 * fq + trq) * 528 + (r * 64 + (2 * half + j) * 16 + 4 * trp) * 2, 528); \
        _Pragma("unroll") for (int n = 0; n < 8; ++n) fb[buf_][n] = lds_frag_tr(lds + SA_BS + (32 * (ks_) + 8 * fq + trq) * 272 + (n * 16 + 4 * trp) * 2, 272); } while (0)
    SA_READ(0, 0);
#pragma unroll
    for (int ks = 0; ks < 4; ++ks) {
        if (ks < 3) SA_READ(ks + 1, (ks + 1) & 1);
        __builtin_amdgcn_sched_barrier(0);
#pragma unroll
        for (int n = 0; n < 8; ++n) { MFMA16(acc[0][n], fa[ks & 1][0], fb[ks & 1][n]); MFMA16(acc[1][n], fa[ks & 1][1], fb[ks & 1][n]); }
        __builtin_amdgcn_sched_barrier(0);
    }
#undef SA_READ
    bf16* so = ST + ((size_t)((b * 64 + c) * 16 + g * 4 + r) * 64) * 128;
#pragma unroll
    for (int j = 0; j < 2; ++j)
#pragma unroll
        for (int n = 0; n < 8; ++n) { v2u w; w.x = pk2(acc[j][n][0], acc[j][n][1]); w.y = pk2(acc[j][n][2], acc[j][n][3]);
            *(v2u*)(so + (size_t)((2 * half + j) * 16 + fr) * 128 + n * 16 + 4 * fq) = w; }
    __syncthreads();
}
__device__ __forceinline__ void ssd_scan(bf16* ST, const float* CHDEC, int gtid, int gthreads) {
    for (int e = gtid; e < 131072; e += gthreads) {
        const int b = e >> 16, rem = e & 65535, h = rem >> 12, pn = rem & 4095;
        unsigned* p = (unsigned*)ST + ((size_t)(b * 64) * 16 + h) * 4096 + pn; const float* dp = CHDEC + (b * 64) * 16 + h;
        float c0 = 0.f, c1 = 0.f;
#pragma unroll 1
        for (int hf = 0; hf < 2; ++hf) {
            unsigned v[32]; unsigned* pb = p + (size_t)hf * 32 * 16 * 4096;
            { const unsigned* q = pb;
#pragma unroll
              for (int c = 0; c < 32; ++c) { v[c] = *q; q += 16 * 4096; asm volatile("" : "+v"(q)); } }
#pragma unroll
            for (int c = 0; c < 32; ++c) { const float dec = dp[(hf * 32 + c) * 16]; const unsigned o = pk2(c0, c1); c0 = c0 * dec + __uint_as_float(v[c] << 16); c1 = c1 * dec + __uint_as_float(v[c] & 0xffff0000u); v[c] = o; }
            { unsigned* q = pb;
#pragma unroll
              for (int c = 0; c < 32; ++c) { *q = v[c]; q += 16 * 4096; asm volatile("" : "+v"(q)); } }
        }
    }
}
constexpr int SC_CS = 0, SC_BS = 34816, SC_XS = 69632, SC_ACS = 137216, SC_DTS = 139264, SC_TMP = 141312, SC_SP = 143360;
template <int PV> __device__ __forceinline__ void ssdC_unit(ldsp lds, const bf16* PROJ0, bf16* OUT  , int opitch, const float* DT, const float* conv_w, const float* conv_b, const float* A_log, const float* Dskip, const float* ssd_norm,
                                          const bf16* ST, float* SSQ, int u, int tid, int lane, int wave) {
    asm volatile("" : "+v"(tid), "+v"(lane));
    const int g = u & 3, c = (u >> 2) & 63, b = u >> 8, t0 = b * SEQ + c * 128;
    const int fr = lane & 15, fq = lane >> 4, trq = (lane & 15) >> 2, trp = lane & 3;
    LAS float* ACS = (LAS float*)(lds + SC_ACS); LAS float* DTS = (LAS float*)(lds + SC_DTS); LAS float* TMP = (LAS float*)(lds + SC_TMP);
    if (!(PV & 1)) ssd_dt_acs(DT, A_log, t0, g, ACS, DTS, TMP, tid);
    if (!(PV & 2)) { const int cg = tid & 63, tg = tid >> 6; const bool isx = cg < 32, isb = cg < 48; const int r = isx ? (cg >> 3) : 0;
      ssd_conv_group(PROJ0, conv_w, conv_b, t0, c == 0, isx ? g * 256 + 8 * cg : (isb ? 1024 + g * 128 + 8 * (cg - 32) : 1536 + g * 128 + 8 * (cg - 48)), tg, isx ? 1 : 2,
                     isx ? lds + SC_XS + cg * 16 : (isb ? lds + SC_BS + (cg - 32) * 16 : lds + SC_CS + (cg - 48) * 16), isx ? 528 : 272, ACS + r * 128, DTS + r * 128); }
    __syncthreads();
    const int l = 16 * wave + fr;
    const ldsp crow = lds + SC_CS + l * 272 + 16 * fq, mrow = lds + SC_BS + l * 272 + 16 * fq;
    const bf16* prow = PROJ0 + (size_t)(t0 + l) * NPROJ0; bf16* orow = OUT + (size_t)(t0 + l) * opitch;
    v2u zw[4]; f32x4 nwn[4]; float dskn;
    v4u spr[2];
    const int sprow = tid >> 3, spch = tid & 7;
    { const bf16* sp = ST + ((size_t)((b * 64 + c) * 16 + g * 4) * 64) * 128;
#pragma unroll
      for (int i = 0; i < 2; ++i) spr[i] = *(const v4u*)(sp + (size_t)(sprow) * 128 + (spch + 8 * i) * 8);
#pragma unroll
      for (int p = 0; p < 4; ++p) { zw[p] = *(const v2u*)(prow + C0_Z + (g * 4) * 64 + 16 * p + 4 * fq); nwn[p] = *(const f32x4*)(ssd_norm + (g * 4) * 64 + 16 * p + 4 * fq); }
      dskn = Dskip[g * 4]; }
    f32x4 cb[8];
#pragma unroll
    for (int n = 0; n < 8; ++n) cb[n] = (f32x4){0.f, 0.f, 0.f, 0.f};
#pragma unroll
    for (int ks = 0; ks < 4; ++ks) { const bf16x8 af = lds_frag(crow + 64 * ks); bf16x8 bfr[8];
#pragma unroll
        for (int n = 0; n < 8; ++n) bfr[n] = lds_frag(lds + SC_BS + (16 * n + fr) * 272 + 64 * ks + 16 * fq);
        __builtin_amdgcn_sched_barrier(0);
#pragma unroll
        for (int n = 0; n < 8; ++n) MFMA16(cb[n], af, bfr[n]);
        __builtin_amdgcn_sched_barrier(0); }
    __syncthreads();
    float ssq = 0.f;
#pragma unroll 1
    for (int r = 0; r < ((PV & 4) ? 0 : 4); ++r) {
        const int h = g * 4 + r; const float al = ACS[r * 128 + l];
#pragma unroll
        for (int i = 0; i < 2; ++i) *(LAS v4u*)(lds + SC_SP + sprow * 272 + (spch + 8 * i) * 16) = spr[i];
        v2u zc[4]; f32x4 nwc[4]; const float dskc = dskn;
#pragma unroll
        for (int p = 0; p < 4; ++p) { zc[p] = zw[p]; nwc[p] = nwn[p]; }
        if (r < 3 && !(PV & 8)) {
            const bf16* sp = ST + ((size_t)((b * 64 + c) * 16 + h + 1) * 64) * 128;
#pragma unroll
            for (int i = 0; i < 2; ++i) spr[i] = *(const v4u*)(sp + (size_t)(sprow) * 128 + (spch + 8 * i) * 8);
#pragma unroll
            for (int p = 0; p < 4; ++p) { zw[p] = *(const v2u*)(prow + C0_Z + (h + 1) * 64 + 16 * p + 4 * fq); nwn[p] = *(const f32x4*)(ssd_norm + (h + 1) * 64 + 16 * p + 4 * fq); }
            dskn = Dskip[h + 1];
        }
        __syncthreads();
#pragma unroll
        for (int n = 0; n < 8; ++n) { const f32x4 as = *(const LAS f32x4*)(ACS + r * 128 + 16 * n + 4 * fq); float mv[4];
#pragma unroll
            for (int i = 0; i < 4; ++i) { const int s = 16 * n + 4 * fq + i; mv[i] = (s <= l) ? cb[n][i] * __expf(al - as[i]) : 0.f; }
            v2u w; w.x = pk2(mv[0], mv[1]); w.y = pk2(mv[2], mv[3]); *(LAS v2u*)(lds + SC_BS + l * 272 + (16 * n + 4 * fq) * 2) = w; }
        f32x4 y[4], yo[4];
#pragma unroll
        for (int p = 0; p < 4; ++p) { y[p] = (f32x4){0.f, 0.f, 0.f, 0.f}; yo[p] = y[p]; }
#pragma unroll
        for (int ks = 0; ks < 4; ++ks) { const bf16x8 af = lds_frag(mrow + 64 * ks);
            bf16x8 xf[4];
#pragma unroll
            for (int p = 0; p < 4; ++p) xf[p] = lds_frag_tr(lds + SC_XS + (32 * ks + 8 * fq + trq) * 528 + (r * 64 + 16 * p + 4 * trp) * 2, 528);
#pragma unroll
            for (int p = 0; p < 4; ++p) MFMA16(y[p], af, xf[p]); }
#pragma unroll
        for (int ks = 0; ks < 4; ++ks) { const bf16x8 cf = lds_frag(crow + 64 * ks); bf16x8 sf[4];
#pragma unroll
            for (int p = 0; p < 4; ++p) sf[p] = lds_frag(lds + SC_SP + (16 * p + fr) * 272 + 64 * ks + 16 * fq);
#pragma unroll
            for (int p = 0; p < 4; ++p) MFMA16(yo[p], cf, sf[p]); }
        __syncthreads();
        const float el = __expf(al), rdt = dskc / DTS[r * 128 + l];
#pragma unroll
        for (int p = 0; p < 4; ++p) { const int ch = h * 64 + 16 * p + 4 * fq;
            const v2u xw = *(const LAS v2u*)(lds + SC_XS + l * 528 + (r * 64 + 16 * p + 4 * fq) * 2); const f32x4 nw = nwc[p];
            const float z[4] = {__uint_as_float(zc[p].x << 16), __uint_as_float(zc[p].x & 0xffff0000u), __uint_as_float(zc[p].y << 16), __uint_as_float(zc[p].y & 0xffff0000u)};
            const float xs[4] = {__uint_as_float(xw.x << 16), __uint_as_float(xw.x & 0xffff0000u), __uint_as_float(xw.y << 16), __uint_as_float(xw.y & 0xffff0000u)};
            float o[4];
#pragma unroll
            for (int i = 0; i < 4; ++i) { float v = y[p][i] + el * yo[p][i] + rdt * xs[i]; v *= silu_f(z[i]); ssq += v * v; o[i] = v * nw[i]; }
            v2u w; w.x = pk2(o[0], o[1]); w.y = pk2(o[2], o[3]); if (!(PV & 16)) *(v2u*)(orow + ch) = w; else asm volatile("" :: "v"(w.x), "v"(w.y)); }
    }
    ssq += __shfl_xor(ssq, 16); ssq += __shfl_xor(ssq, 32);
    if (fq == 0) SSQ[(size_t)(t0 + l) * 4 + g] = ssq;
    __syncthreads();
}
__device__ __forceinline__ void ssd_normalize_rows(bf16* PROJ0, const float* SSQ, int gw, int NGW, int lane) {
    for (int m = gw; m < MTOK; m += NGW) {
        const f32x4 q = *(const f32x4*)(SSQ + (size_t)m * 4); const float r = 1.0f / sqrtf(((q.x + q.y) + (q.z + q.w)) * (1.f / 1024.f) + EPS);
        v4u* p = (v4u*)(PROJ0 + (size_t)m * NPROJ0 + C0_Z + 8 * lane); v4u w0 = p[0], w1 = p[64];
#pragma unroll
        for (int i = 0; i < 4; ++i) { w0[i] = pk2(__uint_as_float(w0[i] << 16) * r, __uint_as_float(w0[i] & 0xffff0000u) * r); w1[i] = pk2(__uint_as_float(w1[i] << 16) * r, __uint_as_float(w1[i] & 0xffff0000u) * r); }
        p[0] = w0; p[64] = w1;
    }
}

__device__ __forceinline__ float quad_max(float v) {
    auto a = __builtin_amdgcn_permlane16_swap(__float_as_uint(v), __float_as_uint(v), false, false); v = fmaxf(__uint_as_float(a[0]), __uint_as_float(a[1]));
    auto b = __builtin_amdgcn_permlane32_swap(__float_as_uint(v), __float_as_uint(v), false, false); return fmaxf(__uint_as_float(b[0]), __uint_as_float(b[1]));
}
__device__ __forceinline__ float quad_sum(float v) {
    auto a = __builtin_amdgcn_permlane16_swap(__float_as_uint(v), __float_as_uint(v), false, false); v = __uint_as_float(a[0]) + __uint_as_float(a[1]);
    auto b = __builtin_amdgcn_permlane32_swap(__float_as_uint(v), __float_as_uint(v), false, false); return __uint_as_float(b[0]) + __uint_as_float(b[1]);
}
__device__ __forceinline__ void glds16_asm(const void* gsrc, unsigned lds_dst) { unsigned keep;
    asm volatile("s_mov_b32 %0, m0\n\ts_mov_b32 m0, %2\n\ts_nop 0\n\tglobal_load_lds_dwordx4 %1, off\n\ts_mov_b32 m0, %0" : "=&s"(keep) : "v"(gsrc), "s"(lds_dst) : "memory"); }
#ifndef DA_NOFAST
#define DA_NOFAST 0
#endif
#ifndef DA_SGB
#define DA_SGB true
#endif
#ifndef DA_PAR
#define DA_PAR 0
#endif
constexpr int DB_K = 0, DB_V = 65536, DB_TSZ = 16384, DB_BT = 147456, DB_XCH = 0;
__device__ __forceinline__ bf16x8 lds_frag_tr2(ldsp p0, ldsp p1) {
    const v4i16_t lo = __builtin_amdgcn_ds_read_tr16_b64_v4i16((LAS v4i16_t*)p0);
    const v4i16_t hi = __builtin_amdgcn_ds_read_tr16_b64_v4i16((LAS v4i16_t*)p1);
    return (bf16x8){lo[0], lo[1], lo[2], lo[3], hi[0], hi[1], hi[2], hi[3]};
}
#define DB_BAR() do { __builtin_amdgcn_sched_barrier(0); asm volatile("s_waitcnt lgkmcnt(0)" ::: "memory"); __builtin_amdgcn_s_barrier(); asm volatile("" ::: "memory"); __builtin_amdgcn_sched_barrier(0); } while (0)
constexpr size_t WS_KMAX = 32 * 1024;
__device__ __forceinline__ void kmax_rows(const bf16* PROJ0, unsigned* KMAX, int gw, int NGW, int lane) {
#pragma unroll 1
    for (int b = 0; b < BATCH; ++b) {
        float mx = 0.f; int m = b * SEQ + (gw % NGW); while (m < b * SEQ) m += NGW;
        for (; m < (b + 1) * SEQ; m += NGW) {
            const v4u* p = (const v4u*)(PROJ0 + (size_t)m * NPROJ0 + C0_K + 16 * lane); const v4u w0 = p[0], w1 = p[1]; float ss = 0.f;
#pragma unroll
            for (int i = 0; i < 4; ++i) { const float a0 = __uint_as_float(w0[i] << 16), a1 = __uint_as_float(w0[i] & 0xffff0000u), b0 = __uint_as_float(w1[i] << 16), b1 = __uint_as_float(w1[i] & 0xffff0000u);
                ss += (a0 * a0 + a1 * a1) + (b0 * b0 + b1 * b1); }
            ss += __shfl_xor(ss, 1); ss += __shfl_xor(ss, 2); mx = fmaxf(mx, ss);
        }
        if ((lane & 3) == 0) atomicMax(KMAX + b * 16 + (lane >> 2), __float_as_uint(mx));
    }
}
template <int PVAR> __device__ __forceinline__ void dattn5_unit(ldsp lds, const bf16* PROJ0, bf16* OUT  , int opitch, const float* rel_bias, const float* diff_norm, const unsigned* KMAX, float lam,
                                                                int b, int h, int qb, int tid, int lane, int wave, const float* SSQ  ) {
    asm volatile("" : "+v"(tid), "+v"(lane));
    const int fr = lane & 15, fq = lane >> 4, trq = (lane & 15) >> 2, trp = lane & 3;
    const int m = wave >> 2, rg = wave & 3;
    const size_t rowbase = (size_t)b * SEQ; const int q0 = qb * 128, row0 = q0 + 32 * rg;
    const int nt = 2 * qb + 2;
    const bf16* kvb = PROJ0 + rowbase * NPROJ0 + h * 128;
    const bf16* ksrc[2]; const bf16* vsrc[2];
#pragma unroll
    for (int i = 0; i < 2; ++i) { const int key = 4 * (wave + 8 * i) + (lane >> 4), slot = lane & 15;
        ksrc[i] = kvb + (size_t)key * NPROJ0 + C0_K + ((slot ^ (key & 15)) * 8); vsrc[i] = kvb + (size_t)key * NPROJ0 + C0_V + ((slot ^ ((key & 7) << 1)) * 8); }
    int kw = 0, vw = 0;
    const unsigned lds0 = (unsigned)(size_t)lds;
#define DB_DMAK(t) do { _Pragma("unroll") for (int i_ = 0; i_ < 2; ++i_) \
        glds16_asm(ksrc[i_] + (size_t)(64 * (t)) * NPROJ0, (unsigned)__builtin_amdgcn_readfirstlane((int)(lds0 + DB_K + kw * DB_TSZ + (wave + 8 * i_) * 1024))); \
        kw = (kw + 1) & 3; } while (0)
#define DB_DMAV(t) do { _Pragma("unroll") for (int i_ = 0; i_ < 2; ++i_) \
        glds16_asm(vsrc[i_] + (size_t)(64 * (t)) * NPROJ0, (unsigned)__builtin_amdgcn_readfirstlane((int)(lds0 + DB_V + vw * DB_TSZ + (wave + 8 * i_) * 1024))); \
        vw = (vw == 4) ? 0 : vw + 1; } while (0)
    DB_DMAK(0); DB_DMAV(0); DB_DMAK(1); DB_DMAV(1); if (nt > 2) { DB_DMAK(2); DB_DMAV(2); } if (nt > 3) DB_DMAK(3);
    const float SC = 0.125f * LOG2E, c31 = rel_bias[31 * 8 + h] * LOG2E;
    bf16x8 qf[2][2]; float qss[2] = {0.f, 0.f};
#pragma unroll
    for (int rt = 0; rt < 2; ++rt)
#pragma unroll
        for (int ks = 0; ks < 2; ++ks) { const v4u raw = *(const v4u*)(PROJ0 + (rowbase + row0 + 16 * rt + fr) * NPROJ0 + C0_Q + h * 128 + m * 64 + ks * 32 + fq * 8); v4u sc;
#pragma unroll
            for (int i = 0; i < 4; ++i) { sc[i] = pk2(__uint_as_float(raw[i] << 16) * SC, __uint_as_float(raw[i] & 0xffff0000u) * SC);
                const float r0 = __uint_as_float(sc[i] << 16), r1 = __uint_as_float(sc[i] & 0xffff0000u); qss[rt] += r0 * r0 + r1 * r1; }
            qf[rt][ks] = __builtin_bit_cast(bf16x8, sc); }
    LAS float* BT = (LAS float*)(lds + DB_BT);
    if (tid < 128) BT[tid] = (rel_bias[t5_bucket(tid) * 8 + h] - rel_bias[31 * 8 + h]) * LOG2E;
    float bmax = rel_bias[h];
#pragma unroll 1
    for (int k = 1; k < 32; ++k) bmax = fmaxf(bmax, rel_bias[k * 8 + h]);
    const float kmx = sqrtf(__uint_as_float(KMAX[(b * 8 + h) * 2 + m]));
    f32x4 cmv[2];
#pragma unroll
    for (int rt = 0; rt < 2; ++rt) { const float c = c31 - (sqrtf(quad_sum(qss[rt])) * kmx * 1.001f + bmax * LOG2E + 0.01f); cmv[rt] = (f32x4){c, c, c, c}; }
    f32x4 o[2][9], s[2][4], sn[2][4]; v4u pk[2][2];
#pragma unroll
    for (int rt = 0; rt < 2; ++rt) {
#pragma unroll
        for (int e = 0; e < 9; ++e) o[rt][e] = (f32x4){0.f, 0.f, 0.f, 0.f};
#pragma unroll
        for (int k2 = 0; k2 < 2; ++k2) pk[rt][k2] = (v4u){0u, 0u, 0u, 0u}; }
    const bf16x8 ones = {0x3F80, 0x3F80, 0x3F80, 0x3F80, 0x3F80, 0x3F80, 0x3F80, 0x3F80};
    const int vswz = ((4 * (fq & 1) + trq) << 1);
    const int vlane = (4 * fq + trq) * 256 + trp * 8;
    int vco[8], kx[2];
#pragma unroll
    for (int e = 0; e < 8; ++e) vco[e] = vlane + (((2 * e) ^ vswz) * 16);
#pragma unroll
    for (int ks = 0; ks < 2; ++ks) kx[ks] = fr * 256 + (((m * 8 + ks * 4 + fq) ^ fr) * 16);
    asm volatile("s_waitcnt vmcnt(0)" ::: "memory");
    DB_BAR();
    int kr = 0, vr = 0;
#define DA_SMAT(DST) do { const ldsp kbuf_ = lds + DB_K + kr * DB_TSZ; kr = (kr + 1) & 3; \
        _Pragma("unroll") for (int n_ = 0; n_ < 4; ++n_) { \
            const bf16x8 k0_ = lds_frag(kbuf_ + kx[0] + n_ * 4096), k1_ = lds_frag(kbuf_ + kx[1] + n_ * 4096); \
            _Pragma("unroll") for (int rt_ = 0; rt_ < 2; ++rt_) { DST[rt_][n_] = __builtin_amdgcn_mfma_f32_16x16x32_bf16(k0_, qf[rt_][0], cmv[rt_], 0, 0, 0); MFMA16(DST[rt_][n_], qf[rt_][1], k1_); } } } while (0)
    DA_SMAT(s);
#define DA_BODY(T_, FAR_, PV_, SN_, SA, SB) do { \
        const bool dmak_ = ((T_) + 4 < nt) && !(PVAR & 1), dmav_ = ((T_) + 3 < nt) && !(PVAR & 1); \
        if (dmak_) DB_DMAK((T_) + 4); \
        if (dmav_) DB_DMAV((T_) + 3); \
        if ((SN_) && !(PVAR & 4)) DA_SMAT(SB); \
        if ((PV_) && !(PVAR & 4)) { \
            const ldsp vb_ = lds + DB_V + vr * DB_TSZ; vr = (vr == 4) ? 0 : vr + 1; \
            _Pragma("unroll") for (int k2 = 0; k2 < 2; ++k2) { \
                _Pragma("unroll") for (int e = 0; e < 8; ++e) { const bf16x8 vf = lds_frag_tr2(vb_ + vco[e] + (32 * k2) * 256, vb_ + vco[e] + (32 * k2 + 16) * 256); \
                    MFMA16(o[0][e], __builtin_bit_cast(bf16x8, pk[0][k2]), vf); MFMA16(o[1][e], __builtin_bit_cast(bf16x8, pk[1][k2]), vf); } \
                MFMA16(o[0][8], __builtin_bit_cast(bf16x8, pk[0][k2]), ones); MFMA16(o[1][8], __builtin_bit_cast(bf16x8, pk[1][k2]), ones); } \
        } \
        if (!(PVAR & 2)) { \
            const int k0 = 64 * (T_); \
            _Pragma("unroll") for (int rt = 0; rt < 2; ++rt) { \
                if (FAR_) { \
                    _Pragma("unroll") for (int n = 0; n < 4; ++n) \
                        _Pragma("unroll") for (int i = 0; i < 4; ++i) SA[rt][n][i] = __builtin_amdgcn_exp2f(SA[rt][n][i]); \
                } else { \
                    const int row = row0 + 16 * rt + fr; \
                    _Pragma("unroll") for (int n = 0; n < 4; ++n) \
                        _Pragma("unroll") for (int i = 0; i < 4; ++i) { const int dist = row - (k0 + 16 * n + 4 * fq + i); const int di = min(max(dist, 0), 127); const float bb = BT[di]; \
                            const float pen = dist < 0 ? -INFINITY : 0.f; SA[rt][n][i] = __builtin_amdgcn_exp2f((SA[rt][n][i] + bb) + pen); } \
                } \
            } \
        } \
        _Pragma("unroll") for (int rt = 0; rt < 2; ++rt) \
            _Pragma("unroll") for (int k2 = 0; k2 < 2; ++k2) { pk[rt][k2].x = pk2(SA[rt][2 * k2][0], SA[rt][2 * k2][1]); pk[rt][k2].y = pk2(SA[rt][2 * k2][2], SA[rt][2 * k2][3]); \
                pk[rt][k2].z = pk2(SA[rt][2 * k2 + 1][0], SA[rt][2 * k2 + 1][1]); pk[rt][k2].w = pk2(SA[rt][2 * k2 + 1][2], SA[rt][2 * k2 + 1][3]); } \
        if (dmak_) asm volatile("s_waitcnt vmcnt(10)" ::: "memory"); else asm volatile("s_waitcnt vmcnt(0)" ::: "memory"); \
        asm volatile("s_waitcnt lgkmcnt(0)" ::: "memory"); __builtin_amdgcn_s_barrier(); asm volatile("" ::: "memory"); \
    } while (0)
#define DA_FAST(T_, SA, SB) do { \
        if (!(PVAR & 1)) { DB_DMAK((T_) + 4); DB_DMAV((T_) + 3); } \
        const ldsp vb_ = lds + DB_V + vr * DB_TSZ; vr = (vr == 4) ? 0 : vr + 1; \
        const ldsp kb_ = lds + DB_K + kr * DB_TSZ; kr = (kr + 1) & 3; \
        bf16x8 vfr[3], kfr[4]; \
        vfr[0] = lds_frag_tr2(vb_ + vco[0], vb_ + vco[0] + 16 * 256); vfr[1] = lds_frag_tr2(vb_ + vco[1], vb_ + vco[1] + 16 * 256); \
        __builtin_amdgcn_sched_barrier(0); \
        _Pragma("unroll") for (int g = 0; g < 52; ++g) { \
            if (g < 32) { const int f = g >> 1, rt = g & 1, k2 = f >> 3, e = f & 7; MFMA16(o[rt][e], __builtin_bit_cast(bf16x8, pk[rt][k2]), vfr[f % 3]); } \
            else if (g < 36) { const int jj = g - 32, rt = jj & 1, k2 = jj >> 1; MFMA16(o[rt][8], __builtin_bit_cast(bf16x8, pk[rt][k2]), ones); } \
            else { const int jj = g - 36, n = jj >> 2, ks = (jj >> 1) & 1, rt = jj & 1; \
                if (ks == 0) SB[rt][n] = __builtin_amdgcn_mfma_f32_16x16x32_bf16(kfr[(n * 2 + ks) & 3], qf[rt][ks], cmv[rt], 0, 0, 0); \
                else MFMA16(SB[rt][n], qf[rt][ks], kfr[(n * 2 + ks) & 3]); } \
            if (g >= 2 && g < 34) { const int jj = g - 2, rt = jj >> 4, n = (jj >> 2) & 3, i = jj & 3; SA[rt][n][i] = __builtin_amdgcn_exp2f(SA[rt][n][i]); } \
            if (g >= 36) { const int q_ = g - 36, rt = q_ >> 3, k2 = (q_ >> 2) & 1, w = q_ & 3; pk[rt][k2][w] = pk2(SA[rt][2 * k2 + (w >> 1)][2 * (w & 1)], SA[rt][2 * k2 + (w >> 1)][2 * (w & 1) + 1]); } \
            if (g < 32 && !(g & 1) && (g >> 1) + 2 < 16) { const int f = (g >> 1) + 2, k2 = f >> 3, e = f & 7; vfr[f % 3] = lds_frag_tr2(vb_ + vco[e] + (32 * k2) * 256, vb_ + vco[e] + (32 * k2 + 16) * 256); } \
            if (g >= 30 && g < 46 && !(g & 1)) { const int c_ = (g - 30) >> 1, n = c_ >> 1, ks = c_ & 1; kfr[c_ & 3] = lds_frag(kb_ + kx[ks] + n * 4096); } \
            __builtin_amdgcn_sched_barrier(0); \
        } \
        if (!(PVAR & 1)) asm volatile("s_waitcnt vmcnt(10)" ::: "memory"); \
        asm volatile("s_waitcnt lgkmcnt(0)" ::: "memory"); __builtin_amdgcn_s_barrier(); asm volatile("" ::: "memory"); \
    } while (0)
    int t = 0;
#define DA_COPY() do { _Pragma("unroll") for (int rt = 0; rt < 2; ++rt) _Pragma("unroll") for (int n = 0; n < 4; ++n) s[rt][n] = sn[rt][n]; } while (0)
    if (nt >= 6) {
        DA_BODY(0, true, false, true, s, sn); DA_COPY();
        for (t = 1; t + 1 <= nt - 5; t += 2) { DA_FAST(t, s, sn); DA_FAST(t + 1, sn, s); }
        if (t <= nt - 5) { DA_FAST(t, s, sn); DA_COPY(); ++t; }
    }
    for (; t < nt; ++t) { const bool far = (q0 - 64 * t - 63) >= 113; DA_BODY(t, far, t > 0, t + 1 < nt, s, sn); DA_COPY(); }
#undef DA_COPY
#undef DA_BODY
#undef DA_FAST
    if (!(PVAR & 4)) {
        const ldsp vb_ = lds + DB_V + vr * DB_TSZ;
#pragma unroll
        for (int k2 = 0; k2 < 2; ++k2) {
#pragma unroll
            for (int e = 0; e < 8; ++e) { const bf16x8 vf = lds_frag_tr2(vb_ + vco[e] + (32 * k2) * 256, vb_ + vco[e] + (32 * k2 + 16) * 256);
                MFMA16(o[0][e], __builtin_bit_cast(bf16x8, pk[0][k2]), vf); MFMA16(o[1][e], __builtin_bit_cast(bf16x8, pk[1][k2]), vf); }
            MFMA16(o[0][8], __builtin_bit_cast(bf16x8, pk[0][k2]), ones); MFMA16(o[1][8], __builtin_bit_cast(bf16x8, pk[1][k2]), ones); }
    }
    asm volatile("s_waitcnt lgkmcnt(0)" ::: "memory"); __builtin_amdgcn_s_barrier(); asm volatile("" ::: "memory");
#undef DB_DMAK
#undef DB_DMAV
#undef DA_SMAT
    float inv[2];
#pragma unroll
    for (int rt = 0; rt < 2; ++rt) inv[rt] = 1.0f / o[rt][8][0];
    LAS float* XCH = (LAS float*)(lds + DB_XCH) + rg * (32 * 132);
    if (m == 1) {
#pragma unroll
        for (int rt = 0; rt < 2; ++rt) { const float f = lam * inv[rt];
#pragma unroll
            for (int e = 0; e < 8; ++e) *(LAS f32x4*)(XCH + (16 * rt + fr) * 132 + 16 * e + 4 * fq) = o[rt][e] * f; }
    }
    __syncthreads();
    if (m == 0) {
        f32x4 dnw[8];
#pragma unroll
        for (int e = 0; e < 8; ++e) dnw[e] = *(const f32x4*)(diff_norm + 16 * e + 4 * fq);
        f32x4 sq[2] = {(f32x4){0.f, 0.f, 0.f, 0.f}, (f32x4){0.f, 0.f, 0.f, 0.f}};
        if (SSQ) {
#pragma unroll
            for (int rt = 0; rt < 2; ++rt) sq[rt] = *(const f32x4*)(SSQ + (size_t)(rowbase + row0 + 16 * rt + fr) * 4); }
#pragma unroll
        for (int rt = 0; rt < 2; ++rt) { float ssq = 0.f;
#pragma unroll
            for (int e = 0; e < 8; ++e) { const f32x4 x2 = *(const LAS f32x4*)(XCH + (16 * rt + fr) * 132 + 16 * e + 4 * fq); const f32x4 v = o[rt][e] * inv[rt] - x2; o[rt][e] = v;
                ssq += (v[0] * v[0] + v[1] * v[1]) + (v[2] * v[2] + v[3] * v[3]); }
            ssq = quad_sum(ssq);
            float rs = 0.8f / sqrtf(ssq * (1.f / 128.f) + EPS);
            if (SSQ) rs *= sqrtf(((sq[rt][0] + sq[rt][1]) + (sq[rt][2] + sq[rt][3])) * (1.f / 1024.f) + EPS);
            bf16* orow = OUT + (rowbase + row0 + 16 * rt + fr) * opitch + h * 128;
#pragma unroll
            for (int e = 0; e < 8; ++e) { const f32x4 dn = dnw[e]; v2u w;
                w.x = pk2(o[rt][e][0] * rs * dn[0], o[rt][e][1] * rs * dn[1]); w.y = pk2(o[rt][e][2] * rs * dn[2], o[rt][e][3] * rs * dn[3]);
                *(v2u*)(orow + 16 * e + 4 * fq) = w; } }
    }
    __syncthreads();
}

constexpr int SW_KS = 0, SW_VS = 36864, SW_BT = 73728;
__device__ __forceinline__ void swa_unit(ldsp lds, const bf16* PROJ1, bf16* OUT  , int opitch, const float* rel_bias, const float* sinks, int b, int blk, int g, int tid, int lane, int wave) {
    asm volatile("" : "+v"(tid), "+v"(lane));
    const int fr = lane & 15, fq = lane >> 4, trq = (lane & 15) >> 2, trp = lane & 3;
    const size_t rowbase = (size_t)b * SEQ; const int qi = 16 * wave + fr;
    const bf16* prow = PROJ1 + (rowbase + blk * 128 + qi) * NPROJ1; bf16* orow = OUT + (rowbase + blk * 128 + qi) * opitch;
    bf16x8 qn[2];
#pragma unroll
    for (int ks = 0; ks < 2; ++ks) qn[ks] = *(const bf16x8*)(prow + C1_SQ + (4 * g) * 64 + ks * 32 + fq * 8);
    LAS float* BT = (LAS float*)(lds + SW_BT);
    { const int r = tid >> 7, d = tid & 127; BT[tid] = rel_bias[t5_bucket(d) * 8 + 4 * g + r] * LOG2E; }
#pragma unroll
    for (int i = 0; i < 4; ++i) { const int idx = tid + 512 * i, key = idx >> 3, ch = idx & 7; const int kp = blk * 128 - 128 + key;
        v4u kv = {0u, 0u, 0u, 0u}, vv = kv;
        if (kp >= 0) { const bf16* p = PROJ1 + (rowbase + kp) * NPROJ1 + g * 64 + ch * 8; kv = *(const v4u*)(p + C1_SK); vv = *(const v4u*)(p + C1_SV); }
        *(LAS v4u*)(lds + SW_KS + key * 144 + ch * 16) = kv; *(LAS v4u*)(lds + SW_VS + key * 144 + ch * 16) = vv; }
    __syncthreads();
    const float SC = 0.125f * LOG2E;
#pragma unroll 1
    for (int r = 0; r < 4; ++r) {
        const float skr = sinks[4 * g + r] * LOG2E;
        bf16x8 qc[2] = {qn[0], qn[1]};
        if (r < 3) {
#pragma unroll
            for (int ks = 0; ks < 2; ++ks) qn[ks] = *(const bf16x8*)(prow + C1_SQ + (4 * g + r + 1) * 64 + ks * 32 + fq * 8); }
        f32x4 s[10];
#pragma unroll
        for (int nn = 0; nn < 9; ++nn) { const int n = wave + nn; bf16x8 kf[2];
#pragma unroll
            for (int ks = 0; ks < 2; ++ks) kf[ks] = lds_frag(lds + SW_KS + (16 * n + fr) * 144 + (ks * 32 + fq * 8) * 2);
            s[nn] = (f32x4){0.f, 0.f, 0.f, 0.f}; MFMA16(s[nn], qc[0], kf[0]); MFMA16(s[nn], qc[1], kf[1]); }
        s[9] = (f32x4){0.f, 0.f, 0.f, 0.f};
        float mx = skr;
#pragma unroll
        for (int nn = 0; nn < 9; ++nn)
#pragma unroll
            for (int i = 0; i < 4; ++i) { const int j = 16 * (wave + nn) + 4 * fq + i, dist = qi + 128 - j; const bool valid = (dist >= 0) && (dist < 128) && (blk * 128 - 128 + j >= 0);
                const float bb = BT[r * 128 + min(max(dist, 0), 127)]; const float pen = valid ? 0.f : -INFINITY; const float v = (s[nn][i] * SC + bb) + pen; s[nn][i] = v; mx = fmaxf(mx, v); }
        mx = quad_max(mx);
        float psum = 0.f;
#pragma unroll
        for (int nn = 0; nn < 9; ++nn)
#pragma unroll
            for (int i = 0; i < 4; ++i) { const float p = __builtin_amdgcn_exp2f(s[nn][i] - mx); s[nn][i] = p; psum += p; }
        const float il = 1.0f / (quad_sum(psum) + __builtin_amdgcn_exp2f(skr - mx));
        f32x4 o[4];
#pragma unroll
        for (int e = 0; e < 4; ++e) o[e] = (f32x4){0.f, 0.f, 0.f, 0.f};
#pragma unroll
        for (int k2 = 0; k2 < 5; ++k2) { v4u pkv; pkv.x = pk2(s[2 * k2][0] * il, s[2 * k2][1] * il); pkv.y = pk2(s[2 * k2][2] * il, s[2 * k2][3] * il);
            pkv.z = pk2(s[2 * k2 + 1][0] * il, s[2 * k2 + 1][1] * il); pkv.w = pk2(s[2 * k2 + 1][2] * il, s[2 * k2 + 1][3] * il);
            const int r0 = 16 * (wave + 2 * k2) + 4 * fq + trq, r1 = min(r0 + 16, 255);
#pragma unroll
            for (int e = 0; e < 4; ++e) { const bf16x8 vf = lds_frag_tr2(lds + SW_VS + r0 * 144 + (16 * e + 4 * trp) * 2, lds + SW_VS + r1 * 144 + (16 * e + 4 * trp) * 2);
                MFMA16(o[e], __builtin_bit_cast(bf16x8, pkv), vf); } }
#pragma unroll
        for (int e = 0; e < 4; ++e) { v2u w; w.x = pk2(o[e][0], o[e][1]); w.y = pk2(o[e][2], o[e][3]); *(v2u*)(orow + (4 * g + r) * 64 + 16 * e + 4 * fq) = w; }
    }
    __syncthreads();
}

__device__ __forceinline__ float ret_log2_gamma(int h) { return log2f(1.0f - exp2f(-5.0f - (float)h)); }
__device__ __forceinline__ void rope_row_store(const bf16* src  , const float* COS, const float* SIN, int pos, int q4, float scale, ldsp dst) {
    v4u lo[2], hi[2];
#pragma unroll
    for (int i = 0; i < 2; ++i) { lo[i] = *(const v4u*)(src + 16 * q4 + 8 * i); hi[i] = *(const v4u*)(src + 64 + 16 * q4 + 8 * i); }
    const float* cp = COS + (size_t)pos * 64 + 16 * q4; const float* sp = SIN + (size_t)pos * 64 + 16 * q4;
#pragma unroll
    for (int i = 0; i < 2; ++i) { v4u ol, oh;
#pragma unroll
        for (int j = 0; j < 4; ++j) { const f32x4 cc = *(const f32x4*)(cp + 8 * i + 4 * (j >> 1)), ss = *(const f32x4*)(sp + 8 * i + 4 * (j >> 1));
            const float c0 = cc[2 * (j & 1)], c1 = cc[2 * (j & 1) + 1], s0 = ss[2 * (j & 1)], s1 = ss[2 * (j & 1) + 1];
            const float a0 = __uint_as_float(lo[i][j] << 16), a1 = __uint_as_float(lo[i][j] & 0xffff0000u), b0 = __uint_as_float(hi[i][j] << 16), b1 = __uint_as_float(hi[i][j] & 0xffff0000u);
            ol[j] = pk2((a0 * c0 - b0 * s0) * scale, (a1 * c1 - b1 * s1) * scale); oh[j] = pk2((a0 * s0 + b0 * c0) * scale, (a1 * s1 + b1 * c1) * scale); }
        *(LAS v4u*)(dst + (16 * q4 + 8 * i) * 2) = ol; *(LAS v4u*)(dst + (64 + 16 * q4 + 8 * i) * 2) = oh; }
}
constexpr int RA_VS = 0, RA_KS = 67584;
__device__ __forceinline__ void retA_unit(ldsp lds, const bf16* PROJ1, const float* COS, const float* SIN, bf16* ST, int u, int tid, int lane, int wave) {
    asm volatile("" : "+v"(tid), "+v"(lane));
    const int h = u & 3, c = (u >> 2) & 63, b = u >> 8, t0 = b * SEQ + c * 128;
    const int fr = lane & 15, fq = lane >> 4, trq = (lane & 15) >> 2, trp = lane & 3;
    const float lg = ret_log2_gamma(h);
#pragma unroll
    for (int i = 0; i < 8; ++i) { const int idx = tid + 512 * i, rw = idx >> 5, ch = idx & 31;
        *(LAS v4u*)(lds + RA_VS + rw * 528 + ch * 16) = *(const v4u*)(PROJ1 + (size_t)(t0 + rw) * NPROJ1 + C1_RV + h * 256 + ch * 8); }
    { const int s = tid >> 2, q4 = tid & 3;
      rope_row_store(PROJ1 + (size_t)(t0 + s) * NPROJ1 + C1_RK + h * 128, COS, SIN, c * 128 + s, q4, 0.08838834764831845f * exp2f((float)(127 - s) * lg), lds + RA_KS + s * 272); }
    __syncthreads();
    f32x4 acc[2][8];
#pragma unroll
    for (int j = 0; j < 2; ++j)
#pragma unroll
        for (int n = 0; n < 8; ++n) acc[j][n] = (f32x4){0.f, 0.f, 0.f, 0.f};
    bf16x8 fa[2][2], fb[2][8];
#define RA_READ(ks_, buf_) do { _Pragma("unroll") for (int j = 0; j < 2; ++j) fa[buf_][j] = lds_frag_tr(lds + RA_VS + (32 * (ks_) + 8 * fq + trq) * 528 + ((2 * wave + j) * 16 + 4 * trp) * 2, 528); \
        _Pragma("unroll") for (int n = 0; n < 8; ++n) fb[buf_][n] = lds_frag_tr(lds + RA_KS + (32 * (ks_) + 8 * fq + trq) * 272 + (n * 16 + 4 * trp) * 2, 272); } while (0)
    RA_READ(0, 0);
#pragma unroll
    for (int ks = 0; ks < 4; ++ks) {
        if (ks < 3) RA_READ(ks + 1, (ks + 1) & 1);
        __builtin_amdgcn_sched_barrier(0);
#pragma unroll
        for (int n = 0; n < 8; ++n) { MFMA16(acc[0][n], fa[ks & 1][0], fb[ks & 1][n]); MFMA16(acc[1][n], fa[ks & 1][1], fb[ks & 1][n]); }
        __builtin_amdgcn_sched_barrier(0);
    }
#undef RA_READ
    bf16* so = ST + ((size_t)((b * 64 + c) * 4 + h) * 256) * 128;
#pragma unroll
    for (int j = 0; j < 2; ++j)
#pragma unroll
        for (int n = 0; n < 8; ++n) { v2u w; w.x = pk2(acc[j][n][0], acc[j][n][1]); w.y = pk2(acc[j][n][2], acc[j][n][3]);
            *(v2u*)(so + (size_t)((2 * wave + j) * 16 + fr) * 128 + n * 16 + 4 * fq) = w; }
    __syncthreads();
}
__device__ __forceinline__ void ret_scan(bf16* ST, int gtid, int gthreads) {
    for (int e = gtid; e < 131072; e += gthreads) {
        const int b = e >> 16, rem = e & 65535, h = rem >> 14, ed = rem & 16383;
        unsigned* p = (unsigned*)ST + ((size_t)(b * 64) * 4 + h) * 16384 + ed; const float dec = exp2f(128.0f * ret_log2_gamma(h));
        float c0 = 0.f, c1 = 0.f;
#pragma unroll 1
        for (int hf = 0; hf < 2; ++hf) {
            unsigned v[32]; unsigned* pb = p + (size_t)hf * 32 * 4 * 16384;
            { const unsigned* q = pb;
#pragma unroll
              for (int c = 0; c < 32; ++c) { v[c] = *q; q += 4 * 16384; asm volatile("" : "+v"(q)); } }
#pragma unroll
            for (int c = 0; c < 32; ++c) { const unsigned o = pk2(c0, c1); c0 = c0 * dec + __uint_as_float(v[c] << 16); c1 = c1 * dec + __uint_as_float(v[c] & 0xffff0000u); v[c] = o; }
            { unsigned* q = pb;
#pragma unroll
              for (int c = 0; c < 32; ++c) { *q = v[c]; q += 4 * 16384; asm volatile("" : "+v"(q)); } }
        }
    }
}
constexpr int RC_KS = 0, RC_VS = 34816, RC_SP = 102400;
template <int PV> __device__ __forceinline__ void retC_unit(ldsp lds, const bf16* PROJ1, bf16* OUT  , int opitch, const float* COS, const float* SIN, const bf16* ST, int u, int tid, int lane, int wave) {
    asm volatile("" : "+v"(tid), "+v"(lane));
    const int h = u & 3, c = (u >> 2) & 63, b = u >> 8, t0 = b * SEQ + c * 128;
    const int fr = lane & 15, fq = lane >> 4, trq = (lane & 15) >> 2, trp = lane & 3;
    const float lg = ret_log2_gamma(h);
    const int l = 16 * wave + fr; const bf16* prow = PROJ1 + (size_t)(t0 + l) * NPROJ1; bf16* orow = OUT + (size_t)(t0 + l) * opitch;
    if (!(PV & 1)) {
#pragma unroll
    for (int i = 0; i < 8; ++i) { const int idx = tid + 512 * i, rw = idx >> 5, ch = idx & 31;
        *(LAS v4u*)(lds + RC_VS + rw * 528 + ch * 16) = *(const v4u*)(PROJ1 + (size_t)(t0 + rw) * NPROJ1 + C1_RV + h * 256 + ch * 8); }
    }
    if (!(PV & 1)) { const int s = tid >> 2, q4 = tid & 3;
      rope_row_store(PROJ1 + (size_t)(t0 + s) * NPROJ1 + C1_RK + h * 128, COS, SIN, c * 128 + s, q4, 0.08838834764831845f, lds + RC_KS + s * 272); }
    bf16x8 qf[4], qx[4];
    { v4u raw[4];
#pragma unroll
      for (int ks = 0; ks < 4; ++ks) raw[ks] = *(const v4u*)(prow + C1_RQ + h * 128 + 32 * ks + 8 * fq);
      const float xi = exp2f((float)(l + 1) * lg);
#pragma unroll
      for (int k2 = 0; k2 < 2; ++k2) { const float* cp = COS + (size_t)(c * 128 + l) * 64 + 32 * k2 + 8 * fq; const float* sp = SIN + (size_t)(c * 128 + l) * 64 + 32 * k2 + 8 * fq;
          v4u o1, o2, x1, x2;
#pragma unroll
          for (int j = 0; j < 4; ++j) { const f32x4 cc = *(const f32x4*)(cp + 4 * (j >> 1)), ss = *(const f32x4*)(sp + 4 * (j >> 1));
              const float c0 = cc[2 * (j & 1)], c1 = cc[2 * (j & 1) + 1], s0 = ss[2 * (j & 1)], s1 = ss[2 * (j & 1) + 1];
              const float a0 = __uint_as_float(raw[k2][j] << 16), a1 = __uint_as_float(raw[k2][j] & 0xffff0000u), b0 = __uint_as_float(raw[k2 + 2][j] << 16), b1 = __uint_as_float(raw[k2 + 2][j] & 0xffff0000u);
              const float r10 = a0 * c0 - b0 * s0, r11 = a1 * c1 - b1 * s1, r20 = a0 * s0 + b0 * c0, r21 = a1 * s1 + b1 * c1;
              o1[j] = pk2(r10, r11); o2[j] = pk2(r20, r21); x1[j] = pk2(r10 * xi, r11 * xi); x2[j] = pk2(r20 * xi, r21 * xi); }
          qf[k2] = __builtin_bit_cast(bf16x8, o1); qf[k2 + 2] = __builtin_bit_cast(bf16x8, o2); qx[k2] = __builtin_bit_cast(bf16x8, x1); qx[k2 + 2] = __builtin_bit_cast(bf16x8, x2); } }
    __syncthreads();
    f32x4 sc[8];
#pragma unroll
    for (int n = 0; n < 8; ++n) { sc[n] = (f32x4){0.f, 0.f, 0.f, 0.f};
#pragma unroll
        for (int ks = 0; ks < 4; ++ks) { const bf16x8 kf = lds_frag(lds + RC_KS + (16 * n + fr) * 272 + 64 * ks + 16 * fq); MFMA16(sc[n], qf[ks], kf); } }
    __syncthreads();
#pragma unroll
    for (int n = 0; n < 8; ++n) { float mv[4];
#pragma unroll
        for (int i = 0; i < 4; ++i) { const int s = 16 * n + 4 * fq + i; mv[i] = (s <= l) ? sc[n][i] * __builtin_amdgcn_exp2f((float)(l - s) * lg) : 0.f; }
        v2u w; w.x = pk2(mv[0], mv[1]); w.y = pk2(mv[2], mv[3]); *(LAS v2u*)(lds + RC_KS + l * 272 + (16 * n + 4 * fq) * 2) = w; }
    f32x4 o[16];
#pragma unroll
    for (int e = 0; e < 16; ++e) o[e] = (f32x4){0.f, 0.f, 0.f, 0.f};
    v2u gts[16];
#pragma unroll
    for (int e = 0; e < 16; ++e) gts[e] = *(const v2u*)(prow + C1_RG + h * 256 + 16 * e + 4 * fq);
    const bf16* sp = ST + ((size_t)((b * 64 + c) * 4 + h) * 256) * 128;
    const int sprow = tid >> 2, spc = tid & 3;
    v4u spr[2];
#pragma unroll
    for (int i = 0; i < 2; ++i) spr[i] = *(const v4u*)(sp + (size_t)(sprow + 128 * i) * 128 + spc * 8);
#pragma unroll
    for (int ks = 0; ks < ((PV & 2) ? 0 : 4); ++ks) {
        const ldsp slot = lds + RC_SP + (ks & 1) * 20480;
#pragma unroll
        for (int i = 0; i < 2; ++i) *(LAS v4u*)(slot + (sprow + 128 * i) * 80 + spc * 16) = spr[i];
        if (ks < 3) {
#pragma unroll
            for (int i = 0; i < 2; ++i) spr[i] = *(const v4u*)(sp + (size_t)(sprow + 128 * i) * 128 + 32 * (ks + 1) + spc * 8); }
        __syncthreads();
        const bf16x8 mf = lds_frag(lds + RC_KS + l * 272 + 64 * ks + 16 * fq);
#pragma unroll
        for (int eh = 0; eh < 2; ++eh) { bf16x8 sf[8], vf[8];
#pragma unroll
            for (int e = 0; e < 8; ++e) { sf[e] = lds_frag(slot + (16 * (8 * eh + e) + fr) * 80 + 16 * fq);
                vf[e] = lds_frag_tr(lds + RC_VS + (32 * ks + 8 * fq + trq) * 528 + (16 * (8 * eh + e) + 4 * trp) * 2, 528); }
            __builtin_amdgcn_sched_barrier(0);
#pragma unroll
            for (int e = 0; e < 8; ++e) { MFMA16(o[8 * eh + e], qx[ks], sf[e]); MFMA16(o[8 * eh + e], mf, vf[e]); }
            __builtin_amdgcn_sched_barrier(0); }
    }
    float ssq = 0.f;
#pragma unroll
    for (int e = 0; e < 16; ++e) ssq += (o[e][0] * o[e][0] + o[e][1] * o[e][1]) + (o[e][2] * o[e][2] + o[e][3] * o[e][3]);
    ssq += __shfl_xor(ssq, 16); ssq += __shfl_xor(ssq, 32);
    const float rs = 1.0f / sqrtf(ssq * (1.f / 256.f) + EPS);
#pragma unroll
    for (int e = 0; e < 16; ++e) { const v2u gw_ = gts[e];
        const float g0 = __uint_as_float(gw_.x << 16), g1 = __uint_as_float(gw_.x & 0xffff0000u), g2 = __uint_as_float(gw_.y << 16), g3 = __uint_as_float(gw_.y & 0xffff0000u);
        v2u w; w.x = pk2(o[e][0] * rs * silu_f(g0), o[e][1] * rs * silu_f(g1)); w.y = pk2(o[e][2] * rs * silu_f(g2), o[e][3] * rs * silu_f(g3)); *(v2u*)(orow + h * 256 + 16 * e + 4 * fq) = w; }
    __syncthreads();
}

#ifndef PROBE_CV
#define PROBE_CV 0
#endif
#ifndef MK_PER_PHASE
#define MK_PER_PHASE 0
#endif
constexpr int N_PHASES = 21;
#ifndef PROBE_G
#define PROBE_G 0u
#endif
#ifndef PROBE_BAR
#define PROBE_BAR 0
#endif
#ifndef PROBE_VAR
#define PROBE_VAR 0
#endif
#ifndef PROBE_REP
#define PROBE_REP 0u
#endif
struct Args { const float* in[N_IN]; float* out; unsigned char* ws; int ph_lo, ph_hi, pad0, pad1; };
__global__ void __launch_bounds__(NTHR, 2) trunk_fwd(Args args) {
    extern __shared__ __attribute__((aligned(16))) unsigned char lds_raw[];
    const ldsp lds = (ldsp)lds_raw;
    volatile LAS unsigned* MISC = (volatile LAS unsigned*)(lds + MISC_OFF);
    const int tid = threadIdx.x, lane = tid & 63, wave = __builtin_amdgcn_readfirstlane(tid >> 6);
    const int G = gridDim.x; const int bx = blockIdx.x; const int vcu = (G % 8 == 0) ? (bx % 8) * (G / 8) + bx / 8 : bx;
    const int gw = vcu * NWAVES + wave, NGW = G * NWAVES, gtid = vcu * NTHR + tid, gthreads = G * NTHR;
    unsigned char* ws = args.ws;
    gu32* ctl = (gu32*)(ws + WS_CTL);
    for (int u = tid; u < 64; u += NTHR) MISC[u] = 0u;
    __syncthreads();
    XcdBarrier bar; bar.bar = (unsigned*)(ctl + CW_BAR); bar.x = 0; bar.st = nullptr;
    if (!MK_PER_PHASE) bar = xcd_barrier_post((unsigned*)(ctl + CW_BAR), MISC + 8);
    const int lo = args.ph_lo, hi = args.ph_hi;
#define IN(k) (lo <= (k) && (k) < hi)
#define SEAM(k) do { if (IN(k) && IN((k) + 1)) { xcd_barrier<true>(bar); if (PROBE_BAR == 1) xcd_barrier<true>(bar); if (PROBE_BAR == 2) xcd_barrier<false>(bar); } } while (0)
#define REPS(k) (((PROBE_REP >> (k)) & 1u) ? 2 : 1)
    float* MOD = (float*)(ws + WS_MOD); bf16* WDT = (bf16*)(ws + WS_WDT); float* CHDEC = (float*)(ws + WS_CHDEC); float* SSQ = (float*)(ws + WS_SSQ);
    bf16* WMIX = (bf16*)(ws + WS_WMIX); bf16* WOUT0 = (bf16*)(ws + WS_WOUT0); bf16* WOUT1 = (bf16*)(ws + WS_WOUT1);
    bf16* PROJ0 = (bf16*)(ws + WS_PROJ0); bf16* XB = (bf16*)(ws + WS_XN2); bf16* XN2 = (bf16*)args.out;     bf16* W1T = (bf16*)(ws + WS_WMLP); bf16* W2T = (bf16*)(ws + WS_WMLP + 8 * MiB);
    bf16* HB = (bf16*)(ws + WS_H); bf16* PROJ1 = (bf16*)(ws + WS_H); bf16* SB = (bf16*)(ws + WS_S); float* DT = (float*)(ws + WS_DT);
    unsigned* KMAX = (unsigned*)(ws + WS_KMAX);
    float* COS = (float*)(ws + WS_ROPE); float* SIN = COS + 8192 * 64;
    const bool fuse = (G == 256) && !PROBE_REP && !PROBE_G;
    float* XCH1 = (float*)(ws + WS_XCH); float* XCH2 = (float*)(ws + WS_XCH + MiB); unsigned* TMO = (unsigned*)(ctl + CW_BAR) + XB_TMO;
    bf16* W1T0 = fuse ? (bf16*)((char*)args.out + 32 * MiB) : W1T; bf16* W2T0 = fuse ? (bf16*)((char*)args.out + 40 * MiB) : W2T;
    const float* x_in = args.in[I_X]; const float* ng = args.in[I_NG]; float* X = args.out;

    if (IN(0)) for (int rep0 = 0; rep0 < REPS(0); ++rep0) {
        const Seg segs[4] = { {args.in[I_EWIN], 6160, 0, 1024, 1024, WMIX, 0}, {args.in[I_EWIN], 6160, 3088, 3072, 1024, WMIX, 1024}, {args.in[I_EWIN], 6160, 1024, 2048, 1024, WMIX, 4096},
                              {args.in[I_EWOUT], 1024, 0, 1024, 2048, WOUT0, 0} };
        convert_set<4>(segs, lds, gw, NGW, wave, lane);
        for (int i = gtid; i < 16384; i += gthreads) { const int h = i >> 10, k = i & 1023; WDT[i] = f2bf(args.in[I_EWIN][(size_t)k * 6160 + 3072 + h]); }
        for (int i = gtid; i < 8192 * 64; i += gthreads) { const int t = i >> 6, f = i & 63; const float inv = powf(10000.0f, -(float)f * (1.0f / 64.0f)); const float ang = (float)t * inv;
            const double a = (double)ang; const double n = rint(a * 0.15915494309189535); const float r = (float)(a - n * 6.283185307179586); COS[i] = __cosf(r); SIN[i] = __sinf(r); }
        __syncthreads();
        mod_phase(args.in[I_C], args.in[I_MODW], args.in[I_MODB], MOD, lds, tid, lane, wave);
    }
    SEAM(0);
    if (IN(1)) for (int rep1 = 0; rep1 < REPS(1); ++rep1) norm_rows<-1, 0, false, 0>(x_in, nullptr, nullptr, SB, MOD, ng, gw, NGW, lane);
    SEAM(1);
    if (IN(2)) {
        pg8::Gemm g{SB, WMIX, MTOK, NPROJ0, DM, DM}; pg8::StaticOrder S; S.init(MTOK, NPROJ0, G, bx);
        pg8::EpiBf16<0> E{PROJ0, NPROJ0, nullptr, 0, 0, 1.f};
        if ((PROBE_G >> 2) & 1u) { pg8::gemm_phase<pg8::EpiBf16<0>, pg8::StaticOrder, true, true>(lds, g, S, E); __syncthreads(); } pg8::gemm_phase<pg8::EpiBf16<0>, pg8::StaticOrder, true, true>(lds, g, S, E);
        dt_phase(SB, WDT, args.in[I_EDTB], DT, gw, NGW, lane);
    }
    SEAM(2);
    if (IN(3)) { kmax_rows(PROJ0, KMAX, gw, NGW, lane);
        for (int rep = 0; rep < REPS(3); ++rep) for (int u = vcu; u < 512; u += G) ssdA_unit(lds, PROJ0, DT, args.in[I_ECONVW], args.in[I_ECONVB], args.in[I_EALOG], SB, CHDEC, u, tid, lane, wave); }
    SEAM(3);
    if (IN(4)) ssd_scan(SB, CHDEC, gtid, gthreads);
    SEAM(4);
    if (IN(5)) { for (int rep = 0; rep < REPS(5); ++rep) for (int u = vcu; u < 512; u += G) { if (rep + 1 < REPS(5)) ssdC_unit<(PROBE_VAR < 32 ? PROBE_VAR : 0)>(lds, PROJ0, (bf16*)args.out, 1024, DT, args.in[I_ECONVW], args.in[I_ECONVB], args.in[I_EALOG], args.in[I_ED], args.in[I_ESSDN], SB, SSQ, u, tid, lane, wave); else ssdC_unit<0>(lds, PROJ0, PROJ0 + C0_Z, NPROJ0, DT, args.in[I_ECONVW], args.in[I_ECONVB], args.in[I_EALOG], args.in[I_ED], args.in[I_ESSDN], SB, SSQ, u, tid, lane, wave); } }
    SEAM(5);
    if (IN(6)) {
        if (!fuse) ssd_normalize_rows(PROJ0, SSQ, gw, NGW, lane);
        const float* lm = args.in[I_ELAM];
        const float lam = expf(wave_sum(lm[lane] * lm[64 + lane])) - expf(wave_sum(lm[128 + lane] * lm[192 + lane])) + 0.2f;
        __syncthreads();
        for (int rep = 0; rep < REPS(6); ++rep)
        for (int u = vcu; u < 1024; u += G) { const int v = u & 255, i = u >> 8, j = v & 15, bh = v >> 4; const int qb = i == 0 ? j : (i == 1 ? 63 - j : (i == 2 ? 16 + j : 47 - j));
            if (PROBE_VAR >= 16 && rep + 1 < REPS(6)) { }
            else if (rep + 1 < REPS(6)) dattn5_unit<PROBE_VAR < 16 ? PROBE_VAR : 0>(lds, PROJ0, (bf16*)args.out, 1024, args.in[I_RELB], args.in[I_EDIFFN], KMAX, lam, bh >> 3, bh & 7, qb, tid, lane, wave, nullptr);
            else dattn5_unit<0>(lds, PROJ0, PROJ0 + C0_Q, NPROJ0, args.in[I_RELB], args.in[I_EDIFFN], KMAX, lam, bh >> 3, bh & 7, qb, tid, lane, wave, fuse ? SSQ : nullptr); }
    }
    SEAM(6);
    if (IN(7)) {
        pg8::Gemm g{PROJ0, WOUT0, MTOK, DM, 2048, NPROJ0}; pg8::StaticOrder S; S.init(MTOK, DM, G, bx);
        if (fuse) { pg8::EpiNorm<0, 1, false, 1, true> EN{x_in, SB  , XN2, MOD, ng, {XCH1, (unsigned*)ctl + 0 * 512, TMO}, {XCH2, (unsigned*)ctl + 1 * 512, TMO}, EPS, SSQ};
            pg8::gemm_phase<pg8::EpiNorm<0, 1, false, 1, true>, pg8::StaticOrder, true, true>(lds, g, S, EN); } else {
        pg8::EpiBf16<0> E{SB, DM, nullptr, 0, 0, 1.f};
        if ((PROBE_G >> 7) & 1u) { pg8::gemm_phase<pg8::EpiBf16<0>, pg8::StaticOrder, true, true>(lds, g, S, E); __syncthreads(); } pg8::gemm_phase<pg8::EpiBf16<0>, pg8::StaticOrder, true, true>(lds, g, S, E); }
    }
    if (!fuse) SEAM(7); else __syncthreads();
    if (IN(8)) {
        const Seg segs[2] = { {args.in[I_W1], 4096, 0, 4096, 1024, W1T0, 0}, {args.in[I_W2], 1024, 0, 1024, 4096, W2T0, 0} };
        convert_set<2>(segs, lds, gw, NGW, wave, lane); if (PROBE_CV) convert_set<2>(segs, lds, gw, NGW, wave, lane);
        if (!fuse) norm_rows<0, 1, false, 1>(x_in, SB, XB, XN2, MOD, ng, gw, NGW, lane);
    }
    SEAM(8);
    if (IN(9)) {
        pg8::Gemm g{XN2, W1T0, MTOK, FF, DM, DM}; pg8::StaticOrder S; S.init(MTOK, FF, G, bx);
        pg8::EpiBf16<2> E{HB, FF, nullptr, 0, 0, 1.f};
        if ((PROBE_G >> 9) & 1u) { pg8::gemm_phase<pg8::EpiBf16<2>, pg8::StaticOrder, true, true>(lds, g, S, E); __syncthreads(); } pg8::gemm_phase<pg8::EpiBf16<2>, pg8::StaticOrder, true, true>(lds, g, S, E);
    }
    SEAM(9);
    if (IN(10)) {
        pg8::Gemm g{HB, W2T0, MTOK, DM, FF, FF}; pg8::StaticOrder S; S.init(MTOK, DM, G, bx);
        if (fuse) { pg8::EpiNorm<1, 2, true, 1> EN{SB, XB, XN2, MOD, ng, {XCH1, (unsigned*)ctl + 2 * 512, TMO}, {XCH2, (unsigned*)ctl + 3 * 512, TMO}, EPS};
            pg8::gemm_phase<pg8::EpiNorm<1, 2, true, 1>, pg8::StaticOrder, true, true>(lds, g, S, EN); } else {
        pg8::EpiBf16<0> E{SB, DM, nullptr, 0, 0, 1.f};
        if ((PROBE_G >> 10) & 1u) { pg8::gemm_phase<pg8::EpiBf16<0>, pg8::StaticOrder, true, true>(lds, g, S, E); __syncthreads(); } pg8::gemm_phase<pg8::EpiBf16<0>, pg8::StaticOrder, true, true>(lds, g, S, E); }
    }
    if (!fuse) SEAM(10); else __syncthreads();
    if (IN(11)) {
        const Seg segs[4] = { {args.in[I_OWIN], 3840, 2048, 1536, 1024, WMIX, 0}, {args.in[I_OWIN], 3840, 0, 2048, 1024, WMIX, 1536}, {args.in[I_OWIN], 3840, 3584, 256, 1024, WMIX, 3584},
                              {args.in[I_OWOUT], 1024, 0, 1024, 1536, WOUT1, 0} };
        convert_set<4>(segs, lds, gw, NGW, wave, lane); if (PROBE_CV) convert_set<4>(segs, lds, gw, NGW, wave, lane);
        if (!fuse) norm_rows<1, 2, true, 1>(XB, SB, XB, XN2, MOD, ng, gw, NGW, lane);
    }
    SEAM(11);
    if (IN(12)) {
        pg8::Gemm g{XN2, WMIX, MTOK, NPROJ1, DM, DM}; pg8::StaticOrder S; S.init(MTOK, NPROJ1, G, bx);
        pg8::EpiBf16<0> E{PROJ1, NPROJ1, nullptr, 0, 0, 1.f};
        if ((PROBE_G >> 12) & 1u) { pg8::gemm_phase<pg8::EpiBf16<0>, pg8::StaticOrder, true, true>(lds, g, S, E); __syncthreads(); } pg8::gemm_phase<pg8::EpiBf16<0>, pg8::StaticOrder, true, true>(lds, g, S, E);
        }
    SEAM(12);
    if (IN(13)) {
        for (int rep = 0; rep < REPS(13); ++rep) {
        for (int u = vcu; u < 512; u += G) retA_unit(lds, PROJ1, COS, SIN, SB, u, tid, lane, wave);
        for (int u = vcu; u < 256; u += G) swa_unit(lds, PROJ1, (rep + 1 < REPS(13)) ? XN2 : PROJ1 + C1_SQ, (rep + 1 < REPS(13)) ? 1024 : NPROJ1, args.in[I_RELB], args.in[I_OSINK], u >> 7, (u >> 1) & 63, u & 1, tid, lane, wave); }
    }
    SEAM(13);
    if (IN(14)) ret_scan(SB, gtid, gthreads);
    SEAM(14);
    if (IN(15)) { for (int rep = 0; rep < REPS(15); ++rep) for (int u = vcu; u < 512; u += G) { if (rep + 1 < REPS(15)) retC_unit<(PROBE_VAR < 16 ? PROBE_VAR : 0)>(lds, PROJ1, XN2, 1024, COS, SIN, SB, u, tid, lane, wave); else retC_unit<0>(lds, PROJ1, PROJ1 + C1_RG, NPROJ1, COS, SIN, SB, u, tid, lane, wave); } }
    SEAM(15);
    if (IN(16)) {
        pg8::Gemm g{PROJ1, WOUT1, MTOK, DM, 1536, NPROJ1}; pg8::StaticOrder S; S.init(MTOK, DM, G, bx);
        if (fuse) { pg8::EpiNorm<2, 3, true, 1> EN{XB, XB, XN2, MOD, ng, {XCH1, (unsigned*)ctl + 4 * 512, TMO}, {XCH2, (unsigned*)ctl + 5 * 512, TMO}, EPS};
            pg8::gemm_phase<pg8::EpiNorm<2, 3, true, 1>, pg8::StaticOrder, true, true>(lds, g, S, EN); } else {
        pg8::EpiBf16<0> E{SB, DM, nullptr, 0, 0, 1.f};
        if ((PROBE_G >> 16) & 1u) { pg8::gemm_phase<pg8::EpiBf16<0>, pg8::StaticOrder, true, true>(lds, g, S, E); __syncthreads(); } pg8::gemm_phase<pg8::EpiBf16<0>, pg8::StaticOrder, true, true>(lds, g, S, E); }
    }
    if (!fuse) SEAM(16); else __syncthreads();
    if (IN(17)) {
        const Seg segs[2] = { {args.in[I_W1] + (size_t)DM * FF, 4096, 0, 4096, 1024, W1T, 0}, {args.in[I_W2] + (size_t)DM * FF, 1024, 0, 1024, 4096, W2T, 0} };
        convert_set<2>(segs, lds, gw, NGW, wave, lane); if (PROBE_CV) convert_set<2>(segs, lds, gw, NGW, wave, lane);
        if (!fuse) norm_rows<2, 3, true, 1>(XB, SB, XB, XN2, MOD, ng, gw, NGW, lane);
    }
    SEAM(17);
    if (IN(18)) {
        pg8::Gemm g{XN2, W1T, MTOK, FF, DM, DM}; pg8::StaticOrder S; S.init(MTOK, FF, G, bx);
        pg8::EpiBf16<2> E{HB, FF, nullptr, 0, 0, 1.f};
        if ((PROBE_G >> 18) & 1u) { pg8::gemm_phase<pg8::EpiBf16<2>, pg8::StaticOrder, true, true>(lds, g, S, E); __syncthreads(); } pg8::gemm_phase<pg8::EpiBf16<2>, pg8::StaticOrder, true, true>(lds, g, S, E);
    }
    SEAM(18);
    if (IN(19)) {
        pg8::Gemm g{HB, W2T, MTOK, DM, FF, FF}; pg8::StaticOrder S; S.init(MTOK, DM, G, bx);
        if (fuse) { pg8::EpiNorm<3, -1, true, 2> EN{XB, X, nullptr, MOD, ng, {XCH1, (unsigned*)ctl + 6 * 512, TMO}, {XCH2, (unsigned*)ctl + 7 * 512, TMO}, EPS};
            pg8::gemm_phase<pg8::EpiNorm<3, -1, true, 2>, pg8::StaticOrder, true, true>(lds, g, S, EN); } else {
        pg8::EpiBf16<0> E{SB, DM, nullptr, 0, 0, 1.f};
        if ((PROBE_G >> 19) & 1u) { pg8::gemm_phase<pg8::EpiBf16<0>, pg8::StaticOrder, true, true>(lds, g, S, E); __syncthreads(); } pg8::gemm_phase<pg8::EpiBf16<0>, pg8::StaticOrder, true, true>(lds, g, S, E); }
    }
    if (!fuse) {
    SEAM(19);
    if (IN(20)) norm_rows<3, -1, true, 2>(XB, SB, X, nullptr, MOD, ng, gw, NGW, lane);
    }
#undef IN
#undef SEAM
}

extern "C" void kernel_launch(void* const* d_in, const int* in_sizes, int n_in, void* d_out, int out_size, void* d_ws, size_t ws_size, hipStream_t stream) {
    static int grid = 0;
    if (grid == 0) {
        if (n_in != N_IN || out_size != MTOK * DM || ws_size < WS_END) { fprintf(stderr, "kernel_launch: unexpected shapes (n_in %d, out %d, ws %zu); nothing launched\n", n_in, out_size, ws_size); grid = -1; return; }
        int dev = 0, cus = 0, per_cu = 0;
        if (hipGetDevice(&dev) != hipSuccess || hipDeviceGetAttribute(&cus, hipDeviceAttributeMultiprocessorCount, dev) != hipSuccess) { grid = -1; return; }
        if (hipFuncSetAttribute((const void*)trunk_fwd, hipFuncAttributeMaxDynamicSharedMemorySize, LDS_BYTES) != hipSuccess) { fprintf(stderr, "kernel_launch: hipFuncSetAttribute failed\n"); grid = -1; return; }
        if (hipOccupancyMaxActiveBlocksPerMultiprocessor(&per_cu, (const void*)trunk_fwd, NTHR, LDS_BYTES) != hipSuccess || per_cu < 1) { fprintf(stderr, "kernel_launch: occupancy query says %d blocks per CU\n", per_cu); (void)hipGetLastError(); grid = -1; return; }
        grid = cus;
    }
    if (grid < 0) return;
    (void)hipMemsetAsync((char*)d_ws + WS_CTL, 0, CTL_ZERO_BYTES, stream);
    Args a{};
    for (int i = 0; i < N_IN; ++i) a.in[i] = (const float*)d_in[i];
    a.out = (float*)d_out; a.ws = (unsigned char*)d_ws;
#if MK_PER_PHASE
    for (int p = 0; p < N_PHASES; ++p) { a.ph_lo = p; a.ph_hi = p + 1; hipLaunchKernelGGL(trunk_fwd, dim3(grid), dim3(NTHR), LDS_BYTES, stream, a); }
#else
    a.ph_lo = 0; a.ph_hi = N_PHASES;
    hipLaunchKernelGGL(trunk_fwd, dim3(grid), dim3(NTHR), LDS_BYTES, stream, a);
#endif
}
```

```cpp
#include <hip/hip_runtime.h>
#include <cstdio>
#include <cstdint>
#include <cmath>
namespace pg8 {
#define PG8_LAS __attribute__((address_space(3)))
typedef unsigned short bf16_t;
typedef short bf16x8 __attribute__((ext_vector_type(8)));
typedef float f32x4 __attribute__((ext_vector_type(4)));
typedef unsigned u32x4 __attribute__((ext_vector_type(4)));
constexpr int BM = 256, BK = 64, HALF = 128, HTB = HALF * BK * 2  , STAGE_BYTES = 8 * HTB, NXCD = 8, WGM = 4;

__host__ __device__ __forceinline__ int lds_byte(int r, int c) { const int st = (r >> 4) * 2 + (c >> 5), rr = r & 15, cc = c & 31, ob = rr * 64 + cc * 2; return st * 1024 + (ob ^ (((ob >> 9) & 1) << 5)); }
__host__ __device__ __forceinline__ void stage_rc(int b, int& R, int& C) { const int st = b / 1024, sb = b % 1024, swz = sb ^ (((sb >> 9) & 1) << 5); R = (st >> 1) * 16 + swz / 64; C = (st & 1) * 32 + (swz % 64) / 2; }
__host__ __device__ __forceinline__ int perm32(int rho) { const int n = rho >> 4, i = rho & 15; return 8 * (i >> 2) + 4 * n + (i & 3); }

struct Unit { int pm, pn; };
struct Gemm { const bf16_t* A; const bf16_t* Bt; int M, N, K, lda; };

struct StaticOrder {
    int nM, nN, nwg, G, c;
    __host__ __device__ void init(int M, int N, int G_, int c_) { nM = M / BM; nN = N / BM; nwg = nM * nN; G = G_; c = c_; }
    __host__ __device__ bool next(int i, Unit& u) const {
        const long L = (long)i * G + c; if (L >= nwg) return false;
        int wgid = (int)L; { const int q = nwg / NXCD, r = nwg % NXCD, xcd = wgid % NXCD, off = wgid / NXCD; wgid = (xcd < r ? xcd * (q + 1) : r * (q + 1) + (xcd - r) * q) + off; }
        const int nig = WGM * nN, gid = wgid / nig, fm = gid * WGM, gsz = (nM - fm) < WGM ? (nM - fm) : WGM;
        u.pm = fm + ((wgid % nig) % gsz); u.pn = (wgid % nig) / gsz; return true;
    }
    __device__ __forceinline__ void a_ready(const Unit&) const {}
    __device__ __forceinline__ void done(const Unit&) const {}
};

__device__ __forceinline__ unsigned cvt_pk_bf16(float lo, float hi) { unsigned r; asm volatile("v_cvt_pk_bf16_f32 %0, %1, %2" : "=v"(r) : "v"(lo), "v"(hi)); return r; }
typedef float f32x2 __attribute__((ext_vector_type(2)));
__device__ __forceinline__ f32x2 gelu_pk(f32x2 v) {
    const f32x2 av = __builtin_elementwise_abs(v), d = av * 0.2316418882f + 1.0f;
    f32x2 t; t.x = __builtin_amdgcn_rcpf(d.x); t.y = __builtin_amdgcn_rcpf(d.y);
    f32x2 q = t * 0.5307027145f + (-0.7265760135f); q = q * t + 0.7107068705f; q = q * t + (-0.142248368f); q = q * t + 0.127414796f; q = q * t;
    const f32x2 s = (v * v) * (-0.72134752044f);
    f32x2 e; e.x = __builtin_amdgcn_exp2f(s.x); e.y = __builtin_amdgcn_exp2f(s.y);
    const f32x2 m = v * (q * e), r = v - m;
    f32x2 o; o.x = v.x < 0.f ? m.x : r.x; o.y = v.y < 0.f ? m.y : r.y; return o;
}

template <int ACT  > struct EpiBf16 {
    static constexpr bool PERM = true, AFTER_DRAIN = false; static_assert(ACT == 0 || ACT == 1 || ACT == 2, "EpiBf16: ACT is 0 (none), 1 (gelu_pk) or 2 (squared relu)");
    bf16_t* O; int ldc; const float* bias; int split_cols; size_t split_stride; float scale0;
    __device__ __forceinline__ void operator()(const f32x4 (&acc)[2][2][4][2], const Unit& u, int wr, int wc, int fr, int fq) const {
        const int row0 = u.pm * BM + wr * 64 + fr; int colt = u.pn * BM; bf16_t* base = O;
        float sc = 1.f; if (split_cols) { const int t = colt / split_cols; base += (size_t)t * split_stride; colt -= t * split_cols; if (t == 0) sc = scale0; }
        const int col0 = colt + wc * 32 + 8 * fq, bcol0 = u.pn * BM + wc * 32 + 8 * fq;
        f32x4 bv[2][2];
#pragma unroll
        for (int bj = 0; bj < 2; ++bj)
#pragma unroll
            for (int n = 0; n < 2; ++n) bv[bj][n] = bias ? *(const f32x4*)(bias + bcol0 + bj * HALF + 4 * n) : (f32x4){0.f, 0.f, 0.f, 0.f};
#pragma unroll
        for (int ai = 0; ai < 2; ++ai)
#pragma unroll
            for (int m = 0; m < 4; ++m) { bf16_t* rowp = base + (size_t)(row0 + ai * HALF + m * 16) * ldc + col0;
#pragma unroll
                for (int bj = 0; bj < 2; ++bj) { f32x4 v0 = acc[ai][bj][m][0] + bv[bj][0], v1 = acc[ai][bj][m][1] + bv[bj][1];
                    if (ACT == 1) { f32x2 a = gelu_pk((f32x2){v0[0], v0[1]}), b = gelu_pk((f32x2){v0[2], v0[3]}), c = gelu_pk((f32x2){v1[0], v1[1]}), d = gelu_pk((f32x2){v1[2], v1[3]});
                        v0 = (f32x4){a.x, a.y, b.x, b.y}; v1 = (f32x4){c.x, c.y, d.x, d.y}; }
                    if (ACT == 2) { v0 = __builtin_elementwise_max(v0, (f32x4){0.f,0.f,0.f,0.f}); v1 = __builtin_elementwise_max(v1, (f32x4){0.f,0.f,0.f,0.f}); v0 = v0 * v0; v1 = v1 * v1; }
                    v0 = v0 * sc; v1 = v1 * sc; u32x4 w; w.x = cvt_pk_bf16(v0[0], v0[1]); w.y = cvt_pk_bf16(v0[2], v0[3]); w.z = cvt_pk_bf16(v1[0], v1[1]); w.w = cvt_pk_bf16(v1[2], v1[3]);
                    *(u32x4*)(rowp + bj * HALF) = w; } }
    }
};

struct RowExch {
    float* slots;
    unsigned* cnt;
    unsigned* tmo;
    __device__ __forceinline__ void publish(const float (&ss)[2][4], const Unit& u, int wr, int wc, int fr, int fq, PG8_LAS unsigned char* lds, int wid, int lane) const {
        PG8_LAS float* P = (PG8_LAS float*)lds;
#pragma unroll
        for (int ai = 0; ai < 2; ++ai)
#pragma unroll
            for (int m = 0; m < 4; ++m) { float s = ss[ai][m]; s += __shfl_xor(s, 16); s += __shfl_xor(s, 32); if (fq == 0) P[(ai * HALF + wr * 64 + m * 16 + fr) * 4 + wc] = s; }
        asm volatile("s_waitcnt lgkmcnt(0)" ::: "memory"); __builtin_amdgcn_s_barrier(); asm volatile("" ::: "memory");
        const int row = wid * 32 + (lane & 31);
        if (lane < 32) { const f32x4 p = *(const PG8_LAS f32x4*)(P + row * 4);
            __hip_atomic_store((unsigned*)slots + ((size_t)(u.pm * BM + row) * 4 + u.pn), __float_as_uint((p[0] + p[1]) + (p[2] + p[3])), __ATOMIC_RELAXED, __HIP_MEMORY_SCOPE_AGENT); }
        asm volatile("s_waitcnt vmcnt(0)" ::: "memory");
        if (lane == 0) __hip_atomic_fetch_add(cnt + 8 * u.pm, 1u, __ATOMIC_RELAXED, __HIP_MEMORY_SCOPE_AGENT);
    }
    __device__ __forceinline__ void collect(const Unit& u, int wr, int fr, PG8_LAS unsigned char* lds, int wid, int lane, float eps, float (&rinv)[2][4]) const {
        PG8_LAS float* S = (PG8_LAS float*)(lds + 4096);
        const int row = wid * 32 + (lane & 31);
        if (wid == 0) { unsigned sp = 0;
            while ((unsigned)__builtin_amdgcn_readfirstlane(__hip_atomic_load(cnt + 8 * u.pm, __ATOMIC_RELAXED, __HIP_MEMORY_SCOPE_AGENT)) < 32u) { __builtin_amdgcn_s_sleep(1);
                if ((++sp & 255u) == 0u) { if (__hip_atomic_load(tmo, __ATOMIC_RELAXED, __HIP_MEMORY_SCOPE_AGENT)) break; if (sp > (1u << 18)) { if (lane == 0) atomicAdd(tmo, 1u); break; } } } }
        asm volatile("s_waitcnt lgkmcnt(0)" ::: "memory"); __builtin_amdgcn_s_barrier(); asm volatile("" ::: "memory");
        if (lane < 32) { const unsigned* sl = (const unsigned*)slots + (size_t)(u.pm * BM + row) * 4; float t = 0.f;
#pragma unroll
            for (int j = 0; j < 4; ++j) t += __uint_as_float(__hip_atomic_load(sl + j, __ATOMIC_RELAXED, __HIP_MEMORY_SCOPE_AGENT));
            S[row] = 1.0f / sqrtf(t * (1.0f / 1024.0f) + eps); }
        asm volatile("s_waitcnt lgkmcnt(0)" ::: "memory"); __builtin_amdgcn_s_barrier(); asm volatile("" ::: "memory");
#pragma unroll
        for (int ai = 0; ai < 2; ++ai)
#pragma unroll
            for (int m = 0; m < 4; ++m) rinv[ai][m] = S[ai * HALF + wr * 64 + m * 16 + fr];
        asm volatile("s_waitcnt lgkmcnt(0)" ::: "memory"); __builtin_amdgcn_s_barrier(); asm volatile("" ::: "memory");
    }
};
template <int SPOST, int SPRE, bool XINB, int XOUT, bool RS = false> struct EpiNorm {
    static constexpr bool PERM = true, AFTER_DRAIN = true;
    const void* xin; void* xout; bf16_t* XN; const float* MOD; const float* ng; RowExch e1, e2; float eps; const float* rowsq;
    __device__ __forceinline__ void operator()(const f32x4 (&)[2][2][4][2], const Unit&, int, int, int, int) const {}
    __device__ __forceinline__ void fused(f32x4 (&acc)[2][2][4][2], const Unit& u, int wr, int wc, int fr, int fq, PG8_LAS unsigned char* lds, int wid, int lane) const {
        const int b = u.pm >> 5;
        const int col0 = u.pn * BM + wc * 32 + 8 * fq;
        const size_t off0 = (size_t)(u.pm * BM + wr * 64 + fr) * 1024 + col0;
#define EN_OFF(ai, m, bj) (off0 + (size_t)((ai) * HALF + (m) * 16) * 1024 + (bj) * HALF)
#define EN_UNPK_LO(q_) ((f32x4){__uint_as_float((q_)[0] << 16), __uint_as_float((q_)[0] & 0xffff0000u), __uint_as_float((q_)[1] << 16), __uint_as_float((q_)[1] & 0xffff0000u)})
#define EN_UNPK_HI(q_) ((f32x4){__uint_as_float((q_)[2] << 16), __uint_as_float((q_)[2] & 0xffff0000u), __uint_as_float((q_)[3] << 16), __uint_as_float((q_)[3] & 0xffff0000u)})
        float ss[2][4], r1[2][4];
        if constexpr (RS) {
            f32x4 q[2][4];
#pragma unroll
            for (int ai = 0; ai < 2; ++ai)
#pragma unroll
                for (int m = 0; m < 4; ++m) q[ai][m] = *(const f32x4*)(rowsq + (size_t)(u.pm * BM + ai * HALF + wr * 64 + m * 16 + fr) * 4);
#pragma unroll
            for (int ai = 0; ai < 2; ++ai)
#pragma unroll
                for (int m = 0; m < 4; ++m) { const float r = 1.0f / sqrtf(((q[ai][m][0] + q[ai][m][1]) + (q[ai][m][2] + q[ai][m][3])) * (1.0f / 1024.0f) + eps);
#pragma unroll
                    for (int bj = 0; bj < 2; ++bj)
#pragma unroll
                        for (int n = 0; n < 2; ++n) acc[ai][bj][m][n] = acc[ai][bj][m][n] * r; }
        }
#pragma unroll
        for (int ai = 0; ai < 2; ++ai)
#pragma unroll
            for (int m = 0; m < 4; ++m) { float s = 0.f;
#pragma unroll
                for (int bj = 0; bj < 2; ++bj)
#pragma unroll
                    for (int n = 0; n < 2; ++n) { const f32x4 x = acc[ai][bj][m][n]; s += (x[0] * x[0] + x[1] * x[1]) + (x[2] * x[2] + x[3] * x[3]); }
                ss[ai][m] = s; }
        e1.publish(ss, u, wr, wc, fr, fq, lds, wid, lane);
        u32x4 xb[2][4][2]; f32x4 xf[4][2][2];
        if constexpr (XINB) {
#pragma unroll
            for (int ai = 0; ai < 2; ++ai)
#pragma unroll
                for (int m = 0; m < 4; ++m)
#pragma unroll
                    for (int bj = 0; bj < 2; ++bj) xb[ai][m][bj] = *(const u32x4*)((const bf16_t*)xin + EN_OFF(ai, m, bj));
        } else {
#pragma unroll
            for (int m = 0; m < 4; ++m)
#pragma unroll
                for (int bj = 0; bj < 2; ++bj) { xf[m][bj][0] = *(const f32x4*)((const float*)xin + EN_OFF(0, m, bj)); xf[m][bj][1] = *(const f32x4*)((const float*)xin + EN_OFF(0, m, bj) + 4); }
        }
        f32x4 gp[2][2];
#pragma unroll
        for (int bj = 0; bj < 2; ++bj)
#pragma unroll
            for (int n = 0; n < 2; ++n) gp[bj][n] = *(const f32x4*)(MOD + (SPOST * 2 + b) * 3072 + 2048 + col0 + bj * HALF + 4 * n) * *(const f32x4*)(ng + (SPOST * 2 + 1) * 1024 + col0 + bj * HALF + 4 * n);
        e1.collect(u, wr, fr, lds, wid, lane, eps, r1);
#pragma unroll
        for (int ai = 0; ai < 2; ++ai) {
            if constexpr (!XINB) { if (ai == 1) {
#pragma unroll
                for (int m = 0; m < 4; ++m)
#pragma unroll
                    for (int bj = 0; bj < 2; ++bj) { xf[m][bj][0] = *(const f32x4*)((const float*)xin + EN_OFF(1, m, bj)); xf[m][bj][1] = *(const f32x4*)((const float*)xin + EN_OFF(1, m, bj) + 4); } } }
#pragma unroll
            for (int m = 0; m < 4; ++m) { const float r = r1[ai][m];
#pragma unroll
                for (int bj = 0; bj < 2; ++bj) { f32x4 x0, x1;
                    if constexpr (XINB) { x0 = EN_UNPK_LO(xb[ai][m][bj]); x1 = EN_UNPK_HI(xb[ai][m][bj]); } else { x0 = xf[m][bj][0]; x1 = xf[m][bj][1]; }
                    f32x4 v0 = x0 + gp[bj][0] * (acc[ai][bj][m][0] * r), v1 = x1 + gp[bj][1] * (acc[ai][bj][m][1] * r);
                    if constexpr (XOUT == 2) { *(f32x4*)((float*)xout + EN_OFF(ai, m, bj)) = v0; *(f32x4*)((float*)xout + EN_OFF(ai, m, bj) + 4) = v1; }
                    if constexpr (XOUT == 1) { u32x4 w; w.x = cvt_pk_bf16(v0[0], v0[1]); w.y = cvt_pk_bf16(v0[2], v0[3]); w.z = cvt_pk_bf16(v1[0], v1[1]); w.w = cvt_pk_bf16(v1[2], v1[3]);
                        v0 = EN_UNPK_LO(w); v1 = EN_UNPK_HI(w); }
                    acc[ai][bj][m][0] = v0; acc[ai][bj][m][1] = v1; } }
        }
        if constexpr (SPRE >= 0) {
            float r2[2][4];
#pragma unroll
            for (int ai = 0; ai < 2; ++ai)
#pragma unroll
                for (int m = 0; m < 4; ++m) { float s = 0.f;
#pragma unroll
                    for (int bj = 0; bj < 2; ++bj)
#pragma unroll
                        for (int n = 0; n < 2; ++n) { const f32x4 x = acc[ai][bj][m][n]; s += (x[0] * x[0] + x[1] * x[1]) + (x[2] * x[2] + x[3] * x[3]); }
                    ss[ai][m] = s; }
            e2.publish(ss, u, wr, wc, fr, fq, lds, wid, lane);
            if constexpr (XOUT == 1) {
#pragma unroll
                for (int ai = 0; ai < 2; ++ai)
#pragma unroll
                    for (int m = 0; m < 4; ++m)
#pragma unroll
                        for (int bj = 0; bj < 2; ++bj) { const f32x4 v0 = acc[ai][bj][m][0], v1 = acc[ai][bj][m][1];
                            u32x4 w; w.x = cvt_pk_bf16(v0[0], v0[1]); w.y = cvt_pk_bf16(v0[2], v0[3]); w.z = cvt_pk_bf16(v1[0], v1[1]); w.w = cvt_pk_bf16(v1[2], v1[3]);
                            *(u32x4*)((bf16_t*)xout + EN_OFF(ai, m, bj)) = w; }
            }
            f32x4 qc[2][2], sh[2][2];
#pragma unroll
            for (int bj = 0; bj < 2; ++bj)
#pragma unroll
                for (int n = 0; n < 2; ++n) { const int c = col0 + bj * HALF + 4 * n;
                    qc[bj][n] = *(const f32x4*)(ng + (SPRE * 2) * 1024 + c) * (*(const f32x4*)(MOD + (SPRE * 2 + b) * 3072 + 1024 + c) + 1.0f); sh[bj][n] = *(const f32x4*)(MOD + (SPRE * 2 + b) * 3072 + c); }
            e2.collect(u, wr, fr, lds, wid, lane, eps, r2);
#pragma unroll
            for (int ai = 0; ai < 2; ++ai)
#pragma unroll
                for (int m = 0; m < 4; ++m) { const float r = r2[ai][m];
#pragma unroll
                    for (int bj = 0; bj < 2; ++bj) { const f32x4 o0 = (acc[ai][bj][m][0] * r) * qc[bj][0] + sh[bj][0], o1 = (acc[ai][bj][m][1] * r) * qc[bj][1] + sh[bj][1];
                        u32x4 w; w.x = cvt_pk_bf16(o0[0], o0[1]); w.y = cvt_pk_bf16(o0[2], o0[3]); w.z = cvt_pk_bf16(o1[0], o1[1]); w.w = cvt_pk_bf16(o1[2], o1[3]);
                        *(u32x4*)(XN + EN_OFF(ai, m, bj)) = w; } }
        } else if constexpr (XOUT == 1) {
#pragma unroll
            for (int ai = 0; ai < 2; ++ai)
#pragma unroll
                for (int m = 0; m < 4; ++m)
#pragma unroll
                    for (int bj = 0; bj < 2; ++bj) { const f32x4 v0 = acc[ai][bj][m][0], v1 = acc[ai][bj][m][1];
                        u32x4 w; w.x = cvt_pk_bf16(v0[0], v0[1]); w.y = cvt_pk_bf16(v0[2], v0[3]); w.z = cvt_pk_bf16(v1[0], v1[1]); w.w = cvt_pk_bf16(v1[2], v1[3]);
                        *(u32x4*)((bf16_t*)xout + EN_OFF(ai, m, bj)) = w; }
        }
#undef EN_OFF
#undef EN_UNPK_LO
#undef EN_UNPK_HI
    }
};
template <class Epi, class Sched, bool ALIGN_EPI = false, bool SP2 = false>
__device__ __forceinline__ void gemm_phase(PG8_LAS unsigned char* lds, const Gemm g, const Sched& S, const Epi& E) {
    const int tid = threadIdx.x, wid = __builtin_amdgcn_readfirstlane(tid >> 6), lane = tid & 63, wr = wid >> 2, wc = wid & 3, fr = lane & 15, fq = lane >> 4;
    const int K = g.K, nt = K / BK;
    unsigned voffA[2], voffB[2];
#pragma unroll
    for (int i = 0; i < 2; ++i) { int R, C; stage_rc(tid * 16 + i * 8192, R, C); const int Rb = Epi::PERM ? ((R & ~31) + perm32(R & 31)) : R;
        voffA[i] = (unsigned)(R * g.lda + C) * 2u; voffB[i] = (unsigned)(Rb * K + C) * 2u; }
    const size_t kstep = (size_t)(BK * 2);
    const size_t hstepA = (size_t)HALF * g.lda * 2, hstepB = (size_t)HALF * K * 2;
    const size_t tstepA = 2 * hstepA, tstepB = 2 * hstepB;
    const unsigned ldsw = (unsigned)wid * 1024u;
    const int aoff = lds_byte(wr * 64 + fr, fq * 8), boff = lds_byte(wc * 32 + fr, fq * 8);
#define PG8_SA(b, h) (((b) * 2 + (h)) * HTB)
#define PG8_SB(b, h) ((4 + (b) * 2 + (h)) * HTB)
#define PG8_STAGE(bufoff, gbase, voff) do { _Pragma("unroll") for (int _i = 0; _i < 2; ++_i) \
        __builtin_amdgcn_global_load_lds((const unsigned*)((const char*)(gbase) + (voff)[_i]), (PG8_LAS unsigned*)(lds + (bufoff) + ldsw + _i * 8192), 16, 0, 0); } while (0)
#define PG8_LDA(dst, b, h) do { _Pragma("unroll") for (int m = 0; m < 4; ++m) _Pragma("unroll") for (int k = 0; k < 2; ++k) dst[m][k] = *(const PG8_LAS bf16x8*)(lds + PG8_SA(b, h) + aoff + m * 2048 + k * 1024); } while (0)
#define PG8_LDB(dst, b, h) do { _Pragma("unroll") for (int n = 0; n < 2; ++n) _Pragma("unroll") for (int k = 0; k < 2; ++k) dst[n][k] = *(const PG8_LAS bf16x8*)(lds + PG8_SB(b, h) + boff + n * 2048 + k * 1024); } while (0)
#define PG8_MMA(ai, bj, At, Bt) do { __builtin_amdgcn_s_setprio(1); _Pragma("unroll") for (int m = 0; m < 4; ++m) _Pragma("unroll") for (int n = 0; n < 2; ++n) _Pragma("unroll") for (int k = 0; k < 2; ++k) \
        acc[ai][bj][m][n] = __builtin_amdgcn_mfma_f32_16x16x32_bf16(Bt[n][k], At[m][k], acc[ai][bj][m][n], 0, 0, 0); __builtin_amdgcn_s_setprio(0); } while (0)
#define PG8_WAIT_V(n) asm volatile("s_waitcnt vmcnt(" #n ")" ::: "memory")
#define PG8_WAIT_L(n) asm volatile("s_waitcnt lgkmcnt(" #n ")" ::: "memory")
#define PG8_BAR __builtin_amdgcn_s_barrier()
#define PG8_SCHED __builtin_amdgcn_sched_barrier(0)
    Unit cur, nxt; int ui = 0;
    if (!S.next(0, cur)) return;
    f32x4 acc[2][2][4][2];
#pragma unroll
    for (int a = 0; a < 2; ++a)
#pragma unroll
        for (int b = 0; b < 2; ++b)
#pragma unroll
            for (int m = 0; m < 4; ++m)
#pragma unroll
                for (int n = 0; n < 2; ++n) acc[a][b][m][n] = (f32x4){0.f, 0.f, 0.f, 0.f};
    bf16x8 At[4][2], B0[2][2], B1[2][2];
    const char* cA = (const char*)g.A + (size_t)cur.pm * tstepA; const char* cB = (const char*)g.Bt + (size_t)cur.pn * tstepB;
    S.a_ready(cur);
    if constexpr (SP2) {
        PG8_STAGE(PG8_SB(0, 0), cB, voffB); PG8_STAGE(PG8_SB(0, 1), cB + hstepB, voffB); PG8_STAGE(PG8_SA(0, 0), cA, voffA); PG8_STAGE(PG8_SA(0, 1), cA + hstepA, voffA);
        if (wr == 1) PG8_BAR;
        PG8_WAIT_V(2); PG8_BAR;
        PG8_STAGE(PG8_SB(1, 0), cB + kstep, voffB); PG8_STAGE(PG8_SA(1, 0), cA + kstep, voffA); PG8_STAGE(PG8_SB(1, 1), cB + hstepB + kstep, voffB);
        PG8_WAIT_V(6); PG8_BAR;
    } else {
        PG8_STAGE(PG8_SB(0, 0), cB, voffB); PG8_STAGE(PG8_SA(0, 0), cA, voffA); PG8_STAGE(PG8_SB(0, 1), cB + hstepB, voffB); PG8_STAGE(PG8_SA(0, 1), cA + hstepA, voffA);
        if (wr == 1) PG8_BAR;
        PG8_WAIT_V(4); PG8_BAR;
        PG8_STAGE(PG8_SB(1, 0), cB + kstep, voffB); PG8_STAGE(PG8_SA(1, 0), cA + kstep, voffA); PG8_STAGE(PG8_SB(1, 1), cB + hstepB + kstep, voffB);
        PG8_WAIT_V(6); PG8_BAR;
    }
    for (;;) {
        const bool has_next = S.next(ui + 1, nxt);
        const char* nA = has_next ? (const char*)g.A + (size_t)nxt.pm * tstepA : cA; const char* nB = has_next ? (const char*)g.Bt + (size_t)nxt.pn * tstepB : cB;
        for (int t = 0; t < nt; t += 2) {
            const bool last = (t == nt - 2);
            const char* a1 = cA + (size_t)(t + 1) * kstep;
            const char* a2 = last ? nA : cA + (size_t)(t + 2) * kstep; const char* b2 = last ? nB : cB + (size_t)(t + 2) * kstep;
            const char* a3 = a2 + kstep; const char* b3 = b2 + kstep;
            if (last && has_next) S.a_ready(nxt);
            if constexpr (SP2) {
            PG8_LDB(B0, 0, 0); PG8_LDB(B1, 0, 1); PG8_SCHED; PG8_LDA(At, 0, 0); PG8_STAGE(PG8_SA(1, 1), a1 + hstepA, voffA);
            PG8_WAIT_V(8); PG8_WAIT_L(0); PG8_BAR; PG8_MMA(0, 0, At, B0); PG8_MMA(0, 1, At, B1); PG8_BAR; PG8_SCHED;
            PG8_LDA(At, 0, 1); PG8_STAGE(PG8_SB(0, 0), b2, voffB); PG8_STAGE(PG8_SB(0, 1), b2 + hstepB, voffB); PG8_STAGE(PG8_SA(0, 0), a2, voffA);
            PG8_WAIT_V(8); PG8_WAIT_L(0); PG8_BAR; PG8_MMA(1, 0, At, B0); PG8_MMA(1, 1, At, B1); PG8_BAR; PG8_SCHED;
            PG8_LDB(B0, 1, 0); PG8_LDB(B1, 1, 1); PG8_SCHED; PG8_LDA(At, 1, 0); PG8_STAGE(PG8_SA(0, 1), a2 + hstepA, voffA);
            PG8_WAIT_V(8); PG8_WAIT_L(0); PG8_BAR; PG8_MMA(0, 0, At, B0); PG8_MMA(0, 1, At, B1); PG8_BAR; PG8_SCHED;
            PG8_LDA(At, 1, 1); PG8_STAGE(PG8_SB(1, 0), b3, voffB); PG8_STAGE(PG8_SB(1, 1), b3 + hstepB, voffB); PG8_STAGE(PG8_SA(1, 0), a3, voffA);
            PG8_WAIT_V(8); PG8_WAIT_L(0); PG8_BAR; PG8_MMA(1, 0, At, B0); PG8_MMA(1, 1, At, B1); PG8_BAR; PG8_SCHED;
            } else {
            PG8_LDB(B0, 0, 0); PG8_SCHED; PG8_LDA(At, 0, 0); PG8_STAGE(PG8_SA(1, 1), a1 + hstepA, voffA);
            PG8_WAIT_L(8); PG8_BAR; PG8_WAIT_L(0); PG8_MMA(0, 0, At, B0); PG8_BAR; PG8_SCHED;
            PG8_LDB(B1, 0, 1); PG8_STAGE(PG8_SB(0, 0), b2, voffB);
            PG8_BAR; PG8_WAIT_L(0); PG8_MMA(0, 1, At, B1); PG8_BAR;
            PG8_LDA(At, 0, 1); PG8_STAGE(PG8_SA(0, 0), a2, voffA);
            PG8_BAR; PG8_WAIT_L(0); PG8_MMA(1, 0, At, B0); PG8_BAR; PG8_SCHED;
            PG8_STAGE(PG8_SB(0, 1), b2 + hstepB, voffB);
            PG8_WAIT_V(6); PG8_BAR; PG8_MMA(1, 1, At, B1); PG8_BAR;
            PG8_LDB(B0, 1, 0); PG8_SCHED; PG8_LDA(At, 1, 0); PG8_STAGE(PG8_SA(0, 1), a2 + hstepA, voffA);
            PG8_WAIT_L(8); PG8_BAR; PG8_WAIT_L(0); PG8_MMA(0, 0, At, B0); PG8_BAR; PG8_SCHED;
            PG8_LDB(B1, 1, 1); PG8_STAGE(PG8_SB(1, 0), b3, voffB);
            PG8_BAR; PG8_WAIT_L(0); PG8_MMA(0, 1, At, B1); PG8_BAR;
            PG8_LDA(At, 1, 1); PG8_STAGE(PG8_SA(1, 0), a3, voffA);
            PG8_BAR; PG8_WAIT_L(0); PG8_MMA(1, 0, At, B0); PG8_BAR; PG8_SCHED;
            PG8_STAGE(PG8_SB(1, 1), b3 + hstepB, voffB);
            PG8_WAIT_V(6); PG8_BAR; PG8_MMA(1, 1, At, B1); PG8_BAR;
            }
        }
        if constexpr (ALIGN_EPI) { if (wr == 0) PG8_BAR; }
        if constexpr (!Epi::AFTER_DRAIN) { E(acc, cur, wr, wc, fr, fq); S.done(cur); }
        if (!has_next) break;
#pragma unroll
        for (int a = 0; a < 2; ++a)
#pragma unroll
            for (int b = 0; b < 2; ++b)
#pragma unroll
                for (int m = 0; m < 4; ++m)
#pragma unroll
                    for (int n = 0; n < 2; ++n) acc[a][b][m][n] = (f32x4){0.f, 0.f, 0.f, 0.f};
        cur = nxt; cA = nA; cB = nB; ++ui;
        if constexpr (ALIGN_EPI) { if (wr == 1) PG8_BAR; }
    }
    PG8_WAIT_V(0);
    if constexpr (!ALIGN_EPI) { if (wr == 0) PG8_BAR; }
    PG8_BAR;
    if constexpr (Epi::AFTER_DRAIN) { E.fused(acc, cur, wr, wc, fr, fq, lds, wid, lane); S.done(cur); }
#undef PG8_SA
#undef PG8_SB
#undef PG8_STAGE
#undef PG8_LDA
#undef PG8_LDB
#undef PG8_MMA
#undef PG8_WAIT_V
#undef PG8_WAIT_L
#undef PG8_BAR
#undef PG8_SCHED
}
}

constexpr int NWAVES = 8, NTHR = NWAVES * 64;
constexpr int BATCH = 2, SEQ = 8192, DM = 1024, MTOK = BATCH * SEQ, FF = 4096;
constexpr int NPROJ0 = 6144, NPROJ1 = 3840;
constexpr float EPS = 1e-6f, LOG2E = 1.4426950408889634f;
constexpr int C0_Z = 0, C0_Q = 1024, C0_K = 2048, C0_V = 3072, C0_XBC = 4096;
constexpr int C1_RG = 0, C1_SQ = 1024, C1_RQ = 1536, C1_RK = 2048, C1_RV = 2560, C1_SK = 3584, C1_SV = 3712;
enum { I_X = 0, I_C, I_RELB, I_NG, I_MODW, I_MODB, I_W1, I_W2, I_EWIN, I_ECONVW, I_ECONVB, I_EDTB, I_EALOG, I_ED, I_ESSDN, I_ELAM, I_EDIFFN, I_EWOUT, I_OWIN, I_OSINK, I_OWOUT, N_IN };

constexpr size_t MiB = 1u << 20;
constexpr size_t WS_CTL = 0, CTL_ZERO_BYTES = 65536;
constexpr size_t WS_MOD = 256 * 1024;
constexpr size_t WS_WDT = 512 * 1024;
constexpr size_t WS_CHDEC = 576 * 1024;
constexpr size_t WS_SSQ = 640 * 1024;
constexpr size_t WS_WMIX = 1 * MiB;
constexpr size_t WS_WOUT0 = 13 * MiB, WS_WOUT1 = 9 * MiB;
constexpr size_t WS_PROJ0 = 17 * MiB;
constexpr size_t WS_XN2 = 17 * MiB;
constexpr size_t WS_WMLP = 49 * MiB;
constexpr size_t WS_H = 65 * MiB;
constexpr size_t WS_S = 209 * MiB;
constexpr size_t WS_DT = 241 * MiB;
constexpr size_t WS_ROPE = 244 * MiB;
constexpr size_t WS_XCH = 248 * MiB;
constexpr size_t WS_END = 250 * MiB;
constexpr int CW_BAR = 4096;

constexpr int LDS_BYTES = 163840 - 1024;
constexpr int MISC_OFF = LDS_BYTES - 256;

#define GAS __attribute__((address_space(1)))
#define LAS __attribute__((address_space(3)))
typedef unsigned short bf16;
typedef unsigned v4u __attribute__((ext_vector_type(4)));
typedef unsigned v2u __attribute__((ext_vector_type(2)));
typedef float f32x4 __attribute__((ext_vector_type(4)));
typedef short bf16x8 __attribute__((ext_vector_type(8)));
typedef short v4i16_t __attribute__((ext_vector_type(4)));
typedef GAS unsigned gu32;
typedef LAS unsigned char* ldsp;
#define RLX_AGENT __ATOMIC_RELAXED, __HIP_MEMORY_SCOPE_AGENT
#define LDS_WAIT() asm volatile("s_waitcnt lgkmcnt(0)" ::: "memory")
#define VM_WAIT() asm volatile("s_waitcnt vmcnt(0)" ::: "memory")

__device__ __forceinline__ float bf2f(unsigned h) { return __uint_as_float(h << 16); }
typedef float f32x2_t __attribute__((ext_vector_type(2))); typedef __bf16 bf16x2_t __attribute__((ext_vector_type(2)));
__device__ __forceinline__ unsigned pk2(float lo, float hi) { f32x2_t v = {lo, hi}; bf16x2_t b = __builtin_convertvector(v, bf16x2_t); return __builtin_bit_cast(unsigned, b); }
__device__ __forceinline__ unsigned short f2bf(float f) { return (unsigned short)(pk2(f, 0.f) & 0xffffu); }
__device__ __forceinline__ float silu_f(float x) { return x * __builtin_amdgcn_rcpf(1.f + __expf(-x)); }
__device__ __forceinline__ float wave_sum(float v) {
#pragma unroll
    for (int o = 1; o < 64; o <<= 1) v += __shfl_xor(v, o);
    return v;
}
#define MFMA16(acc, rowfrag, colfrag) acc = __builtin_amdgcn_mfma_f32_16x16x32_bf16(colfrag, rowfrag, acc, 0, 0, 0)
__device__ __forceinline__ bf16x8 lds_frag(ldsp p) { return *(const LAS bf16x8*)p; }
__device__ __forceinline__ bf16x8 lds_frag_tr(ldsp p, int stride) {
    const v4i16_t lo = __builtin_amdgcn_ds_read_tr16_b64_v4i16((LAS v4i16_t*)p);
    const v4i16_t hi = __builtin_amdgcn_ds_read_tr16_b64_v4i16((LAS v4i16_t*)(p + 4 * stride));
    return (bf16x8){lo[0], lo[1], lo[2], lo[3], hi[0], hi[1], hi[2], hi[3]};
}
__device__ __forceinline__ int t5_bucket(int d) {
    if (d < 16) return d;
    const int v = 16 + (int)(logf((float)d * 0.0625f) / 2.0794415416798357f * 16.0f);
    return v < 31 ? v : 31;
}

#define XB_TMO      128
#define XB_XCNT(j)  (256  + 64 * (j))
#define XB_XSUB(j)  (1280 + 64 * (j))
#define XB_XGEN(j)  (2304 + 64 * (j))
#define XB_TOP      3328
#define XB_TOPGEN   3392
#define XCD_BAR_WORDS 3456
#define XB_SPIN_CAP (1u << 18)

__device__ __forceinline__ unsigned xb_ld(unsigned* p)              { return __hip_atomic_load(p, __ATOMIC_RELAXED, __HIP_MEMORY_SCOPE_AGENT); }
__device__ __forceinline__ unsigned xb_add(unsigned* p, unsigned v) { return __hip_atomic_fetch_add(p, v, __ATOMIC_RELAXED, __HIP_MEMORY_SCOPE_AGENT); }
__device__ __forceinline__ unsigned xb_xcc_id() { return (unsigned)__builtin_amdgcn_s_getreg((3 << 11) | 20) & 0xFu; }
#define XB_SPIN(cond, bar) do { unsigned _sp = 0; while (cond) { __builtin_amdgcn_s_sleep(1); \
    if ((++_sp & 255u) == 0u) { if (xb_ld(&(bar)[XB_TMO])) break; if (_sp > XB_SPIN_CAP) { atomicAdd(&(bar)[XB_TMO], 1u); break; } } } } while (0)

struct XcdBarrier {
    unsigned* bar; unsigned x;
    volatile LAS unsigned* st;
};

__device__ __forceinline__ XcdBarrier xcd_barrier_post(unsigned* bar, volatile LAS unsigned* st) {
    XcdBarrier b; b.bar = bar; b.x = xb_xcc_id(); b.st = st;
    if (threadIdx.x == 0) (void)xb_add(&bar[XB_XCNT(b.x)], 1u);
    return b;
}
__device__ __forceinline__ void xcd_barrier_complete(unsigned* bar, unsigned x, unsigned& nloc, unsigned& nx) {
    const unsigned G = gridDim.x * gridDim.y * gridDim.z;
    unsigned sum, cnt, mine, sp = 0u;
    for (;;) {
        sum = 0u; cnt = 0u; mine = 0u;
#pragma unroll
        for (unsigned j = 0; j < 16; ++j) { const unsigned c = xb_ld(&bar[XB_XCNT(j)]); sum += c; cnt += (c > 0u) ? 1u : 0u; mine = (j == x) ? c : mine; }
        if (sum == G) break;
        __builtin_amdgcn_s_sleep(1);
        if ((++sp & 255u) == 0u) { if (xb_ld(&bar[XB_TMO])) break; if (sp > XB_SPIN_CAP) { atomicAdd(&bar[XB_TMO], 1u); break; } }
    }
    nloc = mine > 0u ? mine : 1u; nx = cnt > 0u ? cnt : 1u;
}

template <bool WB = true> __device__ __forceinline__ void xcd_barrier(const XcdBarrier& b) {
    asm volatile("s_waitcnt vmcnt(0)" ::: "memory");
    __syncthreads();
    if (threadIdx.x == 0) {
        unsigned* bar = b.bar;
        __builtin_amdgcn_s_waitcnt(0);
        unsigned nloc = b.st[0], nx = b.st[1];
        if (nloc == 0u) { xcd_barrier_complete(bar, b.x, nloc, nx); b.st[0] = nloc; b.st[1] = nx; }
        const unsigned old = xb_add(&bar[XB_XSUB(b.x)], 1u);
        const unsigned gen = old / nloc;
        if (old + 1u == (gen + 1u) * nloc) {
            if (WB) asm volatile("buffer_inv sc1\n\tbuffer_wbl2 sc1\n\ts_waitcnt vmcnt(0)" ::: "memory"); else asm volatile("buffer_inv sc1" ::: "memory");
            xb_add(&bar[XB_TOP], 1u);
        } else {
            asm volatile("buffer_inv sc1" ::: "memory");
        }
        XB_SPIN(xb_ld(&bar[XB_TOP]) < (gen + 1u) * nx, bar);
        asm volatile("s_waitcnt vmcnt(0)" ::: "memory");
    }
    __syncthreads();
}

struct Seg { const float* W; int ldw, col0, ncols, K; bf16* WT; int row_off; };
struct CvtItem { const float* src; bf16* dst; int ldw, K; bool valid; };
template <int NSEG> __device__ __forceinline__ CvtItem cvt_resolve(const Seg (&segs)[NSEG], int it, int total, int lane) {
    CvtItem c; c.src = nullptr; c.dst = nullptr; c.ldw = 0; c.K = 0; c.valid = false;
    int r = it < total ? it : -1;
#pragma unroll
    for (int s = 0; s < NSEG; ++s) { const int nblk = segs[s].ncols / 32, n = (segs[s].K / 64) * nblk;
        if (!c.valid && r >= 0 && r < n) { const int kb = r / nblk, nb = r % nblk, k0 = 64 * kb, n0 = 32 * nb;
            c.src = segs[s].W + (size_t)(k0 + (lane >> 5)) * segs[s].ldw + segs[s].col0 + n0 + (lane & 31);
            c.dst = segs[s].WT + (size_t)(segs[s].row_off + n0 + (lane >> 3)) * segs[s].K + k0 + 8 * (lane & 7); c.ldw = segs[s].ldw; c.K = segs[s].K; c.valid = true; }
        r -= n; }
    return c;
}
__device__ __forceinline__ void cvt_loads(const CvtItem& c, float (&wv)[32]) {
    if (c.valid) {
#pragma unroll
        for (int i = 0; i < 32; ++i) wv[i] = c.src[(size_t)(2 * i) * c.ldw]; }
}
__device__ __forceinline__ void cvt_finish(const CvtItem& c, const float (&wv)[32], LAS float* scr, int lane) {
    if (c.valid) {
#pragma unroll
        for (int i = 0; i < 32; ++i) scr[(2 * i + (lane >> 5)) * 33 + (lane & 31)] = wv[i];
        LDS_WAIT(); asm volatile("" ::: "memory");
        const int cc = lane & 7;
#pragma unroll
        for (int j = 0; j < 4; ++j) { const int n = (lane >> 3) + 8 * j; const LAS float* p = scr + (8 * cc) * 33 + n;
            v4u o; o.x = pk2(p[0 * 33], p[1 * 33]); o.y = pk2(p[2 * 33], p[3 * 33]); o.z = pk2(p[4 * 33], p[5 * 33]); o.w = pk2(p[6 * 33], p[7 * 33]);
            *(v4u*)(c.dst + (size_t)(8 * j) * c.K) = o; }
        LDS_WAIT(); asm volatile("" ::: "memory"); }
}
template <int NSEG> __device__ __forceinline__ void convert_set(const Seg (&segs)[NSEG], ldsp lds, int gw, int NGW, int wave, int lane) {
    LAS float* scr = (LAS float*)(lds + wave * 16384);
    int total = 0;
#pragma unroll
    for (int s = 0; s < NSEG; ++s) total += (segs[s].K / 64) * (segs[s].ncols / 32);
    for (int it = gw; it < total; it += 2 * NGW) {
        const CvtItem ca = cvt_resolve<NSEG>(segs, it, total, lane), cb = cvt_resolve<NSEG>(segs, it + NGW, total, lane);
        float wa[32], wb[32];
        cvt_loads(ca, wa); cvt_loads(cb, wb);
        cvt_finish(ca, wa, scr, lane); cvt_finish(cb, wb, scr, lane);
    }
}
__device__ __forceinline__ void mod_phase(const float* c, const float* mod_w, const float* mod_b, float* MOD, ldsp lds, int tid, int lane, int wave) {
    LAS float* sc = (LAS float*)(lds + 16384);
    if (blockIdx.x < 192) { for (int i = tid; i < 2048; i += NTHR) { const float v = c[i]; sc[i] = v / (1.f + expf(-v)); } }
    __syncthreads();
    for (int item = blockIdx.x; item < 192; item += gridDim.x) {
        const int s = item / 48, j0 = (item % 48) * 64, kpart = wave * 4 + (lane >> 4), jl = lane & 15;
        const float* wp = mod_w + ((size_t)s * 1024 + kpart * 32) * 3072 + j0 + 4 * jl;
        f32x4 a0 = {0.f, 0.f, 0.f, 0.f}, a1 = a0;
#pragma unroll
        for (int kk = 0; kk < 32; ++kk) { const int k = kpart * 32 + kk; const f32x4 w = *(const f32x4*)(wp + (size_t)kk * 3072);
            const float s0 = sc[k], s1 = sc[1024 + k]; a0 += w * s0; a1 += w * s1; }
        LAS f32x4* red = (LAS f32x4*)lds;
        red[(kpart * 2 + 0) * 16 + jl] = a0; red[(kpart * 2 + 1) * 16 + jl] = a1;
        __syncthreads();
        if (tid < 128) { const int b = tid >> 6, col = tid & 63; float sum = mod_b[s * 3072 + j0 + col];
#pragma unroll
            for (int kp = 0; kp < 32; ++kp) sum += ((LAS float*)lds)[((kp * 2 + b) * 16 + (col >> 2)) * 4 + (col & 3)];
            MOD[(s * 2 + b) * 3072 + j0 + col] = sum; }
        __syncthreads();
    }
}

template <int SPOST, int SPRE, bool XINB, int XOUT, int R = 2> __device__ __forceinline__ void norm_rows(const void* xin_, const bf16* Y, void* xout_, bf16* XN, const float* MOD, const float* ng, int gw, int NGW, int lane) {
    const float* xinf = (const float*)xin_; const bf16* xinb = (const bf16*)xin_; float* xoutf = (float*)xout_; bf16* xoutb = (bf16*)xout_;
    const int half = NGW >> 1; const bool split = !(NGW & 1);
    const int b0 = split ? gw / half : 0, b1 = split ? b0 + 1 : BATCH, w = split ? gw % half : gw, W = split ? half : NGW;
#define NR_COL(q) (8 * lane + 512 * ((q) >> 1) + 4 * ((q) & 1))
#define NR_UNPK(w_) ((f32x4){__uint_as_float((w_).x << 16), __uint_as_float((w_).x & 0xffff0000u), __uint_as_float((w_).y << 16), __uint_as_float((w_).y & 0xffff0000u)})
#define NR_LOAD(vx, vxb, vy, m_) do { _Pragma("unroll") for (int j = 0; j < 2; ++j) { \
        if constexpr (XINB) vxb[j] = *(const v4u*)(xinb + (size_t)(m_) * DM + 8 * lane + 512 * j); \
        else { vx[2 * j] = *(const f32x4*)(xinf + (size_t)(m_) * DM + NR_COL(2 * j)); vx[2 * j + 1] = *(const f32x4*)(xinf + (size_t)(m_) * DM + NR_COL(2 * j + 1)); } \
        if constexpr (SPOST >= 0) vy[j] = *(const v4u*)(Y + (size_t)(m_) * DM + 8 * lane + 512 * j); } } while (0)
#pragma unroll 1
    for (int b = b0; b < b1; ++b) {
        f32x4 g4[4], p4[4], s4[4], c4[4], q4[4];
#pragma unroll
        for (int q = 0; q < 4; ++q) {
            if constexpr (SPOST >= 0) { g4[q] = *(const f32x4*)(MOD + (SPOST * 2 + b) * 3072 + 2048 + NR_COL(q)); p4[q] = *(const f32x4*)(ng + (SPOST * 2 + 1) * DM + NR_COL(q)); }
            if constexpr (SPRE >= 0) { s4[q] = *(const f32x4*)(MOD + (SPRE * 2 + b) * 3072 + NR_COL(q)); c4[q] = *(const f32x4*)(MOD + (SPRE * 2 + b) * 3072 + 1024 + NR_COL(q)) + 1.0f;
                q4[q] = *(const f32x4*)(ng + (SPRE * 2) * DM + NR_COL(q)); }
        }
        const int cnt = w < SEQ ? (SEQ - w + W - 1) / W : 0;
        f32x4 vx[R][4]; v4u vxb[R][2], vy[R][2];
#pragma unroll
        for (int r = 0; r < R; ++r) if (r < cnt) NR_LOAD(vx[r], vxb[r], vy[r], b * SEQ + w + r * W);
        for (int i0 = 0; i0 < cnt; i0 += R) {
            f32x4 nx[R][4]; v4u nxb[R][2], ny[R][2];
#pragma unroll
            for (int r = 0; r < R; ++r) if (i0 + R + r < cnt) NR_LOAD(nx[r], nxb[r], ny[r], b * SEQ + w + (i0 + R + r) * W);
#pragma unroll
            for (int r = 0; r < R; ++r) if (i0 + r < cnt) {
                const int m = b * SEQ + w + (i0 + r) * W;
                f32x4 v[4];
#pragma unroll
                for (int j = 0; j < 2; ++j) { if constexpr (XINB) { const v2u lo = {vxb[r][j].x, vxb[r][j].y}, hi = {vxb[r][j].z, vxb[r][j].w}; v[2 * j] = NR_UNPK(lo); v[2 * j + 1] = NR_UNPK(hi); }
                                              else { v[2 * j] = vx[r][2 * j]; v[2 * j + 1] = vx[r][2 * j + 1]; } }
                if constexpr (SPOST >= 0) {
                    f32x4 y[4]; float ss = 0.f;
#pragma unroll
                    for (int j = 0; j < 2; ++j) { const v2u lo = {vy[r][j].x, vy[r][j].y}, hi = {vy[r][j].z, vy[r][j].w}; y[2 * j] = NR_UNPK(lo); y[2 * j + 1] = NR_UNPK(hi); }
#pragma unroll
                    for (int q = 0; q < 4; ++q) ss += (y[q].x * y[q].x + y[q].y * y[q].y) + (y[q].z * y[q].z + y[q].w * y[q].w);
                    const float rr = 1.0f / sqrtf(wave_sum(ss) * (1.f / DM) + EPS);
#pragma unroll
                    for (int q = 0; q < 4; ++q) v[q] = v[q] + g4[q] * ((y[q] * rr) * p4[q]);
                    if constexpr (XOUT == 2) {
#pragma unroll
                        for (int q = 0; q < 4; ++q) *(f32x4*)(xoutf + (size_t)m * DM + NR_COL(q)) = v[q]; }
                    if constexpr (XOUT == 1) {
#pragma unroll
                        for (int j = 0; j < 2; ++j) { v4u o; o.x = pk2(v[2 * j].x, v[2 * j].y); o.y = pk2(v[2 * j].z, v[2 * j].w); o.z = pk2(v[2 * j + 1].x, v[2 * j + 1].y); o.w = pk2(v[2 * j + 1].z, v[2 * j + 1].w);
                            *(v4u*)(xoutb + (size_t)m * DM + 8 * lane + 512 * j) = o;
                            const v2u lo = {o.x, o.y}, hi = {o.z, o.w}; v[2 * j] = NR_UNPK(lo); v[2 * j + 1] = NR_UNPK(hi); } }
                }
                if constexpr (SPRE >= 0) {
                    float ss = 0.f;
#pragma unroll
                    for (int q = 0; q < 4; ++q) ss += (v[q].x * v[q].x + v[q].y * v[q].y) + (v[q].z * v[q].z + v[q].w * v[q].w);
                    const float rr = 1.0f / sqrtf(wave_sum(ss) * (1.f / DM) + EPS);
#pragma unroll
                    for (int j = 0; j < 2; ++j) { const f32x4 oa = ((v[2 * j] * rr) * q4[2 * j]) * c4[2 * j] + s4[2 * j], ob = ((v[2 * j + 1] * rr) * q4[2 * j + 1]) * c4[2 * j + 1] + s4[2 * j + 1];
                        v4u o; o.x = pk2(oa.x, oa.y); o.y = pk2(oa.z, oa.w); o.z = pk2(ob.x, ob.y); o.w = pk2(ob.z, ob.w);
                        *(v4u*)(XN + (size_t)m * DM + 8 * lane + 512 * j) = o; }
                }
            }
#pragma unroll
            for (int r = 0; r < R; ++r) {
#pragma unroll
                for (int q = 0; q < 4; ++q) vx[r][q] = nx[r][q];
#pragma unroll
                for (int j = 0; j < 2; ++j) { vxb[r][j] = nxb[r][j]; vy[r][j] = ny[r][j]; } }
        }
    }
#undef NR_LOAD
#undef NR_UNPK
#undef NR_COL
}

__device__ __forceinline__ void dt_phase(const bf16* XN, const bf16* WDT, const float* dt_bias, float* DT, int gw, int NGW, int lane) {
    const int fr = lane & 15, fq = lane >> 4;
    for (int tile = gw; tile < MTOK / 16; tile += NGW) {
        f32x4 acc = {0.f, 0.f, 0.f, 0.f};
        const bf16* arow = XN + (size_t)(tile * 16 + fr) * DM + 8 * fq; const bf16* brow = WDT + fr * DM + 8 * fq;
#pragma unroll 8
        for (int ks = 0; ks < 32; ++ks) { const bf16x8 a = *(const bf16x8*)(arow + 32 * ks), bb = *(const bf16x8*)(brow + 32 * ks); MFMA16(acc, a, bb); }
        const f32x4 bi = *(const f32x4*)(dt_bias + 4 * fq); f32x4 o;
#pragma unroll
        for (int i = 0; i < 4; ++i) { const float v = acc[i] + bi[i]; o[i] = v > 20.f ? v : log1pf(expf(v)); }
        *(f32x4*)(DT + (size_t)(tile * 16 + fr) * 16 + 4 * fq) = o;
    }
}

__device__ __forceinline__ void ssd_dt_acs(const float* DT, const float* A_log, int t0, int g, LAS float* ACS, LAS float* DTS, LAS float* TMP, int tid) {
    const int r = tid >> 7, s = tid & 127, ln = tid & 63;
    const float dt = DT[(size_t)(t0 + s) * 16 + g * 4 + r];
    float v = -expf(A_log[g * 4 + r]) * dt; DTS[r * 128 + s] = dt;
#pragma unroll
    for (int d = 1; d < 64; d <<= 1) { const float t = __shfl_up(v, d); if (ln >= d) v += t; }
    if (ln == 63) TMP[tid >> 6] = v;
    __syncthreads();
    if (s >= 64) v += TMP[(tid >> 6) - 1];
    ACS[r * 128 + s] = v;
    __syncthreads();
}
__device__ __forceinline__ void ssd_conv_group(const bf16* PROJ0, const float* conv_w, const float* conv_b, int t0, bool first_chunk, int cch0, int tg, int mode, ldsp dst  , int stride,
                                               const LAS float* ACSr, const LAS float* DTSr) {
    float w[4][8], cb[8];
#pragma unroll
    for (int j = 0; j < 4; ++j) { const f32x4 a = *(const f32x4*)(conv_w + j * 2048 + cch0), b = *(const f32x4*)(conv_w + j * 2048 + cch0 + 4);
        w[j][0] = a[0]; w[j][1] = a[1]; w[j][2] = a[2]; w[j][3] = a[3]; w[j][4] = b[0]; w[j][5] = b[1]; w[j][6] = b[2]; w[j][7] = b[3]; }
    { const f32x4 a = *(const f32x4*)(conv_b + cch0), b = *(const f32x4*)(conv_b + cch0 + 4); cb[0] = a[0]; cb[1] = a[1]; cb[2] = a[2]; cb[3] = a[3]; cb[4] = b[0]; cb[5] = b[1]; cb[6] = b[2]; cb[7] = b[3]; }
    v4u raw[19];
    const bf16* src = PROJ0 + ((size_t)t0 + 16 * tg) * NPROJ0 + C0_XBC + cch0;
    const bool pad = first_chunk && tg == 0;
#pragma unroll
    for (int i = 0; i < 19; ++i) { if (i < 3 && pad) raw[i] = (v4u){0u, 0u, 0u, 0u}; else raw[i] = *(const v4u*)(src + (ptrdiff_t)(i - 3) * NPROJ0); }
    const float alast = ACSr[127];
#pragma unroll
    for (int k = 0; k < 16; ++k) { const int s = 16 * tg + k;
        float sc = 1.f; if (mode == 0) sc = DTSr[s] * __expf(alast - ACSr[s]); else if (mode == 1) sc = DTSr[s];
        float o[8];
#pragma unroll
        for (int c = 0; c < 8; ++c) { float v = cb[c];
#pragma unroll
            for (int j = 0; j < 4; ++j) { const unsigned d = raw[k + j][c >> 1]; v += w[j][c] * ((c & 1) ? __uint_as_float(d & 0xffff0000u) : __uint_as_float(d << 16)); }
            o[c] = silu_f(v) * sc; }
        v4u ow; ow.x = pk2(o[0], o[1]); ow.y = pk2(o[2], o[3]); ow.z = pk2(o[4], o[5]); ow.w = pk2(o[6], o[7]);
        *(LAS v4u*)(dst + s * stride) = ow; }
}
constexpr int SA_BS = 0, SA_XS = 34816, SA_ACS = 102400, SA_DTS = 104448, SA_TMP = 106496;
__device__ __forceinline__ void ssdA_unit(ldsp lds, const bf16* PROJ0, const float* DT, const float* conv_w, const float* conv_b, const float* A_log, bf16* ST, float* CHDEC, int u, int tid, int lane, int wave) {
    asm volatile("" : "+v"(tid), "+v"(lane));
    const int g = u & 3, c = (u >> 2) & 63, b = u >> 8, t0 = b * SEQ + c * 128;
    const int fr = lane & 15, fq = lane >> 4, trq = (lane & 15) >> 2, trp = lane & 3;
    LAS float* ACS = (LAS float*)(lds + SA_ACS); LAS float* DTS = (LAS float*)(lds + SA_DTS); LAS float* TMP = (LAS float*)(lds + SA_TMP);
    ssd_dt_acs(DT, A_log, t0, g, ACS, DTS, TMP, tid);
    if (tid < 4) CHDEC[(b * 64 + c) * 16 + g * 4 + tid] = __expf(ACS[tid * 128 + 127]);
    if (tid < 384) { const int cg = tid % 48, tg = tid / 48; const bool isx = cg < 32; const int r = isx ? (cg >> 3) : 0;
        ssd_conv_group(PROJ0, conv_w, conv_b, t0, c == 0, isx ? g * 256 + 8 * cg : 1024 + g * 128 + 8 * (cg - 32), tg, isx ? 0 : 2,
                       isx ? lds + SA_XS + cg * 16 : lds + SA_BS + (cg - 32) * 16, isx ? 528 : 272, ACS + r * 128, DTS + r * 128); }
    __syncthreads();
    const int r = wave >> 1, half = wave & 1;
    f32x4 acc[2][8];
#pragma unroll
    for (int j = 0; j < 2; ++j)
#pragma unroll
        for (int n = 0; n < 8; ++n) acc[j][n] = (f32x4){0.f, 0.f, 0.f, 0.f};
    bf16x8 fa[2][2], fb[2][8];
#define SA_READ(ks_, buf_) do { _Pragma("unroll") for (int j = 0; j < 2; ++j) fa[buf_][j] = lds_frag_tr(lds + SA_XS + (32 * (ks_) + 8 * fq + trq) * 528 + (r * 64 + (2 * half + j) * 16 + 4 * trp) * 2, 528); \
        _Pragma("unroll") for (int n = 0; n < 8; ++n) fb[buf_][n] = lds_frag_tr(lds + SA_BS + (32 * (ks_) + 8 * fq + trq) * 272 + (n * 16 + 4 * trp) * 2, 272); } while (0)
    SA_READ(0, 0);
#pragma unroll
    for (int ks = 0; ks < 4; ++ks) {
        if (ks < 3) SA_READ(ks + 1, (ks + 1) & 1);
        __builtin_amdgcn_sched_barrier(0);
#pragma unroll
        for (int n = 0; n < 8; ++n) { MFMA16(acc[0][n], fa[ks & 1][0], fb[ks & 1][n]); MFMA16(acc[1][n], fa[ks & 1][1], fb[ks & 1][n]); }
        __builtin_amdgcn_sched_barrier(0);
    }
#undef SA_READ
    bf16* so = ST + ((size_t)((b * 64 + c) * 16 + g * 4 + r) * 64) * 128;
#pragma unroll
    for (int j = 0; j < 2; ++j)
#pragma unroll
        for (int n = 0; n < 8; ++n) { v2u w; w.x = pk2(acc[j][n][0], acc[j][n][1]); w.y = pk2(acc[j][n][2], acc[j][n][3]);
            *(v2u*)(so + (size_t)((2 * half + j) * 16 + fr) * 128 + n * 16 + 4 * fq) = w; }
    __syncthreads();
}
__device__ __forceinline__ void ssd_scan(bf16* ST, const float* CHDEC, int gtid, int gthreads) {
    for (int e = gtid; e < 131072; e += gthreads) {
        const int b = e >> 16, rem = e & 65535, h = rem >> 12, pn = rem & 4095;
        unsigned* p = (unsigned*)ST + ((size_t)(b * 64) * 16 + h) * 4096 + pn; const float* dp = CHDEC + (b * 64) * 16 + h;
        float c0 = 0.f, c1 = 0.f;
#pragma unroll 1
        for (int hf = 0; hf < 2; ++hf) {
            unsigned v[32]; unsigned* pb = p + (size_t)hf * 32 * 16 * 4096;
            { const unsigned* q = pb;
#pragma unroll
              for (int c = 0; c < 32; ++c) { v[c] = *q; q += 16 * 4096; asm volatile("" : "+v"(q)); } }
#pragma unroll
            for (int c = 0; c < 32; ++c) { const float dec = dp[(hf * 32 + c) * 16]; const unsigned o = pk2(c0, c1); c0 = c0 * dec + __uint_as_float(v[c] << 16); c1 = c1 * dec + __uint_as_float(v[c] & 0xffff0000u); v[c] = o; }
            { unsigned* q = pb;
#pragma unroll
              for (int c = 0; c < 32; ++c) { *q = v[c]; q += 16 * 4096; asm volatile("" : "+v"(q)); } }
        }
    }
}
constexpr int SC_CS = 0, SC_BS = 34816, SC_XS = 69632, SC_ACS = 137216, SC_DTS = 139264, SC_TMP = 141312, SC_SP = 143360;
template <int PV> __device__ __forceinline__ void ssdC_unit(ldsp lds, const bf16* PROJ0, bf16* OUT  , int opitch, const float* DT, const float* conv_w, const float* conv_b, const float* A_log, const float* Dskip, const float* ssd_norm,
                                          const bf16* ST, float* SSQ, int u, int tid, int lane, int wave) {
    asm volatile("" : "+v"(tid), "+v"(lane));
    const int g = u & 3, c = (u >> 2) & 63, b = u >> 8, t0 = b * SEQ + c * 128;
    const int fr = lane & 15, fq = lane >> 4, trq = (lane & 15) >> 2, trp = lane & 3;
    LAS float* ACS = (LAS float*)(lds + SC_ACS); LAS float* DTS = (LAS float*)(lds + SC_DTS); LAS float* TMP = (LAS float*)(lds + SC_TMP);
    if (!(PV & 1)) ssd_dt_acs(DT, A_log, t0, g, ACS, DTS, TMP, tid);
    if (!(PV & 2)) { const int cg = tid & 63, tg = tid >> 6; const bool isx = cg < 32, isb = cg < 48; const int r = isx ? (cg >> 3) : 0;
      ssd_conv_group(PROJ0, conv_w, conv_b, t0, c == 0, isx ? g * 256 + 8 * cg : (isb ? 1024 + g * 128 + 8 * (cg - 32) : 1536 + g * 128 + 8 * (cg - 48)), tg, isx ? 1 : 2,
                     isx ? lds + SC_XS + cg * 16 : (isb ? lds + SC_BS + (cg - 32) * 16 : lds + SC_CS + (cg - 48) * 16), isx ? 528 : 272, ACS + r * 128, DTS + r * 128); }
    __syncthreads();
    const int l = 16 * wave + fr;
    const ldsp crow = lds + SC_CS + l * 272 + 16 * fq, mrow = lds + SC_BS + l * 272 + 16 * fq;
    const bf16* prow = PROJ0 + (size_t)(t0 + l) * NPROJ0; bf16* orow = OUT + (size_t)(t0 + l) * opitch;
    v2u zw[4]; f32x4 nwn[4]; float dskn;
    v4u spr[2];
    const int sprow = tid >> 3, spch = tid & 7;
    { const bf16* sp = ST + ((size_t)((b * 64 + c) * 16 + g * 4) * 64) * 128;
#pragma unroll
      for (int i = 0; i < 2; ++i) spr[i] = *(const v4u*)(sp + (size_t)(sprow) * 128 + (spch + 8 * i) * 8);
#pragma unroll
      for (int p = 0; p < 4; ++p) { zw[p] = *(const v2u*)(prow + C0_Z + (g * 4) * 64 + 16 * p + 4 * fq); nwn[p] = *(const f32x4*)(ssd_norm + (g * 4) * 64 + 16 * p + 4 * fq); }
      dskn = Dskip[g * 4]; }
    f32x4 cb[8];
#pragma unroll
    for (int n = 0; n < 8; ++n) cb[n] = (f32x4){0.f, 0.f, 0.f, 0.f};
#pragma unroll
    for (int ks = 0; ks < 4; ++ks) { const bf16x8 af = lds_frag(crow + 64 * ks); bf16x8 bfr[8];
#pragma unroll
        for (int n = 0; n < 8; ++n) bfr[n] = lds_frag(lds + SC_BS + (16 * n + fr) * 272 + 64 * ks + 16 * fq);
        __builtin_amdgcn_sched_barrier(0);
#pragma unroll
        for (int n = 0; n < 8; ++n) MFMA16(cb[n], af, bfr[n]);
        __builtin_amdgcn_sched_barrier(0); }
    __syncthreads();
    float ssq = 0.f;
#pragma unroll 1
    for (int r = 0; r < ((PV & 4) ? 0 : 4); ++r) {
        const int h = g * 4 + r; const float al = ACS[r * 128 + l];
#pragma unroll
        for (int i = 0; i < 2; ++i) *(LAS v4u*)(lds + SC_SP + sprow * 272 + (spch + 8 * i) * 16) = spr[i];
        v2u zc[4]; f32x4 nwc[4]; const float dskc = dskn;
#pragma unroll
        for (int p = 0; p < 4; ++p) { zc[p] = zw[p]; nwc[p] = nwn[p]; }
        if (r < 3 && !(PV & 8)) {
            const bf16* sp = ST + ((size_t)((b * 64 + c) * 16 + h + 1) * 64) * 128;
#pragma unroll
            for (int i = 0; i < 2; ++i) spr[i] = *(const v4u*)(sp + (size_t)(sprow) * 128 + (spch + 8 * i) * 8);
#pragma unroll
            for (int p = 0; p < 4; ++p) { zw[p] = *(const v2u*)(prow + C0_Z + (h + 1) * 64 + 16 * p + 4 * fq); nwn[p] = *(const f32x4*)(ssd_norm + (h + 1) * 64 + 16 * p + 4 * fq); }
            dskn = Dskip[h + 1];
        }
        __syncthreads();
#pragma unroll
        for (int n = 0; n < 8; ++n) { const f32x4 as = *(const LAS f32x4*)(ACS + r * 128 + 16 * n + 4 * fq); float mv[4];
#pragma unroll
            for (int i = 0; i < 4; ++i) { const int s = 16 * n + 4 * fq + i; mv[i] = (s <= l) ? cb[n][i] * __expf(al - as[i]) : 0.f; }
            v2u w; w.x = pk2(mv[0], mv[1]); w.y = pk2(mv[2], mv[3]); *(LAS v2u*)(lds + SC_BS + l * 272 + (16 * n + 4 * fq) * 2) = w; }
        f32x4 y[4], yo[4];
#pragma unroll
        for (int p = 0; p < 4; ++p) { y[p] = (f32x4){0.f, 0.f, 0.f, 0.f}; yo[p] = y[p]; }
#pragma unroll
        for (int ks = 0; ks < 4; ++ks) { const bf16x8 af = lds_frag(mrow + 64 * ks);
            bf16x8 xf[4];
#pragma unroll
            for (int p = 0; p < 4; ++p) xf[p] = lds_frag_tr(lds + SC_XS + (32 * ks + 8 * fq + trq) * 528 + (r * 64 + 16 * p + 4 * trp) * 2, 528);
#pragma unroll
            for (int p = 0; p < 4; ++p) MFMA16(y[p], af, xf[p]); }
#pragma unroll
        for (int ks = 0; ks < 4; ++ks) { const bf16x8 cf = lds_frag(crow + 64 * ks); bf16x8 sf[4];
#pragma unroll
            for (int p = 0; p < 4; ++p) sf[p] = lds_frag(lds + SC_SP + (16 * p + fr) * 272 + 64 * ks + 16 * fq);
#pragma unroll
            for (int p = 0; p < 4; ++p) MFMA16(yo[p], cf, sf[p]); }
        __syncthreads();
        const float el = __expf(al), rdt = dskc / DTS[r * 128 + l];
#pragma unroll
        for (int p = 0; p < 4; ++p) { const int ch = h * 64 + 16 * p + 4 * fq;
            const v2u xw = *(const LAS v2u*)(lds + SC_XS + l * 528 + (r * 64 + 16 * p + 4 * fq) * 2); const f32x4 nw = nwc[p];
            const float z[4] = {__uint_as_float(zc[p].x << 16), __uint_as_float(zc[p].x & 0xffff0000u), __uint_as_float(zc[p].y << 16), __uint_as_float(zc[p].y & 0xffff0000u)};
            const float xs[4] = {__uint_as_float(xw.x << 16), __uint_as_float(xw.x & 0xffff0000u), __uint_as_float(xw.y << 16), __uint_as_float(xw.y & 0xffff0000u)};
            float o[4];
#pragma unroll
            for (int i = 0; i < 4; ++i) { float v = y[p][i] + el * yo[p][i] + rdt * xs[i]; v *= silu_f(z[i]); ssq += v * v; o[i] = v * nw[i]; }
            v2u w; w.x = pk2(o[0], o[1]); w.y = pk2(o[2], o[3]); if (!(PV & 16)) *(v2u*)(orow + ch) = w; else asm volatile("" :: "v"(w.x), "v"(w.y)); }
    }
    ssq += __shfl_xor(ssq, 16); ssq += __shfl_xor(ssq, 32);
    if (fq == 0) SSQ[(size_t)(t0 + l) * 4 + g] = ssq;
    __syncthreads();
}
__device__ __forceinline__ void ssd_normalize_rows(bf16* PROJ0, const float* SSQ, int gw, int NGW, int lane) {
    for (int m = gw; m < MTOK; m += NGW) {
        const f32x4 q = *(const f32x4*)(SSQ + (size_t)m * 4); const float r = 1.0f / sqrtf(((q.x + q.y) + (q.z + q.w)) * (1.f / 1024.f) + EPS);
        v4u* p = (v4u*)(PROJ0 + (size_t)m * NPROJ0 + C0_Z + 8 * lane); v4u w0 = p[0], w1 = p[64];
#pragma unroll
        for (int i = 0; i < 4; ++i) { w0[i] = pk2(__uint_as_float(w0[i] << 16) * r, __uint_as_float(w0[i] & 0xffff0000u) * r); w1[i] = pk2(__uint_as_float(w1[i] << 16) * r, __uint_as_float(w1[i] & 0xffff0000u) * r); }
        p[0] = w0; p[64] = w1;
    }
}

__device__ __forceinline__ float quad_max(float v) {
    auto a = __builtin_amdgcn_permlane16_swap(__float_as_uint(v), __float_as_uint(v), false, false); v = fmaxf(__uint_as_float(a[0]), __uint_as_float(a[1]));
    auto b = __builtin_amdgcn_permlane32_swap(__float_as_uint(v), __float_as_uint(v), false, false); return fmaxf(__uint_as_float(b[0]), __uint_as_float(b[1]));
}
__device__ __forceinline__ float quad_sum(float v) {
    auto a = __builtin_amdgcn_permlane16_swap(__float_as_uint(v), __float_as_uint(v), false, false); v = __uint_as_float(a[0]) + __uint_as_float(a[1]);
    auto b = __builtin_amdgcn_permlane32_swap(__float_as_uint(v), __float_as_uint(v), false, false); return __uint_as_float(b[0]) + __uint_as_float(b[1]);
}
__device__ __forceinline__ void glds16_asm(const void* gsrc, unsigned lds_dst) { unsigned keep;
    asm volatile("s_mov_b32 %0, m0\n\ts_mov_b32 m0, %2\n\ts_nop 0\n\tglobal_load_lds_dwordx4 %1, off\n\ts_mov_b32 m0, %0" : "=&s"(keep) : "v"(gsrc), "s"(lds_dst) : "memory"); }
#ifndef DA_NOFAST
#define DA_NOFAST 0
#endif
#ifndef DA_SGB
#define DA_SGB true
#endif
#ifndef DA_PAR
#define DA_PAR 0
#endif
constexpr int DB_K = 0, DB_V = 65536, DB_TSZ = 16384, DB_BT = 147456, DB_XCH = 0;
__device__ __forceinline__ bf16x8 lds_frag_tr2(ldsp p0, ldsp p1) {
    const v4i16_t lo = __builtin_amdgcn_ds_read_tr16_b64_v4i16((LAS v4i16_t*)p0);
    const v4i16_t hi = __builtin_amdgcn_ds_read_tr16_b64_v4i16((LAS v4i16_t*)p1);
    return (bf16x8){lo[0], lo[1], lo[2], lo[3], hi[0], hi[1], hi[2], hi[3]};
}
#define DB_BAR() do { __builtin_amdgcn_sched_barrier(0); asm volatile("s_waitcnt lgkmcnt(0)" ::: "memory"); __builtin_amdgcn_s_barrier(); asm volatile("" ::: "memory"); __builtin_amdgcn_sched_barrier(0); } while (0)
constexpr size_t WS_KMAX = 32 * 1024;
__device__ __forceinline__ void kmax_rows(const bf16* PROJ0, unsigned* KMAX, int gw, int NGW, int lane) {
#pragma unroll 1
    for (int b = 0; b < BATCH; ++b) {
        float mx = 0.f; int m = b * SEQ + (gw % NGW); while (m < b * SEQ) m += NGW;
        for (; m < (b + 1) * SEQ; m += NGW) {
            const v4u* p = (const v4u*)(PROJ0 + (size_t)m * NPROJ0 + C0_K + 16 * lane); const v4u w0 = p[0], w1 = p[1]; float ss = 0.f;
#pragma unroll
            for (int i = 0; i < 4; ++i) { const float a0 = __uint_as_float(w0[i] << 16), a1 = __uint_as_float(w0[i] & 0xffff0000u), b0 = __uint_as_float(w1[i] << 16), b1 = __uint_as_float(w1[i] & 0xffff0000u);
                ss += (a0 * a0 + a1 * a1) + (b0 * b0 + b1 * b1); }
            ss += __shfl_xor(ss, 1); ss += __shfl_xor(ss, 2); mx = fmaxf(mx, ss);
        }
        if ((lane & 3) == 0) atomicMax(KMAX + b * 16 + (lane >> 2), __float_as_uint(mx));
    }
}
template <int PVAR> __device__ __forceinline__ void dattn5_unit(ldsp lds, const bf16* PROJ0, bf16* OUT  , int opitch, const float* rel_bias, const float* diff_norm, const unsigned* KMAX, float lam,
                                                                int b, int h, int qb, int tid, int lane, int wave, const float* SSQ  ) {
    asm volatile("" : "+v"(tid), "+v"(lane));
    const int fr = lane & 15, fq = lane >> 4, trq = (lane & 15) >> 2, trp = lane & 3;
    const int m = wave >> 2, rg = wave & 3;
    const size_t rowbase = (size_t)b * SEQ; const int q0 = qb * 128, row0 = q0 + 32 * rg;
    const int nt = 2 * qb + 2;
    const bf16* kvb = PROJ0 + rowbase * NPROJ0 + h * 128;
    const bf16* ksrc[2]; const bf16* vsrc[2];
#pragma unroll
    for (int i = 0; i < 2; ++i) { const int key = 4 * (wave + 8 * i) + (lane >> 4), slot = lane & 15;
        ksrc[i] = kvb + (size_t)key * NPROJ0 + C0_K + ((slot ^ (key & 15)) * 8); vsrc[i] = kvb + (size_t)key * NPROJ0 + C0_V + ((slot ^ ((key & 7) << 1)) * 8); }
    int kw = 0, vw = 0;
    const unsigned lds0 = (unsigned)(size_t)lds;
#define DB_DMAK(t) do { _Pragma("unroll") for (int i_ = 0; i_ < 2; ++i_) \
        glds16_asm(ksrc[i_] + (size_t)(64 * (t)) * NPROJ0, (unsigned)__builtin_amdgcn_readfirstlane((int)(lds0 + DB_K + kw * DB_TSZ + (wave + 8 * i_) * 1024))); \
        kw = (kw + 1) & 3; } while (0)
#define DB_DMAV(t) do { _Pragma("unroll") for (int i_ = 0; i_ < 2; ++i_) \
        glds16_asm(vsrc[i_] + (size_t)(64 * (t)) * NPROJ0, (unsigned)__builtin_amdgcn_readfirstlane((int)(lds0 + DB_V + vw * DB_TSZ + (wave + 8 * i_) * 1024))); \
        vw = (vw == 4) ? 0 : vw + 1; } while (0)
    DB_DMAK(0); DB_DMAV(0); DB_DMAK(1); DB_DMAV(1); if (nt > 2) { DB_DMAK(2); DB_DMAV(2); } if (nt > 3) DB_DMAK(3);
    const float SC = 0.125f * LOG2E, c31 = rel_bias[31 * 8 + h] * LOG2E;
    bf16x8 qf[2][2]; float qss[2] = {0.f, 0.f};
#pragma unroll
    for (int rt = 0; rt < 2; ++rt)
#pragma unroll
        for (int ks = 0; ks < 2; ++ks) { const v4u raw = *(const v4u*)(PROJ0 + (rowbase + row0 + 16 * rt + fr) * NPROJ0 + C0_Q + h * 128 + m * 64 + ks * 32 + fq * 8); v4u sc;
#pragma unroll
            for (int i = 0; i < 4; ++i) { sc[i] = pk2(__uint_as_float(raw[i] << 16) * SC, __uint_as_float(raw[i] & 0xffff0000u) * SC);
                const float r0 = __uint_as_float(sc[i] << 16), r1 = __uint_as_float(sc[i] & 0xffff0000u); qss[rt] += r0 * r0 + r1 * r1; }
            qf[rt][ks] = __builtin_bit_cast(bf16x8, sc); }
    LAS float* BT = (LAS float*)(lds + DB_BT);
    if (tid < 128) BT[tid] = (rel_bias[t5_bucket(tid) * 8 + h] - rel_bias[31 * 8 + h]) * LOG2E;
    float bmax = rel_bias[h];
#pragma unroll 1
    for (int k = 1; k < 32; ++k) bmax = fmaxf(bmax, rel_bias[k * 8 + h]);
    const float kmx = sqrtf(__uint_as_float(KMAX[(b * 8 + h) * 2 + m]));
    f32x4 cmv[2];
#pragma unroll
    for (int rt = 0; rt < 2; ++rt) { const float c = c31 - (sqrtf(quad_sum(qss[rt])) * kmx * 1.001f + bmax * LOG2E + 0.01f); cmv[rt] = (f32x4){c, c, c, c}; }
    f32x4 o[2][9], s[2][4], sn[2][4]; v4u pk[2][2];
#pragma unroll
    for (int rt = 0; rt < 2; ++rt) {
#pragma unroll
        for (int e = 0; e < 9; ++e) o[rt][e] = (f32x4){0.f, 0.f, 0.f, 0.f};
#pragma unroll
        for (int k2 = 0; k2 < 2; ++k2) pk[rt][k2] = (v4u){0u, 0u, 0u, 0u}; }
    const bf16x8 ones = {0x3F80, 0x3F80, 0x3F80, 0x3F80, 0x3F80, 0x3F80, 0x3F80, 0x3F80};
    const int vswz = ((4 * (fq & 1) + trq) << 1);
    const int vlane = (4 * fq + trq) * 256 + trp * 8;
    int vco[8], kx[2];
#pragma unroll
    for (int e = 0; e < 8; ++e) vco[e] = vlane + (((2 * e) ^ vswz) * 16);
#pragma unroll
    for (int ks = 0; ks < 2; ++ks) kx[ks] = fr * 256 + (((m * 8 + ks * 4 + fq) ^ fr) * 16);
    asm volatile("s_waitcnt vmcnt(0)" ::: "memory");
    DB_BAR();
    int kr = 0, vr = 0;
#define DA_SMAT(DST) do { const ldsp kbuf_ = lds + DB_K + kr * DB_TSZ; kr = (kr + 1) & 3; \
        _Pragma("unroll") for (int n_ = 0; n_ < 4; ++n_) { \
            const bf16x8 k0_ = lds_frag(kbuf_ + kx[0] + n_ * 4096), k1_ = lds_frag(kbuf_ + kx[1] + n_ * 4096); \
            _Pragma("unroll") for (int rt_ = 0; rt_ < 2; ++rt_) { DST[rt_][n_] = __builtin_amdgcn_mfma_f32_16x16x32_bf16(k0_, qf[rt_][0], cmv[rt_], 0, 0, 0); MFMA16(DST[rt_][n_], qf[rt_][1], k1_); } } } while (0)
    DA_SMAT(s);
#define DA_BODY(T_, FAR_, PV_, SN_, SA, SB) do { \
        const bool dmak_ = ((T_) + 4 < nt) && !(PVAR & 1), dmav_ = ((T_) + 3 < nt) && !(PVAR & 1); \
        if (dmak_) DB_DMAK((T_) + 4); \
        if (dmav_) DB_DMAV((T_) + 3); \
        if ((SN_) && !(PVAR & 4)) DA_SMAT(SB); \
        if ((PV_) && !(PVAR & 4)) { \
            const ldsp vb_ = lds + DB_V + vr * DB_TSZ; vr = (vr == 4) ? 0 : vr + 1; \
            _Pragma("unroll") for (int k2 = 0; k2 < 2; ++k2) { \
                _Pragma("unroll") for (int e = 0; e < 8; ++e) { const bf16x8 vf = lds_frag_tr2(vb_ + vco[e] + (32 * k2) * 256, vb_ + vco[e] + (32 * k2 + 16) * 256); \
                    MFMA16(o[0][e], __builtin_bit_cast(bf16x8, pk[0][k2]), vf); MFMA16(o[1][e], __builtin_bit_cast(bf16x8, pk[1][k2]), vf); } \
                MFMA16(o[0][8], __builtin_bit_cast(bf16x8, pk[0][k2]), ones); MFMA16(o[1][8], __builtin_bit_cast(bf16x8, pk[1][k2]), ones); } \
        } \
        if (!(PVAR & 2)) { \
            const int k0 = 64 * (T_); \
            _Pragma("unroll") for (int rt = 0; rt < 2; ++rt) { \
                if (FAR_) { \
                    _Pragma("unroll") for (int n = 0; n < 4; ++n) \
                        _Pragma("unroll") for (int i = 0; i < 4; ++i) SA[rt][n][i] = __builtin_amdgcn_exp2f(SA[rt][n][i]); \
                } else { \
                    const int row = row0 + 16 * rt + fr; \
                    _Pragma("unroll") for (int n = 0; n < 4; ++n) \
                        _Pragma("unroll") for (int i = 0; i < 4; ++i) { const int dist = row - (k0 + 16 * n + 4 * fq + i); const int di = min(max(dist, 0), 127); const float bb = BT[di]; \
                            const float pen = dist < 0 ? -INFINITY : 0.f; SA[rt][n][i] = __builtin_amdgcn_exp2f((SA[rt][n][i] + bb) + pen); } \
                } \
            } \
        } \
        _Pragma("unroll") for (int rt = 0; rt < 2; ++rt) \
            _Pragma("unroll") for (int k2 = 0; k2 < 2; ++k2) { pk[rt][k2].x = pk2(SA[rt][2 * k2][0], SA[rt][2 * k2][1]); pk[rt][k2].y = pk2(SA[rt][2 * k2][2], SA[rt][2 * k2][3]); \
                pk[rt][k2].z = pk2(SA[rt][2 * k2 + 1][0], SA[rt][2 * k2 + 1][1]); pk[rt][k2].w = pk2(SA[rt][2 * k2 + 1][2], SA[rt][2 * k2 + 1][3]); } \
        if (dmak_) asm volatile("s_waitcnt vmcnt(10)" ::: "memory"); else asm volatile("s_waitcnt vmcnt(0)" ::: "memory"); \
        asm volatile("s_waitcnt lgkmcnt(0)" ::: "memory"); __builtin_amdgcn_s_barrier(); asm volatile("" ::: "memory"); \
    } while (0)
#define DA_FAST(T_, SA, SB) do { \
        if (!(PVAR & 1)) { DB_DMAK((T_) + 4); DB_DMAV((T_) + 3); } \
        const ldsp vb_ = lds + DB_V + vr * DB_TSZ; vr = (vr == 4) ? 0 : vr + 1; \
        const ldsp kb_ = lds + DB_K + kr * DB_TSZ; kr = (kr + 1) & 3; \
        bf16x8 vfr[3], kfr[4]; \
        vfr[0] = lds_frag_tr2(vb_ + vco[0], vb_ + vco[0] + 16 * 256); vfr[1] = lds_frag_tr2(vb_ + vco[1], vb_ + vco[1] + 16 * 256); \
        __builtin_amdgcn_sched_barrier(0); \
        _Pragma("unroll") for (int g = 0; g < 52; ++g) { \
            if (g < 32) { const int f = g >> 1, rt = g & 1, k2 = f >> 3, e = f & 7; MFMA16(o[rt][e], __builtin_bit_cast(bf16x8, pk[rt][k2]), vfr[f % 3]); } \
            else if (g < 36) { const int jj = g - 32, rt = jj & 1, k2 = jj >> 1; MFMA16(o[rt][8], __builtin_bit_cast(bf16x8, pk[rt][k2]), ones); } \
            else { const int jj = g - 36, n = jj >> 2, ks = (jj >> 1) & 1, rt = jj & 1; \
                if (ks == 0) SB[rt][n] = __builtin_amdgcn_mfma_f32_16x16x32_bf16(kfr[(n * 2 + ks) & 3], qf[rt][ks], cmv[rt], 0, 0, 0); \
                else MFMA16(SB[rt][n], qf[rt][ks], kfr[(n * 2 + ks) & 3]); } \
            if (g >= 2 && g < 34) { const int jj = g - 2, rt = jj >> 4, n = (jj >> 2) & 3, i = jj & 3; SA[rt][n][i] = __builtin_amdgcn_exp2f(SA[rt][n][i]); } \
            if (g >= 36) { const int q_ = g - 36, rt = q_ >> 3, k2 = (q_ >> 2) & 1, w = q_ & 3; pk[rt][k2][w] = pk2(SA[rt][2 * k2 + (w >> 1)][2 * (w & 1)], SA[rt][2 * k2 + (w >> 1)][2 * (w & 1) + 1]); } \
            if (g < 32 && !(g & 1) && (g >> 1) + 2 < 16) { const int f = (g >> 1) + 2, k2 = f >> 3, e = f & 7; vfr[f % 3] = lds_frag_tr2(vb_ + vco[e] + (32 * k2) * 256, vb_ + vco[e] + (32 * k2 + 16) * 256); } \
            if (g >= 30 && g < 46 && !(g & 1)) { const int c_ = (g - 30) >> 1, n = c_ >> 1, ks = c_ & 1; kfr[c_ & 3] = lds_frag(kb_ + kx[ks] + n * 4096); } \
            __builtin_amdgcn_sched_barrier(0); \
        } \
        if (!(PVAR & 1)) asm volatile("s_waitcnt vmcnt(10)" ::: "memory"); \
        asm volatile("s_waitcnt lgkmcnt(0)" ::: "memory"); __builtin_amdgcn_s_barrier(); asm volatile("" ::: "memory"); \
    } while (0)
    int t = 0;
#define DA_COPY() do { _Pragma("unroll") for (int rt = 0; rt < 2; ++rt) _Pragma("unroll") for (int n = 0; n < 4; ++n) s[rt][n] = sn[rt][n]; } while (0)
    if (nt >= 6) {
        DA_BODY(0, true, false, true, s, sn); DA_COPY();
        for (t = 1; t + 1 <= nt - 5; t += 2) { DA_FAST(t, s, sn); DA_FAST(t + 1, sn, s); }
        if (t <= nt - 5) { DA_FAST(t, s, sn); DA_COPY(); ++t; }
    }
    for (; t < nt; ++t) { const bool far = (q0 - 64 * t - 63) >= 113; DA_BODY(t, far, t > 0, t + 1 < nt, s, sn); DA_COPY(); }
#undef DA_COPY
#undef DA_BODY
#undef DA_FAST
    if (!(PVAR & 4)) {
        const ldsp vb_ = lds + DB_V + vr * DB_TSZ;
#pragma unroll
        for (int k2 = 0; k2 < 2; ++k2) {
#pragma unroll
            for (int e = 0; e < 8; ++e) { const bf16x8 vf = lds_frag_tr2(vb_ + vco[e] + (32 * k2) * 256, vb_ + vco[e] + (32 * k2 + 16) * 256);
                MFMA16(o[0][e], __builtin_bit_cast(bf16x8, pk[0][k2]), vf); MFMA16(o[1][e], __builtin_bit_cast(bf16x8, pk[1][k2]), vf); }
            MFMA16(o[0][8], __builtin_bit_cast(bf16x8, pk[0][k2]), ones); MFMA16(o[1][8], __builtin_bit_cast(bf16x8, pk[1][k2]), ones); }
    }
    asm volatile("s_waitcnt lgkmcnt(0)" ::: "memory"); __builtin_amdgcn_s_barrier(); asm volatile("" ::: "memory");
#undef DB_DMAK
#undef DB_DMAV
#undef DA_SMAT
    float inv[2];
#pragma unroll
    for (int rt = 0; rt < 2; ++rt) inv[rt] = 1.0f / o[rt][8][0];
    LAS float* XCH = (LAS float*)(lds + DB_XCH) + rg * (32 * 132);
    if (m == 1) {
#pragma unroll
        for (int rt = 0; rt < 2; ++rt) { const float f = lam * inv[rt];
#pragma unroll
            for (int e = 0; e < 8; ++e) *(LAS f32x4*)(XCH + (16 * rt + fr) * 132 + 16 * e + 4 * fq) = o[rt][e] * f; }
    }
    __syncthreads();
    if (m == 0) {
        f32x4 dnw[8];
#pragma unroll
        for (int e = 0; e < 8; ++e) dnw[e] = *(const f32x4*)(diff_norm + 16 * e + 4 * fq);
        f32x4 sq[2] = {(f32x4){0.f, 0.f, 0.f, 0.f}, (f32x4){0.f, 0.f, 0.f, 0.f}};
        if (SSQ) {
#pragma unroll
            for (int rt = 0; rt < 2; ++rt) sq[rt] = *(const f32x4*)(SSQ + (size_t)(rowbase + row0 + 16 * rt + fr) * 4); }
#pragma unroll
        for (int rt = 0; rt < 2; ++rt) { float ssq = 0.f;
#pragma unroll
            for (int e = 0; e < 8; ++e) { const f32x4 x2 = *(const LAS f32x4*)(XCH + (16 * rt + fr) * 132 + 16 * e + 4 * fq); const f32x4 v = o[rt][e] * inv[rt] - x2; o[rt][e] = v;
                ssq += (v[0] * v[0] + v[1] * v[1]) + (v[2] * v[2] + v[3] * v[3]); }
            ssq = quad_sum(ssq);
            float rs = 0.8f / sqrtf(ssq * (1.f / 128.f) + EPS);
            if (SSQ) rs *= sqrtf(((sq[rt][0] + sq[rt][1]) + (sq[rt][2] + sq[rt][3])) * (1.f / 1024.f) + EPS);
            bf16* orow = OUT + (rowbase + row0 + 16 * rt + fr) * opitch + h * 128;
#pragma unroll
            for (int e = 0; e < 8; ++e) { const f32x4 dn = dnw[e]; v2u w;
                w.x = pk2(o[rt][e][0] * rs * dn[0], o[rt][e][1] * rs * dn[1]); w.y = pk2(o[rt][e][2] * rs * dn[2], o[rt][e][3] * rs * dn[3]);
                *(v2u*)(orow + 16 * e + 4 * fq) = w; } }
    }
    __syncthreads();
}

constexpr int SW_KS = 0, SW_VS = 36864, SW_BT = 73728;
__device__ __forceinline__ void swa_unit(ldsp lds, const bf16* PROJ1, bf16* OUT  , int opitch, const float* rel_bias, const float* sinks, int b, int blk, int g, int tid, int lane, int wave) {
    asm volatile("" : "+v"(tid), "+v"(lane));
    const int fr = lane & 15, fq = lane >> 4, trq = (lane & 15) >> 2, trp = lane & 3;
    const size_t rowbase = (size_t)b * SEQ; const int qi = 16 * wave + fr;
    const bf16* prow = PROJ1 + (rowbase + blk * 128 + qi) * NPROJ1; bf16* orow = OUT + (rowbase + blk * 128 + qi) * opitch;
    bf16x8 qn[2];
#pragma unroll
    for (int ks = 0; ks < 2; ++ks) qn[ks] = *(const bf16x8*)(prow + C1_SQ + (4 * g) * 64 + ks * 32 + fq * 8);
    LAS float* BT = (LAS float*)(lds + SW_BT);
    { const int r = tid >> 7, d = tid & 127; BT[tid] = rel_bias[t5_bucket(d) * 8 + 4 * g + r] * LOG2E; }
#pragma unroll
    for (int i = 0; i < 4; ++i) { const int idx = tid + 512 * i, key = idx >> 3, ch = idx & 7; const int kp = blk * 128 - 128 + key;
        v4u kv = {0u, 0u, 0u, 0u}, vv = kv;
        if (kp >= 0) { const bf16* p = PROJ1 + (rowbase + kp) * NPROJ1 + g * 64 + ch * 8; kv = *(const v4u*)(p + C1_SK); vv = *(const v4u*)(p + C1_SV); }
        *(LAS v4u*)(lds + SW_KS + key * 144 + ch * 16) = kv; *(LAS v4u*)(lds + SW_VS + key * 144 + ch * 16) = vv; }
    __syncthreads();
    const float SC = 0.125f * LOG2E;
#pragma unroll 1
    for (int r = 0; r < 4; ++r) {
        const float skr = sinks[4 * g + r] * LOG2E;
        bf16x8 qc[2] = {qn[0], qn[1]};
        if (r < 3) {
#pragma unroll
            for (int ks = 0; ks < 2; ++ks) qn[ks] = *(const bf16x8*)(prow + C1_SQ + (4 * g + r + 1) * 64 + ks * 32 + fq * 8); }
        f32x4 s[10];
#pragma unroll
        for (int nn = 0; nn < 9; ++nn) { const int n = wave + nn; bf16x8 kf[2];
#pragma unroll
            for (int ks = 0; ks < 2; ++ks) kf[ks] = lds_frag(lds + SW_KS + (16 * n + fr) * 144 + (ks * 32 + fq * 8) * 2);
            s[nn] = (f32x4){0.f, 0.f, 0.f, 0.f}; MFMA16(s[nn], qc[0], kf[0]); MFMA16(s[nn], qc[1], kf[1]); }
        s[9] = (f32x4){0.f, 0.f, 0.f, 0.f};
        float mx = skr;
#pragma unroll
        for (int nn = 0; nn < 9; ++nn)
#pragma unroll
            for (int i = 0; i < 4; ++i) { const int j = 16 * (wave + nn) + 4 * fq + i, dist = qi + 128 - j; const bool valid = (dist >= 0) && (dist < 128) && (blk * 128 - 128 + j >= 0);
                const float bb = BT[r * 128 + min(max(dist, 0), 127)]; const float pen = valid ? 0.f : -INFINITY; const float v = (s[nn][i] * SC + bb) + pen; s[nn][i] = v; mx = fmaxf(mx, v); }
        mx = quad_max(mx);
        float psum = 0.f;
#pragma unroll
        for (int nn = 0; nn < 9; ++nn)
#pragma unroll
            for (int i = 0; i < 4; ++i) { const float p = __builtin_amdgcn_exp2f(s[nn][i] - mx); s[nn][i] = p; psum += p; }
        const float il = 1.0f / (quad_sum(psum) + __builtin_amdgcn_exp2f(skr - mx));
        f32x4 o[4];
#pragma unroll
        for (int e = 0; e < 4; ++e) o[e] = (f32x4){0.f, 0.f, 0.f, 0.f};
#pragma unroll
        for (int k2 = 0; k2 < 5; ++k2) { v4u pkv; pkv.x = pk2(s[2 * k2][0] * il, s[2 * k2][1] * il); pkv.y = pk2(s[2 * k2][2] * il, s[2 * k2][3] * il);
            pkv.z = pk2(s[2 * k2 + 1][0] * il, s[2 * k2 + 1][1] * il); pkv.w = pk2(s[2 * k2 + 1][2] * il, s[2 * k2 + 1][3] * il);
            const int r0 = 16 * (wave + 2 * k2) + 4 * fq + trq, r1 = min(r0 + 16, 255);
#pragma unroll
            for (int e = 0; e < 4; ++e) { const bf16x8 vf = lds_frag_tr2(lds + SW_VS + r0 * 144 + (16 * e + 4 * trp) * 2, lds + SW_VS + r1 * 144 + (16 * e + 4 * trp) * 2);
                MFMA16(o[e], __builtin_bit_cast(bf16x8, pkv), vf); } }
#pragma unroll
        for (int e = 0; e < 4; ++e) { v2u w; w.x = pk2(o[e][0], o[e][1]); w.y = pk2(o[e][2], o[e][3]); *(v2u*)(orow + (4 * g + r) * 64 + 16 * e + 4 * fq) = w; }
    }
    __syncthreads();
}

__device__ __forceinline__ float ret_log2_gamma(int h) { return log2f(1.0f - exp2f(-5.0f - (float)h)); }
__device__ __forceinline__ void rope_row_store(const bf16* src  , const float* COS, const float* SIN, int pos, int q4, float scale, ldsp dst) {
    v4u lo[2], hi[2];
#pragma unroll
    for (int i = 0; i < 2; ++i) { lo[i] = *(const v4u*)(src + 16 * q4 + 8 * i); hi[i] = *(const v4u*)(src + 64 + 16 * q4 + 8 * i); }
    const float* cp = COS + (size_t)pos * 64 + 16 * q4; const float* sp = SIN + (size_t)pos * 64 + 16 * q4;
#pragma unroll
    for (int i = 0; i < 2; ++i) { v4u ol, oh;
#pragma unroll
        for (int j = 0; j < 4; ++j) { const f32x4 cc = *(const f32x4*)(cp + 8 * i + 4 * (j >> 1)), ss = *(const f32x4*)(sp + 8 * i + 4 * (j >> 1));
            const float c0 = cc[2 * (j & 1)], c1 = cc[2 * (j & 1) + 1], s0 = ss[2 * (j & 1)], s1 = ss[2 * (j & 1) + 1];
            const float a0 = __uint_as_float(lo[i][j] << 16), a1 = __uint_as_float(lo[i][j] & 0xffff0000u), b0 = __uint_as_float(hi[i][j] << 16), b1 = __uint_as_float(hi[i][j] & 0xffff0000u);
            ol[j] = pk2((a0 * c0 - b0 * s0) * scale, (a1 * c1 - b1 * s1) * scale); oh[j] = pk2((a0 * s0 + b0 * c0) * scale, (a1 * s1 + b1 * c1) * scale); }
        *(LAS v4u*)(dst + (16 * q4 + 8 * i) * 2) = ol; *(LAS v4u*)(dst + (64 + 16 * q4 + 8 * i) * 2) = oh; }
}
constexpr int RA_VS = 0, RA_KS = 67584;
__device__ __forceinline__ void retA_unit(ldsp lds, const bf16* PROJ1, const float* COS, const float* SIN, bf16* ST, int u, int tid, int lane, int wave) {
    asm volatile("" : "+v"(tid), "+v"(lane));
    const int h = u & 3, c = (u >> 2) & 63, b = u >> 8, t0 = b * SEQ + c * 128;
    const int fr = lane & 15, fq = lane >> 4, trq = (lane & 15) >> 2, trp = lane & 3;
    const float lg = ret_log2_gamma(h);
#pragma unroll
    for (int i = 0; i < 8; ++i) { const int idx = tid + 512 * i, rw = idx >> 5, ch = idx & 31;
        *(LAS v4u*)(lds + RA_VS + rw * 528 + ch * 16) = *(const v4u*)(PROJ1 + (size_t)(t0 + rw) * NPROJ1 + C1_RV + h * 256 + ch * 8); }
    { const int s = tid >> 2, q4 = tid & 3;
      rope_row_store(PROJ1 + (size_t)(t0 + s) * NPROJ1 + C1_RK + h * 128, COS, SIN, c * 128 + s, q4, 0.08838834764831845f * exp2f((float)(127 - s) * lg), lds + RA_KS + s * 272); }
    __syncthreads();
    f32x4 acc[2][8];
#pragma unroll
    for (int j = 0; j < 2; ++j)
#pragma unroll
        for (int n = 0; n < 8; ++n) acc[j][n] = (f32x4){0.f, 0.f, 0.f, 0.f};
    bf16x8 fa[2][2], fb[2][8];
#define RA_READ(ks_, buf_) do { _Pragma("unroll") for (int j = 0; j < 2; ++j) fa[buf_][j] = lds_frag_tr(lds + RA_VS + (32 * (ks_) + 8 * fq + trq) * 528 + ((2 * wave + j) * 16 + 4 * trp) * 2, 528); \
        _Pragma("unroll") for (int n = 0; n < 8; ++n) fb[buf_][n] = lds_frag_tr(lds + RA_KS + (32 * (ks_) + 8 * fq + trq) * 272 + (n * 16 + 4 * trp) * 2, 272); } while (0)
    RA_READ(0, 0);
#pragma unroll
    for (int ks = 0; ks < 4; ++ks) {
        if (ks < 3) RA_READ(ks + 1, (ks + 1) & 1);
        __builtin_amdgcn_sched_barrier(0);
#pragma unroll
        for (int n = 0; n < 8; ++n) { MFMA16(acc[0][n], fa[ks & 1][0], fb[ks & 1][n]); MFMA16(acc[1][n], fa[ks & 1][1], fb[ks & 1][n]); }
        __builtin_amdgcn_sched_barrier(0);
    }
#undef RA_READ
    bf16* so = ST + ((size_t)((b * 64 + c) * 4 + h) * 256) * 128;
#pragma unroll
    for (int j = 0; j < 2; ++j)
#pragma unroll
        for (int n = 0; n < 8; ++n) { v2u w; w.x = pk2(acc[j][n][0], acc[j][n][1]); w.y = pk2(acc[j][n][2], acc[j][n][3]);
            *(v2u*)(so + (size_t)((2 * wave + j) * 16 + fr) * 128 + n * 16 + 4 * fq) = w; }
    __syncthreads();
}
__device__ __forceinline__ void ret_scan(bf16* ST, int gtid, int gthreads) {
    for (int e = gtid; e < 131072; e += gthreads) {
        const int b = e >> 16, rem = e & 65535, h = rem >> 14, ed = rem & 16383;
        unsigned* p = (unsigned*)ST + ((size_t)(b * 64) * 4 + h) * 16384 + ed; const float dec = exp2f(128.0f * ret_log2_gamma(h));
        float c0 = 0.f, c1 = 0.f;
#pragma unroll 1
        for (int hf = 0; hf < 2; ++hf) {
            unsigned v[32]; unsigned* pb = p + (size_t)hf * 32 * 4 * 16384;
            { const unsigned* q = pb;
#pragma unroll
              for (int c = 0; c < 32; ++c) { v[c] = *q; q += 4 * 16384; asm volatile("" : "+v"(q)); } }
#pragma unroll
            for (int c = 0; c < 32; ++c) { const unsigned o = pk2(c0, c1); c0 = c0 * dec + __uint_as_float(v[c] << 16); c1 = c1 * dec + __uint_as_float(v[c] & 0xffff0000u); v[c] = o; }
            { unsigned* q = pb;
#pragma unroll
              for (int c = 0; c < 32; ++c) { *q = v[c]; q += 4 * 16384; asm volatile("" : "+v"(q)); } }
        }
    }
}
constexpr int RC_KS = 0, RC_VS = 34816, RC_SP = 102400;
template <int PV> __device__ __forceinline__ void retC_unit(ldsp lds, const bf16* PROJ1, bf16* OUT  , int opitch, const float* COS, const float* SIN, const bf16* ST, int u, int tid, int lane, int wave) {
    asm volatile("" : "+v"(tid), "+v"(lane));
    const int h = u & 3, c = (u >> 2) & 63, b = u >> 8, t0 = b * SEQ + c * 128;
    const int fr = lane & 15, fq = lane >> 4, trq = (lane & 15) >> 2, trp = lane & 3;
    const float lg = ret_log2_gamma(h);
    const int l = 16 * wave + fr; const bf16* prow = PROJ1 + (size_t)(t0 + l) * NPROJ1; bf16* orow = OUT + (size_t)(t0 + l) * opitch;
    if (!(PV & 1)) {
#pragma unroll
    for (int i = 0; i < 8; ++i) { const int idx = tid + 512 * i, rw = idx >> 5, ch = idx & 31;
        *(LAS v4u*)(lds + RC_VS + rw * 528 + ch * 16) = *(const v4u*)(PROJ1 + (size_t)(t0 + rw) * NPROJ1 + C1_RV + h * 256 + ch * 8); }
    }
    if (!(PV & 1)) { const int s = tid >> 2, q4 = tid & 3;
      rope_row_store(PROJ1 + (size_t)(t0 + s) * NPROJ1 + C1_RK + h * 128, COS, SIN, c * 128 + s, q4, 0.08838834764831845f, lds + RC_KS + s * 272); }
    bf16x8 qf[4], qx[4];
    { v4u raw[4];
#pragma unroll
      for (int ks = 0; ks < 4; ++ks) raw[ks] = *(const v4u*)(prow + C1_RQ + h * 128 + 32 * ks + 8 * fq);
      const float xi = exp2f((float)(l + 1) * lg);
#pragma unroll
      for (int k2 = 0; k2 < 2; ++k2) { const float* cp = COS + (size_t)(c * 128 + l) * 64 + 32 * k2 + 8 * fq; const float* sp = SIN + (size_t)(c * 128 + l) * 64 + 32 * k2 + 8 * fq;
          v4u o1, o2, x1, x2;
#pragma unroll
          for (int j = 0; j < 4; ++j) { const f32x4 cc = *(const f32x4*)(cp + 4 * (j >> 1)), ss = *(const f32x4*)(sp + 4 * (j >> 1));
              const float c0 = cc[2 * (j & 1)], c1 = cc[2 * (j & 1) + 1], s0 = ss[2 * (j & 1)], s1 = ss[2 * (j & 1) + 1];
              const float a0 = __uint_as_float(raw[k2][j] << 16), a1 = __uint_as_float(raw[k2][j] & 0xffff0000u), b0 = __uint_as_float(raw[k2 + 2][j] << 16), b1 = __uint_as_float(raw[k2 + 2][j] & 0xffff0000u);
              const float r10 = a0 * c0 - b0 * s0, r11 = a1 * c1 - b1 * s1, r20 = a0 * s0 + b0 * c0, r21 = a1 * s1 + b1 * c1;
              o1[j] = pk2(r10, r11); o2[j] = pk2(r20, r21); x1[j] = pk2(r10 * xi, r11 * xi); x2[j] = pk2(r20 * xi, r21 * xi); }
          qf[k2] = __builtin_bit_cast(bf16x8, o1); qf[k2 + 2] = __builtin_bit_cast(bf16x8, o2); qx[k2] = __builtin_bit_cast(bf16x8, x1); qx[k2 + 2] = __builtin_bit_cast(bf16x8, x2); } }
    __syncthreads();
    f32x4 sc[8];
#pragma unroll
    for (int n = 0; n < 8; ++n) { sc[n] = (f32x4){0.f, 0.f, 0.f, 0.f};
#pragma unroll
        for (int ks = 0; ks < 4; ++ks) { const bf16x8 kf = lds_frag(lds + RC_KS + (16 * n + fr) * 272 + 64 * ks + 16 * fq); MFMA16(sc[n], qf[ks], kf); } }
    __syncthreads();
#pragma unroll
    for (int n = 0; n < 8; ++n) { float mv[4];
#pragma unroll
        for (int i = 0; i < 4; ++i) { const int s = 16 * n + 4 * fq + i; mv[i] = (s <= l) ? sc[n][i] * __builtin_amdgcn_exp2f((float)(l - s) * lg) : 0.f; }
        v2u w; w.x = pk2(mv[0], mv[1]); w.y = pk2(mv[2], mv[3]); *(LAS v2u*)(lds + RC_KS + l * 272 + (16 * n + 4 * fq) * 2) = w; }
    f32x4 o[16];
#pragma unroll
    for (int e = 0; e < 16; ++e) o[e] = (f32x4){0.f, 0.f, 0.f, 0.f};
    v2u gts[16];
#pragma unroll
    for (int e = 0; e < 16; ++e) gts[e] = *(const v2u*)(prow + C1_RG + h * 256 + 16 * e + 4 * fq);
    const bf16* sp = ST + ((size_t)((b * 64 + c) * 4 + h) * 256) * 128;
    const int sprow = tid >> 2, spc = tid & 3;
    v4u spr[2];
#pragma unroll
    for (int i = 0; i < 2; ++i) spr[i] = *(const v4u*)(sp + (size_t)(sprow + 128 * i) * 128 + spc * 8);
#pragma unroll
    for (int ks = 0; ks < ((PV & 2) ? 0 : 4); ++ks) {
        const ldsp slot = lds + RC_SP + (ks & 1) * 20480;
#pragma unroll
        for (int i = 0; i < 2; ++i) *(LAS v4u*)(slot + (sprow + 128 * i) * 80 + spc * 16) = spr[i];
        if (ks < 3) {
#pragma unroll
            for (int i = 0; i < 2; ++i) spr[i] = *(const v4u*)(sp + (size_t)(sprow + 128 * i) * 128 + 32 * (ks + 1) + spc * 8); }
        __syncthreads();
        const bf16x8 mf = lds_frag(lds + RC_KS + l * 272 + 64 * ks + 16 * fq);
#pragma unroll
        for (int eh = 0; eh < 2; ++eh) { bf16x8 sf[8], vf[8];
#pragma unroll
            for (int e = 0; e < 8; ++e) { sf[e] = lds_frag(slot + (16 * (8 * eh + e) + fr) * 80 + 16 * fq);
                vf[e] = lds_frag_tr(lds + RC_VS + (32 * ks + 8 * fq + trq) * 528 + (16 * (8 * eh + e) + 4 * trp) * 2, 528); }
            __builtin_amdgcn_sched_barrier(0);
#pragma unroll
            for (int e = 0; e < 8; ++e) { MFMA16(o[8 * eh + e], qx[ks], sf[e]); MFMA16(o[8 * eh + e], mf, vf[e]); }
            __builtin_amdgcn_sched_barrier(0); }
    }
    float ssq = 0.f;
#pragma unroll
    for (int e = 0; e < 16; ++e) ssq += (o[e][0] * o[e][0] + o[e][1] * o[e][1]) + (o[e][2] * o[e][2] + o[e][3] * o[e][3]);
    ssq += __shfl_xor(ssq, 16); ssq += __shfl_xor(ssq, 32);
    const float rs = 1.0f / sqrtf(ssq * (1.f / 256.f) + EPS);
#pragma unroll
    for (int e = 0; e < 16; ++e) { const v2u gw_ = gts[e];
        const float g0 = __uint_as_float(gw_.x << 16), g1 = __uint_as_float(gw_.x & 0xffff0000u), g2 = __uint_as_float(gw_.y << 16), g3 = __uint_as_float(gw_.y & 0xffff0000u);
        v2u w; w.x = pk2(o[e][0] * rs * silu_f(g0), o[e][1] * rs * silu_f(g1)); w.y = pk2(o[e][2] * rs * silu_f(g2), o[e][3] * rs * silu_f(g3)); *(v2u*)(orow + h * 256 + 16 * e + 4 * fq) = w; }
    __syncthreads();
}

#ifndef PROBE_CV
#define PROBE_CV 0
#endif
#ifndef MK_PER_PHASE
#define MK_PER_PHASE 0
#endif
constexpr int N_PHASES = 21;
#ifndef PROBE_G
#define PROBE_G 0u
#endif
#ifndef PROBE_BAR
#define PROBE_BAR 0
#endif
#ifndef PROBE_VAR
#define PROBE_VAR 0
#endif
#ifndef PROBE_REP
#define PROBE_REP 0u
#endif
struct Args { const float* in[N_IN]; float* out; unsigned char* ws; int ph_lo, ph_hi, pad0, pad1; };
__global__ void __launch_bounds__(NTHR, 2) trunk_fwd(Args args) {
    extern __shared__ __attribute__((aligned(16))) unsigned char lds_raw[];
    const ldsp lds = (ldsp)lds_raw;
    volatile LAS unsigned* MISC = (volatile LAS unsigned*)(lds + MISC_OFF);
    const int tid = threadIdx.x, lane = tid & 63, wave = __builtin_amdgcn_readfirstlane(tid >> 6);
    const int G = gridDim.x; const int bx = blockIdx.x; const int vcu = (G % 8 == 0) ? (bx % 8) * (G / 8) + bx / 8 : bx;
    const int gw = vcu * NWAVES + wave, NGW = G * NWAVES, gtid = vcu * NTHR + tid, gthreads = G * NTHR;
    unsigned char* ws = args.ws;
    gu32* ctl = (gu32*)(ws + WS_CTL);
    for (int u = tid; u < 64; u += NTHR) MISC[u] = 0u;
    __syncthreads();
    XcdBarrier bar; bar.bar = (unsigned*)(ctl + CW_BAR); bar.x = 0; bar.st = nullptr;
    if (!MK_PER_PHASE) bar = xcd_barrier_post((unsigned*)(ctl + CW_BAR), MISC + 8);
    const int lo = args.ph_lo, hi = args.ph_hi;
#define IN(k) (lo <= (k) && (k) < hi)
#define SEAM(k) do { if (IN(k) && IN((k) + 1)) { xcd_barrier<true>(bar); if (PROBE_BAR == 1) xcd_barrier<true>(bar); if (PROBE_BAR == 2) xcd_barrier<false>(bar); } } while (0)
#define REPS(k) (((PROBE_REP >> (k)) & 1u) ? 2 : 1)
    float* MOD = (float*)(ws + WS_MOD); bf16* WDT = (bf16*)(ws + WS_WDT); float* CHDEC = (float*)(ws + WS_CHDEC); float* SSQ = (float*)(ws + WS_SSQ);
    bf16* WMIX = (bf16*)(ws + WS_WMIX); bf16* WOUT0 = (bf16*)(ws + WS_WOUT0); bf16* WOUT1 = (bf16*)(ws + WS_WOUT1);
    bf16* PROJ0 = (bf16*)(ws + WS_PROJ0); bf16* XB = (bf16*)(ws + WS_XN2); bf16* XN2 = (bf16*)args.out;     bf16* W1T = (bf16*)(ws + WS_WMLP); bf16* W2T = (bf16*)(ws + WS_WMLP + 8 * MiB);
    bf16* HB = (bf16*)(ws + WS_H); bf16* PROJ1 = (bf16*)(ws + WS_H); bf16* SB = (bf16*)(ws + WS_S); float* DT = (float*)(ws + WS_DT);
    unsigned* KMAX = (unsigned*)(ws + WS_KMAX);
    float* COS = (float*)(ws + WS_ROPE); float* SIN = COS + 8192 * 64;
    const bool fuse = (G == 256) && !PROBE_REP && !PROBE_G;
    float* XCH1 = (float*)(ws + WS_XCH); float* XCH2 = (float*)(ws + WS_XCH + MiB); unsigned* TMO = (unsigned*)(ctl + CW_BAR) + XB_TMO;
    bf16* W1T0 = fuse ? (bf16*)((char*)args.out + 32 * MiB) : W1T; bf16* W2T0 = fuse ? (bf16*)((char*)args.out + 40 * MiB) : W2T;
    const float* x_in = args.in[I_X]; const float* ng = args.in[I_NG]; float* X = args.out;

    if (IN(0)) for (int rep0 = 0; rep0 < REPS(0); ++rep0) {
        const Seg segs[4] = { {args.in[I_EWIN], 6160, 0, 1024, 1024, WMIX, 0}, {args.in[I_EWIN], 6160, 3088, 3072, 1024, WMIX, 1024}, {args.in[I_EWIN], 6160, 1024, 2048, 1024, WMIX, 4096},
                              {args.in[I_EWOUT], 1024, 0, 1024, 2048, WOUT0, 0} };
        convert_set<4>(segs, lds, gw, NGW, wave, lane);
        for (int i = gtid; i < 16384; i += gthreads) { const int h = i >> 10, k = i & 1023; WDT[i] = f2bf(args.in[I_EWIN][(size_t)k * 6160 + 3072 + h]); }
        for (int i = gtid; i < 8192 * 64; i += gthreads) { const int t = i >> 6, f = i & 63; const float inv = powf(10000.0f, -(float)f * (1.0f / 64.0f)); const float ang = (float)t * inv;
            const double a = (double)ang; const double n = rint(a * 0.15915494309189535); const float r = (float)(a - n * 6.283185307179586); COS[i] = __cosf(r); SIN[i] = __sinf(r); }
        __syncthreads();
        mod_phase(args.in[I_C], args.in[I_MODW], args.in[I_MODB], MOD, lds, tid, lane, wave);
    }
    SEAM(0);
    if (IN(1)) for (int rep1 = 0; rep1 < REPS(1); ++rep1) norm_rows<-1, 0, false, 0>(x_in, nullptr, nullptr, SB, MOD, ng, gw, NGW, lane);
    SEAM(1);
    if (IN(2)) {
        pg8::Gemm g{SB, WMIX, MTOK, NPROJ0, DM, DM}; pg8::StaticOrder S; S.init(MTOK, NPROJ0, G, bx);
        pg8::EpiBf16<0> E{PROJ0, NPROJ0, nullptr, 0, 0, 1.f};
        if ((PROBE_G >> 2) & 1u) { pg8::gemm_phase<pg8::EpiBf16<0>, pg8::StaticOrder, true, true>(lds, g, S, E); __syncthreads(); } pg8::gemm_phase<pg8::EpiBf16<0>, pg8::StaticOrder, true, true>(lds, g, S, E);
        dt_phase(SB, WDT, args.in[I_EDTB], DT, gw, NGW, lane);
    }
    SEAM(2);
    if (IN(3)) { kmax_rows(PROJ0, KMAX, gw, NGW, lane);
        for (int rep = 0; rep < REPS(3); ++rep) for (int u = vcu; u < 512; u += G) ssdA_unit(lds, PROJ0, DT, args.in[I_ECONVW], args.in[I_ECONVB], args.in[I_EALOG], SB, CHDEC, u, tid, lane, wave); }
    SEAM(3);
    if (IN(4)) ssd_scan(SB, CHDEC, gtid, gthreads);
    SEAM(4);
    if (IN(5)) { for (int rep = 0; rep < REPS(5); ++rep) for (int u = vcu; u < 512; u += G) { if (rep + 1 < REPS(5)) ssdC_unit<(PROBE_VAR < 32 ? PROBE_VAR : 0)>(lds, PROJ0, (bf16*)args.out, 1024, DT, args.in[I_ECONVW], args.in[I_ECONVB], args.in[I_EALOG], args.in[I_ED], args.in[I_ESSDN], SB, SSQ, u, tid, lane, wave); else ssdC_unit<0>(lds, PROJ0, PROJ0 + C0_Z, NPROJ0, DT, args.in[I_ECONVW], args.in[I_ECONVB], args.in[I_EALOG], args.in[I_ED], args.in[I_ESSDN], SB, SSQ, u, tid, lane, wave); } }
    SEAM(5);
    if (IN(6)) {
        if (!fuse) ssd_normalize_rows(PROJ0, SSQ, gw, NGW, lane);
        const float* lm = args.in[I_ELAM];
        const float lam = expf(wave_sum(lm[lane] * lm[64 + lane])) - expf(wave_sum(lm[128 + lane] * lm[192 + lane])) + 0.2f;
        __syncthreads();
        for (int rep = 0; rep < REPS(6); ++rep)
        for (int u = vcu; u < 1024; u += G) { const int v = u & 255, i = u >> 8, j = v & 15, bh = v >> 4; const int qb = i == 0 ? j : (i == 1 ? 63 - j : (i == 2 ? 16 + j : 47 - j));
            if (PROBE_VAR >= 16 && rep + 1 < REPS(6)) { }
            else if (rep + 1 < REPS(6)) dattn5_unit<PROBE_VAR < 16 ? PROBE_VAR : 0>(lds, PROJ0, (bf16*)args.out, 1024, args.in[I_RELB], args.in[I_EDIFFN], KMAX, lam, bh >> 3, bh & 7, qb, tid, lane, wave, nullptr);
            else dattn5_unit<0>(lds, PROJ0, PROJ0 + C0_Q, NPROJ0, args.in[I_RELB], args.in[I_EDIFFN], KMAX, lam, bh >> 3, bh & 7, qb, tid, lane, wave, fuse ? SSQ : nullptr); }
    }
    SEAM(6);
    if (IN(7)) {
        pg8::Gemm g{PROJ0, WOUT0, MTOK, DM, 2048, NPROJ0}; pg8::StaticOrder S; S.init(MTOK, DM, G, bx);
        if (fuse) { pg8::EpiNorm<0, 1, false, 1, true> EN{x_in, SB  , XN2, MOD, ng, {XCH1, (unsigned*)ctl + 0 * 512, TMO}, {XCH2, (unsigned*)ctl + 1 * 512, TMO}, EPS, SSQ};
            pg8::gemm_phase<pg8::EpiNorm<0, 1, false, 1, true>, pg8::StaticOrder, true, true>(lds, g, S, EN); } else {
        pg8::EpiBf16<0> E{SB, DM, nullptr, 0, 0, 1.f};
        if ((PROBE_G >> 7) & 1u) { pg8::gemm_phase<pg8::EpiBf16<0>, pg8::StaticOrder, true, true>(lds, g, S, E); __syncthreads(); } pg8::gemm_phase<pg8::EpiBf16<0>, pg8::StaticOrder, true, true>(lds, g, S, E); }
    }
    if (!fuse) SEAM(7); else __syncthreads();
    if (IN(8)) {
        const Seg segs[2] = { {args.in[I_W1], 4096, 0, 4096, 1024, W1T0, 0}, {args.in[I_W2], 1024, 0, 1024, 4096, W2T0, 0} };
        convert_set<2>(segs, lds, gw, NGW, wave, lane); if (PROBE_CV) convert_set<2>(segs, lds, gw, NGW, wave, lane);
        if (!fuse) norm_rows<0, 1, false, 1>(x_in, SB, XB, XN2, MOD, ng, gw, NGW, lane);
    }
    SEAM(8);
    if (IN(9)) {
        pg8::Gemm g{XN2, W1T0, MTOK, FF, DM, DM}; pg8::StaticOrder S; S.init(MTOK, FF, G, bx);
        pg8::EpiBf16<2> E{HB, FF, nullptr, 0, 0, 1.f};
        if ((PROBE_G >> 9) & 1u) { pg8::gemm_phase<pg8::EpiBf16<2>, pg8::StaticOrder, true, true>(lds, g, S, E); __syncthreads(); } pg8::gemm_phase<pg8::EpiBf16<2>, pg8::StaticOrder, true, true>(lds, g, S, E);
    }
    SEAM(9);
    if (IN(10)) {
        pg8::Gemm g{HB, W2T0, MTOK, DM, FF, FF}; pg8::StaticOrder S; S.init(MTOK, DM, G, bx);
        if (fuse) { pg8::EpiNorm<1, 2, true, 1> EN{SB, XB, XN2, MOD, ng, {XCH1, (unsigned*)ctl + 2 * 512, TMO}, {XCH2, (unsigned*)ctl + 3 * 512, TMO}, EPS};
            pg8::gemm_phase<pg8::EpiNorm<1, 2, true, 1>, pg8::StaticOrder, true, true>(lds, g, S, EN); } else {
        pg8::EpiBf16<0> E{SB, DM, nullptr, 0, 0, 1.f};
        if ((PROBE_G >> 10) & 1u) { pg8::gemm_phase<pg8::EpiBf16<0>, pg8::StaticOrder, true, true>(lds, g, S, E); __syncthreads(); } pg8::gemm_phase<pg8::EpiBf16<0>, pg8::StaticOrder, true, true>(lds, g, S, E); }
    }
    if (!fuse) SEAM(10); else __syncthreads();
    if (IN(11)) {
        const Seg segs[4] = { {args.in[I_OWIN], 3840, 2048, 1536, 1024, WMIX, 0}, {args.in[I_OWIN], 3840, 0, 2048, 1024, WMIX, 1536}, {args.in[I_OWIN], 3840, 3584, 256, 1024, WMIX, 3584},
                              {args.in[I_OWOUT], 1024, 0, 1024, 1536, WOUT1, 0} };
        convert_set<4>(segs, lds, gw, NGW, wave, lane); if (PROBE_CV) convert_set<4>(segs, lds, gw, NGW, wave, lane);
        if (!fuse) norm_rows<1, 2, true, 1>(XB, SB, XB, XN2, MOD, ng, gw, NGW, lane);
    }
    SEAM(11);
    if (IN(12)) {
        pg8::Gemm g{XN2, WMIX, MTOK, NPROJ1, DM, DM}; pg8::StaticOrder S; S.init(MTOK, NPROJ1, G, bx);
        pg8::EpiBf16<0> E{PROJ1, NPROJ1, nullptr, 0, 0, 1.f};
        if ((PROBE_G >> 12) & 1u) { pg8::gemm_phase<pg8::EpiBf16<0>, pg8::StaticOrder, true, true>(lds, g, S, E); __syncthreads(); } pg8::gemm_phase<pg8::EpiBf16<0>, pg8::StaticOrder, true, true>(lds, g, S, E);
        }
    SEAM(12);
    if (IN(13)) {
        for (int rep = 0; rep < REPS(13); ++rep) {
        for (int u = vcu; u < 512; u += G) retA_unit(lds, PROJ1, COS, SIN, SB, u, tid, lane, wave);
        for (int u = vcu; u < 256; u += G) swa_unit(lds, PROJ1, (rep + 1 < REPS(13)) ? XN2 : PROJ1 + C1_SQ, (rep + 1 < REPS(13)) ? 1024 : NPROJ1, args.in[I_RELB], args.in[I_OSINK], u >> 7, (u >> 1) & 63, u & 1, tid, lane, wave); }
    }
    SEAM(13);
    if (IN(14)) ret_scan(SB, gtid, gthreads);
    SEAM(14);
    if (IN(15)) { for (int rep = 0; rep < REPS(15); ++rep) for (int u = vcu; u < 512; u += G) { if (rep + 1 < REPS(15)) retC_unit<(PROBE_VAR < 16 ? PROBE_VAR : 0)>(lds, PROJ1, XN2, 1024, COS, SIN, SB, u, tid, lane, wave); else retC_unit<0>(lds, PROJ1, PROJ1 + C1_RG, NPROJ1, COS, SIN, SB, u, tid, lane, wave); } }
    SEAM(15);
    if (IN(16)) {
        pg8::Gemm g{PROJ1, WOUT1, MTOK, DM, 1536, NPROJ1}; pg8::StaticOrder S; S.init(MTOK, DM, G, bx);
        if (fuse) { pg8::EpiNorm<2, 3, true, 1> EN{XB, XB, XN2, MOD, ng, {XCH1, (unsigned*)ctl + 4 * 512, TMO}, {XCH2, (unsigned*)ctl + 5 * 512, TMO}, EPS};
            pg8::gemm_phase<pg8::EpiNorm<2, 3, true, 1>, pg8::StaticOrder, true, true>(lds, g, S, EN); } else {
        pg8::EpiBf16<0> E{SB, DM, nullptr, 0, 0, 1.f};
        if ((PROBE_G >> 16) & 1u) { pg8::gemm_phase<pg8::EpiBf16<0>, pg8::StaticOrder, true, true>(lds, g, S, E); __syncthreads(); } pg8::gemm_phase<pg8::EpiBf16<0>, pg8::StaticOrder, true, true>(lds, g, S, E); }
    }
    if (!fuse) SEAM(16); else __syncthreads();
    if (IN(17)) {
        const Seg segs[2] = { {args.in[I_W1] + (size_t)DM * FF, 4096, 0, 4096, 1024, W1T, 0}, {args.in[I_W2] + (size_t)DM * FF, 1024, 0, 1024, 4096, W2T, 0} };
        convert_set<2>(segs, lds, gw, NGW, wave, lane); if (PROBE_CV) convert_set<2>(segs, lds, gw, NGW, wave, lane);
        if (!fuse) norm_rows<2, 3, true, 1>(XB, SB, XB, XN2, MOD, ng, gw, NGW, lane);
    }
    SEAM(17);
    if (IN(18)) {
        pg8::Gemm g{XN2, W1T, MTOK, FF, DM, DM}; pg8::StaticOrder S; S.init(MTOK, FF, G, bx);
        pg8::EpiBf16<2> E{HB, FF, nullptr, 0, 0, 1.f};
        if ((PROBE_G >> 18) & 1u) { pg8::gemm_phase<pg8::EpiBf16<2>, pg8::StaticOrder, true, true>(lds, g, S, E); __syncthreads(); } pg8::gemm_phase<pg8::EpiBf16<2>, pg8::StaticOrder, true, true>(lds, g, S, E);
    }
    SEAM(18);
    if (IN(19)) {
        pg8::Gemm g{HB, W2T, MTOK, DM, FF, FF}; pg8::StaticOrder S; S.init(MTOK, DM, G, bx);
        if (fuse) { pg8::EpiNorm<3, -1, true, 2> EN{XB, X, nullptr, MOD, ng, {XCH1, (unsigned*)ctl + 6 * 512, TMO}, {XCH2, (unsigned*)ctl + 7 * 512, TMO}, EPS};
            pg8::gemm_phase<pg8::EpiNorm<3, -1, true, 2>, pg8::StaticOrder, true, true>(lds, g, S, EN); } else {
        pg8::EpiBf16<0> E{SB, DM, nullptr, 0, 0, 1.f};
        if ((PROBE_G >> 19) & 1u) { pg8::gemm_phase<pg8::EpiBf16<0>, pg8::StaticOrder, true, true>(lds, g, S, E); __syncthreads(); } pg8::gemm_phase<pg8::EpiBf16<0>, pg8::StaticOrder, true, true>(lds, g, S, E); }
    }
    if (!fuse) {
    SEAM(19);
    if (IN(20)) norm_rows<3, -1, true, 2>(XB, SB, X, nullptr, MOD, ng, gw, NGW, lane);
    }
#undef IN
#undef SEAM
}

extern "C" void kernel_launch(void* const* d_in, const int* in_sizes, int n_in, void* d_out, int out_size, void* d_ws, size_t ws_size, hipStream_t stream) {
    static int grid = 0;
    if (grid == 0) {
        if (n_in != N_IN || out_size != MTOK * DM || ws_size < WS_END) { fprintf(stderr, "kernel_launch: unexpected shapes (n_in %d, out %d, ws %zu); nothing launched\n", n_in, out_size, ws_size); grid = -1; return; }
        int dev = 0, cus = 0, per_cu = 0;
        if (hipGetDevice(&dev) != hipSuccess || hipDeviceGetAttribute(&cus, hipDeviceAttributeMultiprocessorCount, dev) != hipSuccess) { grid = -1; return; }
        if (hipFuncSetAttribute((const void*)trunk_fwd, hipFuncAttributeMaxDynamicSharedMemorySize, LDS_BYTES) != hipSuccess) { fprintf(stderr, "kernel_launch: hipFuncSetAttribute failed\n"); grid = -1; return; }
        if (hipOccupancyMaxActiveBlocksPerMultiprocessor(&per_cu, (const void*)trunk_fwd, NTHR, LDS_BYTES) != hipSuccess || per_cu < 1) { fprintf(stderr, "kernel_launch: occupancy query says %d blocks per CU\n", per_cu); (void)hipGetLastError(); grid = -1; return; }
        grid = cus;
    }
    if (grid < 0) return;
    (void)hipMemsetAsync((char*)d_ws + WS_CTL, 0, CTL_ZERO_BYTES, stream);
    Args a{};
    for (int i = 0; i < N_IN; ++i) a.in[i] = (const float*)d_in[i];
    a.out = (float*)d_out; a.ws = (unsigned char*)d_ws;
#if MK_PER_PHASE
    for (int p = 0; p < N_PHASES; ++p) { a.ph_lo = p; a.ph_hi = p + 1; hipLaunchKernelGGL(trunk_fwd, dim3(grid), dim3(NTHR), LDS_BYTES, stream, a); }
#else
    a.ph_lo = 0; a.ph_hi = N_PHASES;
    hipLaunchKernelGGL(trunk_fwd, dim3(grid), dim3(NTHR), LDS_BYTES, stream, a);
#endif
}
```

```cpp
#include <hip/hip_runtime.h>
#include <cstdio>
#include <cstdint>
#include <cmath>
namespace pg8 {
#define PG8_LAS __attribute__((address_space(3)))
typedef unsigned short bf16_t;
typedef short bf16x8 __attribute__((ext_vector_type(8)));
typedef float f32x4 __attribute__((ext_vector_type(4)));
typedef unsigned u32x4 __attribute__((ext_vector_type(4)));
constexpr int BM = 256, BK = 64, HALF = 128, HTB = HALF * BK * 2  , STAGE_BYTES = 8 * HTB, NXCD = 8, WGM = 4;

__host__ __device__ __forceinline__ int lds_byte(int r, int c) { const int st = (r >> 4) * 2 + (c >> 5), rr = r & 15, cc = c & 31, ob = rr * 64 + cc * 2; return st * 1024 + (ob ^ (((ob >> 9) & 1) << 5)); }
__host__ __device__ __forceinline__ void stage_rc(int b, int& R, int& C) { const int st = b / 1024, sb = b % 1024, swz = sb ^ (((sb >> 9) & 1) << 5); R = (st >> 1) * 16 + swz / 64; C = (st & 1) * 32 + (swz % 64) / 2; }
__host__ __device__ __forceinline__ int perm32(int rho) { const int n = rho >> 4, i = rho & 15; return 8 * (i >> 2) + 4 * n + (i & 3); }

struct Unit { int pm, pn; };
struct Gemm { const bf16_t* A; const bf16_t* Bt; int M, N, K, lda; };

struct StaticOrder {
    int nM, nN, nwg, G, c;
    __host__ __device__ void init(int M, int N, int G_, int c_) { nM = M / BM; nN = N / BM; nwg = nM * nN; G = G_; c = c_; }
    __host__ __device__ __forceinline__ bool next(int i, Unit& u) const {
        const long L = (long)i * G + c; if (L >= nwg) return false;
        int wgid = (int)L; { const int q = nwg / NXCD, r = nwg % NXCD, xcd = wgid % NXCD, off = wgid / NXCD; wgid = (xcd < r ? xcd * (q + 1) : r * (q + 1) + (xcd - r) * q) + off; }
        const int wgm = (nN <= 4) ? 2 * WGM : WGM;
        const int nig = wgm * nN, gid = wgid / nig, fm = gid * wgm, gsz = (nM - fm) < wgm ? (nM - fm) : wgm;
        u.pm = fm + ((wgid % nig) % gsz); u.pn = (wgid % nig) / gsz; return true;
    }
    __device__ __forceinline__ void a_ready(const Unit&) const {}
    __device__ __forceinline__ void done(const Unit&) const {}
};

__device__ __forceinline__ unsigned cvt_pk_bf16(float lo, float hi) { unsigned r; asm volatile("v_cvt_pk_bf16_f32 %0, %1, %2" : "=v"(r) : "v"(lo), "v"(hi)); return r; }
typedef float f32x2 __attribute__((ext_vector_type(2)));
__device__ __forceinline__ f32x2 gelu_pk(f32x2 v) {
    const f32x2 av = __builtin_elementwise_abs(v), d = av * 0.2316418882f + 1.0f;
    f32x2 t; t.x = __builtin_amdgcn_rcpf(d.x); t.y = __builtin_amdgcn_rcpf(d.y);
    f32x2 q = t * 0.5307027145f + (-0.7265760135f); q = q * t + 0.7107068705f; q = q * t + (-0.142248368f); q = q * t + 0.127414796f; q = q * t;
    const f32x2 s = (v * v) * (-0.72134752044f);
    f32x2 e; e.x = __builtin_amdgcn_exp2f(s.x); e.y = __builtin_amdgcn_exp2f(s.y);
    const f32x2 m = v * (q * e), r = v - m;
    f32x2 o; o.x = v.x < 0.f ? m.x : r.x; o.y = v.y < 0.f ? m.y : r.y; return o;
}

template <int ACT  > struct EpiBf16 {
    static constexpr bool PERM = true, AFTER_DRAIN = false; static_assert(ACT == 0 || ACT == 1 || ACT == 2, "EpiBf16: ACT is 0 (none), 1 (gelu_pk) or 2 (squared relu)");
    bf16_t* O; int ldc; const float* bias; int split_cols; size_t split_stride; float scale0;
    __device__ __forceinline__ void operator()(const f32x4 (&acc)[2][2][4][2], const Unit& u, int wr, int wc, int fr, int fq) const {
        const int row0 = u.pm * BM + wr * 64 + fr; int colt = u.pn * BM; bf16_t* base = O;
        float sc = 1.f; if (split_cols) { const int t = colt / split_cols; base += (size_t)t * split_stride; colt -= t * split_cols; if (t == 0) sc = scale0; }
        const int col0 = colt + wc * 32 + 8 * fq, bcol0 = u.pn * BM + wc * 32 + 8 * fq;
        f32x4 bv[2][2];
#pragma unroll
        for (int bj = 0; bj < 2; ++bj)
#pragma unroll
            for (int n = 0; n < 2; ++n) bv[bj][n] = bias ? *(const f32x4*)(bias + bcol0 + bj * HALF + 4 * n) : (f32x4){0.f, 0.f, 0.f, 0.f};
#pragma unroll
        for (int ai = 0; ai < 2; ++ai)
#pragma unroll
            for (int m = 0; m < 4; ++m) { bf16_t* rowp = base + (size_t)(row0 + ai * HALF + m * 16) * ldc + col0;
#pragma unroll
                for (int bj = 0; bj < 2; ++bj) { f32x4 v0 = acc[ai][bj][m][0] + bv[bj][0], v1 = acc[ai][bj][m][1] + bv[bj][1];
                    if (ACT == 1) { f32x2 a = gelu_pk((f32x2){v0[0], v0[1]}), b = gelu_pk((f32x2){v0[2], v0[3]}), c = gelu_pk((f32x2){v1[0], v1[1]}), d = gelu_pk((f32x2){v1[2], v1[3]});
                        v0 = (f32x4){a.x, a.y, b.x, b.y}; v1 = (f32x4){c.x, c.y, d.x, d.y}; }
                    if (ACT == 2) { v0 = __builtin_elementwise_max(v0, (f32x4){0.f,0.f,0.f,0.f}); v1 = __builtin_elementwise_max(v1, (f32x4){0.f,0.f,0.f,0.f}); v0 = v0 * v0; v1 = v1 * v1; }
                    v0 = v0 * sc; v1 = v1 * sc; u32x4 w; w.x = cvt_pk_bf16(v0[0], v0[1]); w.y = cvt_pk_bf16(v0[2], v0[3]); w.z = cvt_pk_bf16(v1[0], v1[1]); w.w = cvt_pk_bf16(v1[2], v1[3]);
                    *(u32x4*)(rowp + bj * HALF) = w; } }
    }
};

struct RowExch {
    float* slots;
    unsigned* tmo;
    __device__ __forceinline__ void publish(const float (&ss)[2][4], const Unit& u, int wr, int wc, int fr, int fq, PG8_LAS unsigned char* lds, int wid, int lane) const {
        PG8_LAS float* P = (PG8_LAS float*)lds;
#pragma unroll
        for (int ai = 0; ai < 2; ++ai)
#pragma unroll
            for (int m = 0; m < 4; ++m) { float s = ss[ai][m]; s += __shfl_xor(s, 16); s += __shfl_xor(s, 32); if (fq == 0) P[(ai * HALF + wr * 64 + m * 16 + fr) * 4 + wc] = s; }
        asm volatile("s_waitcnt lgkmcnt(0)" ::: "memory"); __builtin_amdgcn_s_barrier(); asm volatile("" ::: "memory");
        const int row = wid * 32 + (lane & 31);
        if (lane < 32) { const f32x4 p = *(const PG8_LAS f32x4*)(P + row * 4);
            __hip_atomic_store((unsigned*)slots + ((size_t)(u.pm * BM + row) * 4 + u.pn), __float_as_uint((p[0] + p[1]) + (p[2] + p[3])), __ATOMIC_RELAXED, __HIP_MEMORY_SCOPE_AGENT); }
        asm volatile("" ::: "memory"); __builtin_amdgcn_sched_barrier(0);
    }
    __device__ __forceinline__ void collect(const Unit& u, int wr, int fr, PG8_LAS unsigned char* lds, int wid, int lane, float eps, float (&rinv)[2][4]) const {
        PG8_LAS float* S = (PG8_LAS float*)(lds + 4096);
        const int row = wid * 32 + (lane & 31);
        const unsigned* sl = (const unsigned*)slots + (size_t)(u.pm * BM + row) * 4;
        u32x4 w; unsigned sp = 0;
#pragma unroll 1
        for (;;) {
            asm volatile("global_load_dwordx4 %0, %1, off sc1\n\ts_waitcnt vmcnt(0)" : "=v"(w) : "v"(sl) : "memory");
            const bool ok = (w[0] != 0xffffffffu) && (w[1] != 0xffffffffu) && (w[2] != 0xffffffffu) && (w[3] != 0xffffffffu);
            if (__builtin_amdgcn_ballot_w64(!ok) == 0ull) break;
            __builtin_amdgcn_s_sleep(1);
            if ((++sp & 255u) == 0u) { if (__hip_atomic_load(tmo, __ATOMIC_RELAXED, __HIP_MEMORY_SCOPE_AGENT)) break; if (sp > (1u << 18)) { if (lane == 0) atomicAdd(tmo, 1u); break; } }
        }
        const unsigned w0 = w[0], w1 = w[1], w2 = w[2], w3 = w[3];
        if (lane < 32) S[row] = 1.0f / sqrtf(((__uint_as_float(w0) + __uint_as_float(w1)) + (__uint_as_float(w2) + __uint_as_float(w3))) * (1.0f / 1024.0f) + eps);
        asm volatile("s_waitcnt lgkmcnt(0)" ::: "memory"); __builtin_amdgcn_s_barrier(); asm volatile("" ::: "memory");
#pragma unroll
        for (int ai = 0; ai < 2; ++ai)
#pragma unroll
            for (int m = 0; m < 4; ++m) rinv[ai][m] = S[ai * HALF + wr * 64 + m * 16 + fr];
        asm volatile("s_waitcnt lgkmcnt(0)" ::: "memory"); __builtin_amdgcn_s_barrier(); asm volatile("" ::: "memory");
    }
};
template <int SPOST, int SPRE, bool XINB, int XOUT, bool RS = false> struct EpiNorm {
    static constexpr bool PERM = true, AFTER_DRAIN = true;
    const void* xin; void* xout; bf16_t* XN; const float* MOD; const float* ng; RowExch e1, e2; float eps; const float* rowsq;
    __device__ __forceinline__ void operator()(const f32x4 (&)[2][2][4][2], const Unit&, int, int, int, int) const {}
    __device__ __forceinline__ void fused(f32x4 (&acc)[2][2][4][2], const Unit& u, int wr, int wc, int fr, int fq, PG8_LAS unsigned char* lds, int wid, int lane) const {
        const int b = u.pm >> 5;
        const int col0 = u.pn * BM + wc * 32 + 8 * fq;
        const size_t off0 = (size_t)(u.pm * BM + wr * 64 + fr) * 1024 + col0;
#define EN_OFF(ai, m, bj) (off0 + (size_t)((ai) * HALF + (m) * 16) * 1024 + (bj) * HALF)
#define EN_UNPK_LO(q_) ((f32x4){__uint_as_float((q_)[0] << 16), __uint_as_float((q_)[0] & 0xffff0000u), __uint_as_float((q_)[1] << 16), __uint_as_float((q_)[1] & 0xffff0000u)})
#define EN_UNPK_HI(q_) ((f32x4){__uint_as_float((q_)[2] << 16), __uint_as_float((q_)[2] & 0xffff0000u), __uint_as_float((q_)[3] << 16), __uint_as_float((q_)[3] & 0xffff0000u)})
        float ss[2][4], r1[2][4];
        if constexpr (RS) {
            f32x4 q[2][4];
#pragma unroll
            for (int ai = 0; ai < 2; ++ai)
#pragma unroll
                for (int m = 0; m < 4; ++m) q[ai][m] = *(const f32x4*)(rowsq + (size_t)(u.pm * BM + ai * HALF + wr * 64 + m * 16 + fr) * 4);
#pragma unroll
            for (int ai = 0; ai < 2; ++ai)
#pragma unroll
                for (int m = 0; m < 4; ++m) { const float r = 1.0f / sqrtf(((q[ai][m][0] + q[ai][m][1]) + (q[ai][m][2] + q[ai][m][3])) * (1.0f / 1024.0f) + eps);
#pragma unroll
                    for (int bj = 0; bj < 2; ++bj)
#pragma unroll
                        for (int n = 0; n < 2; ++n) acc[ai][bj][m][n] = acc[ai][bj][m][n] * r; }
        }
#pragma unroll
        for (int ai = 0; ai < 2; ++ai)
#pragma unroll
            for (int m = 0; m < 4; ++m) { float s = 0.f;
#pragma unroll
                for (int bj = 0; bj < 2; ++bj)
#pragma unroll
                    for (int n = 0; n < 2; ++n) { const f32x4 x = acc[ai][bj][m][n]; s += (x[0] * x[0] + x[1] * x[1]) + (x[2] * x[2] + x[3] * x[3]); }
                ss[ai][m] = s; }
        e1.publish(ss, u, wr, wc, fr, fq, lds, wid, lane);
        u32x4 xb[2][4][2]; f32x4 xf[4][2][2];
        if constexpr (XINB) {
#pragma unroll
            for (int ai = 0; ai < 2; ++ai)
#pragma unroll
                for (int m = 0; m < 4; ++m)
#pragma unroll
                    for (int bj = 0; bj < 2; ++bj) xb[ai][m][bj] = *(const u32x4*)((const bf16_t*)xin + EN_OFF(ai, m, bj));
        } else {
#pragma unroll
            for (int m = 0; m < 4; ++m)
#pragma unroll
                for (int bj = 0; bj < 2; ++bj) { xf[m][bj][0] = __builtin_nontemporal_load((const f32x4*)((const float*)xin + EN_OFF(0, m, bj))); xf[m][bj][1] = __builtin_nontemporal_load((const f32x4*)((const float*)xin + EN_OFF(0, m, bj) + 4)); }
        }
        f32x4 gp[2][2];
#pragma unroll
        for (int bj = 0; bj < 2; ++bj)
#pragma unroll
            for (int n = 0; n < 2; ++n) gp[bj][n] = *(const f32x4*)(MOD + (SPOST * 2 + b) * 3072 + 2048 + col0 + bj * HALF + 4 * n) * *(const f32x4*)(ng + (SPOST * 2 + 1) * 1024 + col0 + bj * HALF + 4 * n);
        e1.collect(u, wr, fr, lds, wid, lane, eps, r1);
#pragma unroll
        for (int ai = 0; ai < 2; ++ai) {
            if constexpr (!XINB) { if (ai == 1) {
#pragma unroll
                for (int m = 0; m < 4; ++m)
#pragma unroll
                    for (int bj = 0; bj < 2; ++bj) { xf[m][bj][0] = __builtin_nontemporal_load((const f32x4*)((const float*)xin + EN_OFF(1, m, bj))); xf[m][bj][1] = __builtin_nontemporal_load((const f32x4*)((const float*)xin + EN_OFF(1, m, bj) + 4)); } } }
#pragma unroll
            for (int m = 0; m < 4; ++m) { const float r = r1[ai][m];
#pragma unroll
                for (int bj = 0; bj < 2; ++bj) { f32x4 x0, x1;
                    if constexpr (XINB) { x0 = EN_UNPK_LO(xb[ai][m][bj]); x1 = EN_UNPK_HI(xb[ai][m][bj]); } else { x0 = xf[m][bj][0]; x1 = xf[m][bj][1]; }
                    f32x4 v0 = x0 + gp[bj][0] * (acc[ai][bj][m][0] * r), v1 = x1 + gp[bj][1] * (acc[ai][bj][m][1] * r);
                    if constexpr (XOUT == 2) { __builtin_nontemporal_store(v0, (f32x4*)((float*)xout + EN_OFF(ai, m, bj))); __builtin_nontemporal_store(v1, (f32x4*)((float*)xout + EN_OFF(ai, m, bj) + 4)); }
                    if constexpr (XOUT == 1) { u32x4 w; w.x = cvt_pk_bf16(v0[0], v0[1]); w.y = cvt_pk_bf16(v0[2], v0[3]); w.z = cvt_pk_bf16(v1[0], v1[1]); w.w = cvt_pk_bf16(v1[2], v1[3]);
                        v0 = EN_UNPK_LO(w); v1 = EN_UNPK_HI(w); }
                    acc[ai][bj][m][0] = v0; acc[ai][bj][m][1] = v1; } }
        }
        if constexpr (SPRE >= 0) {
            float r2[2][4];
#pragma unroll
            for (int ai = 0; ai < 2; ++ai)
#pragma unroll
                for (int m = 0; m < 4; ++m) { float s = 0.f;
#pragma unroll
                    for (int bj = 0; bj < 2; ++bj)
#pragma unroll
                        for (int n = 0; n < 2; ++n) { const f32x4 x = acc[ai][bj][m][n]; s += (x[0] * x[0] + x[1] * x[1]) + (x[2] * x[2] + x[3] * x[3]); }
                    ss[ai][m] = s; }
            e2.publish(ss, u, wr, wc, fr, fq, lds, wid, lane);
            if constexpr (XOUT == 1) { bf16_t* po = (bf16_t*)xout + off0;
#pragma unroll
                for (int ai = 0; ai < 2; ++ai)
#pragma unroll
                    for (int m = 0; m < 4; ++m) {
#pragma unroll
                        for (int bj = 0; bj < 2; ++bj) { const f32x4 v0 = acc[ai][bj][m][0], v1 = acc[ai][bj][m][1];
                            u32x4 w; w.x = cvt_pk_bf16(v0[0], v0[1]); w.y = cvt_pk_bf16(v0[2], v0[3]); w.z = cvt_pk_bf16(v1[0], v1[1]); w.w = cvt_pk_bf16(v1[2], v1[3]);
                            *(u32x4*)(po + bj * HALF) = w; }
                        po += (m == 3 ? (HALF - 48) : 16) * 1024; asm volatile("" : "+v"(po)); }
            }
            f32x4 qc[2][2], sh[2][2];
#pragma unroll
            for (int bj = 0; bj < 2; ++bj)
#pragma unroll
                for (int n = 0; n < 2; ++n) { const int c = col0 + bj * HALF + 4 * n;
                    qc[bj][n] = *(const f32x4*)(ng + (SPRE * 2) * 1024 + c) * (*(const f32x4*)(MOD + (SPRE * 2 + b) * 3072 + 1024 + c) + 1.0f); sh[bj][n] = *(const f32x4*)(MOD + (SPRE * 2 + b) * 3072 + c); }
            e2.collect(u, wr, fr, lds, wid, lane, eps, r2);
            bf16_t* pn = XN + off0;
#pragma unroll
            for (int ai = 0; ai < 2; ++ai)
#pragma unroll
                for (int m = 0; m < 4; ++m) { const float r = r2[ai][m];
#pragma unroll
                    for (int bj = 0; bj < 2; ++bj) { const f32x4 o0 = (acc[ai][bj][m][0] * r) * qc[bj][0] + sh[bj][0], o1 = (acc[ai][bj][m][1] * r) * qc[bj][1] + sh[bj][1];
                        u32x4 w; w.x = cvt_pk_bf16(o0[0], o0[1]); w.y = cvt_pk_bf16(o0[2], o0[3]); w.z = cvt_pk_bf16(o1[0], o1[1]); w.w = cvt_pk_bf16(o1[2], o1[3]);
                        *(u32x4*)(pn + bj * HALF) = w; }
                    pn += (m == 3 ? (HALF - 48) : 16) * 1024; asm volatile("" : "+v"(pn)); }
        } else if constexpr (XOUT == 1) {
#pragma unroll
            for (int ai = 0; ai < 2; ++ai)
#pragma unroll
                for (int m = 0; m < 4; ++m)
#pragma unroll
                    for (int bj = 0; bj < 2; ++bj) { const f32x4 v0 = acc[ai][bj][m][0], v1 = acc[ai][bj][m][1];
                        u32x4 w; w.x = cvt_pk_bf16(v0[0], v0[1]); w.y = cvt_pk_bf16(v0[2], v0[3]); w.z = cvt_pk_bf16(v1[0], v1[1]); w.w = cvt_pk_bf16(v1[2], v1[3]);
                        *(u32x4*)((bf16_t*)xout + EN_OFF(ai, m, bj)) = w; }
        }
#undef EN_OFF
#undef EN_UNPK_LO
#undef EN_UNPK_HI
    }
};
template <class Epi, class Sched, bool ALIGN_EPI = false, bool SP2 = false, bool MIDSCALE = false>
__device__ __forceinline__ void gemm_phase(PG8_LAS unsigned char* lds, const Gemm g, const Sched& S, const Epi& E, const PG8_LAS float* midscale = nullptr) {
    const int tid = threadIdx.x, wid = __builtin_amdgcn_readfirstlane(tid >> 6), lane = tid & 63, wr = wid >> 2, wc = wid & 3, fr = lane & 15, fq = lane >> 4;
    const int K = g.K, nt = K / BK;
    unsigned voffA[2], voffB[2];
#pragma unroll
    for (int i = 0; i < 2; ++i) { int R, C; stage_rc(tid * 16 + i * 8192, R, C); const int Rb = Epi::PERM ? ((R & ~31) + perm32(R & 31)) : R;
        voffA[i] = (unsigned)(R * g.lda + C) * 2u; voffB[i] = (unsigned)(Rb * K + C) * 2u; }
    const size_t kstep = (size_t)(BK * 2);
    const size_t hstepA = (size_t)HALF * g.lda * 2, hstepB = (size_t)HALF * K * 2;
    const size_t tstepA = 2 * hstepA, tstepB = 2 * hstepB;
    const unsigned ldsw = (unsigned)wid * 1024u;
    const int aoff = lds_byte(wr * 64 + fr, fq * 8), boff = lds_byte(wc * 32 + fr, fq * 8);
#define PG8_SA(b, h) (((b) * 2 + (h)) * HTB)
#define PG8_SB(b, h) ((4 + (b) * 2 + (h)) * HTB)
#define PG8_STAGE(bufoff, gbase, voff) do { _Pragma("unroll") for (int _i = 0; _i < 2; ++_i) \
        __builtin_amdgcn_global_load_lds((const unsigned*)((const char*)(gbase) + (voff)[_i]), (PG8_LAS unsigned*)(lds + (bufoff) + ldsw + _i * 8192), 16, 0, 0); } while (0)
#define PG8_LDA(dst, b, h) do { _Pragma("unroll") for (int m = 0; m < 4; ++m) _Pragma("unroll") for (int k = 0; k < 2; ++k) dst[m][k] = *(const PG8_LAS bf16x8*)(lds + PG8_SA(b, h) + aoff + m * 2048 + k * 1024); } while (0)
#define PG8_LDB(dst, b, h) do { _Pragma("unroll") for (int n = 0; n < 2; ++n) _Pragma("unroll") for (int k = 0; k < 2; ++k) dst[n][k] = *(const PG8_LAS bf16x8*)(lds + PG8_SB(b, h) + boff + n * 2048 + k * 1024); } while (0)
#define PG8_MMA(ai, bj, At, Bt) do { __builtin_amdgcn_s_setprio(1); _Pragma("unroll") for (int m = 0; m < 4; ++m) _Pragma("unroll") for (int n = 0; n < 2; ++n) _Pragma("unroll") for (int k = 0; k < 2; ++k) \
        acc[ai][bj][m][n] = __builtin_amdgcn_mfma_f32_16x16x32_bf16(Bt[n][k], At[m][k], acc[ai][bj][m][n], 0, 0, 0); __builtin_amdgcn_s_setprio(0); } while (0)
#define PG8_WAIT_V(n) asm volatile("s_waitcnt vmcnt(" #n ")" ::: "memory")
#define PG8_WAIT_L(n) asm volatile("s_waitcnt lgkmcnt(" #n ")" ::: "memory")
#define PG8_BAR __builtin_amdgcn_s_barrier()
#define PG8_SCHED __builtin_amdgcn_sched_barrier(0)
    Unit cur, nxt; int ui = 0;
    if (!S.next(0, cur)) return;
    f32x4 acc[2][2][4][2];
#pragma unroll
    for (int a = 0; a < 2; ++a)
#pragma unroll
        for (int b = 0; b < 2; ++b)
#pragma unroll
            for (int m = 0; m < 4; ++m)
#pragma unroll
                for (int n = 0; n < 2; ++n) acc[a][b][m][n] = (f32x4){0.f, 0.f, 0.f, 0.f};
    bf16x8 At[4][2], B0[2][2], B1[2][2];
    const char* cA = (const char*)g.A + (size_t)cur.pm * tstepA; const char* cB = (const char*)g.Bt + (size_t)cur.pn * tstepB;
    S.a_ready(cur);
    if constexpr (SP2) {
        PG8_STAGE(PG8_SB(0, 0), cB, voffB); PG8_STAGE(PG8_SB(0, 1), cB + hstepB, voffB); PG8_STAGE(PG8_SA(0, 0), cA, voffA); PG8_STAGE(PG8_SA(0, 1), cA + hstepA, voffA);
        if (wr == 1) PG8_BAR;
        PG8_WAIT_V(2); PG8_BAR;
        PG8_STAGE(PG8_SB(1, 0), cB + kstep, voffB); PG8_STAGE(PG8_SA(1, 0), cA + kstep, voffA); PG8_STAGE(PG8_SB(1, 1), cB + hstepB + kstep, voffB);
        PG8_WAIT_V(6); PG8_BAR;
    } else {
        PG8_STAGE(PG8_SB(0, 0), cB, voffB); PG8_STAGE(PG8_SA(0, 0), cA, voffA); PG8_STAGE(PG8_SB(0, 1), cB + hstepB, voffB); PG8_STAGE(PG8_SA(0, 1), cA + hstepA, voffA);
        if (wr == 1) PG8_BAR;
        PG8_WAIT_V(4); PG8_BAR;
        PG8_STAGE(PG8_SB(1, 0), cB + kstep, voffB); PG8_STAGE(PG8_SA(1, 0), cA + kstep, voffA); PG8_STAGE(PG8_SB(1, 1), cB + hstepB + kstep, voffB);
        PG8_WAIT_V(6); PG8_BAR;
    }
    for (;;) {
        const bool has_next = S.next(ui + 1, nxt);
        const char* nA = has_next ? (const char*)g.A + (size_t)nxt.pm * tstepA : cA; const char* nB = has_next ? (const char*)g.Bt + (size_t)nxt.pn * tstepB : cB;
        for (int t = 0; t < nt; t += 2) {
            if constexpr (MIDSCALE) { if (t == (nt >> 1)) {
#pragma unroll
                for (int a = 0; a < 2; ++a)
#pragma unroll
                    for (int m = 0; m < 4; ++m) { const float sc = midscale[a * HALF + wr * 64 + m * 16 + fr];
#pragma unroll
                        for (int bb = 0; bb < 2; ++bb)
#pragma unroll
                            for (int n = 0; n < 2; ++n) acc[a][bb][m][n] = acc[a][bb][m][n] * sc; } } }
            const bool last = (t == nt - 2);
            const char* a1 = cA + (size_t)(t + 1) * kstep;
            const char* a2 = last ? nA : cA + (size_t)(t + 2) * kstep; const char* b2 = last ? nB : cB + (size_t)(t + 2) * kstep;
            const char* a3 = a2 + kstep; const char* b3 = b2 + kstep;
            if (last && has_next) S.a_ready(nxt);
            if constexpr (SP2) {
            PG8_LDB(B0, 0, 0); PG8_LDB(B1, 0, 1); PG8_SCHED; PG8_LDA(At, 0, 0); PG8_STAGE(PG8_SA(1, 1), a1 + hstepA, voffA);
            PG8_WAIT_V(8); PG8_WAIT_L(0); PG8_BAR; PG8_MMA(0, 0, At, B0); PG8_MMA(0, 1, At, B1); PG8_BAR; PG8_SCHED;
            PG8_LDA(At, 0, 1); PG8_STAGE(PG8_SB(0, 0), b2, voffB); PG8_STAGE(PG8_SB(0, 1), b2 + hstepB, voffB); PG8_STAGE(PG8_SA(0, 0), a2, voffA);
            PG8_WAIT_V(8); PG8_WAIT_L(0); PG8_BAR; PG8_MMA(1, 0, At, B0); PG8_MMA(1, 1, At, B1); PG8_BAR; PG8_SCHED;
            PG8_LDB(B0, 1, 0); PG8_LDB(B1, 1, 1); PG8_SCHED; PG8_LDA(At, 1, 0); PG8_STAGE(PG8_SA(0, 1), a2 + hstepA, voffA);
            PG8_WAIT_V(8); PG8_WAIT_L(0); PG8_BAR; PG8_MMA(0, 0, At, B0); PG8_MMA(0, 1, At, B1); PG8_BAR; PG8_SCHED;
            PG8_LDA(At, 1, 1); PG8_STAGE(PG8_SB(1, 0), b3, voffB); PG8_STAGE(PG8_SB(1, 1), b3 + hstepB, voffB); PG8_STAGE(PG8_SA(1, 0), a3, voffA);
            PG8_WAIT_V(8); PG8_WAIT_L(0); PG8_BAR; PG8_MMA(1, 0, At, B0); PG8_MMA(1, 1, At, B1); PG8_BAR; PG8_SCHED;
            } else {
            PG8_LDB(B0, 0, 0); PG8_SCHED; PG8_LDA(At, 0, 0); PG8_STAGE(PG8_SA(1, 1), a1 + hstepA, voffA);
            PG8_WAIT_L(8); PG8_BAR; PG8_WAIT_L(0); PG8_MMA(0, 0, At, B0); PG8_BAR; PG8_SCHED;
            PG8_LDB(B1, 0, 1); PG8_STAGE(PG8_SB(0, 0), b2, voffB);
            PG8_BAR; PG8_WAIT_L(0); PG8_MMA(0, 1, At, B1); PG8_BAR;
            PG8_LDA(At, 0, 1); PG8_STAGE(PG8_SA(0, 0), a2, voffA);
            PG8_BAR; PG8_WAIT_L(0); PG8_MMA(1, 0, At, B0); PG8_BAR; PG8_SCHED;
            PG8_STAGE(PG8_SB(0, 1), b2 + hstepB, voffB);
            PG8_WAIT_V(6); PG8_BAR; PG8_MMA(1, 1, At, B1); PG8_BAR;
            PG8_LDB(B0, 1, 0); PG8_SCHED; PG8_LDA(At, 1, 0); PG8_STAGE(PG8_SA(0, 1), a2 + hstepA, voffA);
            PG8_WAIT_L(8); PG8_BAR; PG8_WAIT_L(0); PG8_MMA(0, 0, At, B0); PG8_BAR; PG8_SCHED;
            PG8_LDB(B1, 1, 1); PG8_STAGE(PG8_SB(1, 0), b3, voffB);
            PG8_BAR; PG8_WAIT_L(0); PG8_MMA(0, 1, At, B1); PG8_BAR;
            PG8_LDA(At, 1, 1); PG8_STAGE(PG8_SA(1, 0), a3, voffA);
            PG8_BAR; PG8_WAIT_L(0); PG8_MMA(1, 0, At, B0); PG8_BAR; PG8_SCHED;
            PG8_STAGE(PG8_SB(1, 1), b3 + hstepB, voffB);
            PG8_WAIT_V(6); PG8_BAR; PG8_MMA(1, 1, At, B1); PG8_BAR;
            }
        }
        if constexpr (ALIGN_EPI) { if (wr == 0) PG8_BAR; }
        if constexpr (!Epi::AFTER_DRAIN) { E(acc, cur, wr, wc, fr, fq); S.done(cur); }
        if (!has_next) break;
#pragma unroll
        for (int a = 0; a < 2; ++a)
#pragma unroll
            for (int b = 0; b < 2; ++b)
#pragma unroll
                for (int m = 0; m < 4; ++m)
#pragma unroll
                    for (int n = 0; n < 2; ++n) acc[a][b][m][n] = (f32x4){0.f, 0.f, 0.f, 0.f};
        cur = nxt; cA = nA; cB = nB; ++ui;
        if constexpr (ALIGN_EPI) { if (wr == 1) PG8_BAR; }
    }
    PG8_WAIT_V(0);
    if constexpr (!ALIGN_EPI) { if (wr == 0) PG8_BAR; }
    PG8_BAR;
    if constexpr (Epi::AFTER_DRAIN) { E.fused(acc, cur, wr, wc, fr, fq, lds, wid, lane); S.done(cur); }
#undef PG8_SA
#undef PG8_SB
#undef PG8_STAGE
#undef PG8_LDA
#undef PG8_LDB
#undef PG8_MMA
#undef PG8_WAIT_V
#undef PG8_WAIT_L
#undef PG8_BAR
#undef PG8_SCHED
}
}

constexpr int NWAVES = 8, NTHR = NWAVES * 64;
constexpr int BATCH = 2, SEQ = 8192, DM = 1024, MTOK = BATCH * SEQ, FF = 4096;
constexpr int NPROJ0 = 6144, NPROJ1 = 3840;
constexpr float EPS = 1e-6f, LOG2E = 1.4426950408889634f;
constexpr int C0_Z = 0, C0_Q = 1024, C0_K = 2048, C0_V = 3072, C0_XBC = 4096;
constexpr int C1_RG = 0, C1_SQ = 1024, C1_RQ = 1536, C1_RK = 2048, C1_RV = 2560, C1_SK = 3584, C1_SV = 3712;
enum { I_X = 0, I_C, I_RELB, I_NG, I_MODW, I_MODB, I_W1, I_W2, I_EWIN, I_ECONVW, I_ECONVB, I_EDTB, I_EALOG, I_ED, I_ESSDN, I_ELAM, I_EDIFFN, I_EWOUT, I_OWIN, I_OSINK, I_OWOUT, N_IN };

constexpr size_t MiB = 1u << 20;
constexpr size_t WS_CTL = 0, CTL_ZERO_BYTES = 65536;
constexpr size_t WS_MOD = 256 * 1024;
constexpr size_t WS_WDT = 512 * 1024;
constexpr size_t WS_CHDEC = 576 * 1024;
constexpr size_t WS_SSQ = 640 * 1024;
constexpr size_t WS_WMIX = 1 * MiB;
constexpr size_t WS_WOUT0 = 13 * MiB, WS_WOUT1 = 9 * MiB;
constexpr size_t WS_PROJ0 = 17 * MiB;
constexpr size_t WS_XN2 = 17 * MiB;
constexpr size_t WS_WMLP = 49 * MiB;
constexpr size_t WS_H = 65 * MiB;
constexpr size_t WS_S = 209 * MiB;
constexpr size_t WS_DT = 241 * MiB;
constexpr size_t WS_ROPE = 244 * MiB;
constexpr size_t WS_XCH = 248 * MiB;
constexpr size_t WS_END = 250 * MiB;
constexpr int CW_KDONE = 7680;
constexpr int CW_BAR = 4096;

constexpr int LDS_BYTES = 163840 - 1024;
constexpr int MISC_OFF = LDS_BYTES - 256;

#define GAS __attribute__((address_space(1)))
#define LAS __attribute__((address_space(3)))
typedef unsigned short bf16;
typedef unsigned v4u __attribute__((ext_vector_type(4)));
typedef unsigned v2u __attribute__((ext_vector_type(2)));
typedef float f32x4 __attribute__((ext_vector_type(4)));
typedef short bf16x8 __attribute__((ext_vector_type(8)));
typedef short v4i16_t __attribute__((ext_vector_type(4)));
typedef GAS unsigned gu32;
typedef LAS unsigned char* ldsp;
#define RLX_AGENT __ATOMIC_RELAXED, __HIP_MEMORY_SCOPE_AGENT
#define LDS_WAIT() asm volatile("s_waitcnt lgkmcnt(0)" ::: "memory")
#define VM_WAIT() asm volatile("s_waitcnt vmcnt(0)" ::: "memory")

__device__ __forceinline__ float bf2f(unsigned h) { return __uint_as_float(h << 16); }
typedef float f32x2_t __attribute__((ext_vector_type(2))); typedef __bf16 bf16x2_t __attribute__((ext_vector_type(2)));
__device__ __forceinline__ unsigned pk2(float lo, float hi) { f32x2_t v = {lo, hi}; bf16x2_t b = __builtin_convertvector(v, bf16x2_t); return __builtin_bit_cast(unsigned, b); }
__device__ __forceinline__ unsigned short f2bf(float f) { return (unsigned short)(pk2(f, 0.f) & 0xffffu); }
__device__ __forceinline__ float silu_f(float x) { return x * __builtin_amdgcn_rcpf(1.f + __expf(-x)); }
__device__ __forceinline__ float wave_sum(float v) {
#pragma unroll
    for (int o = 1; o < 64; o <<= 1) v += __shfl_xor(v, o);
    return v;
}
#define MFMA16(acc, rowfrag, colfrag) acc = __builtin_amdgcn_mfma_f32_16x16x32_bf16(colfrag, rowfrag, acc, 0, 0, 0)
__device__ __forceinline__ bf16x8 lds_frag(ldsp p) { return *(const LAS bf16x8*)p; }
__device__ __forceinline__ bf16x8 lds_frag_tr(ldsp p, int stride) {
    const v4i16_t lo = __builtin_amdgcn_ds_read_tr16_b64_v4i16((LAS v4i16_t*)p);
    const v4i16_t hi = __builtin_amdgcn_ds_read_tr16_b64_v4i16((LAS v4i16_t*)(p + 4 * stride));
    return (bf16x8){lo[0], lo[1], lo[2], lo[3], hi[0], hi[1], hi[2], hi[3]};
}
__device__ __forceinline__ int t5_bucket(int d) {
    if (d < 16) return d;
    const int v = 16 + (int)(logf((float)d * 0.0625f) / 2.0794415416798357f * 16.0f);
    return v < 31 ? v : 31;
}

#define XB_TMO      128
#define XB_XCNT(j)  (256  + 64 * (j))
#define XB_XSUB(j)  (1280 + 64 * (j))
#define XB_XGEN(j)  (2304 + 64 * (j))
#define XB_TOP      3328
#define XB_TOPGEN   3392
#define XCD_BAR_WORDS 3456
#define XB_SPIN_CAP (1u << 18)

__device__ __forceinline__ unsigned xb_ld(unsigned* p)              { return __hip_atomic_load(p, __ATOMIC_RELAXED, __HIP_MEMORY_SCOPE_AGENT); }
__device__ __forceinline__ unsigned xb_add(unsigned* p, unsigned v) { return __hip_atomic_fetch_add(p, v, __ATOMIC_RELAXED, __HIP_MEMORY_SCOPE_AGENT); }
__device__ __forceinline__ unsigned xb_xcc_id() { return (unsigned)__builtin_amdgcn_s_getreg((3 << 11) | 20) & 0xFu; }
#define XB_SPIN(cond, bar) do { unsigned _sp = 0; while (cond) { __builtin_amdgcn_s_sleep(1); \
    if ((++_sp & 255u) == 0u) { if (xb_ld(&(bar)[XB_TMO])) break; if (_sp > XB_SPIN_CAP) { atomicAdd(&(bar)[XB_TMO], 1u); break; } } } } while (0)

struct XcdBarrier {
    unsigned* bar; unsigned x;
    volatile LAS unsigned* st;
};

__device__ __forceinline__ XcdBarrier xcd_barrier_post(unsigned* bar, volatile LAS unsigned* st) {
    XcdBarrier b; b.bar = bar; b.x = xb_xcc_id(); b.st = st;
    if (threadIdx.x == 0) (void)xb_add(&bar[XB_XCNT(b.x)], 1u);
    return b;
}
__device__ __forceinline__ void xcd_barrier_complete(unsigned* bar, unsigned x, unsigned& nloc, unsigned& nx) {
    const unsigned G = gridDim.x * gridDim.y * gridDim.z;
    unsigned sum, cnt, mine, sp = 0u;
    for (;;) {
        sum = 0u; cnt = 0u; mine = 0u;
#pragma unroll
        for (unsigned j = 0; j < 16; ++j) { const unsigned c = xb_ld(&bar[XB_XCNT(j)]); sum += c; cnt += (c > 0u) ? 1u : 0u; mine = (j == x) ? c : mine; }
        if (sum == G) break;
        __builtin_amdgcn_s_sleep(1);
        if ((++sp & 255u) == 0u) { if (xb_ld(&bar[XB_TMO])) break; if (sp > XB_SPIN_CAP) { atomicAdd(&bar[XB_TMO], 1u); break; } }
    }
    nloc = mine > 0u ? mine : 1u; nx = cnt > 0u ? cnt : 1u;
}

template <bool WB = true> __device__ __forceinline__ void xcd_barrier(const XcdBarrier& b) {
    asm volatile("s_waitcnt vmcnt(0)" ::: "memory");
    __syncthreads();
    if (threadIdx.x == 0) {
        unsigned* bar = b.bar;
        __builtin_amdgcn_s_waitcnt(0);
        unsigned nloc = b.st[0], nx = b.st[1];
        if (nloc == 0u) { xcd_barrier_complete(bar, b.x, nloc, nx); b.st[0] = nloc; b.st[1] = nx; }
        const unsigned old = xb_add(&bar[XB_XSUB(b.x)], 1u);
        const unsigned gen = old / nloc;
        if (old + 1u == (gen + 1u) * nloc) {
            if (WB) asm volatile("buffer_inv sc1\n\tbuffer_wbl2 sc1\n\ts_waitcnt vmcnt(0)" ::: "memory"); else asm volatile("buffer_inv sc1" ::: "memory");
            xb_add(&bar[XB_TOP], 1u);
        } else {
            asm volatile("buffer_inv sc1" ::: "memory");
        }
        XB_SPIN(xb_ld(&bar[XB_TOP]) < (gen + 1u) * nx, bar);
        asm volatile("s_waitcnt vmcnt(0)" ::: "memory");
    }
    __syncthreads();
}

__device__ __forceinline__ void xcd_barrier_arrive(const XcdBarrier& b) {
    asm volatile("s_waitcnt vmcnt(0)" ::: "memory");
    __syncthreads();
    if (threadIdx.x == 0) {
        unsigned* bar = b.bar;
        __builtin_amdgcn_s_waitcnt(0);
        unsigned nloc = b.st[0], nx = b.st[1];
        if (nloc == 0u) { xcd_barrier_complete(bar, b.x, nloc, nx); b.st[0] = nloc; b.st[1] = nx; }
        const unsigned old = xb_add(&bar[XB_XSUB(b.x)], 1u);
        const unsigned gen = old / nloc;
        if (old + 1u == (gen + 1u) * nloc) {
            asm volatile("buffer_wbl2 sc1\n\ts_waitcnt vmcnt(0)" ::: "memory");
            xb_add(&bar[XB_TOP], 1u);
        }
        b.st[2] = (gen + 1u) * nx;
    }
}
__device__ __forceinline__ void xcd_barrier_wait(const XcdBarrier& b) {
    asm volatile("s_waitcnt vmcnt(0)" ::: "memory");
    __syncthreads();
    if (threadIdx.x == 0) {
        unsigned* bar = b.bar; const unsigned tgt = b.st[2];
        XB_SPIN(xb_ld(&bar[XB_TOP]) < tgt, bar);
        asm volatile("buffer_inv sc1\n\ts_waitcnt vmcnt(0)" ::: "memory");
    }
    __syncthreads();
}

struct Seg { const float* W; int ldw, col0, ncols, K; bf16* WT; int row_off; };
struct CvtItem { const float* src; bf16* dst; int ldw, K; bool valid; };
template <int NSEG> __device__ __forceinline__ CvtItem cvt_resolve(const Seg (&segs)[NSEG], int it, int total, int lane) {
    CvtItem c; c.src = nullptr; c.dst = nullptr; c.ldw = 0; c.K = 0; c.valid = false;
    int r = it < total ? it : -1;
#pragma unroll
    for (int s = 0; s < NSEG; ++s) { const int nblk = segs[s].ncols / 32, n = (segs[s].K / 64) * nblk;
        if (!c.valid && r >= 0 && r < n) { const int kb = r / nblk, nb = r % nblk, k0 = 64 * kb, n0 = 32 * nb;
            c.src = segs[s].W + (size_t)(k0 + (lane >> 5)) * segs[s].ldw + segs[s].col0 + n0 + (lane & 31);
            c.dst = segs[s].WT + (size_t)(segs[s].row_off + n0 + (lane >> 3)) * segs[s].K + k0 + 8 * (lane & 7); c.ldw = segs[s].ldw; c.K = segs[s].K; c.valid = true; }
        r -= n; }
    return c;
}
__device__ __forceinline__ void cvt_loads(const CvtItem& c, float (&wv)[32]) {
    if (c.valid) {
#pragma unroll
        for (int i = 0; i < 32; ++i) wv[i] = __builtin_nontemporal_load(c.src + (size_t)(2 * i) * c.ldw); }
}
__device__ __forceinline__ void cvt_finish(const CvtItem& c, const float (&wv)[32], LAS float* scr, int lane) {
    if (c.valid) {
#pragma unroll
        for (int i = 0; i < 32; ++i) scr[(2 * i + (lane >> 5)) * 33 + (lane & 31)] = wv[i];
        LDS_WAIT(); asm volatile("" ::: "memory");
        const int cc = lane & 7;
#pragma unroll
        for (int j = 0; j < 4; ++j) { const int n = (lane >> 3) + 8 * j; const LAS float* p = scr + (8 * cc) * 33 + n;
            v4u o; o.x = pk2(p[0 * 33], p[1 * 33]); o.y = pk2(p[2 * 33], p[3 * 33]); o.z = pk2(p[4 * 33], p[5 * 33]); o.w = pk2(p[6 * 33], p[7 * 33]);
            *(v4u*)(c.dst + (size_t)(8 * j) * c.K) = o; }
        LDS_WAIT(); asm volatile("" ::: "memory"); }
}
template <int NSEG> __device__ __forceinline__ void convert_set(const Seg (&segs)[NSEG], ldsp lds, int gw, int NGW, int wave, int lane) {
    LAS float* scr = (LAS float*)(lds + wave * 16384);
    int total = 0;
#pragma unroll
    for (int s = 0; s < NSEG; ++s) total += (segs[s].K / 64) * (segs[s].ncols / 32);
    for (int it = gw; it < total; it += 2 * NGW) {
        const CvtItem ca = cvt_resolve<NSEG>(segs, it, total, lane), cb = cvt_resolve<NSEG>(segs, it + NGW, total, lane);
        float wa[32], wb[32];
        cvt_loads(ca, wa); cvt_loads(cb, wb);
        cvt_finish(ca, wa, scr, lane); cvt_finish(cb, wb, scr, lane);
    }
}
__device__ __forceinline__ void mod_phase(const float* c, const float* mod_w, const float* mod_b, float* MOD, ldsp lds, int tid, int lane, int wave) {
    LAS float* sc = (LAS float*)(lds + 16384);
    if (blockIdx.x < 192) { for (int i = tid; i < 2048; i += NTHR) { const float v = c[i]; sc[i] = v / (1.f + expf(-v)); } }
    __syncthreads();
    for (int item = blockIdx.x; item < 192; item += gridDim.x) {
        const int s = item / 48, j0 = (item % 48) * 64, kpart = wave * 4 + (lane >> 4), jl = lane & 15;
        const float* wp = mod_w + ((size_t)s * 1024 + kpart * 32) * 3072 + j0 + 4 * jl;
        f32x4 a0 = {0.f, 0.f, 0.f, 0.f}, a1 = a0;
#pragma unroll
        for (int kk = 0; kk < 32; ++kk) { const int k = kpart * 32 + kk; const f32x4 w = __builtin_nontemporal_load((const f32x4*)(wp + (size_t)kk * 3072));
            const float s0 = sc[k], s1 = sc[1024 + k]; a0 += w * s0; a1 += w * s1; }
        LAS f32x4* red = (LAS f32x4*)lds;
        red[(kpart * 2 + 0) * 16 + jl] = a0; red[(kpart * 2 + 1) * 16 + jl] = a1;
        __syncthreads();
        if (tid < 128) { const int b = tid >> 6, col = tid & 63; float sum = mod_b[s * 3072 + j0 + col];
#pragma unroll
            for (int kp = 0; kp < 32; ++kp) sum += ((LAS float*)lds)[((kp * 2 + b) * 16 + (col >> 2)) * 4 + (col & 3)];
            MOD[(s * 2 + b) * 3072 + j0 + col] = sum; }
        __syncthreads();
    }
}

template <int SPOST, int SPRE, bool XINB, int XOUT, int R = 2> __device__ __forceinline__ void norm_rows(const void* xin_, const bf16* Y, void* xout_, bf16* XN, const float* MOD, const float* ng, int gw, int NGW, int lane) {
    const float* xinf = (const float*)xin_; const bf16* xinb = (const bf16*)xin_; float* xoutf = (float*)xout_; bf16* xoutb = (bf16*)xout_;
    const int half = NGW >> 1; const bool split = !(NGW & 1);
    const int b0 = split ? gw / half : 0, b1 = split ? b0 + 1 : BATCH, w = split ? gw % half : gw, W = split ? half : NGW;
#define NR_COL(q) (8 * lane + 512 * ((q) >> 1) + 4 * ((q) & 1))
#define NR_UNPK(w_) ((f32x4){__uint_as_float((w_).x << 16), __uint_as_float((w_).x & 0xffff0000u), __uint_as_float((w_).y << 16), __uint_as_float((w_).y & 0xffff0000u)})
#define NR_LOAD(vx, vxb, vy, m_) do { _Pragma("unroll") for (int j = 0; j < 2; ++j) { \
        if constexpr (XINB) vxb[j] = *(const v4u*)(xinb + (size_t)(m_) * DM + 8 * lane + 512 * j); \
        else { vx[2 * j] = __builtin_nontemporal_load((const f32x4*)(xinf + (size_t)(m_) * DM + NR_COL(2 * j))); vx[2 * j + 1] = __builtin_nontemporal_load((const f32x4*)(xinf + (size_t)(m_) * DM + NR_COL(2 * j + 1))); } \
        if constexpr (SPOST >= 0) vy[j] = *(const v4u*)(Y + (size_t)(m_) * DM + 8 * lane + 512 * j); } } while (0)
#pragma unroll 1
    for (int b = b0; b < b1; ++b) {
        f32x4 g4[4], p4[4], s4[4], c4[4], q4[4];
#pragma unroll
        for (int q = 0; q < 4; ++q) {
            if constexpr (SPOST >= 0) { g4[q] = *(const f32x4*)(MOD + (SPOST * 2 + b) * 3072 + 2048 + NR_COL(q)); p4[q] = *(const f32x4*)(ng + (SPOST * 2 + 1) * DM + NR_COL(q)); }
            if constexpr (SPRE >= 0) { s4[q] = *(const f32x4*)(MOD + (SPRE * 2 + b) * 3072 + NR_COL(q)); c4[q] = *(const f32x4*)(MOD + (SPRE * 2 + b) * 3072 + 1024 + NR_COL(q)) + 1.0f;
                q4[q] = *(const f32x4*)(ng + (SPRE * 2) * DM + NR_COL(q)); }
        }
        const int cnt = w < SEQ ? (SEQ - w + W - 1) / W : 0;
        f32x4 vx[R][4]; v4u vxb[R][2], vy[R][2];
#pragma unroll
        for (int r = 0; r < R; ++r) if (r < cnt) NR_LOAD(vx[r], vxb[r], vy[r], b * SEQ + w + r * W);
        for (int i0 = 0; i0 < cnt; i0 += R) {
            f32x4 nx[R][4]; v4u nxb[R][2], ny[R][2];
#pragma unroll
            for (int r = 0; r < R; ++r) if (i0 + R + r < cnt) NR_LOAD(nx[r], nxb[r], ny[r], b * SEQ + w + (i0 + R + r) * W);
#pragma unroll
            for (int r = 0; r < R; ++r) if (i0 + r < cnt) {
                const int m = b * SEQ + w + (i0 + r) * W;
                f32x4 v[4];
#pragma unroll
                for (int j = 0; j < 2; ++j) { if constexpr (XINB) { const v2u lo = {vxb[r][j].x, vxb[r][j].y}, hi = {vxb[r][j].z, vxb[r][j].w}; v[2 * j] = NR_UNPK(lo); v[2 * j + 1] = NR_UNPK(hi); }
                                              else { v[2 * j] = vx[r][2 * j]; v[2 * j + 1] = vx[r][2 * j + 1]; } }
                if constexpr (SPOST >= 0) {
                    f32x4 y[4]; float ss = 0.f;
#pragma unroll
                    for (int j = 0; j < 2; ++j) { const v2u lo = {vy[r][j].x, vy[r][j].y}, hi = {vy[r][j].z, vy[r][j].w}; y[2 * j] = NR_UNPK(lo); y[2 * j + 1] = NR_UNPK(hi); }
#pragma unroll
                    for (int q = 0; q < 4; ++q) ss += (y[q].x * y[q].x + y[q].y * y[q].y) + (y[q].z * y[q].z + y[q].w * y[q].w);
                    const float rr = 1.0f / sqrtf(wave_sum(ss) * (1.f / DM) + EPS);
#pragma unroll
                    for (int q = 0; q < 4; ++q) v[q] = v[q] + g4[q] * ((y[q] * rr) * p4[q]);
                    if constexpr (XOUT == 2) {
#pragma unroll
                        for (int q = 0; q < 4; ++q) *(f32x4*)(xoutf + (size_t)m * DM + NR_COL(q)) = v[q]; }
                    if constexpr (XOUT == 1) {
#pragma unroll
                        for (int j = 0; j < 2; ++j) { v4u o; o.x = pk2(v[2 * j].x, v[2 * j].y); o.y = pk2(v[2 * j].z, v[2 * j].w); o.z = pk2(v[2 * j + 1].x, v[2 * j + 1].y); o.w = pk2(v[2 * j + 1].z, v[2 * j + 1].w);
                            *(v4u*)(xoutb + (size_t)m * DM + 8 * lane + 512 * j) = o;
                            const v2u lo = {o.x, o.y}, hi = {o.z, o.w}; v[2 * j] = NR_UNPK(lo); v[2 * j + 1] = NR_UNPK(hi); } }
                }
                if constexpr (SPRE >= 0) {
                    float ss = 0.f;
#pragma unroll
                    for (int q = 0; q < 4; ++q) ss += (v[q].x * v[q].x + v[q].y * v[q].y) + (v[q].z * v[q].z + v[q].w * v[q].w);
                    const float rr = 1.0f / sqrtf(wave_sum(ss) * (1.f / DM) + EPS);
#pragma unroll
                    for (int j = 0; j < 2; ++j) { const f32x4 oa = ((v[2 * j] * rr) * q4[2 * j]) * c4[2 * j] + s4[2 * j], ob = ((v[2 * j + 1] * rr) * q4[2 * j + 1]) * c4[2 * j + 1] + s4[2 * j + 1];
                        v4u o; o.x = pk2(oa.x, oa.y); o.y = pk2(oa.z, oa.w); o.z = pk2(ob.x, ob.y); o.w = pk2(ob.z, ob.w);
                        *(v4u*)(XN + (size_t)m * DM + 8 * lane + 512 * j) = o; }
                }
            }
#pragma unroll
            for (int r = 0; r < R; ++r) {
#pragma unroll
                for (int q = 0; q < 4; ++q) vx[r][q] = nx[r][q];
#pragma unroll
                for (int j = 0; j < 2; ++j) { vxb[r][j] = nxb[r][j]; vy[r][j] = ny[r][j]; } }
        }
    }
#undef NR_LOAD
#undef NR_UNPK
#undef NR_COL
}

__device__ __forceinline__ void dt_phase(const bf16* XN, const bf16* WDT, const float* dt_bias, float* DT, int gw, int NGW, int wave, int lane, ldsp lds) {
    const int fr = lane & 15, fq = lane >> 4, half = wave & 1;
    LAS f32x4* xch = (LAS f32x4*)lds + (wave >> 1) * 64 + lane;
    for (int t0 = 0; t0 < MTOK / 16; t0 += NGW / 2) {
        const int tile = t0 + (gw >> 1); const bool on = tile < MTOK / 16;
        f32x4 acc = {0.f, 0.f, 0.f, 0.f};
        if (on) {
            const bf16* arow = XN + (size_t)(tile * 16 + fr) * DM + 512 * half + 8 * fq; const bf16* brow = WDT + fr * DM + 512 * half + 8 * fq;
            bf16x8 a[16], bb[16];
#pragma unroll
            for (int ks = 0; ks < 16; ++ks) { a[ks] = *(const bf16x8*)(arow + 32 * ks); bb[ks] = *(const bf16x8*)(brow + 32 * ks); }
#pragma unroll
            for (int ks = 0; ks < 16; ++ks) MFMA16(acc, a[ks], bb[ks]);
            if (half) *xch = acc;
        }
        __syncthreads();
        if (on && !half) { const f32x4 other = *xch; const f32x4 bi = *(const f32x4*)(dt_bias + 4 * fq); f32x4 o;
#pragma unroll
            for (int i = 0; i < 4; ++i) { const float v = (acc[i] + other[i]) + bi[i]; o[i] = v > 20.f ? v : log1pf(expf(v)); }
            *(f32x4*)(DT + (size_t)(tile * 16 + fr) * 16 + 4 * fq) = o; }
        __syncthreads();
    }
}

__device__ __forceinline__ void ssd_dt_acs(const float* DT, const float* A_log, int t0, int g, LAS float* ACS, LAS float* DTS, LAS float* TMP, int tid) {
    const int r = tid >> 7, s = tid & 127, ln = tid & 63;
    const float dt = DT[(size_t)(t0 + s) * 16 + g * 4 + r];
    float v = -expf(A_log[g * 4 + r]) * dt; DTS[r * 128 + s] = dt;
#pragma unroll
    for (int d = 1; d < 64; d <<= 1) { const float t = __shfl_up(v, d); if (ln >= d) v += t; }
    if (ln == 63) TMP[tid >> 6] = v;
    __syncthreads();
    if (s >= 64) v += TMP[(tid >> 6) - 1];
    ACS[r * 128 + s] = v;
    __syncthreads();
}
__device__ __forceinline__ void ssd_conv_group(const bf16* PROJ0, const float* conv_w, const float* conv_b, int t0, bool first_chunk, int cch0, int tg, int mode, ldsp dst  , int stride,
                                               const LAS float* ACSr, const LAS float* DTSr) {
    float w[4][8], cb[8];
#pragma unroll
    for (int j = 0; j < 4; ++j) { const f32x4 a = *(const f32x4*)(conv_w + j * 2048 + cch0), b = *(const f32x4*)(conv_w + j * 2048 + cch0 + 4);
        w[j][0] = a[0]; w[j][1] = a[1]; w[j][2] = a[2]; w[j][3] = a[3]; w[j][4] = b[0]; w[j][5] = b[1]; w[j][6] = b[2]; w[j][7] = b[3]; }
    { const f32x4 a = *(const f32x4*)(conv_b + cch0), b = *(const f32x4*)(conv_b + cch0 + 4); cb[0] = a[0]; cb[1] = a[1]; cb[2] = a[2]; cb[3] = a[3]; cb[4] = b[0]; cb[5] = b[1]; cb[6] = b[2]; cb[7] = b[3]; }
    v4u raw[19];
    const bf16* src = PROJ0 + ((size_t)t0 + 16 * tg) * NPROJ0 + C0_XBC + cch0;
    const bool pad = first_chunk && tg == 0;
#pragma unroll
    for (int i = 0; i < 19; ++i) { if (i < 3 && pad) raw[i] = (v4u){0u, 0u, 0u, 0u}; else raw[i] = *(const v4u*)(src + (ptrdiff_t)(i - 3) * NPROJ0); }
    const float alast = ACSr[127];
#pragma unroll
    for (int k = 0; k < 16; ++k) { const int s = 16 * tg + k;
        float sc = 1.f; if (mode == 0) sc = DTSr[s] * __expf(alast - ACSr[s]); else if (mode == 1) sc = DTSr[s];
        float o[8];
#pragma unroll
        for (int c = 0; c < 8; ++c) { float v = cb[c];
#pragma unroll
            for (int j = 0; j < 4; ++j) { const unsigned d = raw[k + j][c >> 1]; v += w[j][c] * ((c & 1) ? __uint_as_float(d & 0xffff0000u) : __uint_as_float(d << 16)); }
            o[c] = silu_f(v) * sc; }
        v4u ow; ow.x = pk2(o[0], o[1]); ow.y = pk2(o[2], o[3]); ow.z = pk2(o[4], o[5]); ow.w = pk2(o[6], o[7]);
        *(LAS v4u*)(dst + s * stride) = ow; }
}
constexpr int SA_BS = 0, SA_XS = 34816, SA_ACS = 102400, SA_DTS = 104448, SA_TMP = 106496;
__device__ __forceinline__ void ssdA_unit(ldsp lds, const bf16* PROJ0, const float* DT, const float* conv_w, const float* conv_b, const float* A_log, bf16* ST, float* CHDEC, int u, int tid, int lane, int wave) {
    asm volatile("" : "+v"(tid), "+v"(lane));
    const int g = u & 3, c = (u >> 2) & 63, b = u >> 8, t0 = b * SEQ + c * 128;
    const int fr = lane & 15, fq = lane >> 4, trq = (lane & 15) >> 2, trp = lane & 3;
    LAS float* ACS = (LAS float*)(lds + SA_ACS); LAS float* DTS = (LAS float*)(lds + SA_DTS); LAS float* TMP = (LAS float*)(lds + SA_TMP);
    ssd_dt_acs(DT, A_log, t0, g, ACS, DTS, TMP, tid);
    if (tid < 4) CHDEC[(b * 64 + c) * 16 + g * 4 + tid] = __expf(ACS[tid * 128 + 127]);
    if (tid < 384) { const int cg = tid % 48, tg = tid / 48; const bool isx = cg < 32; const int r = isx ? (cg >> 3) : 0;
        ssd_conv_group(PROJ0, conv_w, conv_b, t0, c == 0, isx ? g * 256 + 8 * cg : 1024 + g * 128 + 8 * (cg - 32), tg, isx ? 0 : 2,
                       isx ? lds + SA_XS + cg * 16 : lds + SA_BS + (cg - 32) * 16, isx ? 528 : 272, ACS + r * 128, DTS + r * 128); }
    __syncthreads();
    const int r = wave >> 1, half = wave & 1;
    f32x4 acc[2][8];
#pragma unroll
    for (int j = 0; j < 2; ++j)
#pragma unroll
        for (int n = 0; n < 8; ++n) acc[j][n] = (f32x4){0.f, 0.f, 0.f, 0.f};
    bf16x8 fa[2][2], fb[2][8];
#define SA_READ(ks_, buf_) do { _Pragma("unroll") for (int j = 0; j < 2; ++j) fa[buf_][j] = lds_frag_tr(lds + SA_XS + (32 * (ks_) + 8 * fq + trq) * 528 + (r * 64 + (2 * half + j) * 16 + 4 * trp) * 2, 528); \
        _Pragma("unroll") for (int n = 0; n < 8; ++n) fb[buf_][n] = lds_frag_tr(lds + SA_BS + (32 * (ks_) + 8 * fq + trq) * 272 + (n * 16 + 4 * trp) * 2, 272); } while (0)
    SA_READ(0, 0);
#pragma unroll
    for (int ks = 0; ks < 4; ++ks) {
        if (ks < 3) SA_READ(ks + 1, (ks + 1) & 1);
        __builtin_amdgcn_sched_barrier(0);
#pragma unroll
        for (int n = 0; n < 8; ++n) { MFMA16(acc[0][n], fa[ks & 1][0], fb[ks & 1][n]); MFMA16(acc[1][n], fa[ks & 1][1], fb[ks & 1][n]); }
        __builtin_amdgcn_sched_barrier(0);
    }
#undef SA_READ
    bf16* so = ST + ((size_t)((b * 64 + c) * 16 + g * 4 + r) * 64) * 128;
#pragma unroll
    for (int j = 0; j < 2; ++j)
#pragma unroll
        for (int n = 0; n < 8; ++n) { v2u w; w.x = pk2(acc[j][n][0], acc[j][n][1]); w.y = pk2(acc[j][n][2], acc[j][n][3]);
            *(v2u*)(so + (size_t)((2 * half + j) * 16 + fr) * 128 + n * 16 + 4 * fq) = w; }
    __syncthreads();
}
__device__ __forceinline__ void ssd_scan(bf16* ST, const float* CHDEC, int gtid, int gthreads) {
    for (int e = gtid; e < 131072; e += gthreads) {
        const int b = e >> 16, rem = e & 65535, h = rem >> 12, pn = rem & 4095;
        unsigned* p = (unsigned*)ST + ((size_t)(b * 64) * 16 + h) * 4096 + pn; const float* dp = CHDEC + (b * 64) * 16 + h;
        float c0 = 0.f, c1 = 0.f;
#pragma unroll 1
        for (int hf = 0; hf < 2; ++hf) {
            unsigned v[32]; unsigned* pb = p + (size_t)hf * 32 * 16 * 4096;
            { const unsigned* q = pb;
#pragma unroll
              for (int c = 0; c < 32; ++c) { v[c] = *q; q += 16 * 4096; asm volatile("" : "+v"(q)); } }
#pragma unroll
            for (int c = 0; c < 32; ++c) { const float dec = dp[(hf * 32 + c) * 16]; const unsigned o = pk2(c0, c1); c0 = c0 * dec + __uint_as_float(v[c] << 16); c1 = c1 * dec + __uint_as_float(v[c] & 0xffff0000u); v[c] = o; }
            { unsigned* q = pb;
#pragma unroll
              for (int c = 0; c < 32; ++c) { *q = v[c]; q += 16 * 4096; asm volatile("" : "+v"(q)); } }
        }
    }
}
constexpr int SC_CS = 0, SC_BS = 34816, SC_XS = 69632, SC_ACS = 137216, SC_DTS = 139264, SC_TMP = 141312, SC_SP = 143360;
template <int PV> __device__ __forceinline__ void ssdC_unit(ldsp lds, const bf16* PROJ0, bf16* OUT  , int opitch, const float* DT, const float* conv_w, const float* conv_b, const float* A_log, const float* Dskip, const float* ssd_norm,
                                          const bf16* ST, float* SSQ, int u, int tid, int lane, int wave) {
    asm volatile("" : "+v"(tid), "+v"(lane));
    const int g = u & 3, c = (u >> 2) & 63, b = u >> 8, t0 = b * SEQ + c * 128;
    const int fr = lane & 15, fq = lane >> 4, trq = (lane & 15) >> 2, trp = lane & 3;
    LAS float* ACS = (LAS float*)(lds + SC_ACS); LAS float* DTS = (LAS float*)(lds + SC_DTS); LAS float* TMP = (LAS float*)(lds + SC_TMP);
    if (!(PV & 1)) ssd_dt_acs(DT, A_log, t0, g, ACS, DTS, TMP, tid);
    if (!(PV & 2)) { const int cg = tid & 63, tg = tid >> 6; const bool isx = cg < 32, isb = cg < 48; const int r = isx ? (cg >> 3) : 0;
      ssd_conv_group(PROJ0, conv_w, conv_b, t0, c == 0, isx ? g * 256 + 8 * cg : (isb ? 1024 + g * 128 + 8 * (cg - 32) : 1536 + g * 128 + 8 * (cg - 48)), tg, isx ? 1 : 2,
                     isx ? lds + SC_XS + cg * 16 : (isb ? lds + SC_BS + (cg - 32) * 16 : lds + SC_CS + (cg - 48) * 16), isx ? 528 : 272, ACS + r * 128, DTS + r * 128); }
    __syncthreads();
    const int l = 16 * wave + fr;
    const ldsp crow = lds + SC_CS + l * 272 + 16 * fq, mrow = lds + SC_BS + l * 272 + 16 * fq;
    const bf16* prow = PROJ0 + (size_t)(t0 + l) * NPROJ0; bf16* orow = OUT + (size_t)(t0 + l) * opitch;
    v2u zw[4]; f32x4 nwn[4]; float dskn;
    v4u spr[2];
    const int sprow = tid >> 3, spch = tid & 7;
    { const bf16* sp = ST + ((size_t)((b * 64 + c) * 16 + g * 4) * 64) * 128;
#pragma unroll
      for (int i = 0; i < 2; ++i) spr[i] = *(const v4u*)(sp + (size_t)(sprow) * 128 + (spch + 8 * i) * 8);
#pragma unroll
      for (int p = 0; p < 4; ++p) { zw[p] = *(const v2u*)(prow + C0_Z + (g * 4) * 64 + 16 * p + 4 * fq); nwn[p] = *(const f32x4*)(ssd_norm + (g * 4) * 64 + 16 * p + 4 * fq); }
      dskn = Dskip[g * 4]; }
    f32x4 cb[8];
#pragma unroll
    for (int n = 0; n < 8; ++n) cb[n] = (f32x4){0.f, 0.f, 0.f, 0.f};
#pragma unroll
    for (int ks = 0; ks < 4; ++ks) { const bf16x8 af = lds_frag(crow + 64 * ks); bf16x8 bfr[8];
#pragma unroll
        for (int n = 0; n < 8; ++n) bfr[n] = lds_frag(lds + SC_BS + (16 * n + fr) * 272 + 64 * ks + 16 * fq);
        __builtin_amdgcn_sched_barrier(0);
#pragma unroll
        for (int n = 0; n < 8; ++n) MFMA16(cb[n], af, bfr[n]);
        __builtin_amdgcn_sched_barrier(0); }
    __syncthreads();
    float ssq = 0.f;
#pragma unroll 1
    for (int r = 0; r < ((PV & 4) ? 0 : 4); ++r) {
        const int h = g * 4 + r; const float al = ACS[r * 128 + l];
#pragma unroll
        for (int i = 0; i < 2; ++i) *(LAS v4u*)(lds + SC_SP + sprow * 272 + (spch + 8 * i) * 16) = spr[i];
        v2u zc[4]; f32x4 nwc[4]; const float dskc = dskn;
#pragma unroll
        for (int p = 0; p < 4; ++p) { zc[p] = zw[p]; nwc[p] = nwn[p]; }
        if (r < 3 && !(PV & 8)) {
            const bf16* sp = ST + ((size_t)((b * 64 + c) * 16 + h + 1) * 64) * 128;
#pragma unroll
            for (int i = 0; i < 2; ++i) spr[i] = *(const v4u*)(sp + (size_t)(sprow) * 128 + (spch + 8 * i) * 8);
#pragma unroll
            for (int p = 0; p < 4; ++p) { zw[p] = *(const v2u*)(prow + C0_Z + (h + 1) * 64 + 16 * p + 4 * fq); nwn[p] = *(const f32x4*)(ssd_norm + (h + 1) * 64 + 16 * p + 4 * fq); }
            dskn = Dskip[h + 1];
        }
        __syncthreads();
#pragma unroll
        for (int n = 0; n < 8; ++n) { const f32x4 as = *(const LAS f32x4*)(ACS + r * 128 + 16 * n + 4 * fq); float mv[4];
#pragma unroll
            for (int i = 0; i < 4; ++i) { const int s = 16 * n + 4 * fq + i; mv[i] = (s <= l) ? cb[n][i] * __expf(al - as[i]) : 0.f; }
            v2u w; w.x = pk2(mv[0], mv[1]); w.y = pk2(mv[2], mv[3]); *(LAS v2u*)(lds + SC_BS + l * 272 + (16 * n + 4 * fq) * 2) = w; }
        f32x4 y[4], yo[4];
#pragma unroll
        for (int p = 0; p < 4; ++p) { y[p] = (f32x4){0.f, 0.f, 0.f, 0.f}; yo[p] = y[p]; }
#pragma unroll
        for (int ks = 0; ks < 4; ++ks) { const bf16x8 af = lds_frag(mrow + 64 * ks);
            bf16x8 xf[4];
#pragma unroll
            for (int p = 0; p < 4; ++p) xf[p] = lds_frag_tr(lds + SC_XS + (32 * ks + 8 * fq + trq) * 528 + (r * 64 + 16 * p + 4 * trp) * 2, 528);
#pragma unroll
            for (int p = 0; p < 4; ++p) MFMA16(y[p], af, xf[p]); }
#pragma unroll
        for (int ks = 0; ks < 4; ++ks) { const bf16x8 cf = lds_frag(crow + 64 * ks); bf16x8 sf[4];
#pragma unroll
            for (int p = 0; p < 4; ++p) sf[p] = lds_frag(lds + SC_SP + (16 * p + fr) * 272 + 64 * ks + 16 * fq);
#pragma unroll
            for (int p = 0; p < 4; ++p) MFMA16(yo[p], cf, sf[p]); }
        __syncthreads();
        const float el = __expf(al), rdt = dskc / DTS[r * 128 + l];
#pragma unroll
        for (int p = 0; p < 4; ++p) { const int ch = h * 64 + 16 * p + 4 * fq;
            const v2u xw = *(const LAS v2u*)(lds + SC_XS + l * 528 + (r * 64 + 16 * p + 4 * fq) * 2); const f32x4 nw = nwc[p];
            const float z[4] = {__uint_as_float(zc[p].x << 16), __uint_as_float(zc[p].x & 0xffff0000u), __uint_as_float(zc[p].y << 16), __uint_as_float(zc[p].y & 0xffff0000u)};
            const float xs[4] = {__uint_as_float(xw.x << 16), __uint_as_float(xw.x & 0xffff0000u), __uint_as_float(xw.y << 16), __uint_as_float(xw.y & 0xffff0000u)};
            float o[4];
#pragma unroll
            for (int i = 0; i < 4; ++i) { float v = y[p][i] + el * yo[p][i] + rdt * xs[i]; v *= silu_f(z[i]); ssq += v * v; o[i] = v * nw[i]; }
            v2u w; w.x = pk2(o[0], o[1]); w.y = pk2(o[2], o[3]); if (!(PV & 16)) *(v2u*)(orow + ch) = w; else asm volatile("" :: "v"(w.x), "v"(w.y)); }
    }
    ssq += __shfl_xor(ssq, 16); ssq += __shfl_xor(ssq, 32);
    if (fq == 0) SSQ[(size_t)(t0 + l) * 4 + g] = ssq;
    __syncthreads();
}
__device__ __forceinline__ void ssd_normalize_rows(bf16* PROJ0, const float* SSQ, int gw, int NGW, int lane) {
    for (int m = gw; m < MTOK; m += NGW) {
        const f32x4 q = *(const f32x4*)(SSQ + (size_t)m * 4); const float r = 1.0f / sqrtf(((q.x + q.y) + (q.z + q.w)) * (1.f / 1024.f) + EPS);
        v4u* p = (v4u*)(PROJ0 + (size_t)m * NPROJ0 + C0_Z + 8 * lane); v4u w0 = p[0], w1 = p[64];
#pragma unroll
        for (int i = 0; i < 4; ++i) { w0[i] = pk2(__uint_as_float(w0[i] << 16) * r, __uint_as_float(w0[i] & 0xffff0000u) * r); w1[i] = pk2(__uint_as_float(w1[i] << 16) * r, __uint_as_float(w1[i] & 0xffff0000u) * r); }
        p[0] = w0; p[64] = w1;
    }
}

__device__ __forceinline__ float quad_max(float v) {
    auto a = __builtin_amdgcn_permlane16_swap(__float_as_uint(v), __float_as_uint(v), false, false); v = fmaxf(__uint_as_float(a[0]), __uint_as_float(a[1]));
    auto b = __builtin_amdgcn_permlane32_swap(__float_as_uint(v), __float_as_uint(v), false, false); return fmaxf(__uint_as_float(b[0]), __uint_as_float(b[1]));
}
__device__ __forceinline__ float quad_sum(float v) {
    auto a = __builtin_amdgcn_permlane16_swap(__float_as_uint(v), __float_as_uint(v), false, false); v = __uint_as_float(a[0]) + __uint_as_float(a[1]);
    auto b = __builtin_amdgcn_permlane32_swap(__float_as_uint(v), __float_as_uint(v), false, false); return __uint_as_float(b[0]) + __uint_as_float(b[1]);
}
__device__ __forceinline__ void glds16_asm(const void* gsrc, unsigned lds_dst) { unsigned keep;
    asm volatile("s_mov_b32 %0, m0\n\ts_mov_b32 m0, %2\n\ts_nop 0\n\tglobal_load_lds_dwordx4 %1, off\n\ts_mov_b32 m0, %0" : "=&s"(keep) : "v"(gsrc), "s"(lds_dst) : "memory"); }
#ifndef DA_NOFAST
#define DA_NOFAST 0
#endif
#ifndef DA_SGB
#define DA_SGB true
#endif
#ifndef DA_PAR
#define DA_PAR 0
#endif
constexpr int DB_K = 0, DB_V = 65536, DB_TSZ = 16384, DB_BT = 147456, DB_XCH = 0;
__device__ __forceinline__ bf16x8 lds_frag_tr2(ldsp p0, ldsp p1) {
    const v4i16_t lo = __builtin_amdgcn_ds_read_tr16_b64_v4i16((LAS v4i16_t*)p0);
    const v4i16_t hi = __builtin_amdgcn_ds_read_tr16_b64_v4i16((LAS v4i16_t*)p1);
    return (bf16x8){lo[0], lo[1], lo[2], lo[3], hi[0], hi[1], hi[2], hi[3]};
}
#define DB_BAR() do { __builtin_amdgcn_sched_barrier(0); asm volatile("s_waitcnt lgkmcnt(0)" ::: "memory"); __builtin_amdgcn_s_barrier(); asm volatile("" ::: "memory"); __builtin_amdgcn_sched_barrier(0); } while (0)
constexpr size_t WS_KMAX = 32 * 1024;
__device__ __forceinline__ void kmax_rows(const bf16* PROJ0, unsigned* KMAX, int gw, int NGW, int lane) {
    for (int r0 = gw % NGW; r0 < SEQ; r0 += 4 * NGW) {
        v4u w0[BATCH][4], w1[BATCH][4];
#pragma unroll
        for (int b = 0; b < BATCH; ++b)
#pragma unroll
            for (int i = 0; i < 4; ++i) { const int r = r0 + i * NGW; if (r < SEQ) { const v4u* p = (const v4u*)(PROJ0 + (size_t)(b * SEQ + r) * NPROJ0 + C0_K + 16 * lane); w0[b][i] = p[0]; w1[b][i] = p[1]; }
                else { w0[b][i] = (v4u){0u, 0u, 0u, 0u}; w1[b][i] = w0[b][i]; } }
#pragma unroll
        for (int b = 0; b < BATCH; ++b) { float mx = 0.f;
#pragma unroll
            for (int i = 0; i < 4; ++i) { float ss = 0.f;
#pragma unroll
                for (int q = 0; q < 4; ++q) { const float a0 = __uint_as_float(w0[b][i][q] << 16), a1 = __uint_as_float(w0[b][i][q] & 0xffff0000u), b0 = __uint_as_float(w1[b][i][q] << 16), b1 = __uint_as_float(w1[b][i][q] & 0xffff0000u);
                    ss += (a0 * a0 + a1 * a1) + (b0 * b0 + b1 * b1); }
                ss += __shfl_xor(ss, 1); ss += __shfl_xor(ss, 2); mx = fmaxf(mx, ss); }
            if ((lane & 3) == 0) atomicMax(KMAX + b * 16 + (lane >> 2), __float_as_uint(mx)); }
    }
}
template <int PVAR> __device__ __forceinline__ void dattn5_unit(ldsp lds, const bf16* PROJ0, bf16* OUT  , int opitch, const float* rel_bias, const float* diff_norm, const unsigned* KMAX, float lam,
                                                                int b, int h, int qb, int tid, int lane, int wave, const float* SSQ  ) {
    asm volatile("" : "+v"(tid), "+v"(lane));
    const int fr = lane & 15, fq = lane >> 4, trq = (lane & 15) >> 2, trp = lane & 3;
    const int m = wave >> 2, rg = wave & 3;
    const size_t rowbase = (size_t)b * SEQ; const int q0 = qb * 128, row0 = q0 + 32 * rg;
    const int nt = 2 * qb + 2;
    const bf16* kvb = PROJ0 + rowbase * NPROJ0 + h * 128;
    const bf16* ksrc[2]; const bf16* vsrc[2];
#pragma unroll
    for (int i = 0; i < 2; ++i) { const int key = 4 * (wave + 8 * i) + (lane >> 4), slot = lane & 15;
        ksrc[i] = kvb + (size_t)key * NPROJ0 + C0_K + ((slot ^ (key & 15)) * 8); vsrc[i] = kvb + (size_t)key * NPROJ0 + C0_V + ((slot ^ ((key & 7) << 1)) * 8); }
    int kw = 0, vw = 0;
    const unsigned lds0 = (unsigned)(size_t)lds;
#define DB_DMAK(t) do { _Pragma("unroll") for (int i_ = 0; i_ < 2; ++i_) \
        glds16_asm(ksrc[i_] + (size_t)(64 * (t)) * NPROJ0, (unsigned)__builtin_amdgcn_readfirstlane((int)(lds0 + DB_K + kw * DB_TSZ + (wave + 8 * i_) * 1024))); \
        kw = (kw + 1) & 3; } while (0)
#define DB_DMAV(t) do { _Pragma("unroll") for (int i_ = 0; i_ < 2; ++i_) \
        glds16_asm(vsrc[i_] + (size_t)(64 * (t)) * NPROJ0, (unsigned)__builtin_amdgcn_readfirstlane((int)(lds0 + DB_V + vw * DB_TSZ + (wave + 8 * i_) * 1024))); \
        vw = (vw == 4) ? 0 : vw + 1; } while (0)
    DB_DMAK(0); DB_DMAV(0); DB_DMAK(1); DB_DMAV(1); if (nt > 2) { DB_DMAK(2); DB_DMAV(2); } if (nt > 3) DB_DMAK(3);
    const float SC = 0.125f * LOG2E, c31 = rel_bias[31 * 8 + h] * LOG2E;
    bf16x8 qf[2][2]; float qss[2] = {0.f, 0.f};
#pragma unroll
    for (int rt = 0; rt < 2; ++rt)
#pragma unroll
        for (int ks = 0; ks < 2; ++ks) { const v4u raw = *(const v4u*)(PROJ0 + (rowbase + row0 + 16 * rt + fr) * NPROJ0 + C0_Q + h * 128 + m * 64 + ks * 32 + fq * 8); v4u sc;
#pragma unroll
            for (int i = 0; i < 4; ++i) { sc[i] = pk2(__uint_as_float(raw[i] << 16) * SC, __uint_as_float(raw[i] & 0xffff0000u) * SC);
                const float r0 = __uint_as_float(sc[i] << 16), r1 = __uint_as_float(sc[i] & 0xffff0000u); qss[rt] += r0 * r0 + r1 * r1; }
            qf[rt][ks] = __builtin_bit_cast(bf16x8, sc); }
    LAS float* BT = (LAS float*)(lds + DB_BT);
    if (tid < 192) { const int d = tid - 32; BT[tid] = d < 0 ? -INFINITY : (rel_bias[t5_bucket(d) * 8 + h] - rel_bias[31 * 8 + h]) * LOG2E; }
    const int blane = 32 + fr - 4 * fq - 3;
    float bmax = rel_bias[(lane & 31) * 8 + h];
#pragma unroll
    for (int o_ = 1; o_ < 32; o_ <<= 1) bmax = fmaxf(bmax, __shfl_xor(bmax, o_));
    const float kmx = sqrtf(__uint_as_float(KMAX[(b * 8 + h) * 2 + m]));
    f32x4 cmv[2];
#pragma unroll
    for (int rt = 0; rt < 2; ++rt) { const float c = c31 - (sqrtf(quad_sum(qss[rt])) * kmx * 1.001f + bmax * LOG2E + 0.01f); cmv[rt] = (f32x4){c, c, c, c}; }
    f32x4 o[2][9], s[2][4], sn[2][4]; v4u pk[2][2];
#pragma unroll
    for (int rt = 0; rt < 2; ++rt) {
#pragma unroll
        for (int e = 0; e < 9; ++e) o[rt][e] = (f32x4){0.f, 0.f, 0.f, 0.f};
#pragma unroll
        for (int k2 = 0; k2 < 2; ++k2) pk[rt][k2] = (v4u){0u, 0u, 0u, 0u}; }
    const bf16x8 ones = {0x3F80, 0x3F80, 0x3F80, 0x3F80, 0x3F80, 0x3F80, 0x3F80, 0x3F80};
    const int vswz = ((4 * (fq & 1) + trq) << 1);
    const int vlane = (4 * fq + trq) * 256 + trp * 8;
    int vco[8], kx[2];
#pragma unroll
    for (int e = 0; e < 8; ++e) vco[e] = vlane + (((2 * e) ^ vswz) * 16);
#pragma unroll
    for (int ks = 0; ks < 2; ++ks) kx[ks] = fr * 256 + (((m * 8 + ks * 4 + fq) ^ fr) * 16);
    asm volatile("s_waitcnt vmcnt(0)" ::: "memory");
    DB_BAR();
    int kr = 0, vr = 0;
#define DA_SMAT(DST) do { const ldsp kbuf_ = lds + DB_K + kr * DB_TSZ; kr = (kr + 1) & 3; \
        _Pragma("unroll") for (int n_ = 0; n_ < 4; ++n_) { \
            const bf16x8 k0_ = lds_frag(kbuf_ + kx[0] + n_ * 4096), k1_ = lds_frag(kbuf_ + kx[1] + n_ * 4096); \
            _Pragma("unroll") for (int rt_ = 0; rt_ < 2; ++rt_) { DST[rt_][n_] = __builtin_amdgcn_mfma_f32_16x16x32_bf16(k0_, qf[rt_][0], cmv[rt_], 0, 0, 0); MFMA16(DST[rt_][n_], qf[rt_][1], k1_); } } } while (0)
    DA_SMAT(s);
#define DA_BODY(T_, FAR_, PV_, SN_, SA, SB) do { \
        const bool dmak_ = ((T_) + 4 < nt) && !(PVAR & 1), dmav_ = ((T_) + 3 < nt) && !(PVAR & 1); \
        if (dmak_) DB_DMAK((T_) + 4); \
        if (dmav_) DB_DMAV((T_) + 3); \
        if ((SN_) && !(PVAR & 4)) DA_SMAT(SB); \
        if ((PV_) && !(PVAR & 4)) { \
            const ldsp vb_ = lds + DB_V + vr * DB_TSZ; vr = (vr == 4) ? 0 : vr + 1; \
            _Pragma("unroll") for (int k2 = 0; k2 < 2; ++k2) { \
                _Pragma("unroll") for (int e = 0; e < 8; ++e) { const bf16x8 vf = lds_frag_tr2(vb_ + vco[e] + (32 * k2) * 256, vb_ + vco[e] + (32 * k2 + 16) * 256); \
                    MFMA16(o[0][e], __builtin_bit_cast(bf16x8, pk[0][k2]), vf); MFMA16(o[1][e], __builtin_bit_cast(bf16x8, pk[1][k2]), vf); } \
                MFMA16(o[0][8], __builtin_bit_cast(bf16x8, pk[0][k2]), ones); MFMA16(o[1][8], __builtin_bit_cast(bf16x8, pk[1][k2]), ones); } \
        } \
        if (!(PVAR & 2)) { \
            const int k0 = 64 * (T_); \
            _Pragma("unroll") for (int rt = 0; rt < 2; ++rt) { \
                if (FAR_) { \
                    _Pragma("unroll") for (int n = 0; n < 4; ++n) \
                        _Pragma("unroll") for (int i = 0; i < 4; ++i) SA[rt][n][i] = __builtin_amdgcn_exp2f(SA[rt][n][i]); \
                } else { \
                    _Pragma("unroll") for (int n = 0; n < 4; ++n) { const int D0 = (row0 + 16 * rt) - (k0 + 16 * n);     \
                        if (D0 >= 128) { _Pragma("unroll") for (int i = 0; i < 4; ++i) SA[rt][n][i] = __builtin_amdgcn_exp2f(SA[rt][n][i]); }              \
                        else if (D0 < -15) SA[rt][n] = (f32x4){0.f, 0.f, 0.f, 0.f};                                                                    \
                        else { const LAS float* bp = BT + (blane + D0); \
                            _Pragma("unroll") for (int i = 0; i < 4; ++i) SA[rt][n][i] = __builtin_amdgcn_exp2f(SA[rt][n][i] + bp[3 - i]); } } \
                } \
            } \
        } \
        _Pragma("unroll") for (int rt = 0; rt < 2; ++rt) \
            _Pragma("unroll") for (int k2 = 0; k2 < 2; ++k2) { pk[rt][k2].x = pk2(SA[rt][2 * k2][0], SA[rt][2 * k2][1]); pk[rt][k2].y = pk2(SA[rt][2 * k2][2], SA[rt][2 * k2][3]); \
                pk[rt][k2].z = pk2(SA[rt][2 * k2 + 1][0], SA[rt][2 * k2 + 1][1]); pk[rt][k2].w = pk2(SA[rt][2 * k2 + 1][2], SA[rt][2 * k2 + 1][3]); } \
        if (dmak_) asm volatile("s_waitcnt vmcnt(10)" ::: "memory"); else asm volatile("s_waitcnt vmcnt(0)" ::: "memory"); \
        asm volatile("s_waitcnt lgkmcnt(0)" ::: "memory"); __builtin_amdgcn_s_barrier(); asm volatile("" ::: "memory"); \
    } while (0)
#define DA_FAST(T_, SA, SB) do { \
        if (!(PVAR & 1)) { DB_DMAK((T_) + 4); DB_DMAV((T_) + 3); } \
        const ldsp vb_ = lds + DB_V + vr * DB_TSZ; vr = (vr == 4) ? 0 : vr + 1; \
        const ldsp kb_ = lds + DB_K + kr * DB_TSZ; kr = (kr + 1) & 3; \
        bf16x8 vfr[3], kfr[4]; \
        vfr[0] = lds_frag_tr2(vb_ + vco[0], vb_ + vco[0] + 16 * 256); vfr[1] = lds_frag_tr2(vb_ + vco[1], vb_ + vco[1] + 16 * 256); \
        __builtin_amdgcn_sched_barrier(0); \
        _Pragma("unroll") for (int g = 0; g < 52; ++g) { \
            if (g < 32) { const int f = g >> 1, rt = g & 1, k2 = f >> 3, e = f & 7; MFMA16(o[rt][e], __builtin_bit_cast(bf16x8, pk[rt][k2]), vfr[f % 3]); } \
            else if (g < 36) { const int jj = g - 32, rt = jj & 1, k2 = jj >> 1; MFMA16(o[rt][8], __builtin_bit_cast(bf16x8, pk[rt][k2]), ones); } \
            else { const int jj = g - 36, n = jj >> 2, ks = (jj >> 1) & 1, rt = jj & 1; \
                if (ks == 0) SB[rt][n] = __builtin_amdgcn_mfma_f32_16x16x32_bf16(kfr[(n * 2 + ks) & 3], qf[rt][ks], cmv[rt], 0, 0, 0); \
                else MFMA16(SB[rt][n], qf[rt][ks], kfr[(n * 2 + ks) & 3]); } \
            if (g >= 2 && g < 34) { const int jj = g - 2, rt = jj >> 4, n = (jj >> 2) & 3, i = jj & 3; SA[rt][n][i] = __builtin_amdgcn_exp2f(SA[rt][n][i]); } \
            if (g >= 36) { const int q_ = g - 36, rt = q_ >> 3, k2 = (q_ >> 2) & 1, w = q_ & 3; pk[rt][k2][w] = pk2(SA[rt][2 * k2 + (w >> 1)][2 * (w & 1)], SA[rt][2 * k2 + (w >> 1)][2 * (w & 1) + 1]); } \
            if (g < 32 && !(g & 1) && (g >> 1) + 2 < 16) { const int f = (g >> 1) + 2, k2 = f >> 3, e = f & 7; vfr[f % 3] = lds_frag_tr2(vb_ + vco[e] + (32 * k2) * 256, vb_ + vco[e] + (32 * k2 + 16) * 256); } \
            if (g >= 30 && g < 46 && !(g & 1)) { const int c_ = (g - 30) >> 1, n = c_ >> 1, ks = c_ & 1; kfr[c_ & 3] = lds_frag(kb_ + kx[ks] + n * 4096); } \
            __builtin_amdgcn_sched_barrier(0); \
        } \
        if (!(PVAR & 1)) asm volatile("s_waitcnt vmcnt(10)" ::: "memory"); \
        asm volatile("s_waitcnt lgkmcnt(0)" ::: "memory"); __builtin_amdgcn_s_barrier(); asm volatile("" ::: "memory"); \
    } while (0)
    int t = 0;
#define DA_COPY() do { _Pragma("unroll") for (int rt = 0; rt < 2; ++rt) _Pragma("unroll") for (int n = 0; n < 4; ++n) s[rt][n] = sn[rt][n]; } while (0)
    if (nt >= 6) {
        DA_BODY(0, true, false, true, s, sn); DA_COPY();
        for (t = 1; t + 1 <= nt - 5; t += 2) { DA_FAST(t, s, sn); DA_FAST(t + 1, sn, s); }
        if (t <= nt - 5) { DA_FAST(t, s, sn); DA_COPY(); ++t; }
    }
    for (; t < nt; ++t) { const bool far = (PVAR & 8) ? true : (q0 - 64 * t - 63) >= 113; DA_BODY(t, far, t > 0, t + 1 < nt, s, sn); DA_COPY(); }
#undef DA_COPY
#undef DA_BODY
#undef DA_FAST
    if (!(PVAR & 4)) {
        const ldsp vb_ = lds + DB_V + vr * DB_TSZ;
#pragma unroll
        for (int k2 = 0; k2 < 2; ++k2) {
#pragma unroll
            for (int e = 0; e < 8; ++e) { const bf16x8 vf = lds_frag_tr2(vb_ + vco[e] + (32 * k2) * 256, vb_ + vco[e] + (32 * k2 + 16) * 256);
                MFMA16(o[0][e], __builtin_bit_cast(bf16x8, pk[0][k2]), vf); MFMA16(o[1][e], __builtin_bit_cast(bf16x8, pk[1][k2]), vf); }
            MFMA16(o[0][8], __builtin_bit_cast(bf16x8, pk[0][k2]), ones); MFMA16(o[1][8], __builtin_bit_cast(bf16x8, pk[1][k2]), ones); }
    }
    asm volatile("s_waitcnt lgkmcnt(0)" ::: "memory"); __builtin_amdgcn_s_barrier(); asm volatile("" ::: "memory");
#undef DB_DMAK
#undef DB_DMAV
#undef DA_SMAT
    float inv[2];
#pragma unroll
    for (int rt = 0; rt < 2; ++rt) inv[rt] = 1.0f / o[rt][8][0];
    LAS float* XCH = (LAS float*)(lds + DB_XCH) + rg * (32 * 132);
    if (m == 1) {
#pragma unroll
        for (int rt = 0; rt < 2; ++rt) { const float f = lam * inv[rt];
#pragma unroll
            for (int e = 0; e < 8; ++e) *(LAS f32x4*)(XCH + (16 * rt + fr) * 132 + 16 * e + 4 * fq) = o[rt][e] * f; }
    }
    __syncthreads();
    if (m == 0) {
        f32x4 dnw[8];
#pragma unroll
        for (int e = 0; e < 8; ++e) dnw[e] = *(const f32x4*)(diff_norm + 16 * e + 4 * fq);
        f32x4 sq[2] = {(f32x4){0.f, 0.f, 0.f, 0.f}, (f32x4){0.f, 0.f, 0.f, 0.f}};
        if (SSQ) {
#pragma unroll
            for (int rt = 0; rt < 2; ++rt) sq[rt] = *(const f32x4*)(SSQ + (size_t)(rowbase + row0 + 16 * rt + fr) * 4); }
#pragma unroll
        for (int rt = 0; rt < 2; ++rt) { float ssq = 0.f;
#pragma unroll
            for (int e = 0; e < 8; ++e) { const f32x4 x2 = *(const LAS f32x4*)(XCH + (16 * rt + fr) * 132 + 16 * e + 4 * fq); const f32x4 v = o[rt][e] * inv[rt] - x2; o[rt][e] = v;
                ssq += (v[0] * v[0] + v[1] * v[1]) + (v[2] * v[2] + v[3] * v[3]); }
            ssq = quad_sum(ssq);
            float rs = 0.8f / sqrtf(ssq * (1.f / 128.f) + EPS);
            if (SSQ) rs *= sqrtf(((sq[rt][0] + sq[rt][1]) + (sq[rt][2] + sq[rt][3])) * (1.f / 1024.f) + EPS);
            bf16* orow = OUT + (rowbase + row0 + 16 * rt + fr) * opitch + h * 128;
#pragma unroll
            for (int e = 0; e < 8; ++e) { const f32x4 dn = dnw[e]; v2u w;
                w.x = pk2(o[rt][e][0] * rs * dn[0], o[rt][e][1] * rs * dn[1]); w.y = pk2(o[rt][e][2] * rs * dn[2], o[rt][e][3] * rs * dn[3]);
                *(v2u*)(orow + 16 * e + 4 * fq) = w; } }
    }
    __syncthreads();
}

constexpr int SW_KS = 0, SW_VS = 36864, SW_BT = 73728;
__device__ __forceinline__ void swa_unit(ldsp lds, const bf16* PROJ1, bf16* OUT  , int opitch, const float* rel_bias, const float* sinks, int b, int blk, int g, int tid, int lane, int wave) {
    asm volatile("" : "+v"(tid), "+v"(lane));
    const int fr = lane & 15, fq = lane >> 4, trq = (lane & 15) >> 2, trp = lane & 3;
    const size_t rowbase = (size_t)b * SEQ; const int qi = 16 * wave + fr;
    const bf16* prow = PROJ1 + (rowbase + blk * 128 + qi) * NPROJ1; bf16* orow = OUT + (rowbase + blk * 128 + qi) * opitch;
    bf16x8 qn[2];
#pragma unroll
    for (int ks = 0; ks < 2; ++ks) qn[ks] = *(const bf16x8*)(prow + C1_SQ + (4 * g) * 64 + ks * 32 + fq * 8);
    LAS float* BT = (LAS float*)(lds + SW_BT);
    { const int r = tid >> 7, d = tid & 127; BT[tid] = rel_bias[t5_bucket(d) * 8 + 4 * g + r] * LOG2E; }
#pragma unroll
    for (int i = 0; i < 4; ++i) { const int idx = tid + 512 * i, key = idx >> 3, ch = idx & 7; const int kp = blk * 128 - 128 + key;
        v4u kv = {0u, 0u, 0u, 0u}, vv = kv;
        if (kp >= 0) { const bf16* p = PROJ1 + (rowbase + kp) * NPROJ1 + g * 64 + ch * 8; kv = *(const v4u*)(p + C1_SK); vv = *(const v4u*)(p + C1_SV); }
        *(LAS v4u*)(lds + SW_KS + key * 144 + ch * 16) = kv; *(LAS v4u*)(lds + SW_VS + key * 144 + ch * 16) = vv; }
    __syncthreads();
    const float SC = 0.125f * LOG2E;
#pragma unroll 1
    for (int r = 0; r < 4; ++r) {
        const float skr = sinks[4 * g + r] * LOG2E;
        bf16x8 qc[2] = {qn[0], qn[1]};
        if (r < 3) {
#pragma unroll
            for (int ks = 0; ks < 2; ++ks) qn[ks] = *(const bf16x8*)(prow + C1_SQ + (4 * g + r + 1) * 64 + ks * 32 + fq * 8); }
        f32x4 s[10];
#pragma unroll
        for (int nn = 0; nn < 9; ++nn) { const int n = wave + nn; bf16x8 kf[2];
#pragma unroll
            for (int ks = 0; ks < 2; ++ks) kf[ks] = lds_frag(lds + SW_KS + (16 * n + fr) * 144 + (ks * 32 + fq * 8) * 2);
            s[nn] = (f32x4){0.f, 0.f, 0.f, 0.f}; MFMA16(s[nn], qc[0], kf[0]); MFMA16(s[nn], qc[1], kf[1]); }
        s[9] = (f32x4){0.f, 0.f, 0.f, 0.f};
        float mx = skr;
#pragma unroll
        for (int nn = 0; nn < 9; ++nn)
#pragma unroll
            for (int i = 0; i < 4; ++i) { const int j = 16 * (wave + nn) + 4 * fq + i, dist = qi + 128 - j; const bool valid = (dist >= 0) && (dist < 128) && (blk * 128 - 128 + j >= 0);
                const float bb = BT[r * 128 + min(max(dist, 0), 127)]; const float pen = valid ? 0.f : -INFINITY; const float v = (s[nn][i] * SC + bb) + pen; s[nn][i] = v; mx = fmaxf(mx, v); }
        mx = quad_max(mx);
        float psum = 0.f;
#pragma unroll
        for (int nn = 0; nn < 9; ++nn)
#pragma unroll
            for (int i = 0; i < 4; ++i) { const float p = __builtin_amdgcn_exp2f(s[nn][i] - mx); s[nn][i] = p; psum += p; }
        const float il = 1.0f / (quad_sum(psum) + __builtin_amdgcn_exp2f(skr - mx));
        f32x4 o[4];
#pragma unroll
        for (int e = 0; e < 4; ++e) o[e] = (f32x4){0.f, 0.f, 0.f, 0.f};
#pragma unroll
        for (int k2 = 0; k2 < 5; ++k2) { v4u pkv; pkv.x = pk2(s[2 * k2][0] * il, s[2 * k2][1] * il); pkv.y = pk2(s[2 * k2][2] * il, s[2 * k2][3] * il);
            pkv.z = pk2(s[2 * k2 + 1][0] * il, s[2 * k2 + 1][1] * il); pkv.w = pk2(s[2 * k2 + 1][2] * il, s[2 * k2 + 1][3] * il);
            const int r0 = 16 * (wave + 2 * k2) + 4 * fq + trq, r1 = min(r0 + 16, 255);
#pragma unroll
            for (int e = 0; e < 4; ++e) { const bf16x8 vf = lds_frag_tr2(lds + SW_VS + r0 * 144 + (16 * e + 4 * trp) * 2, lds + SW_VS + r1 * 144 + (16 * e + 4 * trp) * 2);
                MFMA16(o[e], __builtin_bit_cast(bf16x8, pkv), vf); } }
#pragma unroll
        for (int e = 0; e < 4; ++e) { v2u w; w.x = pk2(o[e][0], o[e][1]); w.y = pk2(o[e][2], o[e][3]); *(v2u*)(orow + (4 * g + r) * 64 + 16 * e + 4 * fq) = w; }
    }
    __syncthreads();
}

__device__ __forceinline__ float ret_log2_gamma(int h) { return log2f(1.0f - exp2f(-5.0f - (float)h)); }
__device__ __forceinline__ void rope_row_store(const bf16* src  , const float* COS, const float* SIN, int pos, int q4, float scale, ldsp dst) {
    v4u lo[2], hi[2];
#pragma unroll
    for (int i = 0; i < 2; ++i) { lo[i] = *(const v4u*)(src + 16 * q4 + 8 * i); hi[i] = *(const v4u*)(src + 64 + 16 * q4 + 8 * i); }
    const float* cp = COS + (size_t)pos * 64 + 16 * q4; const float* sp = SIN + (size_t)pos * 64 + 16 * q4;
#pragma unroll
    for (int i = 0; i < 2; ++i) { v4u ol, oh;
#pragma unroll
        for (int j = 0; j < 4; ++j) { const f32x4 cc = *(const f32x4*)(cp + 8 * i + 4 * (j >> 1)), ss = *(const f32x4*)(sp + 8 * i + 4 * (j >> 1));
            const float c0 = cc[2 * (j & 1)], c1 = cc[2 * (j & 1) + 1], s0 = ss[2 * (j & 1)], s1 = ss[2 * (j & 1) + 1];
            const float a0 = __uint_as_float(lo[i][j] << 16), a1 = __uint_as_float(lo[i][j] & 0xffff0000u), b0 = __uint_as_float(hi[i][j] << 16), b1 = __uint_as_float(hi[i][j] & 0xffff0000u);
            ol[j] = pk2((a0 * c0 - b0 * s0) * scale, (a1 * c1 - b1 * s1) * scale); oh[j] = pk2((a0 * s0 + b0 * c0) * scale, (a1 * s1 + b1 * c1) * scale); }
        *(LAS v4u*)(dst + (16 * q4 + 8 * i) * 2) = ol; *(LAS v4u*)(dst + (64 + 16 * q4 + 8 * i) * 2) = oh; }
}
constexpr int RA_VS = 0, RA_KS = 67584;
__device__ __forceinline__ void retA_unit(ldsp lds, const bf16* PROJ1, const float* COS, const float* SIN, bf16* ST, int u, int tid, int lane, int wave) {
    asm volatile("" : "+v"(tid), "+v"(lane));
    const int h = u & 3, c = (u >> 2) & 63, b = u >> 8, t0 = b * SEQ + c * 128;
    const int fr = lane & 15, fq = lane >> 4, trq = (lane & 15) >> 2, trp = lane & 3;
    const float lg = ret_log2_gamma(h);
#pragma unroll
    for (int i = 0; i < 8; ++i) { const int idx = tid + 512 * i, rw = idx >> 5, ch = idx & 31;
        *(LAS v4u*)(lds + RA_VS + rw * 528 + ch * 16) = *(const v4u*)(PROJ1 + (size_t)(t0 + rw) * NPROJ1 + C1_RV + h * 256 + ch * 8); }
    { const int s = tid >> 2, q4 = tid & 3;
      rope_row_store(PROJ1 + (size_t)(t0 + s) * NPROJ1 + C1_RK + h * 128, COS, SIN, c * 128 + s, q4, 0.08838834764831845f * exp2f((float)(127 - s) * lg), lds + RA_KS + s * 272); }
    __syncthreads();
    f32x4 acc[2][8];
#pragma unroll
    for (int j = 0; j < 2; ++j)
#pragma unroll
        for (int n = 0; n < 8; ++n) acc[j][n] = (f32x4){0.f, 0.f, 0.f, 0.f};
    bf16x8 fa[2][2], fb[2][8];
#define RA_READ(ks_, buf_) do { _Pragma("unroll") for (int j = 0; j < 2; ++j) fa[buf_][j] = lds_frag_tr(lds + RA_VS + (32 * (ks_) + 8 * fq + trq) * 528 + ((2 * wave + j) * 16 + 4 * trp) * 2, 528); \
        _Pragma("unroll") for (int n = 0; n < 8; ++n) fb[buf_][n] = lds_frag_tr(lds + RA_KS + (32 * (ks_) + 8 * fq + trq) * 272 + (n * 16 + 4 * trp) * 2, 272); } while (0)
    RA_READ(0, 0);
#pragma unroll
    for (int ks = 0; ks < 4; ++ks) {
        if (ks < 3) RA_READ(ks + 1, (ks + 1) & 1);
        __builtin_amdgcn_sched_barrier(0);
#pragma unroll
        for (int n = 0; n < 8; ++n) { MFMA16(acc[0][n], fa[ks & 1][0], fb[ks & 1][n]); MFMA16(acc[1][n], fa[ks & 1][1], fb[ks & 1][n]); }
        __builtin_amdgcn_sched_barrier(0);
    }
#undef RA_READ
    bf16* so = ST + ((size_t)((b * 64 + c) * 4 + h) * 256) * 128;
#pragma unroll
    for (int j = 0; j < 2; ++j)
#pragma unroll
        for (int n = 0; n < 8; ++n) { v2u w; w.x = pk2(acc[j][n][0], acc[j][n][1]); w.y = pk2(acc[j][n][2], acc[j][n][3]);
            *(v2u*)(so + (size_t)((2 * wave + j) * 16 + fr) * 128 + n * 16 + 4 * fq) = w; }
    __syncthreads();
}
__device__ __forceinline__ void ret_scan(bf16* ST, int gtid, int gthreads) {
    for (int e = gtid; e < 131072; e += gthreads) {
        const int b = e >> 16, rem = e & 65535, h = rem >> 14, ed = rem & 16383;
        unsigned* p = (unsigned*)ST + ((size_t)(b * 64) * 4 + h) * 16384 + ed; const float dec = exp2f(128.0f * ret_log2_gamma(h));
        float c0 = 0.f, c1 = 0.f;
#pragma unroll 1
        for (int hf = 0; hf < 2; ++hf) {
            unsigned v[32]; unsigned* pb = p + (size_t)hf * 32 * 4 * 16384;
            { const unsigned* q = pb;
#pragma unroll
              for (int c = 0; c < 32; ++c) { v[c] = *q; q += 4 * 16384; asm volatile("" : "+v"(q)); } }
#pragma unroll
            for (int c = 0; c < 32; ++c) { const unsigned o = pk2(c0, c1); c0 = c0 * dec + __uint_as_float(v[c] << 16); c1 = c1 * dec + __uint_as_float(v[c] & 0xffff0000u); v[c] = o; }
            { unsigned* q = pb;
#pragma unroll
              for (int c = 0; c < 32; ++c) { *q = v[c]; q += 4 * 16384; asm volatile("" : "+v"(q)); } }
        }
    }
}
constexpr int RC_KS = 0, RC_VS = 34816, RC_SP = 102400;
template <int PV> __device__ __forceinline__ void retC_unit(ldsp lds, const bf16* PROJ1, bf16* OUT  , int opitch, const float* COS, const float* SIN, const bf16* ST, int u, int tid, int lane, int wave) {
    asm volatile("" : "+v"(tid), "+v"(lane));
    const int h = u & 3, c = (u >> 2) & 63, b = u >> 8, t0 = b * SEQ + c * 128;
    const int fr = lane & 15, fq = lane >> 4, trq = (lane & 15) >> 2, trp = lane & 3;
    const float lg = ret_log2_gamma(h);
    const int l = 16 * wave + fr; const bf16* prow = PROJ1 + (size_t)(t0 + l) * NPROJ1; bf16* orow = OUT + (size_t)(t0 + l) * opitch;
    if (!(PV & 1)) {
#pragma unroll
    for (int i = 0; i < 8; ++i) { const int idx = tid + 512 * i, rw = idx >> 5, ch = idx & 31;
        *(LAS v4u*)(lds + RC_VS + rw * 528 + ch * 16) = *(const v4u*)(PROJ1 + (size_t)(t0 + rw) * NPROJ1 + C1_RV + h * 256 + ch * 8); }
    }
    if (!(PV & 1)) { const int s = tid >> 2, q4 = tid & 3;
      rope_row_store(PROJ1 + (size_t)(t0 + s) * NPROJ1 + C1_RK + h * 128, COS, SIN, c * 128 + s, q4, 0.08838834764831845f, lds + RC_KS + s * 272); }
    bf16x8 qf[4], qx[4];
    { v4u raw[4];
#pragma unroll
      for (int ks = 0; ks < 4; ++ks) raw[ks] = *(const v4u*)(prow + C1_RQ + h * 128 + 32 * ks + 8 * fq);
      const float xi = exp2f((float)(l + 1) * lg);
#pragma unroll
      for (int k2 = 0; k2 < 2; ++k2) { const float* cp = COS + (size_t)(c * 128 + l) * 64 + 32 * k2 + 8 * fq; const float* sp = SIN + (size_t)(c * 128 + l) * 64 + 32 * k2 + 8 * fq;
          v4u o1, o2, x1, x2;
#pragma unroll
          for (int j = 0; j < 4; ++j) { const f32x4 cc = *(const f32x4*)(cp + 4 * (j >> 1)), ss = *(const f32x4*)(sp + 4 * (j >> 1));
              const float c0 = cc[2 * (j & 1)], c1 = cc[2 * (j & 1) + 1], s0 = ss[2 * (j & 1)], s1 = ss[2 * (j & 1) + 1];
              const float a0 = __uint_as_float(raw[k2][j] << 16), a1 = __uint_as_float(raw[k2][j] & 0xffff0000u), b0 = __uint_as_float(raw[k2 + 2][j] << 16), b1 = __uint_as_float(raw[k2 + 2][j] & 0xffff0000u);
              const float r10 = a0 * c0 - b0 * s0, r11 = a1 * c1 - b1 * s1, r20 = a0 * s0 + b0 * c0, r21 = a1 * s1 + b1 * c1;
              o1[j] = pk2(r10, r11); o2[j] = pk2(r20, r21); x1[j] = pk2(r10 * xi, r11 * xi); x2[j] = pk2(r20 * xi, r21 * xi); }
          qf[k2] = __builtin_bit_cast(bf16x8, o1); qf[k2 + 2] = __builtin_bit_cast(bf16x8, o2); qx[k2] = __builtin_bit_cast(bf16x8, x1); qx[k2 + 2] = __builtin_bit_cast(bf16x8, x2); } }
    __syncthreads();
    f32x4 sc[8];
#pragma unroll
    for (int n = 0; n < 8; ++n) { sc[n] = (f32x4){0.f, 0.f, 0.f, 0.f};
#pragma unroll
        for (int ks = 0; ks < 4; ++ks) { const bf16x8 kf = lds_frag(lds + RC_KS + (16 * n + fr) * 272 + 64 * ks + 16 * fq); MFMA16(sc[n], qf[ks], kf); } }
    __syncthreads();
#pragma unroll
    for (int n = 0; n < 8; ++n) { float mv[4];
#pragma unroll
        for (int i = 0; i < 4; ++i) { const int s = 16 * n + 4 * fq + i; mv[i] = (s <= l) ? sc[n][i] * __builtin_amdgcn_exp2f((float)(l - s) * lg) : 0.f; }
        v2u w; w.x = pk2(mv[0], mv[1]); w.y = pk2(mv[2], mv[3]); *(LAS v2u*)(lds + RC_KS + l * 272 + (16 * n + 4 * fq) * 2) = w; }
    f32x4 o[16];
#pragma unroll
    for (int e = 0; e < 16; ++e) o[e] = (f32x4){0.f, 0.f, 0.f, 0.f};
    v2u gts[16];
#pragma unroll
    for (int e = 0; e < 16; ++e) gts[e] = *(const v2u*)(prow + C1_RG + h * 256 + 16 * e + 4 * fq);
    const bf16* sp = ST + ((size_t)((b * 64 + c) * 4 + h) * 256) * 128;
    const int sprow = tid >> 2, spc = tid & 3;
    v4u spr[2];
#pragma unroll
    for (int i = 0; i < 2; ++i) spr[i] = *(const v4u*)(sp + (size_t)(sprow + 128 * i) * 128 + spc * 8);
#pragma unroll
    for (int ks = 0; ks < ((PV & 2) ? 0 : 4); ++ks) {
        const ldsp slot = lds + RC_SP + (ks & 1) * 20480;
#pragma unroll
        for (int i = 0; i < 2; ++i) *(LAS v4u*)(slot + (sprow + 128 * i) * 80 + spc * 16) = spr[i];
        if (ks < 3) {
#pragma unroll
            for (int i = 0; i < 2; ++i) spr[i] = *(const v4u*)(sp + (size_t)(sprow + 128 * i) * 128 + 32 * (ks + 1) + spc * 8); }
        __syncthreads();
        const bf16x8 mf = lds_frag(lds + RC_KS + l * 272 + 64 * ks + 16 * fq);
#pragma unroll
        for (int eh = 0; eh < 2; ++eh) { bf16x8 sf[8], vf[8];
#pragma unroll
            for (int e = 0; e < 8; ++e) { sf[e] = lds_frag(slot + (16 * (8 * eh + e) + fr) * 80 + 16 * fq);
                vf[e] = lds_frag_tr(lds + RC_VS + (32 * ks + 8 * fq + trq) * 528 + (16 * (8 * eh + e) + 4 * trp) * 2, 528); }
            __builtin_amdgcn_sched_barrier(0);
#pragma unroll
            for (int e = 0; e < 8; ++e) { MFMA16(o[8 * eh + e], qx[ks], sf[e]); MFMA16(o[8 * eh + e], mf, vf[e]); }
            __builtin_amdgcn_sched_barrier(0); }
    }
    float ssq = 0.f;
#pragma unroll
    for (int e = 0; e < 16; ++e) ssq += (o[e][0] * o[e][0] + o[e][1] * o[e][1]) + (o[e][2] * o[e][2] + o[e][3] * o[e][3]);
    ssq += __shfl_xor(ssq, 16); ssq += __shfl_xor(ssq, 32);
    const float rs = 1.0f / sqrtf(ssq * (1.f / 256.f) + EPS);
#pragma unroll
    for (int e = 0; e < 16; ++e) { const v2u gw_ = gts[e];
        const float g0 = __uint_as_float(gw_.x << 16), g1 = __uint_as_float(gw_.x & 0xffff0000u), g2 = __uint_as_float(gw_.y << 16), g3 = __uint_as_float(gw_.y & 0xffff0000u);
        v2u w; w.x = pk2(o[e][0] * rs * silu_f(g0), o[e][1] * rs * silu_f(g1)); w.y = pk2(o[e][2] * rs * silu_f(g2), o[e][3] * rs * silu_f(g3)); *(v2u*)(orow + h * 256 + 16 * e + 4 * fq) = w; }
    __syncthreads();
}

#ifndef PROBE_CV
#define PROBE_CV 0
#endif
#ifndef MK_PER_PHASE
#define MK_PER_PHASE 0
#endif
constexpr int N_PHASES = 21;
#ifndef PROBE_G
#define PROBE_G 0u
#endif
#ifndef PROBE_BAR
#define PROBE_BAR 0
#endif
#ifndef PROBE_VAR
#define PROBE_VAR 0
#endif
#ifndef PROBE_REP
#define PROBE_REP 0u
#endif
struct Args { const float* in[N_IN]; float* out; unsigned char* ws; int ph_lo, ph_hi, pad0, pad1; };
template <bool FUSE_T> __global__ void __launch_bounds__(NTHR, 2) trunk_fwd(Args args) {
    extern __shared__ __attribute__((aligned(16))) unsigned char lds_raw[];
    const ldsp lds = (ldsp)lds_raw;
    volatile LAS unsigned* MISC = (volatile LAS unsigned*)(lds + MISC_OFF);
    const int tid = threadIdx.x, lane = tid & 63, wave = __builtin_amdgcn_readfirstlane(tid >> 6);
    const int G = gridDim.x; const int bx = blockIdx.x; const int vcu = (G % 8 == 0) ? (bx % 8) * (G / 8) + bx / 8 : bx;
    const int gw = vcu * NWAVES + wave, NGW = G * NWAVES, gtid = vcu * NTHR + tid, gthreads = G * NTHR;
    unsigned char* ws = args.ws;
    gu32* ctl = (gu32*)(ws + WS_CTL);
    for (int u = tid; u < 64; u += NTHR) MISC[u] = 0u;
    __syncthreads();
    XcdBarrier bar; bar.bar = (unsigned*)(ctl + CW_BAR); bar.x = 0; bar.st = nullptr;
    if (!MK_PER_PHASE) bar = xcd_barrier_post((unsigned*)(ctl + CW_BAR), MISC + 8);
    const int lo = args.ph_lo, hi = args.ph_hi;
#define IN(k) (lo <= (k) && (k) < hi)
#define SEAM(k) do { if (IN(k) && IN((k) + 1)) { xcd_barrier<true>(bar); if (PROBE_BAR == 1) xcd_barrier<true>(bar); if (PROBE_BAR == 2) xcd_barrier<false>(bar); } } while (0)
#define REPS(k) (((PROBE_REP >> (k)) & 1u) ? 2 : 1)
    float* MOD = (float*)(ws + WS_MOD); bf16* WDT = (bf16*)(ws + WS_WDT); float* CHDEC = (float*)(ws + WS_CHDEC); float* SSQ = (float*)(ws + WS_SSQ);
    bf16* WMIX = (bf16*)(ws + WS_WMIX); bf16* WOUT0 = (bf16*)(ws + WS_WOUT0); bf16* WOUT1 = (bf16*)(ws + WS_WOUT1);
    bf16* PROJ0 = (bf16*)(ws + WS_PROJ0); bf16* XB = (bf16*)(ws + WS_XN2); bf16* XN2 = (bf16*)args.out;     bf16* W1T = (bf16*)(ws + WS_WMLP); bf16* W2T = (bf16*)(ws + WS_WMLP + 8 * MiB);
    bf16* HB = (bf16*)(ws + WS_H); bf16* PROJ1 = (bf16*)(ws + WS_H); bf16* SB = (bf16*)(ws + WS_S); float* DT = (float*)(ws + WS_DT);
    unsigned* KMAX = (unsigned*)(ws + WS_KMAX);
    float* COS = (float*)(ws + WS_ROPE); float* SIN = COS + 8192 * 64;
    constexpr bool fuse = FUSE_T && !PROBE_REP && !PROBE_G;
    float* XCH = (float*)(ws + WS_XCH);                              unsigned* TMO = (unsigned*)(ctl + CW_BAR) + XB_TMO;
    bf16* W1T0 = fuse ? (bf16*)((char*)args.out + 32 * MiB) : W1T; bf16* W2T0 = fuse ? (bf16*)((char*)args.out + 40 * MiB) : W2T;
    const float* x_in = args.in[I_X]; const float* ng = args.in[I_NG]; float* X = args.out;

    if (IN(0)) for (int rep0 = 0; rep0 < REPS(0); ++rep0) {
        const Seg segs[4] = { {args.in[I_EWIN], 6160, 0, 1024, 1024, WMIX, 0}, {args.in[I_EWIN], 6160, 3088, 3072, 1024, WMIX, 1024}, {args.in[I_EWIN], 6160, 1024, 2048, 1024, WMIX, 4096},
                              {args.in[I_EWOUT], 1024, 0, 1024, 2048, WOUT0, 0} };
        if (fuse) { const Seg s3[3] = { segs[0], segs[1], segs[2] }; convert_set<3>(s3, lds, gw, NGW, wave, lane); }
        else convert_set<4>(segs, lds, gw, NGW, wave, lane);
        for (int i = gtid; i < 8 * MTOK; i += gthreads) ((v4u*)XCH)[i] = (v4u){0xffffffffu, 0xffffffffu, 0xffffffffu, 0xffffffffu};
        for (int i = gtid; i < 16384; i += gthreads) { const int h = i >> 10, k = i & 1023; WDT[i] = f2bf(args.in[I_EWIN][(size_t)k * 6160 + 3072 + h]); }
        for (int i = gtid; i < 8192 * 64; i += gthreads) { const int t = i >> 6, f = i & 63; const float inv = powf(10000.0f, -(float)f * (1.0f / 64.0f)); const float ang = (float)t * inv;
            const double a = (double)ang; const double n = rint(a * 0.15915494309189535); const float r = (float)(a - n * 6.283185307179586); COS[i] = __cosf(r); SIN[i] = __sinf(r); }
        __syncthreads();
        mod_phase(args.in[I_C], args.in[I_MODW], args.in[I_MODB], MOD, lds, tid, lane, wave);
    }
    SEAM(0);
    if (IN(1)) for (int rep1 = 0; rep1 < REPS(1); ++rep1) norm_rows<-1, 0, false, 0>(x_in, nullptr, nullptr, SB, MOD, ng, gw, NGW, lane);
    SEAM(1);
    if (IN(2)) {
        pg8::Gemm g{SB, WMIX, MTOK, NPROJ0, DM, DM}; pg8::StaticOrder S; S.init(MTOK, NPROJ0, G, bx);
        pg8::EpiBf16<0> E{PROJ0, NPROJ0, nullptr, 0, 0, 1.f};
        if ((PROBE_G >> 2) & 1u) { pg8::gemm_phase<pg8::EpiBf16<0>, pg8::StaticOrder, true, true>(lds, g, S, E); __syncthreads(); } pg8::gemm_phase<pg8::EpiBf16<0>, pg8::StaticOrder, true, true>(lds, g, S, E);
        __syncthreads(); dt_phase(SB, WDT, args.in[I_EDTB], DT, gw, NGW, wave, lane, lds);
    }
    SEAM(2);
    if (IN(3)) { if (!fuse || MK_PER_PHASE) kmax_rows(PROJ0, KMAX, gw, NGW, lane);
        for (int rep = 0; rep < REPS(3); ++rep) for (int u = vcu; u < 512; u += G) ssdA_unit(lds, PROJ0, DT, args.in[I_ECONVW], args.in[I_ECONVB], args.in[I_EALOG], SB, CHDEC, u, tid, lane, wave); }
    if (!fuse || MK_PER_PHASE) SEAM(3); else { xcd_barrier_arrive(bar); kmax_rows(PROJ0, KMAX, gw, NGW, lane); xcd_barrier_wait(bar);
        if (tid == 0) __hip_atomic_fetch_add((unsigned*)ctl + CW_KDONE, 1u, __ATOMIC_RELAXED, __HIP_MEMORY_SCOPE_AGENT); }
    if (IN(4)) ssd_scan(SB, CHDEC, gtid, gthreads);
    if (!fuse || MK_PER_PHASE) SEAM(4); else xcd_barrier_arrive(bar);
#define P5_BODY { for (int rep = 0; rep < REPS(5); ++rep) for (int u = vcu; u < 512; u += G) { if (rep + 1 < REPS(5)) ssdC_unit<(PROBE_VAR < 32 ? PROBE_VAR : 0)>(lds, PROJ0, (bf16*)args.out, 1024, DT, args.in[I_ECONVW], args.in[I_ECONVB], args.in[I_EALOG], args.in[I_ED], args.in[I_ESSDN], SB, SSQ, u, tid, lane, wave); else ssdC_unit<0>(lds, PROJ0, PROJ0 + C0_Z, NPROJ0, DT, args.in[I_ECONVW], args.in[I_ECONVB], args.in[I_EALOG], args.in[I_ED], args.in[I_ESSDN], SB, SSQ, u, tid, lane, wave); } }
    if (!fuse) {
    if (IN(5)) P5_BODY
    SEAM(5);
    }
    if (IN(6)) {
        if (!fuse) ssd_normalize_rows(PROJ0, SSQ, gw, NGW, lane);
        const float* lm = args.in[I_ELAM];
        const float lam = expf(wave_sum(lm[lane] * lm[64 + lane])) - expf(wave_sum(lm[128 + lane] * lm[192 + lane])) + 0.2f;
        if (fuse && !MK_PER_PHASE) { if (tid == 0) { unsigned sp = 0;
                while (__hip_atomic_load((unsigned*)ctl + CW_KDONE, __ATOMIC_RELAXED, __HIP_MEMORY_SCOPE_AGENT) < (unsigned)G) { __builtin_amdgcn_s_sleep(1); if ((++sp & 255u) == 0u) { if (__hip_atomic_load(TMO, __ATOMIC_RELAXED, __HIP_MEMORY_SCOPE_AGENT)) break; if (sp > (1u << 18)) { atomicAdd(TMO, 1u); break; } } } } }
        __syncthreads();
        for (int rep = 0; rep < REPS(6); ++rep)
        for (int u = vcu; u < 1024; u += G) { const int v = u & 255, i = u >> 8, j = v & 15, bh = v >> 4; const int qb = i == 0 ? j : (i == 1 ? 63 - j : (i == 2 ? 16 + j : 47 - j));
            if (PROBE_VAR >= 16 && rep + 1 < REPS(6)) { }
            else if (rep + 1 < REPS(6)) dattn5_unit<PROBE_VAR < 16 ? PROBE_VAR : 0>(lds, PROJ0, (bf16*)args.out, 1024, args.in[I_RELB], args.in[I_EDIFFN], KMAX, lam, bh >> 3, bh & 7, qb, tid, lane, wave, nullptr);
            else dattn5_unit<0>(lds, PROJ0, PROJ0 + C0_Q, NPROJ0, args.in[I_RELB], args.in[I_EDIFFN], KMAX, lam, bh >> 3, bh & 7, qb, tid, lane, wave, nullptr); }
        if (fuse) { if (!MK_PER_PHASE) xcd_barrier_wait(bar); else __syncthreads(); P5_BODY }
        if (fuse) { __syncthreads(); const Seg so[1] = { {args.in[I_EWOUT], 1024, 0, 1024, 2048, WOUT0, 0} }; convert_set<1>(so, lds, gw, NGW, wave, lane); }
    }
    SEAM(6);
    if (IN(7)) {
        pg8::Gemm g{PROJ0, WOUT0, MTOK, DM, 2048, NPROJ0}; pg8::StaticOrder S; S.init(MTOK, DM, G, bx);
        if (fuse) { pg8::Unit u0; S.next(0, u0); LAS float* rsc = (LAS float*)(lds + pg8::STAGE_BYTES);
            if (tid < 256) { const f32x4 q = *(const f32x4*)(SSQ + (size_t)(u0.pm * 256 + tid) * 4); rsc[tid] = 1.0f / sqrtf(((q[0] + q[1]) + (q[2] + q[3])) * (1.f / 1024.f) + EPS); }
            __syncthreads();
            pg8::EpiNorm<0, 1, false, 1> EN{x_in, SB  , XN2, MOD, ng, {XCH + 0 * (MTOK * 4), TMO}, {XCH + 1 * (MTOK * 4), TMO}, EPS};
            pg8::gemm_phase<pg8::EpiNorm<0, 1, false, 1>, pg8::StaticOrder, true, true, true>(lds, g, S, EN, rsc); } else {
        pg8::EpiBf16<0> E{SB, DM, nullptr, 0, 0, 1.f};
        if ((PROBE_G >> 7) & 1u) { pg8::gemm_phase<pg8::EpiBf16<0>, pg8::StaticOrder, true, true>(lds, g, S, E); __syncthreads(); } pg8::gemm_phase<pg8::EpiBf16<0>, pg8::StaticOrder, true, true>(lds, g, S, E); }
    }
    if (!fuse) SEAM(7); else __syncthreads();
    if (IN(8)) {
        const Seg segs[2] = { {args.in[I_W1], 4096, 0, 4096, 1024, W1T0, 0}, {args.in[I_W2], 1024, 0, 1024, 4096, W2T0, 0} };
        if (fuse) { const Seg s1[1] = { segs[0] }; convert_set<1>(s1, lds, gw, NGW, wave, lane); }
        else { convert_set<2>(segs, lds, gw, NGW, wave, lane); if (PROBE_CV) convert_set<2>(segs, lds, gw, NGW, wave, lane); }
        if (!fuse) norm_rows<0, 1, false, 1>(x_in, SB, XB, XN2, MOD, ng, gw, NGW, lane);
    }
    SEAM(8);
    if (IN(9)) {
        pg8::Gemm g{XN2, W1T0, MTOK, FF, DM, DM}; pg8::StaticOrder S; S.init(MTOK, FF, G, bx);
        pg8::EpiBf16<2> E{HB, FF, nullptr, 0, 0, 1.f};
        if ((PROBE_G >> 9) & 1u) { pg8::gemm_phase<pg8::EpiBf16<2>, pg8::StaticOrder, true, true>(lds, g, S, E); __syncthreads(); } pg8::gemm_phase<pg8::EpiBf16<2>, pg8::StaticOrder, true, true>(lds, g, S, E);
        if (fuse) { __syncthreads(); const Seg s2[1] = { {args.in[I_W2], 1024, 0, 1024, 4096, W2T0, 0} }; convert_set<1>(s2, lds, gw, NGW, wave, lane); }
    }
    SEAM(9);
    if (IN(10)) {
        pg8::Gemm g{HB, W2T0, MTOK, DM, FF, FF}; pg8::StaticOrder S; S.init(MTOK, DM, G, bx);
        if (fuse) { pg8::EpiNorm<1, 2, true, 1> EN{SB, XB, XN2, MOD, ng, {XCH + 2 * (MTOK * 4), TMO}, {XCH + 3 * (MTOK * 4), TMO}, EPS};
            pg8::gemm_phase<pg8::EpiNorm<1, 2, true, 1>, pg8::StaticOrder, true, true>(lds, g, S, EN); } else {
        pg8::EpiBf16<0> E{SB, DM, nullptr, 0, 0, 1.f};
        if ((PROBE_G >> 10) & 1u) { pg8::gemm_phase<pg8::EpiBf16<0>, pg8::StaticOrder, true, true>(lds, g, S, E); __syncthreads(); } pg8::gemm_phase<pg8::EpiBf16<0>, pg8::StaticOrder, true, true>(lds, g, S, E); }
    }
    if (!fuse) SEAM(10); else __syncthreads();
    if (IN(11)) {
        const Seg segs[4] = { {args.in[I_OWIN], 3840, 2048, 1536, 1024, WMIX, 0}, {args.in[I_OWIN], 3840, 0, 2048, 1024, WMIX, 1536}, {args.in[I_OWIN], 3840, 3584, 256, 1024, WMIX, 3584},
                              {args.in[I_OWOUT], 1024, 0, 1024, 1536, WOUT1, 0} };
        if (fuse) { const Seg s3[3] = { segs[0], segs[1], segs[2] }; convert_set<3>(s3, lds, gw, NGW, wave, lane); }
        else { convert_set<4>(segs, lds, gw, NGW, wave, lane); if (PROBE_CV) convert_set<4>(segs, lds, gw, NGW, wave, lane); }
        if (!fuse) norm_rows<1, 2, true, 1>(XB, SB, XB, XN2, MOD, ng, gw, NGW, lane);
    }
    SEAM(11);
    if (IN(12)) {
        pg8::Gemm g{XN2, WMIX, MTOK, NPROJ1, DM, DM}; pg8::StaticOrder S; S.init(MTOK, NPROJ1, G, bx);
        pg8::EpiBf16<0> E{PROJ1, NPROJ1, nullptr, 0, 0, 1.f};
        if ((PROBE_G >> 12) & 1u) { pg8::gemm_phase<pg8::EpiBf16<0>, pg8::StaticOrder, true, true>(lds, g, S, E); __syncthreads(); } pg8::gemm_phase<pg8::EpiBf16<0>, pg8::StaticOrder, true, true>(lds, g, S, E);
        }
    SEAM(12);
    if (IN(13)) {
        for (int rep = 0; rep < REPS(13); ++rep) {
        for (int u = vcu; u < 512; u += G) retA_unit(lds, PROJ1, COS, SIN, SB, u, tid, lane, wave);
        if (!fuse) for (int u = vcu; u < 256; u += G) swa_unit(lds, PROJ1, (rep + 1 < REPS(13)) ? XN2 : PROJ1 + C1_SQ, (rep + 1 < REPS(13)) ? 1024 : NPROJ1, args.in[I_RELB], args.in[I_OSINK], u >> 7, (u >> 1) & 63, u & 1, tid, lane, wave); }
    }
    SEAM(13);
    if (IN(14)) ret_scan(SB, gtid, gthreads);
    if (!fuse || MK_PER_PHASE) SEAM(14); else xcd_barrier_arrive(bar);
    if (IN(15)) { if (fuse) { for (int u = vcu; u < 256; u += G) swa_unit(lds, PROJ1, PROJ1 + C1_SQ, NPROJ1, args.in[I_RELB], args.in[I_OSINK], u >> 7, (u >> 1) & 63, u & 1, tid, lane, wave);
            if (!MK_PER_PHASE) xcd_barrier_wait(bar); else __syncthreads(); }
        for (int rep = 0; rep < REPS(15); ++rep) for (int u = vcu; u < 512; u += G) { if (rep + 1 < REPS(15)) retC_unit<(PROBE_VAR < 16 ? PROBE_VAR : 0)>(lds, PROJ1, XN2, 1024, COS, SIN, SB, u, tid, lane, wave); else retC_unit<0>(lds, PROJ1, PROJ1 + C1_RG, NPROJ1, COS, SIN, SB, u, tid, lane, wave); }
        if (fuse) { __syncthreads(); const Seg so[1] = { {args.in[I_OWOUT], 1024, 0, 1024, 1536, WOUT1, 0} }; convert_set<1>(so, lds, gw, NGW, wave, lane); } }
    SEAM(15);
    if (IN(16)) {
        pg8::Gemm g{PROJ1, WOUT1, MTOK, DM, 1536, NPROJ1}; pg8::StaticOrder S; S.init(MTOK, DM, G, bx);
        if (fuse) { pg8::EpiNorm<2, 3, true, 1> EN{XB, XB, XN2, MOD, ng, {XCH + 4 * (MTOK * 4), TMO}, {XCH + 5 * (MTOK * 4), TMO}, EPS};
            pg8::gemm_phase<pg8::EpiNorm<2, 3, true, 1>, pg8::StaticOrder, true, true>(lds, g, S, EN); } else {
        pg8::EpiBf16<0> E{SB, DM, nullptr, 0, 0, 1.f};
        if ((PROBE_G >> 16) & 1u) { pg8::gemm_phase<pg8::EpiBf16<0>, pg8::StaticOrder, true, true>(lds, g, S, E); __syncthreads(); } pg8::gemm_phase<pg8::EpiBf16<0>, pg8::StaticOrder, true, true>(lds, g, S, E); }
    }
    if (!fuse) SEAM(16); else __syncthreads();
    if (IN(17)) {
        const Seg segs[2] = { {args.in[I_W1] + (size_t)DM * FF, 4096, 0, 4096, 1024, W1T, 0}, {args.in[I_W2] + (size_t)DM * FF, 1024, 0, 1024, 4096, W2T, 0} };
        if (fuse) { const Seg s1[1] = { segs[0] }; convert_set<1>(s1, lds, gw, NGW, wave, lane); }
        else { convert_set<2>(segs, lds, gw, NGW, wave, lane); if (PROBE_CV) convert_set<2>(segs, lds, gw, NGW, wave, lane); }
        if (!fuse) norm_rows<2, 3, true, 1>(XB, SB, XB, XN2, MOD, ng, gw, NGW, lane);
    }
    SEAM(17);
    if (IN(18)) {
        pg8::Gemm g{XN2, W1T, MTOK, FF, DM, DM}; pg8::StaticOrder S; S.init(MTOK, FF, G, bx);
        pg8::EpiBf16<2> E{HB, FF, nullptr, 0, 0, 1.f};
        if ((PROBE_G >> 18) & 1u) { pg8::gemm_phase<pg8::EpiBf16<2>, pg8::StaticOrder, true, true>(lds, g, S, E); __syncthreads(); } pg8::gemm_phase<pg8::EpiBf16<2>, pg8::StaticOrder, true, true>(lds, g, S, E);
        if (fuse) { __syncthreads(); const Seg s2[1] = { {args.in[I_W2] + (size_t)DM * FF, 1024, 0, 1024, 4096, W2T, 0} }; convert_set<1>(s2, lds, gw, NGW, wave, lane); }
    }
    SEAM(18);
    if (IN(19)) {
        pg8::Gemm g{HB, W2T, MTOK, DM, FF, FF}; pg8::StaticOrder S; S.init(MTOK, DM, G, bx);
        if (fuse) { pg8::EpiNorm<3, -1, true, 2> EN{XB, X, nullptr, MOD, ng, {XCH + 6 * (MTOK * 4), TMO}, {XCH + 7 * (MTOK * 4), TMO}, EPS};
            pg8::gemm_phase<pg8::EpiNorm<3, -1, true, 2>, pg8::StaticOrder, true, true>(lds, g, S, EN); } else {
        pg8::EpiBf16<0> E{SB, DM, nullptr, 0, 0, 1.f};
        if ((PROBE_G >> 19) & 1u) { pg8::gemm_phase<pg8::EpiBf16<0>, pg8::StaticOrder, true, true>(lds, g, S, E); __syncthreads(); } pg8::gemm_phase<pg8::EpiBf16<0>, pg8::StaticOrder, true, true>(lds, g, S, E); }
    }
    if (!fuse) {
    SEAM(19);
    if (IN(20)) norm_rows<3, -1, true, 2>(XB, SB, X, nullptr, MOD, ng, gw, NGW, lane);
    }
#undef IN
#undef SEAM
}

extern "C" void kernel_launch(void* const* d_in, const int* in_sizes, int n_in, void* d_out, int out_size, void* d_ws, size_t ws_size, hipStream_t stream) {
    static int grid = 0; static bool fused = false;
    if (grid == 0) {
        if (n_in != N_IN || out_size != MTOK * DM || ws_size < WS_END) { fprintf(stderr, "kernel_launch: unexpected shapes (n_in %d, out %d, ws %zu); nothing launched\n", n_in, out_size, ws_size); grid = -1; return; }
        int dev = 0, cus = 0, per_cu = 0;
        if (hipGetDevice(&dev) != hipSuccess || hipDeviceGetAttribute(&cus, hipDeviceAttributeMultiprocessorCount, dev) != hipSuccess) { grid = -1; return; }
        fused = (cus == 256);
        const void* kfn = fused ? (const void*)trunk_fwd<true> : (const void*)trunk_fwd<false>;
        if (hipFuncSetAttribute(kfn, hipFuncAttributeMaxDynamicSharedMemorySize, LDS_BYTES) != hipSuccess) { fprintf(stderr, "kernel_launch: hipFuncSetAttribute failed\n"); grid = -1; return; }
        if (hipOccupancyMaxActiveBlocksPerMultiprocessor(&per_cu, kfn, NTHR, LDS_BYTES) != hipSuccess || per_cu < 1) { fprintf(stderr, "kernel_launch: occupancy query says %d blocks per CU\n", per_cu); (void)hipGetLastError(); grid = -1; return; }
        grid = cus;
    }
    if (grid < 0) return;
    (void)hipMemsetAsync((char*)d_ws + WS_CTL, 0, CTL_ZERO_BYTES, stream);
    Args a{};
    for (int i = 0; i < N_IN; ++i) a.in[i] = (const float*)d_in[i];
    a.out = (float*)d_out; a.ws = (unsigned char*)d_ws;
#if MK_PER_PHASE
    for (int p = 0; p < N_PHASES; ++p) { a.ph_lo = p; a.ph_hi = p + 1; if (fused) hipLaunchKernelGGL(HIP_KERNEL_NAME(trunk_fwd<true>), dim3(grid), dim3(NTHR), LDS_BYTES, stream, a); else hipLaunchKernelGGL(HIP_KERNEL_NAME(trunk_fwd<false>), dim3(grid), dim3(NTHR), LDS_BYTES, stream, a); }
#else
    a.ph_lo = 0; a.ph_hi = N_PHASES;
    if (fused) hipLaunchKernelGGL(HIP_KERNEL_NAME(trunk_fwd<true>), dim3(grid), dim3(NTHR), LDS_BYTES, stream, a); else hipLaunchKernelGGL(HIP_KERNEL_NAME(trunk_fwd<false>), dim3(grid), dim3(NTHR), LDS_BYTES, stream, a);
#endif
}
```
